# Optimizing an MI355X kernel written in HIP

```python
import jax, jax.numpy as jnp
from jax import lax
import numpy as np

D_MODEL = 1024
BATCH = 8
SEQ = 2048
DEPTH = 4

N_MEM = 256
RMS_EPS = 1e-6
N_SUBNORMS = 6

ML_HEADS = 4
ML_QK_DIM = D_MODEL // 2 // ML_HEADS
ML_V_DIM = D_MODEL // ML_HEADS
ML_CHUNK = 64
ML_GATE_CAP = 15.0
ML_IN_WIDTH = 2 * ML_HEADS * ML_QK_DIM + 2 * D_MODEL + 2 * ML_HEADS

SB_HEADS = 16
SB_HEAD_DIM = D_MODEL // SB_HEADS
SB_BLOCK = 128

XA_HEADS = 4
XA_HEAD_DIM = D_MODEL // XA_HEADS

D_FF = -(-8 * D_MODEL // (3 * 256)) * 256

N_ML_LAYERS = (DEPTH + 1) // 2
N_SB_LAYERS = DEPTH // 2

kernel_name = "hybrid_mlstm_stickbreak_memxattn_trunk"


def rms_norm(x, gain):
    x32 = x.astype(jnp.float32)
    y = x32 * lax.rsqrt(jnp.mean(x32 * x32, axis=-1, keepdims=True) + RMS_EPS)
    return (y * gain.astype(jnp.float32)).astype(x.dtype)


def mlstm_mixer(h, w_in, b_gate, head_gain, w_out):
    B, S, _ = h.shape
    H, dk, dv, L = ML_HEADS, ML_QK_DIM, ML_V_DIM, ML_CHUNK
    nc = S // L
    qk = H * dk
    proj = h @ w_in
    q, k, v, o, gates = jnp.split(proj, [qk, 2 * qk, 2 * qk + D_MODEL, 2 * qk + 2 * D_MODEL], axis=-1)
    gates = gates.astype(jnp.float32) + b_gate.astype(jnp.float32)
    gates = ML_GATE_CAP * jnp.tanh(gates / ML_GATE_CAP)
    ig = gates[..., :H]
    lf = jax.nn.log_sigmoid(gates[..., H:])

    def to_chunks(t, d):
        return t.astype(jnp.float32).reshape(B, nc, L, H, d).transpose(1, 0, 3, 2, 4)

    def gate_chunks(t):
        return t.reshape(B, nc, L, H).transpose(1, 0, 3, 2)

    qc = to_chunks(q, dk)
    kc = to_chunks(k, dk) * (dk ** -0.5)
    vc = to_chunks(v, dv)
    igc, lfc = gate_chunks(ig), gate_chunks(lf)
    causal = jnp.tril(jnp.ones((L, L), dtype=bool))

    def step(carry, inp):
        C, n, m = carry
        qb, kb, vb, igb, lfb = inp
        b = jnp.cumsum(lfb, axis=-1)
        log_d = jnp.where(causal, b[..., :, None] - b[..., None, :] + igb[..., None, :], -jnp.inf)
        m_inter = b + m[..., None]
        m_t = jnp.maximum(jnp.max(log_d, axis=-1), m_inter)
        d = jnp.exp(log_d - m_t[..., None])
        s = jnp.einsum('bhtd,bhsd->bhts', qb, kb) * d
        inter = jnp.exp(m_inter - m_t)
        num = jnp.einsum('bhts,bhsv->bhtv', s, vb) + inter[..., None] * jnp.einsum('bhvd,bhtd->bhtv', C, qb)
        den = jnp.sum(s, axis=-1) + inter * jnp.einsum('bhd,bhtd->bht', n, qb)
        h_out = num / jnp.maximum(jnp.abs(den), jnp.exp(-m_t))[..., None]
        b_last = b[..., -1]
        g = b_last[..., None] - b + igb
        m_new = jnp.maximum(b_last + m, jnp.max(g, axis=-1))
        w = jnp.exp(g - m_new[..., None])
        decay = jnp.exp(b_last + m - m_new)
        C = decay[..., None, None] * C + jnp.einsum('bhs,bhsv,bhsd->bhvd', w, vb, kb)
        n = decay[..., None] * n + jnp.einsum('bhs,bhsd->bhd', w, kb)
        return (C, n, m_new), h_out

    init = (jnp.zeros((B, H, dv, dk), jnp.float32),
            jnp.zeros((B, H, dk), jnp.float32),
            jnp.zeros((B, H), jnp.float32))
    _, hs = lax.scan(step, init, (qc, kc, vc, igc, lfc))
    hs = hs.transpose(1, 0, 3, 2, 4).reshape(B, S, H, dv)
    hs = rms_norm(hs, head_gain.reshape(H, dv))
    og = jax.nn.sigmoid(o.astype(jnp.float32)).reshape(B, S, H, dv)
    out = (hs * og).reshape(B, S, D_MODEL).astype(h.dtype)
    return out @ w_out


def stick_breaking_mixer(h, w_qkv, w_out):
    B, S, _ = h.shape
    H, dh = SB_HEADS, SB_HEAD_DIM
    qkv = (h @ w_qkv).reshape(B, S, 3, H, dh).astype(jnp.float32)
    q = qkv[:, :, 0].transpose(0, 2, 1, 3)
    k = qkv[:, :, 1].transpose(0, 2, 1, 3)
    v = qkv[:, :, 2].transpose(0, 2, 1, 3)
    scale = dh ** -0.5
    outs = []
    for blk in range(S // SB_BLOCK):
        q0 = blk * SB_BLOCK
        kend = q0 + SB_BLOCK
        qb = q[:, :, q0:kend]
        kb = k[:, :, :kend]
        vb = v[:, :, :kend]
        z = jnp.einsum('bhtd,bhsd->bhts', qb, kb) * scale
        t_idx = q0 + jnp.arange(SB_BLOCK)[:, None]
        s_idx = jnp.arange(kend)[None, :]
        strict = s_idx < t_idx
        log_1m = jnp.where(strict, jax.nn.log_sigmoid(-z), 0.0)
        suffix = lax.cumsum(log_1m, axis=3, reverse=True) - log_1m
        a = jnp.where(strict, jnp.exp(jax.nn.log_sigmoid(z) + suffix), 0.0)
        outs.append(jnp.einsum('bhts,bhsd->bhtd', a, vb))
    o = jnp.concatenate(outs, axis=2)
    o = o.transpose(0, 2, 1, 3).reshape(B, S, D_MODEL).astype(h.dtype)
    return o @ w_out


def memory_cross_attention(h, mem_n, w_q, w_kv, w_o):
    B, S, _ = h.shape
    q = (h @ w_q).reshape(B, S, XA_HEADS, XA_HEAD_DIM)
    kv = (mem_n @ w_kv).reshape(B, mem_n.shape[1], 2, XA_HEADS, XA_HEAD_DIM)
    k, v = kv[:, :, 0], kv[:, :, 1]
    s = jnp.einsum('bthd,bmhd->bhtm', q, k).astype(jnp.float32) * (XA_HEAD_DIM ** -0.5)
    p = jax.nn.softmax(s, axis=-1).astype(v.dtype)
    o = jnp.einsum('bhtm,bmhd->bthd', p, v).reshape(B, S, D_MODEL)
    return o @ w_o


def swiglu_ffn(h, w_gate_up, w_down):
    gate, up = jnp.split(h @ w_gate_up, 2, axis=-1)
    return (jax.nn.silu(gate) * up) @ w_down


def setup_inputs(seed: int = 0) -> dict:
    key = jax.random.key(seed)
    ks = jax.random.split(key, 16)

    def w(k, shape, fan_in):
        return jax.random.normal(k, shape, jnp.float32) * (fan_in ** -0.5)

    x = jax.random.normal(ks[0], (BATCH, SEQ, D_MODEL), jnp.float32)
    mem = jax.random.normal(ks[1], (BATCH, N_MEM, D_MODEL), jnp.float32)
    mem_norm_gain = 1.0 + 0.02 * jax.random.normal(ks[2], (D_MODEL,), jnp.float32)
    norm_gains = 1.0 + 0.02 * jax.random.normal(ks[3], (DEPTH, N_SUBNORMS, D_MODEL), jnp.float32)
    ml_w_in = w(ks[4], (N_ML_LAYERS, D_MODEL, ML_IN_WIDTH), D_MODEL)
    kb1, kb2 = jax.random.split(ks[5])
    b_in = 0.01 * jax.random.normal(kb1, (N_ML_LAYERS, ML_HEADS), jnp.float32)
    b_f = jnp.linspace(3.0, 6.0, ML_HEADS)[None, :] + 0.01 * jax.random.normal(kb2, (N_ML_LAYERS, ML_HEADS), jnp.float32)
    ml_b_gate = jnp.concatenate([b_in, b_f], axis=-1)
    ml_head_gain = 1.0 + 0.02 * jax.random.normal(ks[6], (N_ML_LAYERS, D_MODEL), jnp.float32)
    ml_w_out = w(ks[7], (N_ML_LAYERS, D_MODEL, D_MODEL), D_MODEL)
    sb_w_qkv = w(ks[8], (N_SB_LAYERS, D_MODEL, 3 * D_MODEL), D_MODEL)
    sb_w_out = w(ks[9], (N_SB_LAYERS, D_MODEL, D_MODEL), D_MODEL)
    xa_w_q = w(ks[10], (DEPTH, D_MODEL, D_MODEL), D_MODEL)
    xa_w_kv = w(ks[11], (DEPTH, D_MODEL, 2 * D_MODEL), D_MODEL)
    xa_w_o = w(ks[12], (DEPTH, D_MODEL, D_MODEL), D_MODEL)
    ffn_w_gate_up = w(ks[13], (DEPTH, D_MODEL, 2 * D_FF), D_MODEL)
    ffn_w_down = w(ks[14], (DEPTH, D_FF, D_MODEL), D_FF)
    return {"x": x, "mem": mem, "mem_norm_gain": mem_norm_gain, "norm_gains": norm_gains,
            "ml_w_in": ml_w_in, "ml_b_gate": ml_b_gate, "ml_head_gain": ml_head_gain, "ml_w_out": ml_w_out,
            "sb_w_qkv": sb_w_qkv, "sb_w_out": sb_w_out,
            "xa_w_q": xa_w_q, "xa_w_kv": xa_w_kv, "xa_w_o": xa_w_o,
            "ffn_w_gate_up": ffn_w_gate_up, "ffn_w_down": ffn_w_down}


def reference(x, mem, mem_norm_gain, norm_gains, ml_w_in, ml_b_gate, ml_head_gain, ml_w_out,
              sb_w_qkv, sb_w_out, xa_w_q, xa_w_kv, xa_w_o, ffn_w_gate_up, ffn_w_down):
    mem_n = rms_norm(mem, mem_norm_gain)
    for layer in range(DEPTH):
        g = norm_gains[layer]
        j = layer // 2
        hn = rms_norm(x, g[0])
        if layer % 2 == 0:
            y = mlstm_mixer(hn, ml_w_in[j], ml_b_gate[j], ml_head_gain[j], ml_w_out[j])
        else:
            y = stick_breaking_mixer(hn, sb_w_qkv[j], sb_w_out[j])
        x = x + rms_norm(y, g[1])
        y = memory_cross_attention(rms_norm(x, g[2]), mem_n, xa_w_q[layer], xa_w_kv[layer], xa_w_o[layer])
        x = x + rms_norm(y, g[3])
        y = swiglu_ffn(rms_norm(x, g[4]), ffn_w_gate_up[layer], ffn_w_down[layer])
        x = x + rms_norm(y, g[5])
    return x
```

```cpp
#include <hip/hip_runtime.h>
#include <cstdio>
#include <cstdint>

constexpr int D = 1024, BATCH = 8, SEQ = 2048, DEPTH = 4, NMEM = 256;
constexpr int M = BATCH * SEQ;
constexpr int MM = BATCH * NMEM;
constexpr int ML_H = 4, ML_DK = 128, ML_DV = 256, ML_W = 3080;
constexpr int SB_H = 16, SB_DH = 64;
constexpr int XA_H = 4, XA_DH = 256;
constexpr int DFF = 2816;
constexpr float EPS = 1e-6f;

__device__ __forceinline__ float wave_sum(float v) {
#pragma unroll
    for (int o = 1; o < 64; o <<= 1) v += __shfl_xor(v, o);
    return v;
}
__device__ __forceinline__ float wave_max(float v) {
#pragma unroll
    for (int o = 1; o < 64; o <<= 1) v = fmaxf(v, __shfl_xor(v, o));
    return v;
}
__device__ __forceinline__ float softplusf(float z) { return fmaxf(z, 0.f) + log1pf(expf(-fabsf(z))); }

__global__ void k_rmsnorm(const float* in, const float* g, const float* res, float* out, int rows, int width) {
    const int lane = threadIdx.x & 63, w = (blockIdx.x * blockDim.x + threadIdx.x) >> 6;
    if (w >= rows) return;
    const float* r = in + (size_t)w * width;
    float s = 0.f;
    for (int i = lane; i < width; i += 64) s += r[i] * r[i];
    s = wave_sum(s);
    const float rs = rsqrtf(s / width + EPS);
    for (int i = lane; i < width; i += 64) {
        float v = r[i] * rs * g[i];
        if (res) v += res[(size_t)w * width + i];
        out[(size_t)w * width + i] = v;
    }
}

__global__ void __launch_bounds__(256) k_gemm(const float* A, int lda, const float* B, int ldb, float* C, int ldc, int Mr, int N, int K) {
    __shared__ float As[16][64 + 4];
    __shared__ float Bs[16][64 + 4];
    const int tx = threadIdx.x & 15, ty = threadIdx.x >> 4;
    const int m0 = blockIdx.y * 64, n0 = blockIdx.x * 64;
    float acc[4][4] = {};
    for (int k0 = 0; k0 < K; k0 += 16) {
        for (int i = threadIdx.x; i < 64 * 16; i += 256) {
            const int r = i >> 4, c = i & 15;
            As[c][r] = (m0 + r < Mr) ? A[(size_t)(m0 + r) * lda + k0 + c] : 0.f;
        }
        for (int i = threadIdx.x; i < 16 * 64; i += 256) {
            const int r = i >> 6, c = i & 63;
            Bs[r][c] = (n0 + c < N) ? B[(size_t)(k0 + r) * ldb + n0 + c] : 0.f;
        }
        __syncthreads();
#pragma unroll
        for (int kk = 0; kk < 16; ++kk) {
            float a[4], b[4];
#pragma unroll
            for (int i = 0; i < 4; ++i) { a[i] = As[kk][ty * 4 + i]; b[i] = Bs[kk][tx * 4 + i]; }
#pragma unroll
            for (int i = 0; i < 4; ++i)
#pragma unroll
                for (int j = 0; j < 4; ++j) acc[i][j] += a[i] * b[j];
        }
        __syncthreads();
    }
#pragma unroll
    for (int i = 0; i < 4; ++i)
#pragma unroll
        for (int j = 0; j < 4; ++j) {
            const int r = m0 + ty * 4 + i, c = n0 + tx * 4 + j;
            if (r < Mr && c < N) C[(size_t)r * ldc + c] = acc[i][j];
        }
}

__global__ void __launch_bounds__(256) k_mlstm(const float* proj, const float* bgate, const float* hgain, float* hs  ) {
    const int bh = blockIdx.x, b = bh / ML_H, h = bh % ML_H, v0 = blockIdx.y * 32;
    const int tid = threadIdx.x, vi = tid >> 3, kq = tid & 7;
    float C[16], n[16];
#pragma unroll
    for (int i = 0; i < 16; ++i) { C[i] = 0.f; n[i] = 0.f; }
    float m = 0.f;
    const float bi = bgate[h], bf = bgate[ML_H + h];
    for (int t = 0; t < SEQ; ++t) {
        const float* p = proj + (size_t)(b * SEQ + t) * ML_W;
        float gi = p[3072 + h] + bi, gf = p[3072 + ML_H + h] + bf;
        gi = 15.f * tanhf(gi / 15.f); gf = 15.f * tanhf(gf / 15.f);
        const float lf = -softplusf(-gf);
        const float mn = fmaxf(lf + m, gi);
        const float dec = expf(lf + m - mn), wi = expf(gi - mn);
        m = mn;
        const float vv = p[1024 + h * ML_DV + v0 + vi];
        float num = 0.f, den = 0.f;
#pragma unroll
        for (int i = 0; i < 16; ++i) {
            const int d = kq * 16 + i;
            const float kk = p[512 + h * ML_DK + d] * 0.08838834764831845f, qq = p[h * ML_DK + d];
            C[i] = dec * C[i] + wi * vv * kk;
            n[i] = dec * n[i] + wi * kk;
            num += C[i] * qq; den += n[i] * qq;
        }
        num += __shfl_xor(num, 1); num += __shfl_xor(num, 2); num += __shfl_xor(num, 4);
        den += __shfl_xor(den, 1); den += __shfl_xor(den, 2); den += __shfl_xor(den, 4);
        if (kq == 0) hs[(size_t)(b * SEQ + t) * D + h * ML_DV + v0 + vi] = num / fmaxf(fabsf(den), expf(-mn));
    }
}
__global__ void k_mlstm_post(const float* hs, const float* proj, const float* hgain, float* out) {
    const int lane = threadIdx.x & 63, w = (blockIdx.x * blockDim.x + threadIdx.x) >> 6;
    if (w >= M * ML_H) return;
    const int tok = w / ML_H, h = w % ML_H;
    const float* r = hs + (size_t)tok * D + h * ML_DV;
    float v[4], s = 0.f;
#pragma unroll
    for (int j = 0; j < 4; ++j) { v[j] = r[lane + 64 * j]; s += v[j] * v[j]; }
    s = wave_sum(s);
    const float rs = rsqrtf(s / ML_DV + EPS);
#pragma unroll
    for (int j = 0; j < 4; ++j) {
        const int c = h * ML_DV + lane + 64 * j;
        const float o = proj[(size_t)tok * ML_W + 2048 + c];
        out[(size_t)tok * D + c] = v[j] * rs * hgain[c] * (1.f / (1.f + expf(-o)));
    }
}

__global__ void __launch_bounds__(64) k_sb(const float* qkv, float* out) {
    const int lane = threadIdx.x, tb = blockIdx.x, h = blockIdx.y, b = blockIdx.z;
    const int t = tb * 64 + lane;
    float q[64], o[64];
    const float* qp = qkv + (size_t)(b * SEQ + t) * 3072 + h * 64;
#pragma unroll
    for (int d = 0; d < 64; ++d) { q[d] = qp[d] * 0.125f; o[d] = 0.f; }
    float run = 0.f;
    const int smax = tb * 64 + 63;
    for (int s = smax - 1; s >= 0; --s) {
        const float* kp = qkv + (size_t)(b * SEQ + s) * 3072 + 1024 + h * 64;
        const float* vp = kp + 1024;
        float z = 0.f;
#pragma unroll
        for (int d = 0; d < 64; ++d) z += q[d] * kp[d];
        if (s < t) {
            const float sp = softplusf(z);
            const float a = expf(z - sp + run);
            run -= sp;
#pragma unroll
            for (int d = 0; d < 64; ++d) o[d] += a * vp[d];
        }
    }
    float* op = out + (size_t)(b * SEQ + t) * D + h * 64;
#pragma unroll
    for (int d = 0; d < 64; ++d) op[d] = o[d];
}

__global__ void __launch_bounds__(256) k_xattn(const float* q, const float* kv, float* out) {
    __shared__ float qs[4][256];
    __shared__ float ps[4][256];
    const int lane = threadIdx.x & 63, wv = threadIdx.x >> 6, w = blockIdx.x * 4 + wv;
    const int tok = w / XA_H, h = w % XA_H, b = tok / SEQ;
    const float* qp = q + (size_t)tok * D + h * XA_DH;
#pragma unroll
    for (int j = 0; j < 4; ++j) qs[wv][lane + 64 * j] = qp[lane + 64 * j];
    __syncthreads();
    float sc[4], mx = -INFINITY;
#pragma unroll
    for (int j = 0; j < 4; ++j) {
        const int mi = lane + 64 * j;
        const float* kp = kv + (size_t)(b * NMEM + mi) * 2048 + h * XA_DH;
        float s = 0.f;
        for (int d = 0; d < 256; d += 4) { const float4 k4 = *(const float4*)(kp + d); s += qs[wv][d] * k4.x + qs[wv][d + 1] * k4.y + qs[wv][d + 2] * k4.z + qs[wv][d + 3] * k4.w; }
        sc[j] = s * 0.0625f; mx = fmaxf(mx, sc[j]);
    }
    mx = wave_max(mx);
    float sum = 0.f;
#pragma unroll
    for (int j = 0; j < 4; ++j) { sc[j] = expf(sc[j] - mx); sum += sc[j]; }
    sum = wave_sum(sum);
#pragma unroll
    for (int j = 0; j < 4; ++j) ps[wv][lane + 64 * j] = sc[j] / sum;
    __syncthreads();
    float o[4] = {0.f, 0.f, 0.f, 0.f};
    for (int mi = 0; mi < NMEM; ++mi) {
        const float p = ps[wv][mi];
        const float* vp = kv + (size_t)(b * NMEM + mi) * 2048 + 1024 + h * XA_DH;
#pragma unroll
        for (int j = 0; j < 4; ++j) o[j] += p * vp[lane + 64 * j];
    }
#pragma unroll
    for (int j = 0; j < 4; ++j) out[(size_t)tok * D + h * XA_DH + lane + 64 * j] = o[j];
}

__global__ void k_swiglu(const float* gu, float* hout, int rows) {
    const size_t i = (size_t)blockIdx.x * blockDim.x + threadIdx.x;
    if (i >= (size_t)rows * DFF) return;
    const size_t r = i / DFF, c = i % DFF;
    const float g = gu[r * 2 * DFF + c], u = gu[r * 2 * DFF + DFF + c];
    hout[i] = g / (1.f + expf(-g)) * u;
}

static void gemm(hipStream_t st, const float* A, int lda, const float* B, int ldb, float* C, int ldc, int Mr, int N, int K) {
    dim3 grid((N + 63) / 64, (Mr + 63) / 64);
    hipLaunchKernelGGL(k_gemm, grid, dim3(256), 0, st, A, lda, B, ldb, C, ldc, Mr, N, K);
}
static void rmsnorm(hipStream_t st, const float* in, const float* g, const float* res, float* out, int rows, int width) {
    hipLaunchKernelGGL(k_rmsnorm, dim3((rows + 3) / 4), dim3(256), 0, st, in, g, res, out, rows, width);
}

extern "C" void kernel_launch(void* const* d_in, const int* in_sizes, int n_in, void* d_out, int out_size, void* d_ws, size_t ws_size, hipStream_t stream) {
    const float* x_in = (const float*)d_in[0];
    const float* mem = (const float*)d_in[1];
    const float* mem_g = (const float*)d_in[2];
    const float* gains = (const float*)d_in[3];
    const float* ml_w_in = (const float*)d_in[4];
    const float* ml_b = (const float*)d_in[5];
    const float* ml_hg = (const float*)d_in[6];
    const float* ml_w_out = (const float*)d_in[7];
    const float* sb_w_qkv = (const float*)d_in[8];
    const float* sb_w_out = (const float*)d_in[9];
    const float* xa_w_q = (const float*)d_in[10];
    const float* xa_w_kv = (const float*)d_in[11];
    const float* xa_w_o = (const float*)d_in[12];
    const float* ffn_gu = (const float*)d_in[13];
    const float* ffn_dn = (const float*)d_in[14];
    float* x = (float*)d_out;
    float* ws = (float*)d_ws;
    size_t off = 0;
    float* memn = ws + off; off += (size_t)MM * D;
    float* kv = ws + off; off += (size_t)MM * 2048;
    float* hn = ws + off; off += (size_t)M * D;
    float* big = ws + off; off += (size_t)M * ML_W;
    float* t1 = ws + off; off += (size_t)M * D;
    if (off * 4 > ws_size) { fprintf(stderr, "ws too small: need %zu have %zu\n", off * 4, ws_size); return; }

    hipMemcpyAsync(x, x_in, (size_t)M * D * 4, hipMemcpyDeviceToDevice, stream);
    rmsnorm(stream, mem, mem_g, nullptr, memn, MM, D);
    for (int l = 0; l < DEPTH; ++l) {
        const float* g = gains + (size_t)l * 6 * D;
        const int j = l / 2;
        float* y = hn;
        rmsnorm(stream, x, g, nullptr, hn, M, D);
        if (l % 2 == 0) {
            gemm(stream, hn, D, ml_w_in + (size_t)j * D * ML_W, ML_W, big, ML_W, M, ML_W, D);
            hipLaunchKernelGGL(k_mlstm, dim3(BATCH * ML_H, ML_DV / 32), dim3(256), 0, stream, big, ml_b + j * 8, ml_hg + j * D, t1);
            hipLaunchKernelGGL(k_mlstm_post, dim3(M * ML_H / 4), dim3(256), 0, stream, t1, big, ml_hg + j * D, t1);
            gemm(stream, t1, D, ml_w_out + (size_t)j * D * D, D, y, D, M, D, D);
        } else {
            gemm(stream, hn, D, sb_w_qkv + (size_t)j * D * 3072, 3072, big, 3072, M, 3072, D);
            hipLaunchKernelGGL(k_sb, dim3(SEQ / 64, SB_H, BATCH), dim3(64), 0, stream, big, t1);
            gemm(stream, t1, D, sb_w_out + (size_t)j * D * D, D, y, D, M, D, D);
        }
        rmsnorm(stream, y, g + D, x, x, M, D);
        rmsnorm(stream, x, g + 2 * D, nullptr, hn, M, D);
        gemm(stream, hn, D, xa_w_q + (size_t)l * D * D, D, t1, D, M, D, D);
        gemm(stream, memn, D, xa_w_kv + (size_t)l * D * 2048, 2048, kv, 2048, MM, 2048, D);
        hipLaunchKernelGGL(k_xattn, dim3(M * XA_H / 4), dim3(256), 0, stream, t1, kv, big);
        gemm(stream, big, D, xa_w_o + (size_t)l * D * D, D, y, D, M, D, D);
        rmsnorm(stream, y, g + 3 * D, x, x, M, D);
        rmsnorm(stream, x, g + 4 * D, nullptr, hn, M, D);
        constexpr int TC = M / 4;
        float* gu = big; float* hff = big + (size_t)TC * 2 * DFF;
        for (int c = 0; c < 4; ++c) {
            gemm(stream, hn + (size_t)c * TC * D, D, ffn_gu + (size_t)l * D * 2 * DFF, 2 * DFF, gu, 2 * DFF, TC, 2 * DFF, D);
            hipLaunchKernelGGL(k_swiglu, dim3((unsigned)(((size_t)TC * DFF + 255) / 256)), dim3(256), 0, stream, gu, hff, TC);
            gemm(stream, hff, DFF, ffn_dn + (size_t)l * DFF * D, D, t1 + (size_t)c * TC * D, D, TC, D, DFF);
        }
        rmsnorm(stream, t1, g + 5 * D, x, x, M, D);
    }
}
```

```cpp
#include <hip/hip_runtime.h>
#include <cstdio>
#include <cstdint>
namespace pg8 {
#define PG8_LAS __attribute__((address_space(3)))
typedef unsigned short bf16_t;
typedef short bf16x8 __attribute__((ext_vector_type(8)));
typedef float f32x4 __attribute__((ext_vector_type(4)));
typedef unsigned u32x4 __attribute__((ext_vector_type(4)));
constexpr int BM = 256, BK = 64, HALF = 128, HTB = HALF * BK * 2  , STAGE_BYTES = 8 * HTB, NXCD = 8, WGM = 8;

__host__ __device__ __forceinline__ int lds_byte(int r, int c) { const int st = (r >> 4) * 2 + (c >> 5), rr = r & 15, cc = c & 31, ob = rr * 64 + cc * 2; return st * 1024 + (ob ^ (((ob >> 9) & 1) << 5)); }
__host__ __device__ __forceinline__ void stage_rc(int b, int& R, int& C) { const int st = b / 1024, sb = b % 1024, swz = sb ^ (((sb >> 9) & 1) << 5); R = (st >> 1) * 16 + swz / 64; C = (st & 1) * 32 + (swz % 64) / 2; }
__host__ __device__ __forceinline__ int perm32(int rho) { const int n = rho >> 4, i = rho & 15; return 8 * (i >> 2) + 4 * n + (i & 3); }

struct Unit { int pm, pn; };
struct Gemm { const bf16_t* A; const bf16_t* Bt; int M, N, K; };

struct StaticOrder {
    int nM, nN, nwg, G, c;
    __host__ __device__ void init(int M, int N, int G_, int c_) { nM = M / BM; nN = N / BM; nwg = nM * nN; G = G_; c = c_; }
    __host__ __device__ bool next(int i, Unit& u) const {
        const long L = (long)i * G + c; if (L >= nwg) return false;
        int wgid = (int)L; { const int q = nwg / NXCD, r = nwg % NXCD, xcd = wgid % NXCD, off = wgid / NXCD; wgid = (xcd < r ? xcd * (q + 1) : r * (q + 1) + (xcd - r) * q) + off; }
        const int nig = WGM * nN, gid = wgid / nig, fm = gid * WGM, gsz = (nM - fm) < WGM ? (nM - fm) : WGM;
        u.pm = fm + ((wgid % nig) % gsz); u.pn = (wgid % nig) / gsz; return true;
    }
    __device__ __forceinline__ void a_ready(const Unit&) const {}
    __device__ __forceinline__ void done(const Unit&) const {}
};

__device__ __forceinline__ unsigned cvt_pk_bf16(float lo, float hi) { unsigned r; asm volatile("v_cvt_pk_bf16_f32 %0, %1, %2" : "=v"(r) : "v"(lo), "v"(hi)); return r; }
typedef float f32x2 __attribute__((ext_vector_type(2)));
__device__ __forceinline__ f32x2 gelu_pk(f32x2 v) {
    const f32x2 av = __builtin_elementwise_abs(v), d = av * 0.2316418882f + 1.0f;
    f32x2 t; t.x = __builtin_amdgcn_rcpf(d.x); t.y = __builtin_amdgcn_rcpf(d.y);
    f32x2 q = t * 0.5307027145f + (-0.7265760135f); q = q * t + 0.7107068705f; q = q * t + (-0.142248368f); q = q * t + 0.127414796f; q = q * t;
    const f32x2 s = (v * v) * (-0.72134752044f);
    f32x2 e; e.x = __builtin_amdgcn_exp2f(s.x); e.y = __builtin_amdgcn_exp2f(s.y);
    const f32x2 m = v * (q * e), r = v - m;
    f32x2 o; o.x = v.x < 0.f ? m.x : r.x; o.y = v.y < 0.f ? m.y : r.y; return o;
}

template <int ACT  > struct EpiBf16 {
    static constexpr bool PERM = true, AFTER_DRAIN = false; static_assert(ACT == 0 || ACT == 1, "EpiBf16: ACT is 0 (none) or 1 (gelu_pk)");
    bf16_t* O; int ldc; const float* bias; int split_cols; size_t split_stride; float scale0;
    __device__ __forceinline__ void operator()(const f32x4 (&acc)[2][2][4][2], const Unit& u, int wr, int wc, int fr, int fq) const {
        const int row0 = u.pm * BM + wr * 64 + fr; int colt = u.pn * BM; bf16_t* base = O;
        float sc = 1.f; if (split_cols) { const int t = colt / split_cols; base += (size_t)t * split_stride; colt -= t * split_cols; if (t == 0) sc = scale0; }
        const int col0 = colt + wc * 32 + 8 * fq, bcol0 = u.pn * BM + wc * 32 + 8 * fq;
        f32x4 bv[2][2];
#pragma unroll
        for (int bj = 0; bj < 2; ++bj)
#pragma unroll
            for (int n = 0; n < 2; ++n) bv[bj][n] = bias ? *(const f32x4*)(bias + bcol0 + bj * HALF + 4 * n) : (f32x4){0.f, 0.f, 0.f, 0.f};
#pragma unroll
        for (int ai = 0; ai < 2; ++ai)
#pragma unroll
            for (int m = 0; m < 4; ++m) { bf16_t* rowp = base + (size_t)(row0 + ai * HALF + m * 16) * ldc + col0;
#pragma unroll
                for (int bj = 0; bj < 2; ++bj) { f32x4 v0 = acc[ai][bj][m][0] + bv[bj][0], v1 = acc[ai][bj][m][1] + bv[bj][1];
                    if (ACT == 1) { f32x2 a = gelu_pk((f32x2){v0[0], v0[1]}), b = gelu_pk((f32x2){v0[2], v0[3]}), c = gelu_pk((f32x2){v1[0], v1[1]}), d = gelu_pk((f32x2){v1[2], v1[3]});
                        v0 = (f32x4){a.x, a.y, b.x, b.y}; v1 = (f32x4){c.x, c.y, d.x, d.y}; }
                    v0 = v0 * sc; v1 = v1 * sc; u32x4 w; w.x = cvt_pk_bf16(v0[0], v0[1]); w.y = cvt_pk_bf16(v0[2], v0[3]); w.z = cvt_pk_bf16(v1[0], v1[1]); w.w = cvt_pk_bf16(v1[2], v1[3]);
                    *(u32x4*)(rowp + bj * HALF) = w; } }
    }
};

struct PanelStats {
    unsigned* xbuf;
    unsigned* cnt;
    unsigned* tmo;
    int ntn; float eps;
    unsigned code;
    __device__ __forceinline__ bool run(const f32x4 (&v)[2][2][4][2], const Unit& u, int wr, int wc, int fr, int fq, PG8_LAS unsigned char* lds, int wid, int lane) const {
        typedef float f32x2v __attribute__((ext_vector_type(2)));
        PG8_LAS f32x2v* P = (PG8_LAS f32x2v*)lds;
        PG8_LAS f32x2v* S = (PG8_LAS f32x2v*)(lds + 8192);
        PG8_LAS unsigned* flag = (PG8_LAS unsigned*)(lds + 8192 + 2048);
#pragma unroll
        for (int ai = 0; ai < 2; ++ai)
#pragma unroll
            for (int m = 0; m < 4; ++m) {
                float s = 0.f;
#pragma unroll
                for (int bj = 0; bj < 2; ++bj)
#pragma unroll
                    for (int n = 0; n < 2; ++n) { const f32x4 x = v[ai][bj][m][n]; s += (x[0] + x[1]) + (x[2] + x[3]); }
                s += __shfl_xor(s, 16); s += __shfl_xor(s, 32);
                const float mw = s * (1.0f / 64.0f); float q = 0.f;
#pragma unroll
                for (int bj = 0; bj < 2; ++bj)
#pragma unroll
                    for (int n = 0; n < 2; ++n) { const f32x4 d = v[ai][bj][m][n] - mw; q += (d[0] * d[0] + d[1] * d[1]) + (d[2] * d[2] + d[3] * d[3]); }
                q += __shfl_xor(q, 16); q += __shfl_xor(q, 32);
                if (fq == 0) P[(ai * HALF + wr * 64 + m * 16 + fr) * 4 + wc] = (f32x2v){mw, q};
            }
        asm volatile("s_waitcnt lgkmcnt(0)" ::: "memory"); __builtin_amdgcn_s_barrier(); asm volatile("" ::: "memory");
#if defined(BROKEN_EXCHANGE_NO_WAIT)
#warning BROKEN CONTROL BUILD: the row-statistics exchange does not wait; results are wrong by design
        if (blockIdx.x >= 64) { const long long t0_ = clock64(); while (clock64() - t0_ < 60000) __builtin_amdgcn_s_sleep(8); }
#endif
        const int row = wid * 32 + (lane & 31);
        if (lane < 32) {
            const f32x2v a = P[row * 4 + 0], b = P[row * 4 + 1], c = P[row * 4 + 2], d = P[row * 4 + 3];
            const float mt = (a.x + b.x + c.x + d.x) * 0.25f;
            const float da = a.x - mt, db = b.x - mt, dc = c.x - mt, dd = d.x - mt;
            const float m2 = (a.y + b.y) + (c.y + d.y) + 64.0f * ((da * da + db * db) + (dc * dc + dd * dd));
            unsigned long long* slot = (unsigned long long*)xbuf + ((size_t)(u.pm * BM + row) * 4 + u.pn);
            __hip_atomic_store(slot, ((unsigned long long)__float_as_uint(m2) << 32) | __float_as_uint(mt), __ATOMIC_RELAXED, __HIP_MEMORY_SCOPE_AGENT);
        }
        asm volatile("s_waitcnt vmcnt(0)" ::: "memory");
        if (lane == 0) __hip_atomic_fetch_add(cnt + 64 * u.pm, 1u, __ATOMIC_RELAXED, __HIP_MEMORY_SCOPE_AGENT);
        if (wid == 0) {
            bool dead = false; const unsigned long long t0 = __builtin_amdgcn_s_memrealtime(); const unsigned want = 8u * (unsigned)ntn;
            for (;;) {
#if defined(BROKEN_EXCHANGE_NO_WAIT)
                break;
#endif
                if ((unsigned)__builtin_amdgcn_readfirstlane(__hip_atomic_load(cnt + 64 * u.pm, __ATOMIC_RELAXED, __HIP_MEMORY_SCOPE_AGENT)) >= want) break;
                if (__builtin_amdgcn_s_memrealtime() - t0 > 2000000ull) {
                    if (lane == 0) { unsigned expect = 0u; __hip_atomic_compare_exchange_strong(tmo + 1, &expect, code | (unsigned)(u.pm & 0xff), __ATOMIC_RELAXED, __ATOMIC_RELAXED, __HIP_MEMORY_SCOPE_AGENT);
                                     __hip_atomic_store(tmo, 1u, __ATOMIC_RELAXED, __HIP_MEMORY_SCOPE_AGENT); }
                    dead = true; break; }
                __builtin_amdgcn_s_sleep(2);
            }
            __builtin_amdgcn_fence(__ATOMIC_ACQUIRE, "agent");
            if (lane == 0) flag[0] = dead ? 1u : 0u;
        }
        asm volatile("s_waitcnt vmcnt(0) lgkmcnt(0)" ::: "memory"); __builtin_amdgcn_s_barrier(); asm volatile("" ::: "memory");
        const bool bad = flag[0] != 0u;
        if (lane < 32) {
            const unsigned long long* slot = (const unsigned long long*)xbuf + (size_t)(u.pm * BM + row) * 4; float mt[4], m2[4]; float ms = 0.f;
#pragma unroll
            for (int t = 0; t < 4; ++t) { if (t < ntn) { const unsigned long long w = __hip_atomic_load(slot + t, __ATOMIC_RELAXED, __HIP_MEMORY_SCOPE_AGENT); mt[t] = __uint_as_float((unsigned)w); m2[t] = __uint_as_float((unsigned)(w >> 32)); } else { mt[t] = 0.f; m2[t] = 0.f; } ms += mt[t]; }
            const float mean = ms / (float)ntn; float q = 0.f;
#pragma unroll
            for (int t = 0; t < 4; ++t) if (t < ntn) { const float dm = mt[t] - mean; q += m2[t] + 256.0f * dm * dm; }
            S[row] = (f32x2v){mean, 1.0f / sqrtf(q / (256.0f * (float)ntn) + eps)};
        }
        asm volatile("s_waitcnt lgkmcnt(0)" ::: "memory"); __builtin_amdgcn_s_barrier(); asm volatile("" ::: "memory");
        return bad;
    }
};
struct EpiLnRes {
    static constexpr bool PERM = false, AFTER_DRAIN = true;
    const float* base; float* out; int ldc; const float* bias; PanelStats st; unsigned poison;
    __device__ __forceinline__ void fused(f32x4 (&acc)[2][2][4][2], const Unit& u, int wr, int wc, int fr, int fq, PG8_LAS unsigned char* lds, int wid, int lane) const {
        typedef float f32x2v __attribute__((ext_vector_type(2)));
        const PG8_LAS f32x2v* S = (const PG8_LAS f32x2v*)(lds + 8192);
        const int col0 = u.pn * BM + wc * 32 + 4 * fq;
#pragma unroll
        for (int bj = 0; bj < 2; ++bj)
#pragma unroll
            for (int n = 0; n < 2; ++n) { const f32x4 bv = bias ? *(const f32x4*)(bias + col0 + bj * HALF + n * 16) : (f32x4){0.f, 0.f, 0.f, 0.f};
#pragma unroll
                for (int ai = 0; ai < 2; ++ai)
#pragma unroll
                    for (int m = 0; m < 4; ++m) acc[ai][bj][m][n] += bv; }
        f32x4 pre[4][2][2];
#pragma unroll
        for (int m = 0; m < 4; ++m) { const size_t off = (size_t)(u.pm * BM + wr * 64 + m * 16 + fr) * ldc + col0;
#pragma unroll
            for (int bj = 0; bj < 2; ++bj)
#pragma unroll
                for (int n = 0; n < 2; ++n) pre[m][bj][n] = *(const f32x4*)(base + off + bj * HALF + n * 16); }
        const bool bad = st.run(acc, u, wr, wc, fr, fq, lds, wid, lane) || poison != 0u;
        const float qnan = __builtin_nanf("");
#pragma unroll
        for (int ai = 0; ai < 2; ++ai)
#pragma unroll
            for (int m = 0; m < 4; ++m) { const int r = ai * HALF + wr * 64 + m * 16 + fr; const f32x2v sr = S[r]; const size_t off = (size_t)(u.pm * BM + r) * ldc + col0;
#pragma unroll
                for (int bj = 0; bj < 2; ++bj)
#pragma unroll
                    for (int n = 0; n < 2; ++n) { const f32x4 bs = ai == 0 ? pre[m][bj][n] : *(const f32x4*)(base + off + bj * HALF + n * 16); f32x4 o = bs + (acc[ai][bj][m][n] - sr.x) * sr.y;
                        if (bad) o = (f32x4){qnan, qnan, qnan, qnan}; *(f32x4*)(out + off + bj * HALF + n * 16) = o; }
                if (m & 1) asm volatile("" ::: "memory"); }
    }
};
struct EpiLnResLn {
    static constexpr bool PERM = false, AFTER_DRAIN = true;
    const float* base; float* out; bf16_t* xn; int ldc; const float* bias; PanelStats st1, st2; unsigned poison;
    __device__ __forceinline__ void fused(f32x4 (&acc)[2][2][4][2], const Unit& u, int wr, int wc, int fr, int fq, PG8_LAS unsigned char* lds, int wid, int lane) const {
        typedef float f32x2v __attribute__((ext_vector_type(2))); typedef unsigned u32x2v __attribute__((ext_vector_type(2)));
        const PG8_LAS f32x2v* S = (const PG8_LAS f32x2v*)(lds + 8192);
        const int col0 = u.pn * BM + wc * 32 + 4 * fq;
#pragma unroll
        for (int bj = 0; bj < 2; ++bj)
#pragma unroll
            for (int n = 0; n < 2; ++n) { const f32x4 bv = bias ? *(const f32x4*)(bias + col0 + bj * HALF + n * 16) : (f32x4){0.f, 0.f, 0.f, 0.f};
#pragma unroll
                for (int ai = 0; ai < 2; ++ai)
#pragma unroll
                    for (int m = 0; m < 4; ++m) acc[ai][bj][m][n] += bv; }
        bool bad = st1.run(acc, u, wr, wc, fr, fq, lds, wid, lane) || poison != 0u;
        const float qnan = __builtin_nanf("");
#pragma unroll
        for (int ai = 0; ai < 2; ++ai)
#pragma unroll
            for (int m = 0; m < 4; ++m) { const int r = ai * HALF + wr * 64 + m * 16 + fr; const f32x2v sr = S[r]; const size_t off = (size_t)(u.pm * BM + r) * ldc + col0;
#pragma unroll
                for (int bj = 0; bj < 2; ++bj)
#pragma unroll
                    for (int n = 0; n < 2; ++n) { const f32x4 bs = *(const f32x4*)(base + off + bj * HALF + n * 16); acc[ai][bj][m][n] = bs + (acc[ai][bj][m][n] - sr.x) * sr.y; }
                asm volatile("" : "+v"(acc[ai][0][m][0]), "+v"(acc[ai][0][m][1]), "+v"(acc[ai][1][m][0]), "+v"(acc[ai][1][m][1]));
                if (m & 1) asm volatile("" ::: "memory"); }
        const bool bad1 = bad;
        bad = st2.run(acc, u, wr, wc, fr, fq, lds, wid, lane) || bad;
#pragma unroll
        for (int ai = 0; ai < 2; ++ai)
#pragma unroll
            for (int m = 0; m < 4; ++m) { const int r = ai * HALF + wr * 64 + m * 16 + fr; const f32x2v sr = S[r]; const size_t off = (size_t)(u.pm * BM + r) * ldc + col0;
#pragma unroll
                for (int bj = 0; bj < 2; ++bj)
#pragma unroll
                    for (int n = 0; n < 2; ++n) { const f32x4 x1 = acc[ai][bj][m][n]; *(f32x4*)(out + off + bj * HALF + n * 16) = bad1 ? (f32x4){qnan, qnan, qnan, qnan} : x1;
                        const f32x4 o = (x1 - sr.x) * sr.y; u32x2v w; w.x = cvt_pk_bf16(o[0], o[1]); w.y = cvt_pk_bf16(o[2], o[3]);
                        if (bad) { w.x = 0x7fc07fc0u; w.y = 0x7fc07fc0u; } *(u32x2v*)(xn + off + bj * HALF + n * 16) = w; }
                asm volatile("" ::: "memory"); }
    }
};

template <class Epi, class Sched, bool ALIGN_EPI = false, bool SP2 = false>
__device__ __forceinline__ void gemm_phase(PG8_LAS unsigned char* lds, const Gemm g, const Sched& S, const Epi& E) {
    int tid_ = threadIdx.x; asm volatile("" : "+v"(tid_));
    const int tid = tid_, wid = __builtin_amdgcn_readfirstlane(tid >> 6), lane = tid & 63, wr = wid >> 2, wc = wid & 3, fr = lane & 15, fq = lane >> 4;
    const int K = g.K, nt = K / BK;
    unsigned voffA[2], voffB[2];
#pragma unroll
    for (int i = 0; i < 2; ++i) { int R, C; stage_rc(tid * 16 + i * 8192, R, C); const int Rb = Epi::PERM ? ((R & ~31) + perm32(R & 31)) : R;
        voffA[i] = (unsigned)(R * K + C) * 2u; voffB[i] = (unsigned)(Rb * K + C) * 2u; }
    const size_t kstep = (size_t)(BK * 2);
    const size_t hstep = (size_t)HALF * K * 2;
    const size_t tstep = 2 * hstep;
    const unsigned ldsw = (unsigned)wid * 1024u;
    const int aoff = lds_byte(wr * 64 + fr, fq * 8), boff = lds_byte(wc * 32 + fr, fq * 8);
#define PG8_SA(b, h) (((b) * 2 + (h)) * HTB)
#define PG8_SB(b, h) ((4 + (b) * 2 + (h)) * HTB)
#define PG8_STAGE(bufoff, gbase, voff) do { _Pragma("unroll") for (int _i = 0; _i < 2; ++_i) \
        __builtin_amdgcn_global_load_lds((const unsigned*)((const char*)(gbase) + (voff)[_i]), (PG8_LAS unsigned*)(lds + (bufoff) + ldsw + _i * 8192), 16, 0, 0); } while (0)
#define PG8_LDA(dst, b, h) do { _Pragma("unroll") for (int m = 0; m < 4; ++m) _Pragma("unroll") for (int k = 0; k < 2; ++k) dst[m][k] = *(const PG8_LAS bf16x8*)(lds + PG8_SA(b, h) + aoff + m * 2048 + k * 1024); } while (0)
#define PG8_LDB(dst, b, h) do { _Pragma("unroll") for (int n = 0; n < 2; ++n) _Pragma("unroll") for (int k = 0; k < 2; ++k) dst[n][k] = *(const PG8_LAS bf16x8*)(lds + PG8_SB(b, h) + boff + n * 2048 + k * 1024); } while (0)
#define PG8_MMA(ai, bj, At, Bt) do { __builtin_amdgcn_s_setprio(1); _Pragma("unroll") for (int m = 0; m < 4; ++m) _Pragma("unroll") for (int n = 0; n < 2; ++n) _Pragma("unroll") for (int k = 0; k < 2; ++k) \
        acc[ai][bj][m][n] = __builtin_amdgcn_mfma_f32_16x16x32_bf16(Bt[n][k], At[m][k], acc[ai][bj][m][n], 0, 0, 0); __builtin_amdgcn_s_setprio(0); } while (0)
#define PG8_WAIT_V(n) asm volatile("s_waitcnt vmcnt(" #n ")" ::: "memory")
#define PG8_WAIT_L(n) asm volatile("s_waitcnt lgkmcnt(" #n ")" ::: "memory")
#define PG8_BAR __builtin_amdgcn_s_barrier()
#define PG8_SCHED __builtin_amdgcn_sched_barrier(0)
    Unit cur, nxt; int ui = 0;
    if (!S.next(0, cur)) return;
    f32x4 acc[2][2][4][2];
#pragma unroll
    for (int a = 0; a < 2; ++a)
#pragma unroll
        for (int b = 0; b < 2; ++b)
#pragma unroll
            for (int m = 0; m < 4; ++m)
#pragma unroll
                for (int n = 0; n < 2; ++n) acc[a][b][m][n] = (f32x4){0.f, 0.f, 0.f, 0.f};
    bf16x8 At[4][2], B0[2][2], B1[2][2];
    const char* cA = (const char*)g.A + (size_t)cur.pm * tstep; const char* cB = (const char*)g.Bt + (size_t)cur.pn * tstep;
    S.a_ready(cur);
    if constexpr (SP2) {
        PG8_STAGE(PG8_SB(0, 0), cB, voffB); PG8_STAGE(PG8_SB(0, 1), cB + hstep, voffB); PG8_STAGE(PG8_SA(0, 0), cA, voffA); PG8_STAGE(PG8_SA(0, 1), cA + hstep, voffA);
        if (wr == 1) PG8_BAR;
        PG8_WAIT_V(2); PG8_BAR;
        PG8_STAGE(PG8_SB(1, 0), cB + kstep, voffB); PG8_STAGE(PG8_SA(1, 0), cA + kstep, voffA); PG8_STAGE(PG8_SB(1, 1), cB + hstep + kstep, voffB);
        PG8_WAIT_V(6); PG8_BAR;
    } else {
        PG8_STAGE(PG8_SB(0, 0), cB, voffB); PG8_STAGE(PG8_SA(0, 0), cA, voffA); PG8_STAGE(PG8_SB(0, 1), cB + hstep, voffB); PG8_STAGE(PG8_SA(0, 1), cA + hstep, voffA);
        if (wr == 1) PG8_BAR;
        PG8_WAIT_V(4); PG8_BAR;
        PG8_STAGE(PG8_SB(1, 0), cB + kstep, voffB); PG8_STAGE(PG8_SA(1, 0), cA + kstep, voffA); PG8_STAGE(PG8_SB(1, 1), cB + hstep + kstep, voffB);
        PG8_WAIT_V(6); PG8_BAR;
    }
    for (;;) {
        const bool has_next = S.next(ui + 1, nxt);
        const char* nA = has_next ? (const char*)g.A + (size_t)nxt.pm * tstep : cA; const char* nB = has_next ? (const char*)g.Bt + (size_t)nxt.pn * tstep : cB;
        for (int t = 0; t < nt; t += 2) {
            const bool last = (t == nt - 2);
            const char* a1 = cA + (size_t)(t + 1) * kstep;
            const char* a2 = last ? nA : cA + (size_t)(t + 2) * kstep; const char* b2 = last ? nB : cB + (size_t)(t + 2) * kstep;
            const char* a3 = a2 + kstep; const char* b3 = b2 + kstep;
            if (last && has_next) S.a_ready(nxt);
            if constexpr (SP2) {
            PG8_LDB(B0, 0, 0); PG8_LDB(B1, 0, 1); PG8_SCHED; PG8_LDA(At, 0, 0); PG8_STAGE(PG8_SA(1, 1), a1 + hstep, voffA);
            PG8_WAIT_V(8); PG8_WAIT_L(0); PG8_BAR; PG8_MMA(0, 0, At, B0); PG8_MMA(0, 1, At, B1); PG8_BAR; PG8_SCHED;
            PG8_LDA(At, 0, 1); PG8_STAGE(PG8_SB(0, 0), b2, voffB); PG8_STAGE(PG8_SB(0, 1), b2 + hstep, voffB); PG8_STAGE(PG8_SA(0, 0), a2, voffA);
            PG8_WAIT_V(8); PG8_WAIT_L(0); PG8_BAR; PG8_MMA(1, 0, At, B0); PG8_MMA(1, 1, At, B1); PG8_BAR; PG8_SCHED;
            PG8_LDB(B0, 1, 0); PG8_LDB(B1, 1, 1); PG8_SCHED; PG8_LDA(At, 1, 0); PG8_STAGE(PG8_SA(0, 1), a2 + hstep, voffA);
            PG8_WAIT_V(8); PG8_WAIT_L(0); PG8_BAR; PG8_MMA(0, 0, At, B0); PG8_MMA(0, 1, At, B1); PG8_BAR; PG8_SCHED;
            PG8_LDA(At, 1, 1); PG8_STAGE(PG8_SB(1, 0), b3, voffB); PG8_STAGE(PG8_SB(1, 1), b3 + hstep, voffB); PG8_STAGE(PG8_SA(1, 0), a3, voffA);
            PG8_WAIT_V(8); PG8_WAIT_L(0); PG8_BAR; PG8_MMA(1, 0, At, B0); PG8_MMA(1, 1, At, B1); PG8_BAR; PG8_SCHED;
            } else {
            PG8_LDB(B0, 0, 0); PG8_SCHED; PG8_LDA(At, 0, 0); PG8_STAGE(PG8_SA(1, 1), a1 + hstep, voffA);
            PG8_WAIT_L(8); PG8_BAR; PG8_WAIT_L(0); PG8_MMA(0, 0, At, B0); PG8_BAR; PG8_SCHED;
            PG8_LDB(B1, 0, 1); PG8_STAGE(PG8_SB(0, 0), b2, voffB);
            PG8_BAR; PG8_WAIT_L(0); PG8_MMA(0, 1, At, B1); PG8_BAR;
            PG8_LDA(At, 0, 1); PG8_STAGE(PG8_SA(0, 0), a2, voffA);
            PG8_BAR; PG8_WAIT_L(0); PG8_MMA(1, 0, At, B0); PG8_BAR; PG8_SCHED;
            PG8_STAGE(PG8_SB(0, 1), b2 + hstep, voffB);
            PG8_WAIT_V(6); PG8_BAR; PG8_MMA(1, 1, At, B1); PG8_BAR;
            PG8_LDB(B0, 1, 0); PG8_SCHED; PG8_LDA(At, 1, 0); PG8_STAGE(PG8_SA(0, 1), a2 + hstep, voffA);
            PG8_WAIT_L(8); PG8_BAR; PG8_WAIT_L(0); PG8_MMA(0, 0, At, B0); PG8_BAR; PG8_SCHED;
            PG8_LDB(B1, 1, 1); PG8_STAGE(PG8_SB(1, 0), b3, voffB);
            PG8_BAR; PG8_WAIT_L(0); PG8_MMA(0, 1, At, B1); PG8_BAR;
            PG8_LDA(At, 1, 1); PG8_STAGE(PG8_SA(1, 0), a3, voffA);
            PG8_BAR; PG8_WAIT_L(0); PG8_MMA(1, 0, At, B0); PG8_BAR; PG8_SCHED;
            PG8_STAGE(PG8_SB(1, 1), b3 + hstep, voffB);
            PG8_WAIT_V(6); PG8_BAR; PG8_MMA(1, 1, At, B1); PG8_BAR;
            }
        }
        if constexpr (ALIGN_EPI) { if (wr == 0) PG8_BAR; }
        if constexpr (!Epi::AFTER_DRAIN) { E(acc, cur, wr, wc, fr, fq); S.done(cur); }
        if (!has_next) break;
#pragma unroll
        for (int a = 0; a < 2; ++a)
#pragma unroll
            for (int b = 0; b < 2; ++b)
#pragma unroll
                for (int m = 0; m < 4; ++m)
#pragma unroll
                    for (int n = 0; n < 2; ++n) acc[a][b][m][n] = (f32x4){0.f, 0.f, 0.f, 0.f};
        cur = nxt; cA = nA; cB = nB; ++ui;
        if constexpr (ALIGN_EPI) { if (wr == 1) PG8_BAR; }
    }
    PG8_WAIT_V(0);
    if constexpr (!ALIGN_EPI) { if (wr == 0) PG8_BAR; }
    PG8_BAR;
    if constexpr (Epi::AFTER_DRAIN) { E.fused(acc, cur, wr, wc, fr, fq, lds, wid, lane); S.done(cur); }
#undef PG8_SA
#undef PG8_SB
#undef PG8_STAGE
#undef PG8_LDA
#undef PG8_LDB
#undef PG8_MMA
#undef PG8_WAIT_V
#undef PG8_WAIT_L
#undef PG8_BAR
#undef PG8_SCHED
}
}
#define GAS __attribute__((address_space(1)))
#define LAS __attribute__((address_space(3)))
typedef unsigned short bf16;
typedef unsigned v4u __attribute__((ext_vector_type(4)));
typedef float f32x4 __attribute__((ext_vector_type(4)));
typedef short bf16x8 __attribute__((ext_vector_type(8)));
typedef GAS unsigned gu32;
typedef GAS unsigned long long gu64;
#define RLX_AGENT __ATOMIC_RELAXED, __HIP_MEMORY_SCOPE_AGENT
#define LDS_WAIT() asm volatile("s_waitcnt lgkmcnt(0)" ::: "memory")
#define VM_WAIT() asm volatile("s_waitcnt vmcnt(0)" ::: "memory")
__device__ __forceinline__ unsigned long long rt() { return __builtin_amdgcn_s_memrealtime(); }
__device__ __forceinline__ unsigned f2bf(float f) { unsigned u = __builtin_bit_cast(unsigned, f); return (u + 0x7fffu + ((u >> 16) & 1u)) >> 16; }
__device__ __forceinline__ unsigned pk2(float lo, float hi) { return f2bf(lo) | (f2bf(hi) << 16); }

#define XB_TMO      128
#define XB_XCNT(j)  (256  + 64 * (j))
#define XB_XSUB(j)  (1280 + 64 * (j))
#define XB_XGEN(j)  (2304 + 64 * (j))
#define XB_TOP      3328
#define XB_TOPGEN   3392
#define XCD_BAR_WORDS 3456
#define XB_SPIN_CAP (1u << 18)

__device__ __forceinline__ unsigned xb_ld(unsigned* p)              { return __hip_atomic_load(p, __ATOMIC_RELAXED, __HIP_MEMORY_SCOPE_AGENT); }
__device__ __forceinline__ unsigned xb_add(unsigned* p, unsigned v) { return __hip_atomic_fetch_add(p, v, __ATOMIC_RELAXED, __HIP_MEMORY_SCOPE_AGENT); }
__device__ __forceinline__ unsigned xb_xcc_id() { return (unsigned)__builtin_amdgcn_s_getreg((3 << 11) | 20) & 0xFu; }
#define XB_SPIN(cond, bar) do { unsigned _sp = 0; while (cond) { __builtin_amdgcn_s_sleep(1); \
    if ((++_sp & 255u) == 0u) { if (xb_ld(&(bar)[XB_TMO])) break; if (_sp > XB_SPIN_CAP) { atomicAdd(&(bar)[XB_TMO], 1u); break; } } } } while (0)

struct XcdBarrier {
    unsigned* bar; unsigned x;
    volatile LAS unsigned* st;
};

__device__ __forceinline__ XcdBarrier xcd_barrier_post(unsigned* bar, volatile LAS unsigned* st) {
    XcdBarrier b; b.bar = bar; b.x = xb_xcc_id(); b.st = st;
    if (threadIdx.x == 0) (void)xb_add(&bar[XB_XCNT(b.x)], 1u);
    return b;
}
__device__ __forceinline__ void xcd_barrier_complete(unsigned* bar, unsigned x, unsigned& nloc, unsigned& nx) {
    const unsigned G = gridDim.x * gridDim.y * gridDim.z;
    unsigned sum, cnt, mine, sp = 0u;
    for (;;) {
        sum = 0u; cnt = 0u; mine = 0u;
#pragma unroll
        for (unsigned j = 0; j < 16; ++j) { const unsigned c = xb_ld(&bar[XB_XCNT(j)]); sum += c; cnt += (c > 0u) ? 1u : 0u; mine = (j == x) ? c : mine; }
        if (sum == G) break;
        __builtin_amdgcn_s_sleep(1);
        if ((++sp & 255u) == 0u) { if (xb_ld(&bar[XB_TMO])) break; if (sp > XB_SPIN_CAP) { atomicAdd(&bar[XB_TMO], 1u); break; } }
    }
    nloc = mine > 0u ? mine : 1u; nx = cnt > 0u ? cnt : 1u;
}

__device__ __forceinline__ void xcd_barrier(const XcdBarrier& b) {
    asm volatile("s_waitcnt vmcnt(0)" ::: "memory");
    __syncthreads();
    if (threadIdx.x == 0) {
        unsigned* bar = b.bar;
        __builtin_amdgcn_s_waitcnt(0);
        unsigned nloc = b.st[0], nx = b.st[1];
        if (nloc == 0u) { xcd_barrier_complete(bar, b.x, nloc, nx); b.st[0] = nloc; b.st[1] = nx; }
        const unsigned old = xb_add(&bar[XB_XSUB(b.x)], 1u);
        const unsigned gen = old / nloc;
        if (old + 1u == (gen + 1u) * nloc) {
            __builtin_amdgcn_fence(__ATOMIC_RELEASE, "agent");
            asm volatile("s_waitcnt vmcnt(0)" ::: "memory");
            const unsigned og = xb_add(&bar[XB_TOP], 1u);
            const unsigned tg = og / nx;
            if (og + 1u == (tg + 1u) * nx) xb_add(&bar[XB_TOPGEN], 1u);
            else XB_SPIN(xb_ld(&bar[XB_TOPGEN]) == tg, bar);
            __builtin_amdgcn_fence(__ATOMIC_ACQUIRE, "agent");
            xb_add(&bar[XB_XGEN(b.x)], 1u);
            asm volatile("s_waitcnt vmcnt(0)" ::: "memory");
        } else {
            XB_SPIN(xb_ld(&bar[XB_XGEN(b.x)]) == gen, bar);
            __builtin_amdgcn_fence(__ATOMIC_ACQUIRE, "agent");
            asm volatile("s_waitcnt vmcnt(0)" ::: "memory");
        }
    }
    __syncthreads();
}

constexpr int D = 1024, BATCH = 8, SEQ = 2048, DEPTH = 4, NMEM = 256;
constexpr int M = BATCH * SEQ;
constexpr int MM = BATCH * NMEM;
constexpr int ML_H = 4, ML_DK = 128, ML_DV = 256, ML_W = 3080;
constexpr int SB_H = 16, SB_DH = 64;
constexpr int XA_H = 4, XA_DH = 256;
constexpr int DFF = 2816;
constexpr float EPS = 1e-6f;
constexpr int NWAVES = 8;

constexpr size_t MiB = 1u << 20;
constexpr size_t WS_CTL = 0, CTL_ZERO_BYTES = 1 * MiB;
constexpr size_t WS_WG = 1 * MiB;
constexpr size_t WS_GATES = 1 * MiB + 512 * 1024;
constexpr size_t WS_MEMN = 2 * MiB;
constexpr size_t WS_W = 8 * MiB;
constexpr size_t W_KV = 0;
constexpr size_t W_LAYER0 = (size_t)8192 * 1024;
constexpr size_t WL_IN = 0, WL_OUT = WL_IN + (size_t)3072 * 1024, WL_Q = WL_OUT + (size_t)1024 * 1024, WL_O = WL_Q + (size_t)1024 * 1024,
                 WL_GU = WL_O + (size_t)1024 * 1024, WL_DN = WL_GU + (size_t)5632 * 1024, WL_SIZE = WL_DN + (size_t)1024 * 2816;
constexpr size_t WS_KV = WS_W + (W_LAYER0 + 4 * WL_SIZE) * 2;
static_assert(WS_KV == 138 * MiB, "weight region size");
constexpr size_t WS_XN = WS_KV + 32 * MiB;
constexpr size_t WS_MIX = WS_XN + 32 * MiB;
constexpr size_t WS_BIG = WS_MIX + 32 * MiB;
constexpr size_t WS_END = WS_BIG + 96 * MiB;
constexpr int CW_BAR = 4096;

constexpr int RING_OFF = 0, RING_BYTES = 131072;
constexpr int LDSCTL_OFF = RING_BYTES, MISC_OFF = LDSCTL_OFF + 320;
constexpr int LDS_BYTES = 147456;

__device__ __forceinline__ float wave_sum(float v) {
#pragma unroll
    for (int o = 1; o < 64; o <<= 1) v += __shfl_xor(v, o);
    return v;
}
__device__ __forceinline__ float wave_max(float v) {
#pragma unroll
    for (int o = 1; o < 64; o <<= 1) v = fmaxf(v, __shfl_xor(v, o));
    return v;
}
__device__ __forceinline__ float softplusf(float z) { return fmaxf(z, 0.f) + log1pf(__expf(-fabsf(z))); }
__device__ __forceinline__ float bf2f(unsigned short h) { return __uint_as_float((unsigned)h << 16); }
__device__ __forceinline__ float bflo(unsigned w) { return __uint_as_float(w << 16); }
__device__ __forceinline__ float bfhi(unsigned w) { return __uint_as_float(w & 0xffff0000u); }

struct Frame {
    LAS unsigned char* lds;
    int tid, lane, wave, G, gw, NGW;
    unsigned char* ws;
};
__device__ __forceinline__ const float* inp(const Frame& F, int i) {
    volatile LAS unsigned* t = (volatile LAS unsigned*)(F.lds + LDSCTL_OFF) + 2 * i;
    const unsigned lo = __builtin_amdgcn_readfirstlane(t[0]), hi = __builtin_amdgcn_readfirstlane(t[1]);
    return (const float*)(((unsigned long long)hi << 32) | lo);
}
__device__ __forceinline__ void relane(Frame& F) {
    int t = threadIdx.x; asm volatile("" : "+v"(t));
    F.tid = t; F.lane = t & 63; F.wave = __builtin_amdgcn_readfirstlane(t >> 6);
    int g = gridDim.x, b = blockIdx.x; asm volatile("" : "+s"(g), "+s"(b));
    F.G = g; F.gw = b * NWAVES + F.wave; F.NGW = g * NWAVES;
}

struct EpiStore {
    static constexpr bool PERM = true, AFTER_DRAIN = false;
    bf16* O; int ldc;
    __device__ __forceinline__ void operator()(const f32x4 (&acc)[2][2][4][2], const pg8::Unit& u, int wr, int wc, int fr, int fq) const {
        const int row0 = u.pm * 256 + wr * 64 + fr, col0 = u.pn * 256 + wc * 32 + 8 * fq;
#pragma unroll
        for (int ai = 0; ai < 2; ++ai)
#pragma unroll
            for (int m = 0; m < 4; ++m) { bf16* rowp = O + (size_t)(row0 + ai * 128 + m * 16) * ldc + col0;
#pragma unroll
                for (int bj = 0; bj < 2; ++bj) { const f32x4 v0 = acc[ai][bj][m][0], v1 = acc[ai][bj][m][1];
                    pg8::u32x4 w; w.x = pg8::cvt_pk_bf16(v0[0], v0[1]); w.y = pg8::cvt_pk_bf16(v0[2], v0[3]); w.z = pg8::cvt_pk_bf16(v1[0], v1[1]); w.w = pg8::cvt_pk_bf16(v1[2], v1[3]);
                    *(pg8::u32x4*)(rowp + bj * 128) = w; } }
    }
};
struct EpiSwiglu {
    static constexpr bool PERM = true, AFTER_DRAIN = false;
    bf16* O; int ldc;
    __device__ __forceinline__ void operator()(const f32x4 (&acc)[2][2][4][2], const pg8::Unit& u, int wr, int wc, int fr, int fq) const {
        const int row0 = u.pm * 256 + wr * 64 + fr, col0 = u.pn * 128 + wc * 32 + 8 * fq;
#pragma unroll
        for (int ai = 0; ai < 2; ++ai)
#pragma unroll
            for (int m = 0; m < 4; ++m) { bf16* rowp = O + (size_t)(row0 + ai * 128 + m * 16) * ldc + col0;
                float r[8];
#pragma unroll
                for (int n = 0; n < 2; ++n)
#pragma unroll
                    for (int e = 0; e < 4; ++e) { const float g = acc[ai][0][m][n][e], up = acc[ai][1][m][n][e]; r[n * 4 + e] = g * __builtin_amdgcn_rcpf(1.f + __expf(-g)) * up; }
                pg8::u32x4 w; w.x = pg8::cvt_pk_bf16(r[0], r[1]); w.y = pg8::cvt_pk_bf16(r[2], r[3]); w.z = pg8::cvt_pk_bf16(r[4], r[5]); w.w = pg8::cvt_pk_bf16(r[6], r[7]);
                *(pg8::u32x4*)rowp = w; }
    }
};

__device__ __forceinline__ void transpose_item(const float* W, int ld, int K, bf16* WT, int k0, int n0, int drow, LAS float* scr, int lane) {
#pragma unroll 8
    for (int i = 0; i < 32; ++i) { const int kk = 2 * i + (lane >> 5); scr[kk * 33 + (lane & 31)] = W[(size_t)(k0 + kk) * ld + n0 + (lane & 31)]; }
    LDS_WAIT(); asm volatile("" ::: "memory");
    const int c = lane & 7;
#pragma unroll
    for (int j = 0; j < 4; ++j) { const int n = (lane >> 3) + 8 * j; const LAS float* s = scr + (8 * c) * 33 + n;
        v4u o; o.x = pk2(s[0 * 33], s[1 * 33]); o.y = pk2(s[2 * 33], s[3 * 33]); o.z = pk2(s[4 * 33], s[5 * 33]); o.w = pk2(s[6 * 33], s[7 * 33]);
        *(GAS v4u*)(WT + (size_t)(drow + n) * K + k0 + 8 * c) = o; }
    LDS_WAIT(); asm volatile("" ::: "memory");
}
__device__ __forceinline__ void p0_convert(Frame& F) {
    relane(F);
    LAS float* scr = (LAS float*)(F.lds + RING_OFF + F.wave * 16384);
    bf16* Wb = (bf16*)(F.ws + WS_W);
    constexpr int I_IN = 16 * 96, I_OUT = 16 * 32, I_Q = 16 * 32, I_O = 16 * 32, I_KV = 16 * 64, I_GU = 16 * 176, I_DN = 44 * 32;
    constexpr int I_LAYER = I_IN + I_OUT + I_Q + I_O + I_KV + I_GU + I_DN;
    for (int it = F.gw; it < 4 * I_LAYER; it += F.NGW) {
        const int l = it / I_LAYER, j = l >> 1; int r = it % I_LAYER;
        bf16* WL = Wb + W_LAYER0 + (size_t)l * WL_SIZE;
        if (r < I_IN) { const int kb = r / 96, nb = r % 96;
            if (l & 1) transpose_item(inp(F, 8) + (size_t)j * D * 3072, 3072, D, WL + WL_IN, kb * 64, nb * 32, nb * 32, scr, F.lane);
            else       transpose_item(inp(F, 4) + (size_t)j * D * ML_W, ML_W, D, WL + WL_IN, kb * 64, nb * 32, nb * 32, scr, F.lane);
            continue; } r -= I_IN;
        if (r < I_OUT) { const int kb = r / 32, nb = r % 32;
            transpose_item(((l & 1) ? inp(F, 9) : inp(F, 7)) + (size_t)j * D * D, D, D, WL + WL_OUT, kb * 64, nb * 32, nb * 32, scr, F.lane); continue; } r -= I_OUT;
        if (r < I_Q) { const int kb = r / 32, nb = r % 32; transpose_item(inp(F, 10) + (size_t)l * D * D, D, D, WL + WL_Q, kb * 64, nb * 32, nb * 32, scr, F.lane); continue; } r -= I_Q;
        if (r < I_O) { const int kb = r / 32, nb = r % 32; transpose_item(inp(F, 12) + (size_t)l * D * D, D, D, WL + WL_O, kb * 64, nb * 32, nb * 32, scr, F.lane); continue; } r -= I_O;
        if (r < I_KV) { const int kb = r / 64, nb = r % 64; transpose_item(inp(F, 11) + (size_t)l * D * 2048, 2048, D, Wb + W_KV, kb * 64, nb * 32, l * 2048 + nb * 32, scr, F.lane); continue; } r -= I_KV;
        if (r < I_GU) { const int kb = r / 176, nb = r % 176; const int c0 = nb * 32; const int up = c0 >= DFF, jj = up ? c0 - DFF : c0;
            transpose_item(inp(F, 13) + (size_t)l * D * 2 * DFF, 2 * DFF, D, WL + WL_GU, kb * 64, c0, 256 * (jj >> 7) + 128 * up + (jj & 127), scr, F.lane); continue; } r -= I_GU;
        { const int kb = r / 32, nb = r % 32; transpose_item(inp(F, 14) + (size_t)l * DFF * D, D, DFF, WL + WL_DN, kb * 64, nb * 32, nb * 32, scr, F.lane); }
    }
    bf16* MEMN = (bf16*)(F.ws + WS_MEMN);
    for (int m = F.gw; m < MM; m += F.NGW) {
        const GAS f32x4* xr = (const GAS f32x4*)(inp(F, 1) + (size_t)m * D) + F.lane; const GAS f32x4* gr = (const GAS f32x4*)inp(F, 2) + F.lane;
        f32x4 v[4]; float s = 0.f;
#pragma unroll
        for (int q = 0; q < 4; ++q) { v[q] = xr[64 * q]; s += (v[q].x * v[q].x + v[q].y * v[q].y) + (v[q].z * v[q].z + v[q].w * v[q].w); }
        const float rs = rsqrtf(wave_sum(s) * (1.f / D) + EPS);
        GAS unsigned long long* o8 = (GAS unsigned long long*)(MEMN + (size_t)m * D) + F.lane;
#pragma unroll
        for (int q = 0; q < 4; ++q) { const f32x4 g = gr[64 * q]; o8[64 * q] = (unsigned long long)pk2(v[q].x * rs * g.x, v[q].y * rs * g.y) | ((unsigned long long)pk2(v[q].z * rs * g.z, v[q].w * rs * g.w) << 32); }
    }
}

__device__ __forceinline__ void row_phase(Frame& F, const float* xin, float* xout, const bf16* Y, const float* ga, const float* gb, bf16* XN, const float* WG, int wgs, const float* bg, float* GT) {
    relane(F);
    for (int m = F.gw; m < M; m += F.NGW) {
        const GAS f32x4* xr = (const GAS f32x4*)(xin + (size_t)m * D) + F.lane;
        f32x4 v[4];
#pragma unroll
        for (int q = 0; q < 4; ++q) v[q] = xr[64 * q];
        if (Y) {
            const GAS unsigned long long* yr = (const GAS unsigned long long*)(Y + (size_t)m * D) + F.lane;
            f32x4 y[4]; float s = 0.f;
#pragma unroll
            for (int q = 0; q < 4; ++q) { const unsigned long long w = yr[64 * q]; const unsigned lo = (unsigned)w, hi = (unsigned)(w >> 32);
                y[q] = (f32x4){bflo(lo), bfhi(lo), bflo(hi), bfhi(hi)}; s += (y[q].x * y[q].x + y[q].y * y[q].y) + (y[q].z * y[q].z + y[q].w * y[q].w); }
            const float rs = rsqrtf(wave_sum(s) * (1.f / D) + EPS);
            const GAS f32x4* gr = (const GAS f32x4*)ga + F.lane;
#pragma unroll
            for (int q = 0; q < 4; ++q) { const f32x4 g = gr[64 * q]; v[q] = v[q] + y[q] * rs * g; }
        }
        if (Y || xin != xout) { GAS f32x4* xo = (GAS f32x4*)(xout + (size_t)m * D) + F.lane;
#pragma unroll
            for (int q = 0; q < 4; ++q) xo[64 * q] = v[q]; }
        if (gb) {
            float s = 0.f;
#pragma unroll
            for (int q = 0; q < 4; ++q) s += (v[q].x * v[q].x + v[q].y * v[q].y) + (v[q].z * v[q].z + v[q].w * v[q].w);
            const float rs = rsqrtf(wave_sum(s) * (1.f / D) + EPS);
            const GAS f32x4* gr = (const GAS f32x4*)gb + F.lane;
            GAS unsigned long long* o8 = (GAS unsigned long long*)(XN + (size_t)m * D) + F.lane;
#pragma unroll
            for (int q = 0; q < 4; ++q) { const f32x4 g = gr[64 * q]; v[q] = v[q] * rs * g; o8[64 * q] = (unsigned long long)pk2(v[q].x, v[q].y) | ((unsigned long long)pk2(v[q].z, v[q].w) << 32); }
            if (WG) {
                float acc[8];
#pragma unroll
                for (int c = 0; c < 8; ++c) acc[c] = 0.f;
#pragma unroll
                for (int q = 0; q < 4; ++q)
#pragma unroll
                    for (int e = 0; e < 4; ++e) { const GAS f32x4* w = (const GAS f32x4*)(WG + (size_t)(4 * F.lane + 256 * q + e) * wgs); const f32x4 w0 = w[0], w1 = w[1]; const float h = v[q][e];
                        acc[0] += h * w0.x; acc[1] += h * w0.y; acc[2] += h * w0.z; acc[3] += h * w0.w; acc[4] += h * w1.x; acc[5] += h * w1.y; acc[6] += h * w1.z; acc[7] += h * w1.w; }
#pragma unroll
                for (int c = 0; c < 8; ++c) acc[c] = wave_sum(acc[c]);
                if (F.lane < 8) {
                    float a = 0.f;
#pragma unroll
                    for (int c = 0; c < 8; ++c) a = (F.lane == c) ? acc[c] : a;
                    a = 15.f * tanhf((a + bg[F.lane]) * (1.f / 15.f));
                    if (F.lane >= 4) a = -softplusf(-a);
                    GT[(size_t)m * 8 + F.lane] = a;
                }
            }
        }
    }
}

__device__ __forceinline__ void mlstm_scan_v1(Frame& F, const bf16* PROJ, const float* GT, bf16* MIX) {
    relane(F);
    const int vi = F.tid >> 4, kq = F.tid & 15;
    for (int task = blockIdx.x; task < BATCH * ML_H * 8; task += F.G) {
        const int bh = task >> 3, vs = task & 7, b = bh >> 2, h = bh & 3;
        float C[8], n[8], m = 0.f;
#pragma unroll
        for (int i = 0; i < 8; ++i) { C[i] = 0.f; n[i] = 0.f; }
        const bf16* p0 = PROJ + (size_t)b * SEQ * 3072;
        const float* g0 = GT + (size_t)b * SEQ * 8;
        v4u qn = *(const GAS v4u*)(p0 + h * 128 + kq * 8), kn = *(const GAS v4u*)(p0 + 512 + h * 128 + kq * 8);
        unsigned short vn = *(const GAS unsigned short*)(p0 + 1024 + h * 256 + vs * 32 + vi);
        float ign = g0[h], lfn = g0[4 + h];
        for (int t = 0; t < SEQ; ++t) {
            const v4u qc = qn, kc = kn; const float vv = bf2f(vn), ig = ign, lf = lfn;
            if (t + 1 < SEQ) { const bf16* p = p0 + (size_t)(t + 1) * 3072; qn = *(const GAS v4u*)(p + h * 128 + kq * 8); kn = *(const GAS v4u*)(p + 512 + h * 128 + kq * 8);
                vn = *(const GAS unsigned short*)(p + 1024 + h * 256 + vs * 32 + vi); ign = g0[(t + 1) * 8 + h]; lfn = g0[(t + 1) * 8 + 4 + h]; }
            const float mn = fmaxf(lf + m, ig), dec = __expf(lf + m - mn), wi = __expf(ig - mn); m = mn;
            const float qf[8] = {bflo(qc.x), bfhi(qc.x), bflo(qc.y), bfhi(qc.y), bflo(qc.z), bfhi(qc.z), bflo(qc.w), bfhi(qc.w)};
            const float kf[8] = {bflo(kc.x), bfhi(kc.x), bflo(kc.y), bfhi(kc.y), bflo(kc.z), bfhi(kc.z), bflo(kc.w), bfhi(kc.w)};
            float num = 0.f, den = 0.f;
#pragma unroll
            for (int i = 0; i < 8; ++i) { const float kk = kf[i] * 0.08838834764831845f;
                C[i] = dec * C[i] + wi * vv * kk; n[i] = dec * n[i] + wi * kk; num += C[i] * qf[i]; den += n[i] * qf[i]; }
#pragma unroll
            for (int o = 1; o < 16; o <<= 1) { num += __shfl_xor(num, o); den += __shfl_xor(den, o); }
            if (kq == 0) { const float r = num / fmaxf(fabsf(den), __expf(-mn)); ((GAS unsigned short*)MIX)[(size_t)(b * SEQ + t) * D + h * 256 + vs * 32 + vi] = (unsigned short)f2bf(r); }
        }
    }
}
__device__ __forceinline__ void mlstm_post_v1(Frame& F, const bf16* PROJ, const float* hg, bf16* MIX) {
    relane(F);
    for (int w = F.gw; w < M * ML_H; w += F.NGW) {
        const int tok = w >> 2, h = w & 3;
        GAS unsigned long long* r = (GAS unsigned long long*)(MIX + (size_t)tok * D + h * 256) + F.lane;
        const unsigned long long hw = *r, ow = *((const GAS unsigned long long*)(PROJ + (size_t)tok * 3072 + 2048 + h * 256) + F.lane);
        const float v[4] = {bflo((unsigned)hw), bfhi((unsigned)hw), bflo((unsigned)(hw >> 32)), bfhi((unsigned)(hw >> 32))};
        const float o[4] = {bflo((unsigned)ow), bfhi((unsigned)ow), bflo((unsigned)(ow >> 32)), bfhi((unsigned)(ow >> 32))};
        const float rs = rsqrtf(wave_sum((v[0] * v[0] + v[1] * v[1]) + (v[2] * v[2] + v[3] * v[3])) * (1.f / 256.f) + EPS);
        const f32x4 g = *((const GAS f32x4*)(hg + h * 256) + F.lane);
        float y[4];
#pragma unroll
        for (int e = 0; e < 4; ++e) y[e] = v[e] * rs * g[e] / (1.f + __expf(-o[e]));
        *r = (unsigned long long)pk2(y[0], y[1]) | ((unsigned long long)pk2(y[2], y[3]) << 32);
    }
}

__device__ __forceinline__ void sb_attn_v1(Frame& F, const bf16* QKV, bf16* MIX) {
    relane(F);
    for (int task = F.gw; task < BATCH * SB_H * 16; task += F.NGW) {
        const int bh = task >> 4, pr = task & 15, b = bh >> 4, h = bh & 15;
#pragma unroll 1
        for (int half = 0; half < 2; ++half) {
            const int tb = half ? 31 - pr : pr, t = tb * 64 + F.lane;
            float q[64], o[64];
            const GAS v4u* qp = (const GAS v4u*)(QKV + (size_t)(b * SEQ + t) * 3072 + h * 64);
#pragma unroll
            for (int c = 0; c < 8; ++c) { const v4u w = qp[c]; q[8 * c] = bflo(w.x) * 0.125f; q[8 * c + 1] = bfhi(w.x) * 0.125f; q[8 * c + 2] = bflo(w.y) * 0.125f; q[8 * c + 3] = bfhi(w.y) * 0.125f;
                q[8 * c + 4] = bflo(w.z) * 0.125f; q[8 * c + 5] = bfhi(w.z) * 0.125f; q[8 * c + 6] = bflo(w.w) * 0.125f; q[8 * c + 7] = bfhi(w.w) * 0.125f; }
#pragma unroll
            for (int d = 0; d < 64; ++d) o[d] = 0.f;
            float run = 0.f;
            for (int s = tb * 64 + 62; s >= 0; --s) {
                const GAS v4u* kp = (const GAS v4u*)(QKV + (size_t)(b * SEQ + s) * 3072 + 1024 + h * 64);
                float z = 0.f;
#pragma unroll
                for (int c = 0; c < 8; ++c) { const v4u w = kp[c]; z += q[8 * c] * bflo(w.x) + q[8 * c + 1] * bfhi(w.x) + q[8 * c + 2] * bflo(w.y) + q[8 * c + 3] * bfhi(w.y)
                        + q[8 * c + 4] * bflo(w.z) + q[8 * c + 5] * bfhi(w.z) + q[8 * c + 6] * bflo(w.w) + q[8 * c + 7] * bfhi(w.w); }
                if (s < t) {
                    const float sp = softplusf(z), a = __expf(z - sp + run); run -= sp;
                    const GAS v4u* vp = kp + 128;
#pragma unroll
                    for (int c = 0; c < 8; ++c) { const v4u w = vp[c]; o[8 * c] += a * bflo(w.x); o[8 * c + 1] += a * bfhi(w.x); o[8 * c + 2] += a * bflo(w.y); o[8 * c + 3] += a * bfhi(w.y);
                        o[8 * c + 4] += a * bflo(w.z); o[8 * c + 5] += a * bfhi(w.z); o[8 * c + 6] += a * bflo(w.w); o[8 * c + 7] += a * bfhi(w.w); }
                }
            }
            GAS v4u* op = (GAS v4u*)(MIX + (size_t)(b * SEQ + t) * D + h * 64);
#pragma unroll
            for (int c = 0; c < 8; ++c) { v4u w; w.x = pk2(o[8 * c], o[8 * c + 1]); w.y = pk2(o[8 * c + 2], o[8 * c + 3]); w.z = pk2(o[8 * c + 4], o[8 * c + 5]); w.w = pk2(o[8 * c + 6], o[8 * c + 7]); op[c] = w; }
        }
    }
}

__device__ __forceinline__ void xattn_v1(Frame& F, const bf16* XQ, const bf16* KVl, bf16* MIX) {
    relane(F);
    LAS float* qs = (LAS float*)(F.lds + RING_OFF + F.wave * 2048);
    LAS float* ps = qs + 256;
    for (int w = F.gw; w < M * XA_H; w += F.NGW) {
        const int tok = w >> 2, h = w & 3, b = tok >> 11;
        { const unsigned long long qw = *((const GAS unsigned long long*)(XQ + (size_t)tok * D + h * 256) + F.lane);
          qs[4 * F.lane] = bflo((unsigned)qw); qs[4 * F.lane + 1] = bfhi((unsigned)qw); qs[4 * F.lane + 2] = bflo((unsigned)(qw >> 32)); qs[4 * F.lane + 3] = bfhi((unsigned)(qw >> 32)); }
        LDS_WAIT(); asm volatile("" ::: "memory");
        float sc[4], mx = -INFINITY;
#pragma unroll
        for (int j = 0; j < 4; ++j) {
            const GAS v4u* kp = (const GAS v4u*)(KVl + (size_t)(b * NMEM + F.lane + 64 * j) * 8192 + h * 256);
            float s = 0.f;
#pragma unroll 8
            for (int c = 0; c < 32; ++c) { const v4u kw = kp[c]; const LAS float* qq = qs + 8 * c;
                s += qq[0] * bflo(kw.x) + qq[1] * bfhi(kw.x) + qq[2] * bflo(kw.y) + qq[3] * bfhi(kw.y) + qq[4] * bflo(kw.z) + qq[5] * bfhi(kw.z) + qq[6] * bflo(kw.w) + qq[7] * bfhi(kw.w); }
            sc[j] = s * 0.0625f; mx = fmaxf(mx, sc[j]);
        }
        mx = wave_max(mx);
        float sum = 0.f;
#pragma unroll
        for (int j = 0; j < 4; ++j) { sc[j] = __expf(sc[j] - mx); sum += sc[j]; }
        const float inv = 1.f / wave_sum(sum);
#pragma unroll
        for (int j = 0; j < 4; ++j) ps[F.lane + 64 * j] = sc[j] * inv;
        LDS_WAIT(); asm volatile("" ::: "memory");
        float o[4] = {0.f, 0.f, 0.f, 0.f};
        const GAS unsigned long long* vp = (const GAS unsigned long long*)(KVl + (size_t)(b * NMEM) * 8192 + 1024 + h * 256) + F.lane;
#pragma unroll 8
        for (int mi = 0; mi < NMEM; ++mi) { const float p = ps[mi]; const unsigned long long vw = vp[(size_t)mi * (8192 / 4)];
            o[0] += p * bflo((unsigned)vw); o[1] += p * bfhi((unsigned)vw); o[2] += p * bflo((unsigned)(vw >> 32)); o[3] += p * bfhi((unsigned)(vw >> 32)); }
        *((GAS unsigned long long*)(MIX + (size_t)tok * D + h * 256) + F.lane) = (unsigned long long)pk2(o[0], o[1]) | ((unsigned long long)pk2(o[2], o[3]) << 32);
        LDS_WAIT(); asm volatile("" ::: "memory");
    }
}

template <int MR, int N, int K, class Epi> __device__ __forceinline__ void run_gemm(Frame& F, const bf16* A, const bf16* Bt, const Epi E) {
    int gd = gridDim.x, bi = blockIdx.x; asm volatile("" : "+s"(gd), "+s"(bi));
    pg8::Gemm g{A, Bt, MR, N, K}; pg8::StaticOrder S; S.init(MR, N, gd, bi);
    pg8::gemm_phase<Epi, pg8::StaticOrder, true, true>(F.lds + RING_OFF, g, S, E);
}
struct Args { const float* in[15]; float* out; unsigned char* ws; int pad[2]; };
__global__ void __launch_bounds__(NWAVES * 64, 2) mega_fwd(Args args) {
    extern __shared__ __attribute__((aligned(16))) unsigned char lds[];
    Frame F;
    F.lds = (LAS unsigned char*)lds; F.ws = args.ws;
    relane(F);
    for (int u = F.tid; u < (LDS_BYTES - LDSCTL_OFF) / 4; u += NWAVES * 64) ((LAS unsigned*)(F.lds + LDSCTL_OFF))[u] = 0u;
    __syncthreads();
    if (F.tid < 16) { const unsigned long long p = (F.tid < 15) ? (unsigned long long)args.in[F.tid < 15 ? F.tid : 0] : (unsigned long long)args.out;
        ((LAS unsigned*)(F.lds + LDSCTL_OFF))[2 * F.tid] = (unsigned)p; ((LAS unsigned*)(F.lds + LDSCTL_OFF))[2 * F.tid + 1] = (unsigned)(p >> 32); }
    __syncthreads();
    gu32* ctl = (gu32*)(F.ws + WS_CTL);
    XcdBarrier bar = xcd_barrier_post((unsigned*)(ctl + CW_BAR), (volatile LAS unsigned*)(F.lds + MISC_OFF) + 8);
#define GRID_BAR() xcd_barrier(bar)

#define Wb ((bf16*)(F.ws + WS_W))
#define XN ((bf16*)(F.ws + WS_XN))
#define MIX ((bf16*)(F.ws + WS_MIX))
#define BIG ((bf16*)(F.ws + WS_BIG))
#define XQ (BIG + (size_t)M * D)
#define KV ((bf16*)(F.ws + WS_KV))
#define MEMN ((bf16*)(F.ws + WS_MEMN))
#define GT ((float*)(F.ws + WS_GATES))
#define gains inp(F, 3)

    p0_convert(F);
    row_phase(F, inp(F, 0), (float*)inp(F, 15), nullptr, nullptr, gains, XN, inp(F, 4) + 3072, ML_W, inp(F, 5), GT);
    GRID_BAR();
    run_gemm<MM, 8192, D>(F, MEMN, Wb + W_KV, EpiStore{KV, 8192});

#pragma unroll 1
    for (int l = 0; l < DEPTH; ++l) {
#define WL (Wb + W_LAYER0 + (size_t)l * WL_SIZE)
#define GL (gains + (size_t)l * 6 * D)
        const bool ml = (l & 1) == 0;
        run_gemm<M, 3072, D>(F, XN, WL + WL_IN, EpiStore{BIG, 3072}); GRID_BAR();
        if (ml) { mlstm_scan_v1(F, BIG, GT, MIX); GRID_BAR(); mlstm_post_v1(F, BIG, inp(F, 6) + (size_t)(l >> 1) * D, MIX); } else sb_attn_v1(F, BIG, MIX);
        GRID_BAR();
        run_gemm<M, D, D>(F, MIX, WL + WL_OUT, EpiStore{BIG, D}); GRID_BAR();
        row_phase(F, (float*)inp(F, 15), (float*)inp(F, 15), BIG, GL + D, GL + 2 * D, XN, nullptr, 0, nullptr, nullptr); GRID_BAR();
        run_gemm<M, D, D>(F, XN, WL + WL_Q, EpiStore{XQ, D}); GRID_BAR();
        xattn_v1(F, XQ, KV + (size_t)l * 2048, MIX); GRID_BAR();
        run_gemm<M, D, D>(F, MIX, WL + WL_O, EpiStore{BIG, D}); GRID_BAR();
        row_phase(F, (float*)inp(F, 15), (float*)inp(F, 15), BIG, GL + 3 * D, GL + 4 * D, XN, nullptr, 0, nullptr, nullptr); GRID_BAR();
        run_gemm<M, 2 * DFF, D>(F, XN, WL + WL_GU, EpiSwiglu{BIG, DFF}); GRID_BAR();
        run_gemm<M, D, DFF>(F, BIG, WL + WL_DN, EpiStore{MIX, D}); GRID_BAR();
        { const bool last = (l + 1 == DEPTH), gates = !last && (((l + 1) & 1) == 0);
          row_phase(F, (float*)inp(F, 15), (float*)inp(F, 15), MIX, GL + 5 * D, last ? nullptr : GL + 6 * D, XN,
                    gates ? inp(F, 4) + (size_t)((l + 1) >> 1) * D * ML_W + 3072 : nullptr, ML_W, inp(F, 5) + ((l + 1) >> 1) * 8, GT);
          if (!last) GRID_BAR(); }
    }
}

extern "C" void kernel_launch(void* const* d_in, const int* in_sizes, int n_in, void* d_out, int out_size, void* d_ws, size_t ws_size, hipStream_t stream) {
    static int grid = 0;
    if (grid == 0) {
        if (n_in != 15 || out_size != M * D || ws_size < WS_END) { fprintf(stderr, "kernel_launch: unexpected shapes (n_in %d out %d ws %zu need %zu)\n", n_in, out_size, ws_size, (size_t)WS_END); grid = -1; return; }
        int dev = 0, cus = 0, per_cu = 0;
        if (hipGetDevice(&dev) != hipSuccess || hipDeviceGetAttribute(&cus, hipDeviceAttributeMultiprocessorCount, dev) != hipSuccess) { grid = -1; return; }
        if (hipFuncSetAttribute((const void*)mega_fwd, hipFuncAttributeMaxDynamicSharedMemorySize, LDS_BYTES) != hipSuccess) { fprintf(stderr, "kernel_launch: hipFuncSetAttribute failed\n"); grid = -1; return; }
        if (hipOccupancyMaxActiveBlocksPerMultiprocessor(&per_cu, (const void*)mega_fwd, NWAVES * 64, LDS_BYTES) != hipSuccess || per_cu < 1) fprintf(stderr, "kernel_launch: occupancy query reports %d\n", per_cu);
        (void)hipGetLastError();
        grid = cus;
    }
    if (grid < 0) return;
    if (hipMemsetAsync((char*)d_ws + WS_CTL, 0, CTL_ZERO_BYTES, stream) != hipSuccess) return;
    Args a{};
    for (int i = 0; i < 15; ++i) a.in[i] = (const float*)d_in[i];
    a.out = (float*)d_out; a.ws = (unsigned char*)d_ws;
    hipLaunchKernelGGL(mega_fwd, dim3(grid), dim3(NWAVES * 64), LDS_BYTES, stream, a);
}
```

```cpp
#include <hip/hip_runtime.h>
#include <cstdio>
#include <cstdint>
namespace pg8 {
#define PG8_LAS __attribute__((address_space(3)))
typedef unsigned short bf16_t;
typedef short bf16x8 __attribute__((ext_vector_type(8)));
typedef float f32x4 __attribute__((ext_vector_type(4)));
typedef unsigned u32x4 __attribute__((ext_vector_type(4)));
constexpr int BM = 256, BK = 64, HALF = 128, HTB = HALF * BK * 2  , STAGE_BYTES = 8 * HTB, NXCD = 8, WGM = 8;

__host__ __device__ __forceinline__ int lds_byte(int r, int c) { const int st = (r >> 4) * 2 + (c >> 5), rr = r & 15, cc = c & 31, ob = rr * 64 + cc * 2; return st * 1024 + (ob ^ (((ob >> 9) & 1) << 5)); }
__host__ __device__ __forceinline__ void stage_rc(int b, int& R, int& C) { const int st = b / 1024, sb = b % 1024, swz = sb ^ (((sb >> 9) & 1) << 5); R = (st >> 1) * 16 + swz / 64; C = (st & 1) * 32 + (swz % 64) / 2; }
__host__ __device__ __forceinline__ int perm32(int rho) { const int n = rho >> 4, i = rho & 15; return 8 * (i >> 2) + 4 * n + (i & 3); }

struct Unit { int pm, pn; size_t aoff, boff; };
struct Gemm { const bf16_t* A; const bf16_t* Bt; int M, N, K, lda, ldb; };

struct StaticOrder {
    int nM, nN, nwg, G, c, pmb; size_t a_rt, b_rt, b_batch;
    __host__ __device__ void init(int M, int N, int G_, int c_, int lda, int ldb, int pmb_ = 0, size_t b_batch_ = 0) { nM = M / BM; nN = N / BM; nwg = nM * nN; G = G_; c = c_; a_rt = (size_t)BM * lda * 2; b_rt = (size_t)BM * ldb * 2; pmb = pmb_; b_batch = b_batch_; }
    __host__ __device__ bool next(int i, Unit& u) const {
        const long L = (long)i * G + c; if (L >= nwg) return false;
        int wgid = (int)L; { const int q = nwg / NXCD, r = nwg % NXCD, xcd = wgid % NXCD, off = wgid / NXCD; wgid = (xcd < r ? xcd * (q + 1) : r * (q + 1) + (xcd - r) * q) + off; }
        const int nig = WGM * nN, gid = wgid / nig, fm = gid * WGM, gsz = (nM - fm) < WGM ? (nM - fm) : WGM;
        u.pm = fm + ((wgid % nig) % gsz); u.pn = (wgid % nig) / gsz; u.aoff = (size_t)u.pm * a_rt; u.boff = (size_t)u.pn * b_rt + (pmb ? (size_t)(u.pm / pmb) * b_batch : 0); return true;
    }
    __device__ __forceinline__ void a_ready(const Unit&) const {}
    __device__ __forceinline__ void done(const Unit&) const {}
};

__device__ __forceinline__ unsigned cvt_pk_bf16(float lo, float hi) { unsigned r; asm volatile("v_cvt_pk_bf16_f32 %0, %1, %2" : "=v"(r) : "v"(lo), "v"(hi)); return r; }
typedef float f32x2 __attribute__((ext_vector_type(2)));
__device__ __forceinline__ f32x2 gelu_pk(f32x2 v) {
    const f32x2 av = __builtin_elementwise_abs(v), d = av * 0.2316418882f + 1.0f;
    f32x2 t; t.x = __builtin_amdgcn_rcpf(d.x); t.y = __builtin_amdgcn_rcpf(d.y);
    f32x2 q = t * 0.5307027145f + (-0.7265760135f); q = q * t + 0.7107068705f; q = q * t + (-0.142248368f); q = q * t + 0.127414796f; q = q * t;
    const f32x2 s = (v * v) * (-0.72134752044f);
    f32x2 e; e.x = __builtin_amdgcn_exp2f(s.x); e.y = __builtin_amdgcn_exp2f(s.y);
    const f32x2 m = v * (q * e), r = v - m;
    f32x2 o; o.x = v.x < 0.f ? m.x : r.x; o.y = v.y < 0.f ? m.y : r.y; return o;
}

template <int ACT  > struct EpiBf16 {
    static constexpr bool PERM = true, AFTER_DRAIN = false; static_assert(ACT == 0 || ACT == 1, "EpiBf16: ACT is 0 (none) or 1 (gelu_pk)");
    bf16_t* O; int ldc; const float* bias; int split_cols; size_t split_stride; float scale0;
    __device__ __forceinline__ void operator()(const f32x4 (&acc)[2][2][4][2], const Unit& u, int wr, int wc, int fr, int fq) const {
        const int row0 = u.pm * BM + wr * 64 + fr; int colt = u.pn * BM; bf16_t* base = O;
        float sc = 1.f; if (split_cols) { const int t = colt / split_cols; base += (size_t)t * split_stride; colt -= t * split_cols; if (t == 0) sc = scale0; }
        const int col0 = colt + wc * 32 + 8 * fq, bcol0 = u.pn * BM + wc * 32 + 8 * fq;
        f32x4 bv[2][2];
#pragma unroll
        for (int bj = 0; bj < 2; ++bj)
#pragma unroll
            for (int n = 0; n < 2; ++n) bv[bj][n] = bias ? *(const f32x4*)(bias + bcol0 + bj * HALF + 4 * n) : (f32x4){0.f, 0.f, 0.f, 0.f};
#pragma unroll
        for (int ai = 0; ai < 2; ++ai)
#pragma unroll
            for (int m = 0; m < 4; ++m) { bf16_t* rowp = base + (size_t)(row0 + ai * HALF + m * 16) * ldc + col0;
#pragma unroll
                for (int bj = 0; bj < 2; ++bj) { f32x4 v0 = acc[ai][bj][m][0] + bv[bj][0], v1 = acc[ai][bj][m][1] + bv[bj][1];
                    if (ACT == 1) { f32x2 a = gelu_pk((f32x2){v0[0], v0[1]}), b = gelu_pk((f32x2){v0[2], v0[3]}), c = gelu_pk((f32x2){v1[0], v1[1]}), d = gelu_pk((f32x2){v1[2], v1[3]});
                        v0 = (f32x4){a.x, a.y, b.x, b.y}; v1 = (f32x4){c.x, c.y, d.x, d.y}; }
                    v0 = v0 * sc; v1 = v1 * sc; u32x4 w; w.x = cvt_pk_bf16(v0[0], v0[1]); w.y = cvt_pk_bf16(v0[2], v0[3]); w.z = cvt_pk_bf16(v1[0], v1[1]); w.w = cvt_pk_bf16(v1[2], v1[3]);
                    *(u32x4*)(rowp + bj * HALF) = w; } }
    }
};

struct PanelStats {
    unsigned* xbuf;
    unsigned* cnt;
    unsigned* tmo;
    int ntn; float eps;
    unsigned code;
    __device__ __forceinline__ bool run(const f32x4 (&v)[2][2][4][2], const Unit& u, int wr, int wc, int fr, int fq, PG8_LAS unsigned char* lds, int wid, int lane) const {
        typedef float f32x2v __attribute__((ext_vector_type(2)));
        PG8_LAS f32x2v* P = (PG8_LAS f32x2v*)lds;
        PG8_LAS f32x2v* S = (PG8_LAS f32x2v*)(lds + 8192);
        PG8_LAS unsigned* flag = (PG8_LAS unsigned*)(lds + 8192 + 2048);
#pragma unroll
        for (int ai = 0; ai < 2; ++ai)
#pragma unroll
            for (int m = 0; m < 4; ++m) {
                float s = 0.f;
#pragma unroll
                for (int bj = 0; bj < 2; ++bj)
#pragma unroll
                    for (int n = 0; n < 2; ++n) { const f32x4 x = v[ai][bj][m][n]; s += (x[0] + x[1]) + (x[2] + x[3]); }
                s += __shfl_xor(s, 16); s += __shfl_xor(s, 32);
                const float mw = s * (1.0f / 64.0f); float q = 0.f;
#pragma unroll
                for (int bj = 0; bj < 2; ++bj)
#pragma unroll
                    for (int n = 0; n < 2; ++n) { const f32x4 d = v[ai][bj][m][n] - mw; q += (d[0] * d[0] + d[1] * d[1]) + (d[2] * d[2] + d[3] * d[3]); }
                q += __shfl_xor(q, 16); q += __shfl_xor(q, 32);
                if (fq == 0) P[(ai * HALF + wr * 64 + m * 16 + fr) * 4 + wc] = (f32x2v){mw, q};
            }
        asm volatile("s_waitcnt lgkmcnt(0)" ::: "memory"); __builtin_amdgcn_s_barrier(); asm volatile("" ::: "memory");
#if defined(BROKEN_EXCHANGE_NO_WAIT)
#warning BROKEN CONTROL BUILD: the row-statistics exchange does not wait; results are wrong by design
        if (blockIdx.x >= 64) { const long long t0_ = clock64(); while (clock64() - t0_ < 60000) __builtin_amdgcn_s_sleep(8); }
#endif
        const int row = wid * 32 + (lane & 31);
        if (lane < 32) {
            const f32x2v a = P[row * 4 + 0], b = P[row * 4 + 1], c = P[row * 4 + 2], d = P[row * 4 + 3];
            const float mt = (a.x + b.x + c.x + d.x) * 0.25f;
            const float da = a.x - mt, db = b.x - mt, dc = c.x - mt, dd = d.x - mt;
            const float m2 = (a.y + b.y) + (c.y + d.y) + 64.0f * ((da * da + db * db) + (dc * dc + dd * dd));
            unsigned long long* slot = (unsigned long long*)xbuf + ((size_t)(u.pm * BM + row) * 4 + u.pn);
            __hip_atomic_store(slot, ((unsigned long long)__float_as_uint(m2) << 32) | __float_as_uint(mt), __ATOMIC_RELAXED, __HIP_MEMORY_SCOPE_AGENT);
        }
        asm volatile("s_waitcnt vmcnt(0)" ::: "memory");
        if (lane == 0) __hip_atomic_fetch_add(cnt + 64 * u.pm, 1u, __ATOMIC_RELAXED, __HIP_MEMORY_SCOPE_AGENT);
        if (wid == 0) {
            bool dead = false; const unsigned long long t0 = __builtin_amdgcn_s_memrealtime(); const unsigned want = 8u * (unsigned)ntn;
            for (;;) {
#if defined(BROKEN_EXCHANGE_NO_WAIT)
                break;
#endif
                if ((unsigned)__builtin_amdgcn_readfirstlane(__hip_atomic_load(cnt + 64 * u.pm, __ATOMIC_RELAXED, __HIP_MEMORY_SCOPE_AGENT)) >= want) break;
                if (__builtin_amdgcn_s_memrealtime() - t0 > 2000000ull) {
                    if (lane == 0) { unsigned expect = 0u; __hip_atomic_compare_exchange_strong(tmo + 1, &expect, code | (unsigned)(u.pm & 0xff), __ATOMIC_RELAXED, __ATOMIC_RELAXED, __HIP_MEMORY_SCOPE_AGENT);
                                     __hip_atomic_store(tmo, 1u, __ATOMIC_RELAXED, __HIP_MEMORY_SCOPE_AGENT); }
                    dead = true; break; }
                __builtin_amdgcn_s_sleep(2);
            }
            __builtin_amdgcn_fence(__ATOMIC_ACQUIRE, "agent");
            if (lane == 0) flag[0] = dead ? 1u : 0u;
        }
        asm volatile("s_waitcnt vmcnt(0) lgkmcnt(0)" ::: "memory"); __builtin_amdgcn_s_barrier(); asm volatile("" ::: "memory");
        const bool bad = flag[0] != 0u;
        if (lane < 32) {
            const unsigned long long* slot = (const unsigned long long*)xbuf + (size_t)(u.pm * BM + row) * 4; float mt[4], m2[4]; float ms = 0.f;
#pragma unroll
            for (int t = 0; t < 4; ++t) { if (t < ntn) { const unsigned long long w = __hip_atomic_load(slot + t, __ATOMIC_RELAXED, __HIP_MEMORY_SCOPE_AGENT); mt[t] = __uint_as_float((unsigned)w); m2[t] = __uint_as_float((unsigned)(w >> 32)); } else { mt[t] = 0.f; m2[t] = 0.f; } ms += mt[t]; }
            const float mean = ms / (float)ntn; float q = 0.f;
#pragma unroll
            for (int t = 0; t < 4; ++t) if (t < ntn) { const float dm = mt[t] - mean; q += m2[t] + 256.0f * dm * dm; }
            S[row] = (f32x2v){mean, 1.0f / sqrtf(q / (256.0f * (float)ntn) + eps)};
        }
        asm volatile("s_waitcnt lgkmcnt(0)" ::: "memory"); __builtin_amdgcn_s_barrier(); asm volatile("" ::: "memory");
        return bad;
    }
};
struct EpiLnRes {
    static constexpr bool PERM = false, AFTER_DRAIN = true;
    const float* base; float* out; int ldc; const float* bias; PanelStats st; unsigned poison;
    __device__ __forceinline__ void fused(f32x4 (&acc)[2][2][4][2], const Unit& u, int wr, int wc, int fr, int fq, PG8_LAS unsigned char* lds, int wid, int lane) const {
        typedef float f32x2v __attribute__((ext_vector_type(2)));
        const PG8_LAS f32x2v* S = (const PG8_LAS f32x2v*)(lds + 8192);
        const int col0 = u.pn * BM + wc * 32 + 4 * fq;
#pragma unroll
        for (int bj = 0; bj < 2; ++bj)
#pragma unroll
            for (int n = 0; n < 2; ++n) { const f32x4 bv = bias ? *(const f32x4*)(bias + col0 + bj * HALF + n * 16) : (f32x4){0.f, 0.f, 0.f, 0.f};
#pragma unroll
                for (int ai = 0; ai < 2; ++ai)
#pragma unroll
                    for (int m = 0; m < 4; ++m) acc[ai][bj][m][n] += bv; }
        f32x4 pre[4][2][2];
#pragma unroll
        for (int m = 0; m < 4; ++m) { const size_t off = (size_t)(u.pm * BM + wr * 64 + m * 16 + fr) * ldc + col0;
#pragma unroll
            for (int bj = 0; bj < 2; ++bj)
#pragma unroll
                for (int n = 0; n < 2; ++n) pre[m][bj][n] = *(const f32x4*)(base + off + bj * HALF + n * 16); }
        const bool bad = st.run(acc, u, wr, wc, fr, fq, lds, wid, lane) || poison != 0u;
        const float qnan = __builtin_nanf("");
#pragma unroll
        for (int ai = 0; ai < 2; ++ai)
#pragma unroll
            for (int m = 0; m < 4; ++m) { const int r = ai * HALF + wr * 64 + m * 16 + fr; const f32x2v sr = S[r]; const size_t off = (size_t)(u.pm * BM + r) * ldc + col0;
#pragma unroll
                for (int bj = 0; bj < 2; ++bj)
#pragma unroll
                    for (int n = 0; n < 2; ++n) { const f32x4 bs = ai == 0 ? pre[m][bj][n] : *(const f32x4*)(base + off + bj * HALF + n * 16); f32x4 o = bs + (acc[ai][bj][m][n] - sr.x) * sr.y;
                        if (bad) o = (f32x4){qnan, qnan, qnan, qnan}; *(f32x4*)(out + off + bj * HALF + n * 16) = o; }
                if (m & 1) asm volatile("" ::: "memory"); }
    }
};
struct EpiLnResLn {
    static constexpr bool PERM = false, AFTER_DRAIN = true;
    const float* base; float* out; bf16_t* xn; int ldc; const float* bias; PanelStats st1, st2; unsigned poison;
    __device__ __forceinline__ void fused(f32x4 (&acc)[2][2][4][2], const Unit& u, int wr, int wc, int fr, int fq, PG8_LAS unsigned char* lds, int wid, int lane) const {
        typedef float f32x2v __attribute__((ext_vector_type(2))); typedef unsigned u32x2v __attribute__((ext_vector_type(2)));
        const PG8_LAS f32x2v* S = (const PG8_LAS f32x2v*)(lds + 8192);
        const int col0 = u.pn * BM + wc * 32 + 4 * fq;
#pragma unroll
        for (int bj = 0; bj < 2; ++bj)
#pragma unroll
            for (int n = 0; n < 2; ++n) { const f32x4 bv = bias ? *(const f32x4*)(bias + col0 + bj * HALF + n * 16) : (f32x4){0.f, 0.f, 0.f, 0.f};
#pragma unroll
                for (int ai = 0; ai < 2; ++ai)
#pragma unroll
                    for (int m = 0; m < 4; ++m) acc[ai][bj][m][n] += bv; }
        bool bad = st1.run(acc, u, wr, wc, fr, fq, lds, wid, lane) || poison != 0u;
        const float qnan = __builtin_nanf("");
#pragma unroll
        for (int ai = 0; ai < 2; ++ai)
#pragma unroll
            for (int m = 0; m < 4; ++m) { const int r = ai * HALF + wr * 64 + m * 16 + fr; const f32x2v sr = S[r]; const size_t off = (size_t)(u.pm * BM + r) * ldc + col0;
#pragma unroll
                for (int bj = 0; bj < 2; ++bj)
#pragma unroll
                    for (int n = 0; n < 2; ++n) { const f32x4 bs = *(const f32x4*)(base + off + bj * HALF + n * 16); acc[ai][bj][m][n] = bs + (acc[ai][bj][m][n] - sr.x) * sr.y; }
                asm volatile("" : "+v"(acc[ai][0][m][0]), "+v"(acc[ai][0][m][1]), "+v"(acc[ai][1][m][0]), "+v"(acc[ai][1][m][1]));
                if (m & 1) asm volatile("" ::: "memory"); }
        const bool bad1 = bad;
        bad = st2.run(acc, u, wr, wc, fr, fq, lds, wid, lane) || bad;
#pragma unroll
        for (int ai = 0; ai < 2; ++ai)
#pragma unroll
            for (int m = 0; m < 4; ++m) { const int r = ai * HALF + wr * 64 + m * 16 + fr; const f32x2v sr = S[r]; const size_t off = (size_t)(u.pm * BM + r) * ldc + col0;
#pragma unroll
                for (int bj = 0; bj < 2; ++bj)
#pragma unroll
                    for (int n = 0; n < 2; ++n) { const f32x4 x1 = acc[ai][bj][m][n]; *(f32x4*)(out + off + bj * HALF + n * 16) = bad1 ? (f32x4){qnan, qnan, qnan, qnan} : x1;
                        const f32x4 o = (x1 - sr.x) * sr.y; u32x2v w; w.x = cvt_pk_bf16(o[0], o[1]); w.y = cvt_pk_bf16(o[2], o[3]);
                        if (bad) { w.x = 0x7fc07fc0u; w.y = 0x7fc07fc0u; } *(u32x2v*)(xn + off + bj * HALF + n * 16) = w; }
                asm volatile("" ::: "memory"); }
    }
};

template <class Epi, class Sched, bool ALIGN_EPI = false, bool SP2 = false>
__device__ __forceinline__ void gemm_phase(PG8_LAS unsigned char* lds, const Gemm g, const Sched& S, const Epi& E) {
    int tid_ = threadIdx.x; asm volatile("" : "+v"(tid_));
    const int tid = tid_, wid = __builtin_amdgcn_readfirstlane(tid >> 6), lane = tid & 63, wr = wid >> 2, wc = wid & 3, fr = lane & 15, fq = lane >> 4;
    const int K = g.K, nt = K / BK;
    unsigned voffA[2], voffB[2];
#pragma unroll
    for (int i = 0; i < 2; ++i) { int R, C; stage_rc(tid * 16 + i * 8192, R, C); const int Rb = Epi::PERM ? ((R & ~31) + perm32(R & 31)) : R;
        voffA[i] = (unsigned)(R * g.lda + C) * 2u; voffB[i] = (unsigned)(Rb * g.ldb + C) * 2u; }
    const size_t kstep = (size_t)(BK * 2);
    const size_t hstepA = (size_t)HALF * g.lda * 2, hstepB = (size_t)HALF * g.ldb * 2;
    const unsigned ldsw = (unsigned)wid * 1024u;
    const int aoff = lds_byte(wr * 64 + fr, fq * 8), boff = lds_byte(wc * 32 + fr, fq * 8);
#define PG8_SA(b, h) (((b) * 2 + (h)) * HTB)
#define PG8_SB(b, h) ((4 + (b) * 2 + (h)) * HTB)
#define PG8_STAGE(bufoff, gbase, voff) do { _Pragma("unroll") for (int _i = 0; _i < 2; ++_i) \
        __builtin_amdgcn_global_load_lds((const unsigned*)((const char*)(gbase) + (voff)[_i]), (PG8_LAS unsigned*)(lds + (bufoff) + ldsw + _i * 8192), 16, 0, 0); } while (0)
#define PG8_LDA(dst, b, h) do { _Pragma("unroll") for (int m = 0; m < 4; ++m) _Pragma("unroll") for (int k = 0; k < 2; ++k) dst[m][k] = *(const PG8_LAS bf16x8*)(lds + PG8_SA(b, h) + aoff + m * 2048 + k * 1024); } while (0)
#define PG8_LDB(dst, b, h) do { _Pragma("unroll") for (int n = 0; n < 2; ++n) _Pragma("unroll") for (int k = 0; k < 2; ++k) dst[n][k] = *(const PG8_LAS bf16x8*)(lds + PG8_SB(b, h) + boff + n * 2048 + k * 1024); } while (0)
#define PG8_MMA(ai, bj, At, Bt) do { __builtin_amdgcn_s_setprio(1); _Pragma("unroll") for (int m = 0; m < 4; ++m) _Pragma("unroll") for (int n = 0; n < 2; ++n) _Pragma("unroll") for (int k = 0; k < 2; ++k) \
        acc[ai][bj][m][n] = __builtin_amdgcn_mfma_f32_16x16x32_bf16(Bt[n][k], At[m][k], acc[ai][bj][m][n], 0, 0, 0); __builtin_amdgcn_s_setprio(0); } while (0)
#define PG8_WAIT_V(n) asm volatile("s_waitcnt vmcnt(" #n ")" ::: "memory")
#define PG8_WAIT_L(n) asm volatile("s_waitcnt lgkmcnt(" #n ")" ::: "memory")
#define PG8_BAR __builtin_amdgcn_s_barrier()
#define PG8_SCHED __builtin_amdgcn_sched_barrier(0)
    Unit cur, nxt; int ui = 0;
    if (!S.next(0, cur)) return;
    f32x4 acc[2][2][4][2];
#pragma unroll
    for (int a = 0; a < 2; ++a)
#pragma unroll
        for (int b = 0; b < 2; ++b)
#pragma unroll
            for (int m = 0; m < 4; ++m)
#pragma unroll
                for (int n = 0; n < 2; ++n) acc[a][b][m][n] = (f32x4){0.f, 0.f, 0.f, 0.f};
    bf16x8 At[4][2], B0[2][2], B1[2][2];
    const char* cA = (const char*)g.A + cur.aoff; const char* cB = (const char*)g.Bt + cur.boff;
    S.a_ready(cur);
    if constexpr (SP2) {
        PG8_STAGE(PG8_SB(0, 0), cB, voffB); PG8_STAGE(PG8_SB(0, 1), cB + hstepB, voffB); PG8_STAGE(PG8_SA(0, 0), cA, voffA); PG8_STAGE(PG8_SA(0, 1), cA + hstepA, voffA);
        if (wr == 1) PG8_BAR;
        PG8_WAIT_V(2); PG8_BAR;
        PG8_STAGE(PG8_SB(1, 0), cB + kstep, voffB); PG8_STAGE(PG8_SA(1, 0), cA + kstep, voffA); PG8_STAGE(PG8_SB(1, 1), cB + hstepB + kstep, voffB);
        PG8_WAIT_V(6); PG8_BAR;
    } else {
        PG8_STAGE(PG8_SB(0, 0), cB, voffB); PG8_STAGE(PG8_SA(0, 0), cA, voffA); PG8_STAGE(PG8_SB(0, 1), cB + hstepB, voffB); PG8_STAGE(PG8_SA(0, 1), cA + hstepA, voffA);
        if (wr == 1) PG8_BAR;
        PG8_WAIT_V(4); PG8_BAR;
        PG8_STAGE(PG8_SB(1, 0), cB + kstep, voffB); PG8_STAGE(PG8_SA(1, 0), cA + kstep, voffA); PG8_STAGE(PG8_SB(1, 1), cB + hstepB + kstep, voffB);
        PG8_WAIT_V(6); PG8_BAR;
    }
    for (;;) {
        const bool has_next = S.next(ui + 1, nxt);
        const char* nA = has_next ? (const char*)g.A + nxt.aoff : cA; const char* nB = has_next ? (const char*)g.Bt + nxt.boff : cB;
        for (int t = 0; t < nt; t += 2) {
            const bool last = (t == nt - 2);
            const char* a1 = cA + (size_t)(t + 1) * kstep;
            const char* a2 = last ? nA : cA + (size_t)(t + 2) * kstep; const char* b2 = last ? nB : cB + (size_t)(t + 2) * kstep;
            const char* a3 = a2 + kstep; const char* b3 = b2 + kstep;
            if (last && has_next) S.a_ready(nxt);
            if constexpr (SP2) {
            PG8_LDB(B0, 0, 0); PG8_LDB(B1, 0, 1); PG8_SCHED; PG8_LDA(At, 0, 0); PG8_STAGE(PG8_SA(1, 1), a1 + hstepA, voffA);
            PG8_WAIT_V(8); PG8_WAIT_L(0); PG8_BAR; PG8_MMA(0, 0, At, B0); PG8_MMA(0, 1, At, B1); PG8_BAR; PG8_SCHED;
            PG8_LDA(At, 0, 1); PG8_STAGE(PG8_SB(0, 0), b2, voffB); PG8_STAGE(PG8_SB(0, 1), b2 + hstepB, voffB); PG8_STAGE(PG8_SA(0, 0), a2, voffA);
            PG8_WAIT_V(8); PG8_WAIT_L(0); PG8_BAR; PG8_MMA(1, 0, At, B0); PG8_MMA(1, 1, At, B1); PG8_BAR; PG8_SCHED;
            PG8_LDB(B0, 1, 0); PG8_LDB(B1, 1, 1); PG8_SCHED; PG8_LDA(At, 1, 0); PG8_STAGE(PG8_SA(0, 1), a2 + hstepA, voffA);
            PG8_WAIT_V(8); PG8_WAIT_L(0); PG8_BAR; PG8_MMA(0, 0, At, B0); PG8_MMA(0, 1, At, B1); PG8_BAR; PG8_SCHED;
            PG8_LDA(At, 1, 1); PG8_STAGE(PG8_SB(1, 0), b3, voffB); PG8_STAGE(PG8_SB(1, 1), b3 + hstepB, voffB); PG8_STAGE(PG8_SA(1, 0), a3, voffA);
            PG8_WAIT_V(8); PG8_WAIT_L(0); PG8_BAR; PG8_MMA(1, 0, At, B0); PG8_MMA(1, 1, At, B1); PG8_BAR; PG8_SCHED;
            } else {
            PG8_LDB(B0, 0, 0); PG8_SCHED; PG8_LDA(At, 0, 0); PG8_STAGE(PG8_SA(1, 1), a1 + hstepA, voffA);
            PG8_WAIT_L(8); PG8_BAR; PG8_WAIT_L(0); PG8_MMA(0, 0, At, B0); PG8_BAR; PG8_SCHED;
            PG8_LDB(B1, 0, 1); PG8_STAGE(PG8_SB(0, 0), b2, voffB);
            PG8_BAR; PG8_WAIT_L(0); PG8_MMA(0, 1, At, B1); PG8_BAR;
            PG8_LDA(At, 0, 1); PG8_STAGE(PG8_SA(0, 0), a2, voffA);
            PG8_BAR; PG8_WAIT_L(0); PG8_MMA(1, 0, At, B0); PG8_BAR; PG8_SCHED;
            PG8_STAGE(PG8_SB(0, 1), b2 + hstepB, voffB);
            PG8_WAIT_V(6); PG8_BAR; PG8_MMA(1, 1, At, B1); PG8_BAR;
            PG8_LDB(B0, 1, 0); PG8_SCHED; PG8_LDA(At, 1, 0); PG8_STAGE(PG8_SA(0, 1), a2 + hstepA, voffA);
            PG8_WAIT_L(8); PG8_BAR; PG8_WAIT_L(0); PG8_MMA(0, 0, At, B0); PG8_BAR; PG8_SCHED;
            PG8_LDB(B1, 1, 1); PG8_STAGE(PG8_SB(1, 0), b3, voffB);
            PG8_BAR; PG8_WAIT_L(0); PG8_MMA(0, 1, At, B1); PG8_BAR;
            PG8_LDA(At, 1, 1); PG8_STAGE(PG8_SA(1, 0), a3, voffA);
            PG8_BAR; PG8_WAIT_L(0); PG8_MMA(1, 0, At, B0); PG8_BAR; PG8_SCHED;
            PG8_STAGE(PG8_SB(1, 1), b3 + hstepB, voffB);
            PG8_WAIT_V(6); PG8_BAR; PG8_MMA(1, 1, At, B1); PG8_BAR;
            }
        }
        if constexpr (ALIGN_EPI) { if (wr == 0) PG8_BAR; }
        if constexpr (!Epi::AFTER_DRAIN) { E(acc, cur, wr, wc, fr, fq); S.done(cur); }
        if (!has_next) break;
#pragma unroll
        for (int a = 0; a < 2; ++a)
#pragma unroll
            for (int b = 0; b < 2; ++b)
#pragma unroll
                for (int m = 0; m < 4; ++m)
#pragma unroll
                    for (int n = 0; n < 2; ++n) acc[a][b][m][n] = (f32x4){0.f, 0.f, 0.f, 0.f};
        cur = nxt; cA = nA; cB = nB; ++ui;
        if constexpr (ALIGN_EPI) { if (wr == 1) PG8_BAR; }
    }
    PG8_WAIT_V(0);
    if constexpr (!ALIGN_EPI) { if (wr == 0) PG8_BAR; }
    PG8_BAR;
    if constexpr (Epi::AFTER_DRAIN) { E.fused(acc, cur, wr, wc, fr, fq, lds, wid, lane); S.done(cur); }
#undef PG8_SA
#undef PG8_SB
#undef PG8_STAGE
#undef PG8_LDA
#undef PG8_LDB
#undef PG8_MMA
#undef PG8_WAIT_V
#undef PG8_WAIT_L
#undef PG8_BAR
#undef PG8_SCHED
}
}
#define GAS __attribute__((address_space(1)))
#define LAS __attribute__((address_space(3)))
typedef unsigned short bf16;
typedef unsigned v4u __attribute__((ext_vector_type(4)));
typedef float f32x4 __attribute__((ext_vector_type(4)));
typedef short bf16x8 __attribute__((ext_vector_type(8)));
typedef GAS unsigned gu32;
typedef GAS unsigned long long gu64;
#define RLX_AGENT __ATOMIC_RELAXED, __HIP_MEMORY_SCOPE_AGENT
#define LDS_WAIT() asm volatile("s_waitcnt lgkmcnt(0)" ::: "memory")
#define VM_WAIT() asm volatile("s_waitcnt vmcnt(0)" ::: "memory")
__device__ __forceinline__ unsigned long long rt() { return __builtin_amdgcn_s_memrealtime(); }
__device__ __forceinline__ unsigned f2bf(float f) { unsigned u = __builtin_bit_cast(unsigned, f); return (u + 0x7fffu + ((u >> 16) & 1u)) >> 16; }
__device__ __forceinline__ unsigned pk2(float lo, float hi) { return f2bf(lo) | (f2bf(hi) << 16); }

#define XB_TMO      128
#define XB_XCNT(j)  (256  + 64 * (j))
#define XB_XSUB(j)  (1280 + 64 * (j))
#define XB_XGEN(j)  (2304 + 64 * (j))
#define XB_TOP      3328
#define XB_TOPGEN   3392
#define XCD_BAR_WORDS 3456
#define XB_SPIN_CAP (1u << 18)

__device__ __forceinline__ unsigned xb_ld(unsigned* p)              { return __hip_atomic_load(p, __ATOMIC_RELAXED, __HIP_MEMORY_SCOPE_AGENT); }
__device__ __forceinline__ unsigned xb_add(unsigned* p, unsigned v) { return __hip_atomic_fetch_add(p, v, __ATOMIC_RELAXED, __HIP_MEMORY_SCOPE_AGENT); }
__device__ __forceinline__ unsigned xb_xcc_id() { return (unsigned)__builtin_amdgcn_s_getreg((3 << 11) | 20) & 0xFu; }
#define XB_SPIN(cond, bar) do { unsigned _sp = 0; while (cond) { __builtin_amdgcn_s_sleep(1); \
    if ((++_sp & 255u) == 0u) { if (xb_ld(&(bar)[XB_TMO])) break; if (_sp > XB_SPIN_CAP) { atomicAdd(&(bar)[XB_TMO], 1u); break; } } } } while (0)

struct XcdBarrier {
    unsigned* bar; unsigned x;
    volatile LAS unsigned* st;
};

__device__ __forceinline__ XcdBarrier xcd_barrier_post(unsigned* bar, volatile LAS unsigned* st) {
    XcdBarrier b; b.bar = bar; b.x = xb_xcc_id(); b.st = st;
    if (threadIdx.x == 0) (void)xb_add(&bar[XB_XCNT(b.x)], 1u);
    return b;
}
__device__ __forceinline__ void xcd_barrier_complete(unsigned* bar, unsigned x, unsigned& nloc, unsigned& nx) {
    const unsigned G = gridDim.x * gridDim.y * gridDim.z;
    unsigned sum, cnt, mine, sp = 0u;
    for (;;) {
        sum = 0u; cnt = 0u; mine = 0u;
#pragma unroll
        for (unsigned j = 0; j < 16; ++j) { const unsigned c = xb_ld(&bar[XB_XCNT(j)]); sum += c; cnt += (c > 0u) ? 1u : 0u; mine = (j == x) ? c : mine; }
        if (sum == G) break;
        __builtin_amdgcn_s_sleep(1);
        if ((++sp & 255u) == 0u) { if (xb_ld(&bar[XB_TMO])) break; if (sp > XB_SPIN_CAP) { atomicAdd(&bar[XB_TMO], 1u); break; } }
    }
    nloc = mine > 0u ? mine : 1u; nx = cnt > 0u ? cnt : 1u;
}

__device__ __forceinline__ void xcd_barrier(const XcdBarrier& b) {
    asm volatile("s_waitcnt vmcnt(0)" ::: "memory");
    __syncthreads();
    if (threadIdx.x == 0) {
        unsigned* bar = b.bar;
        __builtin_amdgcn_s_waitcnt(0);
        unsigned nloc = b.st[0], nx = b.st[1];
        if (nloc == 0u) { xcd_barrier_complete(bar, b.x, nloc, nx); b.st[0] = nloc; b.st[1] = nx; }
        const unsigned old = xb_add(&bar[XB_XSUB(b.x)], 1u);
        const unsigned gen = old / nloc;
        if (old + 1u == (gen + 1u) * nloc) {
            __builtin_amdgcn_fence(__ATOMIC_RELEASE, "agent");
            asm volatile("s_waitcnt vmcnt(0)" ::: "memory");
            const unsigned og = xb_add(&bar[XB_TOP], 1u);
            const unsigned tg = og / nx;
            if (og + 1u == (tg + 1u) * nx) xb_add(&bar[XB_TOPGEN], 1u);
            else XB_SPIN(xb_ld(&bar[XB_TOPGEN]) == tg, bar);
            __builtin_amdgcn_fence(__ATOMIC_ACQUIRE, "agent");
            xb_add(&bar[XB_XGEN(b.x)], 1u);
            asm volatile("s_waitcnt vmcnt(0)" ::: "memory");
        } else {
            XB_SPIN(xb_ld(&bar[XB_XGEN(b.x)]) == gen, bar);
            __builtin_amdgcn_fence(__ATOMIC_ACQUIRE, "agent");
            asm volatile("s_waitcnt vmcnt(0)" ::: "memory");
        }
    }
    __syncthreads();
}

constexpr int D = 1024, BATCH = 8, SEQ = 2048, DEPTH = 4, NMEM = 256;
constexpr int M = BATCH * SEQ;
constexpr int MM = BATCH * NMEM;
constexpr int ML_H = 4, ML_DK = 128, ML_DV = 256, ML_W = 3080;
constexpr int SB_H = 16, SB_DH = 64;
constexpr int XA_H = 4, XA_DH = 256;
constexpr int DFF = 2816;
constexpr float EPS = 1e-6f;
constexpr int NWAVES = 8;

constexpr size_t MiB = 1u << 20;
constexpr size_t WS_CTL = 0, CTL_ZERO_BYTES = 1 * MiB;
constexpr size_t WS_WG = 1 * MiB;
constexpr size_t WS_GATES = 1 * MiB + 512 * 1024;
constexpr size_t WS_MEMN = 2 * MiB;
constexpr size_t WS_W = 8 * MiB;
constexpr size_t WL_IN = 0, WL_OUT = WL_IN + (size_t)3072 * 1024, WL_QN = WL_OUT + (size_t)1024 * 1024, WL_OT = WL_QN + (size_t)1024 * 1024,
                 WL_GU = WL_OT + (size_t)1024 * 1024, WL_DN = WL_GU + (size_t)5632 * 1024, WL_SIZE = WL_DN + (size_t)1024 * 2816;
constexpr size_t WS_XWT = WS_W + 4 * WL_SIZE * 2;
static_assert(WS_XWT == 122 * MiB, "weight region size");
constexpr size_t WS_KV = WS_XWT + 32 * MiB;
constexpr size_t WS_XN = WS_KV + 32 * MiB;
constexpr size_t WS_MIX = WS_XN + 32 * MiB;
constexpr size_t WS_BIG = WS_MIX + 32 * MiB;
constexpr size_t WS_END = WS_BIG + 96 * MiB;
constexpr int CW_BAR = 4096;

constexpr int RING_OFF = 0, RING_BYTES = 131072;
constexpr int LDSCTL_OFF = RING_BYTES, MISC_OFF = LDSCTL_OFF + 320;
constexpr int LDS_BYTES = 147456;

__device__ __forceinline__ float wave_sum(float v) {
#pragma unroll
    for (int o = 1; o < 64; o <<= 1) v += __shfl_xor(v, o);
    return v;
}
__device__ __forceinline__ float wave_max(float v) {
#pragma unroll
    for (int o = 1; o < 64; o <<= 1) v = fmaxf(v, __shfl_xor(v, o));
    return v;
}
__device__ __forceinline__ float softplusf(float z) { return fmaxf(z, 0.f) + log1pf(__expf(-fabsf(z))); }
__device__ __forceinline__ float bf2f(unsigned short h) { return __uint_as_float((unsigned)h << 16); }
__device__ __forceinline__ float bflo(unsigned w) { return __uint_as_float(w << 16); }
__device__ __forceinline__ float bfhi(unsigned w) { return __uint_as_float(w & 0xffff0000u); }

struct Frame {
    LAS unsigned char* lds;
    int tid, lane, wave, G, gw, NGW;
    unsigned char* ws;
};
__device__ __forceinline__ const float* inp(const Frame& F, int i) {
    volatile LAS unsigned* t = (volatile LAS unsigned*)(F.lds + LDSCTL_OFF) + 2 * i;
    const unsigned lo = __builtin_amdgcn_readfirstlane(t[0]), hi = __builtin_amdgcn_readfirstlane(t[1]);
    return (const float*)(((unsigned long long)hi << 32) | lo);
}
__device__ __forceinline__ void relane(Frame& F) {
    int t = threadIdx.x; asm volatile("" : "+v"(t));
    F.tid = t; F.lane = t & 63; F.wave = __builtin_amdgcn_readfirstlane(t >> 6);
    int g = gridDim.x, b = blockIdx.x; asm volatile("" : "+s"(g), "+s"(b));
    F.G = g; F.gw = b * NWAVES + F.wave; F.NGW = g * NWAVES;
}

struct EpiStore {
    static constexpr bool PERM = true, AFTER_DRAIN = false;
    bf16* O; int ldc;
    __device__ __forceinline__ void operator()(const f32x4 (&acc)[2][2][4][2], const pg8::Unit& u, int wr, int wc, int fr, int fq) const {
        const int row0 = u.pm * 256 + wr * 64 + fr, col0 = u.pn * 256 + wc * 32 + 8 * fq;
#pragma unroll
        for (int ai = 0; ai < 2; ++ai)
#pragma unroll
            for (int m = 0; m < 4; ++m) { bf16* rowp = O + (size_t)(row0 + ai * 128 + m * 16) * ldc + col0;
#pragma unroll
                for (int bj = 0; bj < 2; ++bj) { const f32x4 v0 = acc[ai][bj][m][0], v1 = acc[ai][bj][m][1];
                    pg8::u32x4 w; w.x = pg8::cvt_pk_bf16(v0[0], v0[1]); w.y = pg8::cvt_pk_bf16(v0[2], v0[3]); w.z = pg8::cvt_pk_bf16(v1[0], v1[1]); w.w = pg8::cvt_pk_bf16(v1[2], v1[3]);
                    *(pg8::u32x4*)(rowp + bj * 128) = w; } }
    }
};
struct EpiSwiglu {
    static constexpr bool PERM = true, AFTER_DRAIN = false;
    bf16* O; int ldc;
    __device__ __forceinline__ void operator()(const f32x4 (&acc)[2][2][4][2], const pg8::Unit& u, int wr, int wc, int fr, int fq) const {
        const int row0 = u.pm * 256 + wr * 64 + fr, col0 = u.pn * 128 + wc * 32 + 8 * fq;
#pragma unroll
        for (int ai = 0; ai < 2; ++ai)
#pragma unroll
            for (int m = 0; m < 4; ++m) { bf16* rowp = O + (size_t)(row0 + ai * 128 + m * 16) * ldc + col0;
                float r[8];
#pragma unroll
                for (int n = 0; n < 2; ++n)
#pragma unroll
                    for (int e = 0; e < 4; ++e) { const float g = acc[ai][0][m][n][e], up = acc[ai][1][m][n][e]; r[n * 4 + e] = g * __builtin_amdgcn_rcpf(1.f + __expf(-g)) * up; }
                pg8::u32x4 w; w.x = pg8::cvt_pk_bf16(r[0], r[1]); w.y = pg8::cvt_pk_bf16(r[2], r[3]); w.z = pg8::cvt_pk_bf16(r[4], r[5]); w.w = pg8::cvt_pk_bf16(r[6], r[7]);
                *(pg8::u32x4*)rowp = w; }
    }
};

struct EpiSoftmax {
    static constexpr bool PERM = true, AFTER_DRAIN = true;
    bf16* O; int ldc;
    __device__ __forceinline__ void fused(f32x4 (&acc)[2][2][4][2], const pg8::Unit& u, int wr, int wc, int fr, int fq, LAS unsigned char* lds, int wid, int lane) const {
        typedef float f32x2v __attribute__((ext_vector_type(2)));
        constexpr float C2 = 0.0625f * 1.4426950408889634f;
        LAS f32x2v* ST = (LAS f32x2v*)lds;
#pragma unroll
        for (int ai = 0; ai < 2; ++ai)
#pragma unroll
            for (int m = 0; m < 4; ++m) {
                float mx = -INFINITY;
#pragma unroll
                for (int bj = 0; bj < 2; ++bj)
#pragma unroll
                    for (int n = 0; n < 2; ++n) { const f32x4 x = acc[ai][bj][m][n]; mx = fmaxf(mx, fmaxf(fmaxf(x[0], x[1]), fmaxf(x[2], x[3]))); }
                mx = fmaxf(mx, __shfl_xor(mx, 16)); mx = fmaxf(mx, __shfl_xor(mx, 32));
                float sum = 0.f;
#pragma unroll
                for (int bj = 0; bj < 2; ++bj)
#pragma unroll
                    for (int n = 0; n < 2; ++n) { f32x4 x = acc[ai][bj][m][n];
#pragma unroll
                        for (int e = 0; e < 4; ++e) { x[e] = __builtin_amdgcn_exp2f((x[e] - mx) * C2); sum += x[e]; }
                        acc[ai][bj][m][n] = x; }
                sum += __shfl_xor(sum, 16); sum += __shfl_xor(sum, 32);
                if (fq == 0) ST[(ai * 128 + wr * 64 + m * 16 + fr) * 4 + wc] = (f32x2v){mx, sum};
            }
        asm volatile("s_waitcnt lgkmcnt(0)" ::: "memory"); __builtin_amdgcn_s_barrier(); asm volatile("" ::: "memory");
        const int row0 = u.pm * 256 + wr * 64 + fr, col0 = u.pn * 256 + wc * 32 + 8 * fq;
#pragma unroll
        for (int ai = 0; ai < 2; ++ai)
#pragma unroll
            for (int m = 0; m < 4; ++m) {
                const LAS f32x2v* sp = ST + (ai * 128 + wr * 64 + m * 16 + fr) * 4;
                const f32x2v s0 = sp[0], s1 = sp[1], s2 = sp[2], s3 = sp[3];
                const float MX = fmaxf(fmaxf(s0.x, s1.x), fmaxf(s2.x, s3.x));
                const float L = s0.y * __builtin_amdgcn_exp2f((s0.x - MX) * C2) + s1.y * __builtin_amdgcn_exp2f((s1.x - MX) * C2) + s2.y * __builtin_amdgcn_exp2f((s2.x - MX) * C2) + s3.y * __builtin_amdgcn_exp2f((s3.x - MX) * C2);
                const float mine = (wc == 0) ? s0.x : (wc == 1) ? s1.x : (wc == 2) ? s2.x : s3.x;
                const float f = __builtin_amdgcn_exp2f((mine - MX) * C2) / L;
                bf16* rowp = O + (size_t)(row0 + ai * 128 + m * 16) * ldc + col0;
#pragma unroll
                for (int bj = 0; bj < 2; ++bj) { const f32x4 v0 = acc[ai][bj][m][0] * f, v1 = acc[ai][bj][m][1] * f;
                    pg8::u32x4 w; w.x = pg8::cvt_pk_bf16(v0[0], v0[1]); w.y = pg8::cvt_pk_bf16(v0[2], v0[3]); w.z = pg8::cvt_pk_bf16(v1[0], v1[1]); w.w = pg8::cvt_pk_bf16(v1[2], v1[3]);
                    *(pg8::u32x4*)(rowp + bj * 128) = w; }
            }
    }
};
struct OneUnit {
    __device__ __forceinline__ bool next(int i, pg8::Unit& u) const { if (i) return false; u.pm = 0; u.pn = 0; u.aoff = 0; u.boff = 0; return true; }
    __device__ __forceinline__ void a_ready(const pg8::Unit&) const {}
    __device__ __forceinline__ void done(const pg8::Unit&) const {}
};

__device__ __forceinline__ void transpose_item(const float* W, int ld, int K, bf16* WT, int k0, int n0, int drow, LAS float* scr, int lane) {
#pragma unroll 8
    for (int i = 0; i < 32; ++i) { const int kk = 2 * i + (lane >> 5); scr[kk * 33 + (lane & 31)] = W[(size_t)(k0 + kk) * ld + n0 + (lane & 31)]; }
    LDS_WAIT(); asm volatile("" ::: "memory");
    const int c = lane & 7;
#pragma unroll
    for (int j = 0; j < 4; ++j) { const int n = (lane >> 3) + 8 * j; const LAS float* s = scr + (8 * c) * 33 + n;
        v4u o; o.x = pk2(s[0 * 33], s[1 * 33]); o.y = pk2(s[2 * 33], s[3 * 33]); o.z = pk2(s[4 * 33], s[5 * 33]); o.w = pk2(s[6 * 33], s[7 * 33]);
        *(GAS v4u*)(WT + (size_t)(drow + n) * K + k0 + 8 * c) = o; }
    LDS_WAIT(); asm volatile("" ::: "memory");
}
__device__ __forceinline__ void p0_convert(Frame& F) {
    relane(F);
    LAS float* scr = (LAS float*)(F.lds + RING_OFF + F.wave * 16384);
    bf16* Wb = (bf16*)(F.ws + WS_W); bf16* Wkv = (bf16*)(F.ws + WS_XWT);
    constexpr int I_IN = 16 * 96, I_OUT = 16 * 32, I_Q = 16 * 32, I_O = 16 * 32, I_KV = 16 * 64, I_GU = 16 * 176, I_DN = 44 * 32;
    constexpr int I_LAYER = I_IN + I_OUT + I_Q + I_O + I_KV + I_GU + I_DN;
    for (int it = F.gw; it < 4 * I_LAYER; it += F.NGW) {
        const int l = it / I_LAYER, j = l >> 1; int r = it % I_LAYER;
        bf16* WL = Wb + (size_t)l * WL_SIZE;
        if (r < I_IN) { const int kb = r / 96, nb = r % 96;
            if (l & 1) transpose_item(inp(F, 8) + (size_t)j * D * 3072, 3072, D, WL + WL_IN, kb * 64, nb * 32, nb * 32, scr, F.lane);
            else       transpose_item(inp(F, 4) + (size_t)j * D * ML_W, ML_W, D, WL + WL_IN, kb * 64, nb * 32, nb * 32, scr, F.lane);
            continue; } r -= I_IN;
        if (r < I_OUT) { const int kb = r / 32, nb = r % 32;
            transpose_item(((l & 1) ? inp(F, 9) : inp(F, 7)) + (size_t)j * D * D, D, D, WL + WL_OUT, kb * 64, nb * 32, nb * 32, scr, F.lane); continue; } r -= I_OUT;
        if (r < I_Q) { const int e0 = r * 2048 + F.lane * 8;
#pragma unroll
            for (int q = 0; q < 4; ++q) { const GAS f32x4* sp = (const GAS f32x4*)(inp(F, 10) + (size_t)l * D * D + e0 + q * 512); const f32x4 x0 = sp[0], x1 = sp[1];
                v4u o; o.x = pk2(x0.x, x0.y); o.y = pk2(x0.z, x0.w); o.z = pk2(x1.x, x1.y); o.w = pk2(x1.z, x1.w); *(GAS v4u*)(WL + WL_QN + e0 + q * 512) = o; }
            continue; } r -= I_Q;
        if (r < I_O) { const int kb = r / 32, nb = r % 32; transpose_item(inp(F, 12) + (size_t)l * D * D, D, D, WL + WL_OT, kb * 64, nb * 32, nb * 32, scr, F.lane); continue; } r -= I_O;
        if (r < I_KV) { const int kb = r / 64, nb = r % 64; transpose_item(inp(F, 11) + (size_t)l * D * 2048, 2048, D, Wkv, kb * 64, nb * 32, l * 2048 + nb * 32, scr, F.lane); continue; } r -= I_KV;
        if (r < I_GU) { const int kb = r / 176, nb = r % 176; const int c0 = nb * 32; const int up = c0 >= DFF, jj = up ? c0 - DFF : c0;
            transpose_item(inp(F, 13) + (size_t)l * D * 2 * DFF, 2 * DFF, D, WL + WL_GU, kb * 64, c0, 256 * (jj >> 7) + 128 * up + (jj & 127), scr, F.lane); continue; } r -= I_GU;
        { const int kb = r / 32, nb = r % 32; transpose_item(inp(F, 14) + (size_t)l * DFF * D, D, DFF, WL + WL_DN, kb * 64, nb * 32, nb * 32, scr, F.lane); }
    }
    bf16* MEMN = (bf16*)(F.ws + WS_MEMN);
    for (int m = F.gw; m < MM; m += F.NGW) {
        const GAS f32x4* xr = (const GAS f32x4*)(inp(F, 1) + (size_t)m * D) + F.lane; const GAS f32x4* gr = (const GAS f32x4*)inp(F, 2) + F.lane;
        f32x4 v[4]; float s = 0.f;
#pragma unroll
        for (int q = 0; q < 4; ++q) { v[q] = xr[64 * q]; s += (v[q].x * v[q].x + v[q].y * v[q].y) + (v[q].z * v[q].z + v[q].w * v[q].w); }
        const float rs = rsqrtf(wave_sum(s) * (1.f / D) + EPS);
        GAS unsigned long long* o8 = (GAS unsigned long long*)(MEMN + (size_t)m * D) + F.lane;
#pragma unroll
        for (int q = 0; q < 4; ++q) { const f32x4 g = gr[64 * q]; o8[64 * q] = (unsigned long long)pk2(v[q].x * rs * g.x, v[q].y * rs * g.y) | ((unsigned long long)pk2(v[q].z * rs * g.z, v[q].w * rs * g.w) << 32); }
    }
}

__device__ __forceinline__ void row_phase(Frame& F, const float* xin, float* xout, const bf16* Y, const float* ga, const float* gb, bf16* XN, const float* WG, int wgs, const float* bg, float* GT) {
    relane(F);
    for (int m = F.gw; m < M; m += F.NGW) {
        const GAS f32x4* xr = (const GAS f32x4*)(xin + (size_t)m * D) + F.lane;
        f32x4 v[4];
#pragma unroll
        for (int q = 0; q < 4; ++q) v[q] = xr[64 * q];
        if (Y) {
            const GAS unsigned long long* yr = (const GAS unsigned long long*)(Y + (size_t)m * D) + F.lane;
            f32x4 y[4]; float s = 0.f;
#pragma unroll
            for (int q = 0; q < 4; ++q) { const unsigned long long w = yr[64 * q]; const unsigned lo = (unsigned)w, hi = (unsigned)(w >> 32);
                y[q] = (f32x4){bflo(lo), bfhi(lo), bflo(hi), bfhi(hi)}; s += (y[q].x * y[q].x + y[q].y * y[q].y) + (y[q].z * y[q].z + y[q].w * y[q].w); }
            const float rs = rsqrtf(wave_sum(s) * (1.f / D) + EPS);
            const GAS f32x4* gr = (const GAS f32x4*)ga + F.lane;
#pragma unroll
            for (int q = 0; q < 4; ++q) { const f32x4 g = gr[64 * q]; v[q] = v[q] + y[q] * rs * g; }
        }
        if (Y || xin != xout) { GAS f32x4* xo = (GAS f32x4*)(xout + (size_t)m * D) + F.lane;
#pragma unroll
            for (int q = 0; q < 4; ++q) xo[64 * q] = v[q]; }
        if (gb) {
            float s = 0.f;
#pragma unroll
            for (int q = 0; q < 4; ++q) s += (v[q].x * v[q].x + v[q].y * v[q].y) + (v[q].z * v[q].z + v[q].w * v[q].w);
            const float rs = rsqrtf(wave_sum(s) * (1.f / D) + EPS);
            const GAS f32x4* gr = (const GAS f32x4*)gb + F.lane;
            GAS unsigned long long* o8 = (GAS unsigned long long*)(XN + (size_t)m * D) + F.lane;
#pragma unroll
            for (int q = 0; q < 4; ++q) { const f32x4 g = gr[64 * q]; v[q] = v[q] * rs * g; o8[64 * q] = (unsigned long long)pk2(v[q].x, v[q].y) | ((unsigned long long)pk2(v[q].z, v[q].w) << 32); }
            if (WG) {
                float acc[8];
#pragma unroll
                for (int c = 0; c < 8; ++c) acc[c] = 0.f;
#pragma unroll
                for (int q = 0; q < 4; ++q)
#pragma unroll
                    for (int e = 0; e < 4; ++e) { const GAS f32x4* w = (const GAS f32x4*)(WG + (size_t)(4 * F.lane + 256 * q + e) * wgs); const f32x4 w0 = w[0], w1 = w[1]; const float h = v[q][e];
                        acc[0] += h * w0.x; acc[1] += h * w0.y; acc[2] += h * w0.z; acc[3] += h * w0.w; acc[4] += h * w1.x; acc[5] += h * w1.y; acc[6] += h * w1.z; acc[7] += h * w1.w; }
#pragma unroll
                for (int c = 0; c < 8; ++c) acc[c] = wave_sum(acc[c]);
                if (F.lane < 8) {
                    float a = 0.f;
#pragma unroll
                    for (int c = 0; c < 8; ++c) a = (F.lane == c) ? acc[c] : a;
                    a = 15.f * tanhf((a + bg[F.lane]) * (1.f / 15.f));
                    if (F.lane >= 4) a = -softplusf(-a);
                    GT[(size_t)m * 8 + F.lane] = a;
                }
            }
        }
    }
}

__device__ __forceinline__ void mlstm_scan_v1(Frame& F, const bf16* PROJ, const float* GT, bf16* MIX) {
    relane(F);
    const int vi = F.tid >> 4, kq = F.tid & 15;
    for (int task = blockIdx.x; task < BATCH * ML_H * 8; task += F.G) {
        const int bh = task >> 3, vs = task & 7, b = bh >> 2, h = bh & 3;
        float C[8], n[8], m = 0.f;
#pragma unroll
        for (int i = 0; i < 8; ++i) { C[i] = 0.f; n[i] = 0.f; }
        const bf16* p0 = PROJ + (size_t)b * SEQ * 3072;
        const float* g0 = GT + (size_t)b * SEQ * 8;
        v4u qn = *(const GAS v4u*)(p0 + h * 128 + kq * 8), kn = *(const GAS v4u*)(p0 + 512 + h * 128 + kq * 8);
        unsigned short vn = *(const GAS unsigned short*)(p0 + 1024 + h * 256 + vs * 32 + vi);
        float ign = g0[h], lfn = g0[4 + h];
        for (int t = 0; t < SEQ; ++t) {
            const v4u qc = qn, kc = kn; const float vv = bf2f(vn), ig = ign, lf = lfn;
            if (t + 1 < SEQ) { const bf16* p = p0 + (size_t)(t + 1) * 3072; qn = *(const GAS v4u*)(p + h * 128 + kq * 8); kn = *(const GAS v4u*)(p + 512 + h * 128 + kq * 8);
                vn = *(const GAS unsigned short*)(p + 1024 + h * 256 + vs * 32 + vi); ign = g0[(t + 1) * 8 + h]; lfn = g0[(t + 1) * 8 + 4 + h]; }
            const float mn = fmaxf(lf + m, ig), dec = __expf(lf + m - mn), wi = __expf(ig - mn); m = mn;
            const float qf[8] = {bflo(qc.x), bfhi(qc.x), bflo(qc.y), bfhi(qc.y), bflo(qc.z), bfhi(qc.z), bflo(qc.w), bfhi(qc.w)};
            const float kf[8] = {bflo(kc.x), bfhi(kc.x), bflo(kc.y), bfhi(kc.y), bflo(kc.z), bfhi(kc.z), bflo(kc.w), bfhi(kc.w)};
            float num = 0.f, den = 0.f;
#pragma unroll
            for (int i = 0; i < 8; ++i) { const float kk = kf[i] * 0.08838834764831845f;
                C[i] = dec * C[i] + wi * vv * kk; n[i] = dec * n[i] + wi * kk; num += C[i] * qf[i]; den += n[i] * qf[i]; }
#pragma unroll
            for (int o = 1; o < 16; o <<= 1) { num += __shfl_xor(num, o); den += __shfl_xor(den, o); }
            if (kq == 0) { const float r = num / fmaxf(fabsf(den), __expf(-mn)); ((GAS unsigned short*)MIX)[(size_t)(b * SEQ + t) * D + h * 256 + vs * 32 + vi] = (unsigned short)f2bf(r); }
        }
    }
}
__device__ __forceinline__ void mlstm_post_v1(Frame& F, const bf16* PROJ, const float* hg, bf16* MIX) {
    relane(F);
    for (int w = F.gw; w < M * ML_H; w += F.NGW) {
        const int tok = w >> 2, h = w & 3;
        GAS unsigned long long* r = (GAS unsigned long long*)(MIX + (size_t)tok * D + h * 256) + F.lane;
        const unsigned long long hw = *r, ow = *((const GAS unsigned long long*)(PROJ + (size_t)tok * 3072 + 2048 + h * 256) + F.lane);
        const float v[4] = {bflo((unsigned)hw), bfhi((unsigned)hw), bflo((unsigned)(hw >> 32)), bfhi((unsigned)(hw >> 32))};
        const float o[4] = {bflo((unsigned)ow), bfhi((unsigned)ow), bflo((unsigned)(ow >> 32)), bfhi((unsigned)(ow >> 32))};
        const float rs = rsqrtf(wave_sum((v[0] * v[0] + v[1] * v[1]) + (v[2] * v[2] + v[3] * v[3])) * (1.f / 256.f) + EPS);
        const f32x4 g = *((const GAS f32x4*)(hg + h * 256) + F.lane);
        float y[4];
#pragma unroll
        for (int e = 0; e < 4; ++e) y[e] = v[e] * rs * g[e] / (1.f + __expf(-o[e]));
        *r = (unsigned long long)pk2(y[0], y[1]) | ((unsigned long long)pk2(y[2], y[3]) << 32);
    }
}

__device__ __forceinline__ void sb_attn_v1(Frame& F, const bf16* QKV, bf16* MIX) {
    relane(F);
    for (int task = F.gw; task < BATCH * SB_H * 16; task += F.NGW) {
        const int bh = task >> 4, pr = task & 15, b = bh >> 4, h = bh & 15;
#pragma unroll 1
        for (int half = 0; half < 2; ++half) {
            const int tb = half ? 31 - pr : pr, t = tb * 64 + F.lane;
            float q[64], o[64];
            const GAS v4u* qp = (const GAS v4u*)(QKV + (size_t)(b * SEQ + t) * 3072 + h * 64);
#pragma unroll
            for (int c = 0; c < 8; ++c) { const v4u w = qp[c]; q[8 * c] = bflo(w.x) * 0.125f; q[8 * c + 1] = bfhi(w.x) * 0.125f; q[8 * c + 2] = bflo(w.y) * 0.125f; q[8 * c + 3] = bfhi(w.y) * 0.125f;
                q[8 * c + 4] = bflo(w.z) * 0.125f; q[8 * c + 5] = bfhi(w.z) * 0.125f; q[8 * c + 6] = bflo(w.w) * 0.125f; q[8 * c + 7] = bfhi(w.w) * 0.125f; }
#pragma unroll
            for (int d = 0; d < 64; ++d) o[d] = 0.f;
            float run = 0.f;
            for (int s = tb * 64 + 62; s >= 0; --s) {
                const GAS v4u* kp = (const GAS v4u*)(QKV + (size_t)(b * SEQ + s) * 3072 + 1024 + h * 64);
                float z = 0.f;
#pragma unroll
                for (int c = 0; c < 8; ++c) { const v4u w = kp[c]; z += q[8 * c] * bflo(w.x) + q[8 * c + 1] * bfhi(w.x) + q[8 * c + 2] * bflo(w.y) + q[8 * c + 3] * bfhi(w.y)
                        + q[8 * c + 4] * bflo(w.z) + q[8 * c + 5] * bfhi(w.z) + q[8 * c + 6] * bflo(w.w) + q[8 * c + 7] * bfhi(w.w); }
                if (s < t) {
                    const float sp = softplusf(z), a = __expf(z - sp + run); run -= sp;
                    const GAS v4u* vp = kp + 128;
#pragma unroll
                    for (int c = 0; c < 8; ++c) { const v4u w = vp[c]; o[8 * c] += a * bflo(w.x); o[8 * c + 1] += a * bfhi(w.x); o[8 * c + 2] += a * bflo(w.y); o[8 * c + 3] += a * bfhi(w.y);
                        o[8 * c + 4] += a * bflo(w.z); o[8 * c + 5] += a * bfhi(w.z); o[8 * c + 6] += a * bflo(w.w); o[8 * c + 7] += a * bfhi(w.w); }
                }
            }
            GAS v4u* op = (GAS v4u*)(MIX + (size_t)(b * SEQ + t) * D + h * 64);
#pragma unroll
            for (int c = 0; c < 8; ++c) { v4u w; w.x = pk2(o[8 * c], o[8 * c + 1]); w.y = pk2(o[8 * c + 2], o[8 * c + 3]); w.z = pk2(o[8 * c + 4], o[8 * c + 5]); w.w = pk2(o[8 * c + 6], o[8 * c + 7]); op[c] = w; }
        }
    }
}

template <int MR, int N, int K, bool ALIGN, class Epi> __device__ __forceinline__ void run_gemm(Frame& F, const bf16* A, int lda, const bf16* Bt, int ldb, int pmb, size_t b_batch, const Epi E) {
    int gd = gridDim.x, bi = blockIdx.x; asm volatile("" : "+s"(gd), "+s"(bi));
    pg8::Gemm g{A, Bt, MR, N, K, lda, ldb}; pg8::StaticOrder S; S.init(MR, N, gd, bi, lda, ldb, pmb, b_batch);
    pg8::gemm_phase<Epi, pg8::StaticOrder, ALIGN, true>(F.lds + RING_OFF, g, S, E);
}
__device__ __forceinline__ void xw_gemms(Frame& F, const bf16* KVl, const bf16* WQN, const bf16* WOT, bf16* XWTp) {
    int gd = gridDim.x, bi = blockIdx.x; asm volatile("" : "+s"(gd), "+s"(bi));
    for (int L = bi; L < 256; L += gd) {
        const int idx = L & 127, b = idx >> 4, h = (idx >> 2) & 3, t = idx & 3;
        OneUnit S; int kk = 256; asm volatile("" : "+s"(kk));
        if (L < 128) {
            pg8::Gemm g{KVl + (size_t)(b * NMEM) * 8192 + h * 256, WQN + (size_t)(t * 256) * D + h * 256, 256, 256, kk, 8192, D};
            EpiStore E{XWTp + (size_t)b * D * D + (size_t)(h * 256) * D + t * 256, D};
            pg8::gemm_phase<EpiStore, OneUnit, true, true>(F.lds + RING_OFF, g, S, E);
        } else {
            pg8::Gemm g{WOT + (size_t)(t * 256) * D + h * 256, KVl + (size_t)(b * NMEM) * 8192 + 1024 + h * 256, 256, 256, kk, D, 8192};
            EpiStore E{XWTp + (size_t)(8 + b) * D * D + (size_t)(t * 256) * D + h * 256, D};
            pg8::gemm_phase<EpiStore, OneUnit, true, true>(F.lds + RING_OFF, g, S, E);
        }
    }
}
struct Args { const float* in[15]; float* out; unsigned char* ws; int pad[2]; };
__global__ void __launch_bounds__(NWAVES * 64, 2) mega_fwd(Args args) {
    extern __shared__ __attribute__((aligned(16))) unsigned char lds[];
    Frame F;
    F.lds = (LAS unsigned char*)lds; F.ws = args.ws;
    relane(F);
    for (int u = F.tid; u < (LDS_BYTES - LDSCTL_OFF) / 4; u += NWAVES * 64) ((LAS unsigned*)(F.lds + LDSCTL_OFF))[u] = 0u;
    __syncthreads();
    if (F.tid < 16) { const unsigned long long p = (F.tid < 15) ? (unsigned long long)args.in[F.tid < 15 ? F.tid : 0] : (unsigned long long)args.out;
        ((LAS unsigned*)(F.lds + LDSCTL_OFF))[2 * F.tid] = (unsigned)p; ((LAS unsigned*)(F.lds + LDSCTL_OFF))[2 * F.tid + 1] = (unsigned)(p >> 32); }
    __syncthreads();
    gu32* ctl = (gu32*)(F.ws + WS_CTL);
    XcdBarrier bar = xcd_barrier_post((unsigned*)(ctl + CW_BAR), (volatile LAS unsigned*)(F.lds + MISC_OFF) + 8);
#define GRID_BAR() xcd_barrier(bar)

#define Wb ((bf16*)(F.ws + WS_W))
#define XWT ((bf16*)(F.ws + WS_XWT))
#define XN ((bf16*)(F.ws + WS_XN))
#define MIX ((bf16*)(F.ws + WS_MIX))
#define BIG ((bf16*)(F.ws + WS_BIG))
#define PB (BIG + (size_t)M * D)
#define KV ((bf16*)(F.ws + WS_KV))
#define MEMN ((bf16*)(F.ws + WS_MEMN))
#define GT ((float*)(F.ws + WS_GATES))
#define gains inp(F, 3)
#define XOUT ((float*)inp(F, 15))

    p0_convert(F);
    row_phase(F, inp(F, 0), XOUT, nullptr, nullptr, gains, XN, inp(F, 4) + 3072, ML_W, inp(F, 5), GT);
    GRID_BAR();
    run_gemm<MM, 8192, D, true>(F, MEMN, D, XWT, D, 0, 0, EpiStore{KV, 8192});

#pragma unroll 1
    for (int l = 0; l < DEPTH; ++l) {
#define WL (Wb + (size_t)l * WL_SIZE)
#define GL (gains + (size_t)l * 6 * D)
        const bool ml = (l & 1) == 0;
        run_gemm<M, 3072, D, true>(F, XN, D, WL + WL_IN, D, 0, 0, EpiStore{BIG, 3072}); GRID_BAR();
        if (ml) { mlstm_scan_v1(F, BIG, GT, MIX); GRID_BAR(); mlstm_post_v1(F, BIG, inp(F, 6) + (size_t)(l >> 1) * D, MIX); } else sb_attn_v1(F, BIG, MIX);
        GRID_BAR();
        run_gemm<M, D, D, true>(F, MIX, D, WL + WL_OUT, D, 0, 0, EpiStore{BIG, D});
        xw_gemms(F, KV + (size_t)l * 2048, WL + WL_QN, WL + WL_OT, XWT); GRID_BAR();
        row_phase(F, XOUT, XOUT, BIG, GL + D, GL + 2 * D, XN, nullptr, 0, nullptr, nullptr); GRID_BAR();
        run_gemm<M, D, D, false>(F, XN, D, XWT, D, 8, (size_t)D * D * 2, EpiSoftmax{PB, D}); GRID_BAR();
        run_gemm<M, D, D, true>(F, PB, D, XWT + (size_t)8 * D * D, D, 8, (size_t)D * D * 2, EpiStore{BIG, D}); GRID_BAR();
        row_phase(F, XOUT, XOUT, BIG, GL + 3 * D, GL + 4 * D, XN, nullptr, 0, nullptr, nullptr); GRID_BAR();
        run_gemm<M, 2 * DFF, D, true>(F, XN, D, WL + WL_GU, D, 0, 0, EpiSwiglu{BIG, DFF}); GRID_BAR();
        run_gemm<M, D, DFF, true>(F, BIG, DFF, WL + WL_DN, DFF, 0, 0, EpiStore{MIX, D}); GRID_BAR();
        { const bool last = (l + 1 == DEPTH), gates = !last && (((l + 1) & 1) == 0);
          row_phase(F, XOUT, XOUT, MIX, GL + 5 * D, last ? nullptr : GL + 6 * D, XN,
                    gates ? inp(F, 4) + (size_t)((l + 1) >> 1) * D * ML_W + 3072 : nullptr, ML_W, inp(F, 5) + ((l + 1) >> 1) * 8, GT);
          if (!last) GRID_BAR(); }
    }
}

extern "C" void kernel_launch(void* const* d_in, const int* in_sizes, int n_in, void* d_out, int out_size, void* d_ws, size_t ws_size, hipStream_t stream) {
    static int grid = 0;
    if (grid == 0) {
        if (n_in != 15 || out_size != M * D || ws_size < WS_END) { fprintf(stderr, "kernel_launch: unexpected shapes (n_in %d out %d ws %zu need %zu)\n", n_in, out_size, ws_size, (size_t)WS_END); grid = -1; return; }
        int dev = 0, cus = 0, per_cu = 0;
        if (hipGetDevice(&dev) != hipSuccess || hipDeviceGetAttribute(&cus, hipDeviceAttributeMultiprocessorCount, dev) != hipSuccess) { grid = -1; return; }
        if (hipFuncSetAttribute((const void*)mega_fwd, hipFuncAttributeMaxDynamicSharedMemorySize, LDS_BYTES) != hipSuccess) { fprintf(stderr, "kernel_launch: hipFuncSetAttribute failed\n"); grid = -1; return; }
        if (hipOccupancyMaxActiveBlocksPerMultiprocessor(&per_cu, (const void*)mega_fwd, NWAVES * 64, LDS_BYTES) != hipSuccess || per_cu < 1) fprintf(stderr, "kernel_launch: occupancy query reports %d\n", per_cu);
        (void)hipGetLastError();
        grid = cus;
    }
    if (grid < 0) return;
    if (hipMemsetAsync((char*)d_ws + WS_CTL, 0, CTL_ZERO_BYTES, stream) != hipSuccess) return;
    Args a{};
    for (int i = 0; i < 15; ++i) a.in[i] = (const float*)d_in[i];
    a.out = (float*)d_out; a.ws = (unsigned char*)d_ws;
    hipLaunchKernelGGL(mega_fwd, dim3(grid), dim3(NWAVES * 64), LDS_BYTES, stream, a);
}
```

```cpp
#include <hip/hip_runtime.h>
#include <cstdio>
#include <cstdint>
namespace pg8 {
#define PG8_LAS __attribute__((address_space(3)))
typedef unsigned short bf16_t;
typedef short bf16x8 __attribute__((ext_vector_type(8)));
typedef float f32x4 __attribute__((ext_vector_type(4)));
typedef unsigned u32x4 __attribute__((ext_vector_type(4)));
constexpr int BM = 256, BK = 64, HALF = 128, HTB = HALF * BK * 2  , STAGE_BYTES = 8 * HTB, NXCD = 8, WGM = 8;

__host__ __device__ __forceinline__ int lds_byte(int r, int c) { const int st = (r >> 4) * 2 + (c >> 5), rr = r & 15, cc = c & 31, ob = rr * 64 + cc * 2; return st * 1024 + (ob ^ (((ob >> 9) & 1) << 5)); }
__host__ __device__ __forceinline__ void stage_rc(int b, int& R, int& C) { const int st = b / 1024, sb = b % 1024, swz = sb ^ (((sb >> 9) & 1) << 5); R = (st >> 1) * 16 + swz / 64; C = (st & 1) * 32 + (swz % 64) / 2; }
__host__ __device__ __forceinline__ int perm32(int rho) { const int n = rho >> 4, i = rho & 15; return 8 * (i >> 2) + 4 * n + (i & 3); }

struct Unit { int pm, pn; size_t aoff, boff; };
struct Gemm { const bf16_t* A; const bf16_t* Bt; int M, N, K, lda, ldb; };

struct StaticOrder {
    int nM, nN, nwg, G, c, pmb; size_t a_rt, b_rt, b_batch;
    __host__ __device__ void init(int M, int N, int G_, int c_, int lda, int ldb, int pmb_ = 0, size_t b_batch_ = 0) { nM = M / BM; nN = N / BM; nwg = nM * nN; G = G_; c = c_; a_rt = (size_t)BM * lda * 2; b_rt = (size_t)BM * ldb * 2; pmb = pmb_; b_batch = b_batch_; }
    __host__ __device__ bool next(int i, Unit& u) const {
        const long L = (long)i * G + c; if (L >= nwg) return false;
        int wgid = (int)L; { const int q = nwg / NXCD, r = nwg % NXCD, xcd = wgid % NXCD, off = wgid / NXCD; wgid = (xcd < r ? xcd * (q + 1) : r * (q + 1) + (xcd - r) * q) + off; }
        const int nig = WGM * nN, gid = wgid / nig, fm = gid * WGM, gsz = (nM - fm) < WGM ? (nM - fm) : WGM;
        u.pm = fm + ((wgid % nig) % gsz); u.pn = (wgid % nig) / gsz; u.aoff = (size_t)u.pm * a_rt; u.boff = (size_t)u.pn * b_rt + (pmb ? (size_t)(u.pm / pmb) * b_batch : 0); return true;
    }
    __device__ __forceinline__ void a_ready(const Unit&) const {}
    __device__ __forceinline__ void done(const Unit&) const {}
};

__device__ __forceinline__ unsigned cvt_pk_bf16(float lo, float hi) { unsigned r; asm volatile("v_cvt_pk_bf16_f32 %0, %1, %2" : "=v"(r) : "v"(lo), "v"(hi)); return r; }
typedef float f32x2 __attribute__((ext_vector_type(2)));
__device__ __forceinline__ f32x2 gelu_pk(f32x2 v) {
    const f32x2 av = __builtin_elementwise_abs(v), d = av * 0.2316418882f + 1.0f;
    f32x2 t; t.x = __builtin_amdgcn_rcpf(d.x); t.y = __builtin_amdgcn_rcpf(d.y);
    f32x2 q = t * 0.5307027145f + (-0.7265760135f); q = q * t + 0.7107068705f; q = q * t + (-0.142248368f); q = q * t + 0.127414796f; q = q * t;
    const f32x2 s = (v * v) * (-0.72134752044f);
    f32x2 e; e.x = __builtin_amdgcn_exp2f(s.x); e.y = __builtin_amdgcn_exp2f(s.y);
    const f32x2 m = v * (q * e), r = v - m;
    f32x2 o; o.x = v.x < 0.f ? m.x : r.x; o.y = v.y < 0.f ? m.y : r.y; return o;
}

template <int ACT  > struct EpiBf16 {
    static constexpr bool PERM = true, AFTER_DRAIN = false; static_assert(ACT == 0 || ACT == 1, "EpiBf16: ACT is 0 (none) or 1 (gelu_pk)");
    bf16_t* O; int ldc; const float* bias; int split_cols; size_t split_stride; float scale0;
    __device__ __forceinline__ void operator()(const f32x4 (&acc)[2][2][4][2], const Unit& u, int wr, int wc, int fr, int fq) const {
        const int row0 = u.pm * BM + wr * 64 + fr; int colt = u.pn * BM; bf16_t* base = O;
        float sc = 1.f; if (split_cols) { const int t = colt / split_cols; base += (size_t)t * split_stride; colt -= t * split_cols; if (t == 0) sc = scale0; }
        const int col0 = colt + wc * 32 + 8 * fq, bcol0 = u.pn * BM + wc * 32 + 8 * fq;
        f32x4 bv[2][2];
#pragma unroll
        for (int bj = 0; bj < 2; ++bj)
#pragma unroll
            for (int n = 0; n < 2; ++n) bv[bj][n] = bias ? *(const f32x4*)(bias + bcol0 + bj * HALF + 4 * n) : (f32x4){0.f, 0.f, 0.f, 0.f};
#pragma unroll
        for (int ai = 0; ai < 2; ++ai)
#pragma unroll
            for (int m = 0; m < 4; ++m) { bf16_t* rowp = base + (size_t)(row0 + ai * HALF + m * 16) * ldc + col0;
#pragma unroll
                for (int bj = 0; bj < 2; ++bj) { f32x4 v0 = acc[ai][bj][m][0] + bv[bj][0], v1 = acc[ai][bj][m][1] + bv[bj][1];
                    if (ACT == 1) { f32x2 a = gelu_pk((f32x2){v0[0], v0[1]}), b = gelu_pk((f32x2){v0[2], v0[3]}), c = gelu_pk((f32x2){v1[0], v1[1]}), d = gelu_pk((f32x2){v1[2], v1[3]});
                        v0 = (f32x4){a.x, a.y, b.x, b.y}; v1 = (f32x4){c.x, c.y, d.x, d.y}; }
                    v0 = v0 * sc; v1 = v1 * sc; u32x4 w; w.x = cvt_pk_bf16(v0[0], v0[1]); w.y = cvt_pk_bf16(v0[2], v0[3]); w.z = cvt_pk_bf16(v1[0], v1[1]); w.w = cvt_pk_bf16(v1[2], v1[3]);
                    *(u32x4*)(rowp + bj * HALF) = w; } }
    }
};

struct PanelStats {
    unsigned* xbuf;
    unsigned* cnt;
    unsigned* tmo;
    int ntn; float eps;
    unsigned code;
    __device__ __forceinline__ bool run(const f32x4 (&v)[2][2][4][2], const Unit& u, int wr, int wc, int fr, int fq, PG8_LAS unsigned char* lds, int wid, int lane) const {
        typedef float f32x2v __attribute__((ext_vector_type(2)));
        PG8_LAS f32x2v* P = (PG8_LAS f32x2v*)lds;
        PG8_LAS f32x2v* S = (PG8_LAS f32x2v*)(lds + 8192);
        PG8_LAS unsigned* flag = (PG8_LAS unsigned*)(lds + 8192 + 2048);
#pragma unroll
        for (int ai = 0; ai < 2; ++ai)
#pragma unroll
            for (int m = 0; m < 4; ++m) {
                float s = 0.f;
#pragma unroll
                for (int bj = 0; bj < 2; ++bj)
#pragma unroll
                    for (int n = 0; n < 2; ++n) { const f32x4 x = v[ai][bj][m][n]; s += (x[0] + x[1]) + (x[2] + x[3]); }
                s += __shfl_xor(s, 16); s += __shfl_xor(s, 32);
                const float mw = s * (1.0f / 64.0f); float q = 0.f;
#pragma unroll
                for (int bj = 0; bj < 2; ++bj)
#pragma unroll
                    for (int n = 0; n < 2; ++n) { const f32x4 d = v[ai][bj][m][n] - mw; q += (d[0] * d[0] + d[1] * d[1]) + (d[2] * d[2] + d[3] * d[3]); }
                q += __shfl_xor(q, 16); q += __shfl_xor(q, 32);
                if (fq == 0) P[(ai * HALF + wr * 64 + m * 16 + fr) * 4 + wc] = (f32x2v){mw, q};
            }
        asm volatile("s_waitcnt lgkmcnt(0)" ::: "memory"); __builtin_amdgcn_s_barrier(); asm volatile("" ::: "memory");
#if defined(BROKEN_EXCHANGE_NO_WAIT)
#warning BROKEN CONTROL BUILD: the row-statistics exchange does not wait; results are wrong by design
        if (blockIdx.x >= 64) { const long long t0_ = clock64(); while (clock64() - t0_ < 60000) __builtin_amdgcn_s_sleep(8); }
#endif
        const int row = wid * 32 + (lane & 31);
        if (lane < 32) {
            const f32x2v a = P[row * 4 + 0], b = P[row * 4 + 1], c = P[row * 4 + 2], d = P[row * 4 + 3];
            const float mt = (a.x + b.x + c.x + d.x) * 0.25f;
            const float da = a.x - mt, db = b.x - mt, dc = c.x - mt, dd = d.x - mt;
            const float m2 = (a.y + b.y) + (c.y + d.y) + 64.0f * ((da * da + db * db) + (dc * dc + dd * dd));
            unsigned long long* slot = (unsigned long long*)xbuf + ((size_t)(u.pm * BM + row) * 4 + u.pn);
            __hip_atomic_store(slot, ((unsigned long long)__float_as_uint(m2) << 32) | __float_as_uint(mt), __ATOMIC_RELAXED, __HIP_MEMORY_SCOPE_AGENT);
        }
        asm volatile("s_waitcnt vmcnt(0)" ::: "memory");
        if (lane == 0) __hip_atomic_fetch_add(cnt + 64 * u.pm, 1u, __ATOMIC_RELAXED, __HIP_MEMORY_SCOPE_AGENT);
        if (wid == 0) {
            bool dead = false; const unsigned long long t0 = __builtin_amdgcn_s_memrealtime(); const unsigned want = 8u * (unsigned)ntn;
            for (;;) {
#if defined(BROKEN_EXCHANGE_NO_WAIT)
                break;
#endif
                if ((unsigned)__builtin_amdgcn_readfirstlane(__hip_atomic_load(cnt + 64 * u.pm, __ATOMIC_RELAXED, __HIP_MEMORY_SCOPE_AGENT)) >= want) break;
                if (__builtin_amdgcn_s_memrealtime() - t0 > 2000000ull) {
                    if (lane == 0) { unsigned expect = 0u; __hip_atomic_compare_exchange_strong(tmo + 1, &expect, code | (unsigned)(u.pm & 0xff), __ATOMIC_RELAXED, __ATOMIC_RELAXED, __HIP_MEMORY_SCOPE_AGENT);
                                     __hip_atomic_store(tmo, 1u, __ATOMIC_RELAXED, __HIP_MEMORY_SCOPE_AGENT); }
                    dead = true; break; }
                __builtin_amdgcn_s_sleep(2);
            }
            __builtin_amdgcn_fence(__ATOMIC_ACQUIRE, "agent");
            if (lane == 0) flag[0] = dead ? 1u : 0u;
        }
        asm volatile("s_waitcnt vmcnt(0) lgkmcnt(0)" ::: "memory"); __builtin_amdgcn_s_barrier(); asm volatile("" ::: "memory");
        const bool bad = flag[0] != 0u;
        if (lane < 32) {
            const unsigned long long* slot = (const unsigned long long*)xbuf + (size_t)(u.pm * BM + row) * 4; float mt[4], m2[4]; float ms = 0.f;
#pragma unroll
            for (int t = 0; t < 4; ++t) { if (t < ntn) { const unsigned long long w = __hip_atomic_load(slot + t, __ATOMIC_RELAXED, __HIP_MEMORY_SCOPE_AGENT); mt[t] = __uint_as_float((unsigned)w); m2[t] = __uint_as_float((unsigned)(w >> 32)); } else { mt[t] = 0.f; m2[t] = 0.f; } ms += mt[t]; }
            const float mean = ms / (float)ntn; float q = 0.f;
#pragma unroll
            for (int t = 0; t < 4; ++t) if (t < ntn) { const float dm = mt[t] - mean; q += m2[t] + 256.0f * dm * dm; }
            S[row] = (f32x2v){mean, 1.0f / sqrtf(q / (256.0f * (float)ntn) + eps)};
        }
        asm volatile("s_waitcnt lgkmcnt(0)" ::: "memory"); __builtin_amdgcn_s_barrier(); asm volatile("" ::: "memory");
        return bad;
    }
};
struct EpiLnRes {
    static constexpr bool PERM = false, AFTER_DRAIN = true;
    const float* base; float* out; int ldc; const float* bias; PanelStats st; unsigned poison;
    __device__ __forceinline__ void fused(f32x4 (&acc)[2][2][4][2], const Unit& u, int wr, int wc, int fr, int fq, PG8_LAS unsigned char* lds, int wid, int lane) const {
        typedef float f32x2v __attribute__((ext_vector_type(2)));
        const PG8_LAS f32x2v* S = (const PG8_LAS f32x2v*)(lds + 8192);
        const int col0 = u.pn * BM + wc * 32 + 4 * fq;
#pragma unroll
        for (int bj = 0; bj < 2; ++bj)
#pragma unroll
            for (int n = 0; n < 2; ++n) { const f32x4 bv = bias ? *(const f32x4*)(bias + col0 + bj * HALF + n * 16) : (f32x4){0.f, 0.f, 0.f, 0.f};
#pragma unroll
                for (int ai = 0; ai < 2; ++ai)
#pragma unroll
                    for (int m = 0; m < 4; ++m) acc[ai][bj][m][n] += bv; }
        f32x4 pre[4][2][2];
#pragma unroll
        for (int m = 0; m < 4; ++m) { const size_t off = (size_t)(u.pm * BM + wr * 64 + m * 16 + fr) * ldc + col0;
#pragma unroll
            for (int bj = 0; bj < 2; ++bj)
#pragma unroll
                for (int n = 0; n < 2; ++n) pre[m][bj][n] = *(const f32x4*)(base + off + bj * HALF + n * 16); }
        const bool bad = st.run(acc, u, wr, wc, fr, fq, lds, wid, lane) || poison != 0u;
        const float qnan = __builtin_nanf("");
#pragma unroll
        for (int ai = 0; ai < 2; ++ai)
#pragma unroll
            for (int m = 0; m < 4; ++m) { const int r = ai * HALF + wr * 64 + m * 16 + fr; const f32x2v sr = S[r]; const size_t off = (size_t)(u.pm * BM + r) * ldc + col0;
#pragma unroll
                for (int bj = 0; bj < 2; ++bj)
#pragma unroll
                    for (int n = 0; n < 2; ++n) { const f32x4 bs = ai == 0 ? pre[m][bj][n] : *(const f32x4*)(base + off + bj * HALF + n * 16); f32x4 o = bs + (acc[ai][bj][m][n] - sr.x) * sr.y;
                        if (bad) o = (f32x4){qnan, qnan, qnan, qnan}; *(f32x4*)(out + off + bj * HALF + n * 16) = o; }
                if (m & 1) asm volatile("" ::: "memory"); }
    }
};
struct EpiLnResLn {
    static constexpr bool PERM = false, AFTER_DRAIN = true;
    const float* base; float* out; bf16_t* xn; int ldc; const float* bias; PanelStats st1, st2; unsigned poison;
    __device__ __forceinline__ void fused(f32x4 (&acc)[2][2][4][2], const Unit& u, int wr, int wc, int fr, int fq, PG8_LAS unsigned char* lds, int wid, int lane) const {
        typedef float f32x2v __attribute__((ext_vector_type(2))); typedef unsigned u32x2v __attribute__((ext_vector_type(2)));
        const PG8_LAS f32x2v* S = (const PG8_LAS f32x2v*)(lds + 8192);
        const int col0 = u.pn * BM + wc * 32 + 4 * fq;
#pragma unroll
        for (int bj = 0; bj < 2; ++bj)
#pragma unroll
            for (int n = 0; n < 2; ++n) { const f32x4 bv = bias ? *(const f32x4*)(bias + col0 + bj * HALF + n * 16) : (f32x4){0.f, 0.f, 0.f, 0.f};
#pragma unroll
                for (int ai = 0; ai < 2; ++ai)
#pragma unroll
                    for (int m = 0; m < 4; ++m) acc[ai][bj][m][n] += bv; }
        bool bad = st1.run(acc, u, wr, wc, fr, fq, lds, wid, lane) || poison != 0u;
        const float qnan = __builtin_nanf("");
#pragma unroll
        for (int ai = 0; ai < 2; ++ai)
#pragma unroll
            for (int m = 0; m < 4; ++m) { const int r = ai * HALF + wr * 64 + m * 16 + fr; const f32x2v sr = S[r]; const size_t off = (size_t)(u.pm * BM + r) * ldc + col0;
#pragma unroll
                for (int bj = 0; bj < 2; ++bj)
#pragma unroll
                    for (int n = 0; n < 2; ++n) { const f32x4 bs = *(const f32x4*)(base + off + bj * HALF + n * 16); acc[ai][bj][m][n] = bs + (acc[ai][bj][m][n] - sr.x) * sr.y; }
                asm volatile("" : "+v"(acc[ai][0][m][0]), "+v"(acc[ai][0][m][1]), "+v"(acc[ai][1][m][0]), "+v"(acc[ai][1][m][1]));
                if (m & 1) asm volatile("" ::: "memory"); }
        const bool bad1 = bad;
        bad = st2.run(acc, u, wr, wc, fr, fq, lds, wid, lane) || bad;
#pragma unroll
        for (int ai = 0; ai < 2; ++ai)
#pragma unroll
            for (int m = 0; m < 4; ++m) { const int r = ai * HALF + wr * 64 + m * 16 + fr; const f32x2v sr = S[r]; const size_t off = (size_t)(u.pm * BM + r) * ldc + col0;
#pragma unroll
                for (int bj = 0; bj < 2; ++bj)
#pragma unroll
                    for (int n = 0; n < 2; ++n) { const f32x4 x1 = acc[ai][bj][m][n]; *(f32x4*)(out + off + bj * HALF + n * 16) = bad1 ? (f32x4){qnan, qnan, qnan, qnan} : x1;
                        const f32x4 o = (x1 - sr.x) * sr.y; u32x2v w; w.x = cvt_pk_bf16(o[0], o[1]); w.y = cvt_pk_bf16(o[2], o[3]);
                        if (bad) { w.x = 0x7fc07fc0u; w.y = 0x7fc07fc0u; } *(u32x2v*)(xn + off + bj * HALF + n * 16) = w; }
                asm volatile("" ::: "memory"); }
    }
};

template <class Epi, class Sched, bool ALIGN_EPI = false, bool SP2 = false>
__device__ __forceinline__ void gemm_phase(PG8_LAS unsigned char* lds, const Gemm g, const Sched& S, const Epi& E) {
    int tid_ = threadIdx.x; asm volatile("" : "+v"(tid_));
    const int tid = tid_, wid = __builtin_amdgcn_readfirstlane(tid >> 6), lane = tid & 63, wr = wid >> 2, wc = wid & 3, fr = lane & 15, fq = lane >> 4;
    const int K = g.K, nt = K / BK;
    unsigned voffA[2], voffB[2];
#pragma unroll
    for (int i = 0; i < 2; ++i) { int R, C; stage_rc(tid * 16 + i * 8192, R, C); const int Rb = Epi::PERM ? ((R & ~31) + perm32(R & 31)) : R;
        voffA[i] = (unsigned)(R * g.lda + C) * 2u; voffB[i] = (unsigned)(Rb * g.ldb + C) * 2u; }
    const size_t kstep = (size_t)(BK * 2);
    const size_t hstepA = (size_t)HALF * g.lda * 2, hstepB = (size_t)HALF * g.ldb * 2;
    const unsigned ldsw = (unsigned)wid * 1024u;
    const int aoff = lds_byte(wr * 64 + fr, fq * 8), boff = lds_byte(wc * 32 + fr, fq * 8);
#define PG8_SA(b, h) (((b) * 2 + (h)) * HTB)
#define PG8_SB(b, h) ((4 + (b) * 2 + (h)) * HTB)
#define PG8_STAGE(bufoff, gbase, voff) do { _Pragma("unroll") for (int _i = 0; _i < 2; ++_i) \
        __builtin_amdgcn_global_load_lds((const unsigned*)((const char*)(gbase) + (voff)[_i]), (PG8_LAS unsigned*)(lds + (bufoff) + ldsw + _i * 8192), 16, 0, 0); } while (0)
#define PG8_LDA(dst, b, h) do { _Pragma("unroll") for (int m = 0; m < 4; ++m) _Pragma("unroll") for (int k = 0; k < 2; ++k) dst[m][k] = *(const PG8_LAS bf16x8*)(lds + PG8_SA(b, h) + aoff + m * 2048 + k * 1024); } while (0)
#define PG8_LDB(dst, b, h) do { _Pragma("unroll") for (int n = 0; n < 2; ++n) _Pragma("unroll") for (int k = 0; k < 2; ++k) dst[n][k] = *(const PG8_LAS bf16x8*)(lds + PG8_SB(b, h) + boff + n * 2048 + k * 1024); } while (0)
#define PG8_MMA(ai, bj, At, Bt) do { __builtin_amdgcn_s_setprio(1); _Pragma("unroll") for (int m = 0; m < 4; ++m) _Pragma("unroll") for (int n = 0; n < 2; ++n) _Pragma("unroll") for (int k = 0; k < 2; ++k) \
        acc[ai][bj][m][n] = __builtin_amdgcn_mfma_f32_16x16x32_bf16(Bt[n][k], At[m][k], acc[ai][bj][m][n], 0, 0, 0); __builtin_amdgcn_s_setprio(0); } while (0)
#define PG8_WAIT_V(n) asm volatile("s_waitcnt vmcnt(" #n ")" ::: "memory")
#define PG8_WAIT_L(n) asm volatile("s_waitcnt lgkmcnt(" #n ")" ::: "memory")
#define PG8_BAR __builtin_amdgcn_s_barrier()
#define PG8_SCHED __builtin_amdgcn_sched_barrier(0)
    Unit cur, nxt; int ui = 0;
    if (!S.next(0, cur)) return;
    f32x4 acc[2][2][4][2];
#pragma unroll
    for (int a = 0; a < 2; ++a)
#pragma unroll
        for (int b = 0; b < 2; ++b)
#pragma unroll
            for (int m = 0; m < 4; ++m)
#pragma unroll
                for (int n = 0; n < 2; ++n) acc[a][b][m][n] = (f32x4){0.f, 0.f, 0.f, 0.f};
    bf16x8 At[4][2], B0[2][2], B1[2][2];
    const char* cA = (const char*)g.A + cur.aoff; const char* cB = (const char*)g.Bt + cur.boff;
    S.a_ready(cur);
    if constexpr (SP2) {
        PG8_STAGE(PG8_SB(0, 0), cB, voffB); PG8_STAGE(PG8_SB(0, 1), cB + hstepB, voffB); PG8_STAGE(PG8_SA(0, 0), cA, voffA); PG8_STAGE(PG8_SA(0, 1), cA + hstepA, voffA);
        if (wr == 1) PG8_BAR;
        PG8_WAIT_V(2); PG8_BAR;
        PG8_STAGE(PG8_SB(1, 0), cB + kstep, voffB); PG8_STAGE(PG8_SA(1, 0), cA + kstep, voffA); PG8_STAGE(PG8_SB(1, 1), cB + hstepB + kstep, voffB);
        PG8_WAIT_V(6); PG8_BAR;
    } else {
        PG8_STAGE(PG8_SB(0, 0), cB, voffB); PG8_STAGE(PG8_SA(0, 0), cA, voffA); PG8_STAGE(PG8_SB(0, 1), cB + hstepB, voffB); PG8_STAGE(PG8_SA(0, 1), cA + hstepA, voffA);
        if (wr == 1) PG8_BAR;
        PG8_WAIT_V(4); PG8_BAR;
        PG8_STAGE(PG8_SB(1, 0), cB + kstep, voffB); PG8_STAGE(PG8_SA(1, 0), cA + kstep, voffA); PG8_STAGE(PG8_SB(1, 1), cB + hstepB + kstep, voffB);
        PG8_WAIT_V(6); PG8_BAR;
    }
    for (;;) {
        const bool has_next = S.next(ui + 1, nxt);
        const char* nA = has_next ? (const char*)g.A + nxt.aoff : cA; const char* nB = has_next ? (const char*)g.Bt + nxt.boff : cB;
        for (int t = 0; t < nt; t += 2) {
            const bool last = (t == nt - 2);
            const char* a1 = cA + (size_t)(t + 1) * kstep;
            const char* a2 = last ? nA : cA + (size_t)(t + 2) * kstep; const char* b2 = last ? nB : cB + (size_t)(t + 2) * kstep;
            const char* a3 = a2 + kstep; const char* b3 = b2 + kstep;
            if (last && has_next) S.a_ready(nxt);
            if constexpr (SP2) {
            PG8_LDB(B0, 0, 0); PG8_LDB(B1, 0, 1); PG8_SCHED; PG8_LDA(At, 0, 0); PG8_STAGE(PG8_SA(1, 1), a1 + hstepA, voffA);
            PG8_WAIT_V(8); PG8_WAIT_L(0); PG8_BAR; PG8_MMA(0, 0, At, B0); PG8_MMA(0, 1, At, B1); PG8_BAR; PG8_SCHED;
            PG8_LDA(At, 0, 1); PG8_STAGE(PG8_SB(0, 0), b2, voffB); PG8_STAGE(PG8_SB(0, 1), b2 + hstepB, voffB); PG8_STAGE(PG8_SA(0, 0), a2, voffA);
            PG8_WAIT_V(8); PG8_WAIT_L(0); PG8_BAR; PG8_MMA(1, 0, At, B0); PG8_MMA(1, 1, At, B1); PG8_BAR; PG8_SCHED;
            PG8_LDB(B0, 1, 0); PG8_LDB(B1, 1, 1); PG8_SCHED; PG8_LDA(At, 1, 0); PG8_STAGE(PG8_SA(0, 1), a2 + hstepA, voffA);
            PG8_WAIT_V(8); PG8_WAIT_L(0); PG8_BAR; PG8_MMA(0, 0, At, B0); PG8_MMA(0, 1, At, B1); PG8_BAR; PG8_SCHED;
            PG8_LDA(At, 1, 1); PG8_STAGE(PG8_SB(1, 0), b3, voffB); PG8_STAGE(PG8_SB(1, 1), b3 + hstepB, voffB); PG8_STAGE(PG8_SA(1, 0), a3, voffA);
            PG8_WAIT_V(8); PG8_WAIT_L(0); PG8_BAR; PG8_MMA(1, 0, At, B0); PG8_MMA(1, 1, At, B1); PG8_BAR; PG8_SCHED;
            } else {
            PG8_LDB(B0, 0, 0); PG8_SCHED; PG8_LDA(At, 0, 0); PG8_STAGE(PG8_SA(1, 1), a1 + hstepA, voffA);
            PG8_WAIT_L(8); PG8_BAR; PG8_WAIT_L(0); PG8_MMA(0, 0, At, B0); PG8_BAR; PG8_SCHED;
            PG8_LDB(B1, 0, 1); PG8_STAGE(PG8_SB(0, 0), b2, voffB);
            PG8_BAR; PG8_WAIT_L(0); PG8_MMA(0, 1, At, B1); PG8_BAR;
            PG8_LDA(At, 0, 1); PG8_STAGE(PG8_SA(0, 0), a2, voffA);
            PG8_BAR; PG8_WAIT_L(0); PG8_MMA(1, 0, At, B0); PG8_BAR; PG8_SCHED;
            PG8_STAGE(PG8_SB(0, 1), b2 + hstepB, voffB);
            PG8_WAIT_V(6); PG8_BAR; PG8_MMA(1, 1, At, B1); PG8_BAR;
            PG8_LDB(B0, 1, 0); PG8_SCHED; PG8_LDA(At, 1, 0); PG8_STAGE(PG8_SA(0, 1), a2 + hstepA, voffA);
            PG8_WAIT_L(8); PG8_BAR; PG8_WAIT_L(0); PG8_MMA(0, 0, At, B0); PG8_BAR; PG8_SCHED;
            PG8_LDB(B1, 1, 1); PG8_STAGE(PG8_SB(1, 0), b3, voffB);
            PG8_BAR; PG8_WAIT_L(0); PG8_MMA(0, 1, At, B1); PG8_BAR;
            PG8_LDA(At, 1, 1); PG8_STAGE(PG8_SA(1, 0), a3, voffA);
            PG8_BAR; PG8_WAIT_L(0); PG8_MMA(1, 0, At, B0); PG8_BAR; PG8_SCHED;
            PG8_STAGE(PG8_SB(1, 1), b3 + hstepB, voffB);
            PG8_WAIT_V(6); PG8_BAR; PG8_MMA(1, 1, At, B1); PG8_BAR;
            }
        }
        if constexpr (ALIGN_EPI) { if (wr == 0) PG8_BAR; }
        if constexpr (!Epi::AFTER_DRAIN) { E(acc, cur, wr, wc, fr, fq); S.done(cur); }
        if (!has_next) break;
#pragma unroll
        for (int a = 0; a < 2; ++a)
#pragma unroll
            for (int b = 0; b < 2; ++b)
#pragma unroll
                for (int m = 0; m < 4; ++m)
#pragma unroll
                    for (int n = 0; n < 2; ++n) acc[a][b][m][n] = (f32x4){0.f, 0.f, 0.f, 0.f};
        cur = nxt; cA = nA; cB = nB; ++ui;
        if constexpr (ALIGN_EPI) { if (wr == 1) PG8_BAR; }
    }
    PG8_WAIT_V(0);
    if constexpr (!ALIGN_EPI) { if (wr == 0) PG8_BAR; }
    PG8_BAR;
    if constexpr (Epi::AFTER_DRAIN) { E.fused(acc, cur, wr, wc, fr, fq, lds, wid, lane); S.done(cur); }
#undef PG8_SA
#undef PG8_SB
#undef PG8_STAGE
#undef PG8_LDA
#undef PG8_LDB
#undef PG8_MMA
#undef PG8_WAIT_V
#undef PG8_WAIT_L
#undef PG8_BAR
#undef PG8_SCHED
}
}
#define GAS __attribute__((address_space(1)))
#define LAS __attribute__((address_space(3)))
typedef unsigned short bf16;
typedef unsigned v4u __attribute__((ext_vector_type(4)));
typedef float f32x4 __attribute__((ext_vector_type(4)));
typedef short bf16x8 __attribute__((ext_vector_type(8)));
typedef GAS unsigned gu32;
typedef GAS unsigned long long gu64;
#define RLX_AGENT __ATOMIC_RELAXED, __HIP_MEMORY_SCOPE_AGENT
#define LDS_WAIT() asm volatile("s_waitcnt lgkmcnt(0)" ::: "memory")
#define VM_WAIT() asm volatile("s_waitcnt vmcnt(0)" ::: "memory")
__device__ __forceinline__ unsigned long long rt() { return __builtin_amdgcn_s_memrealtime(); }
__device__ __forceinline__ unsigned f2bf(float f) { unsigned u = __builtin_bit_cast(unsigned, f); return (u + 0x7fffu + ((u >> 16) & 1u)) >> 16; }
__device__ __forceinline__ unsigned pk2(float lo, float hi) { return f2bf(lo) | (f2bf(hi) << 16); }

#define XB_TMO      128
#define XB_XCNT(j)  (256  + 64 * (j))
#define XB_XSUB(j)  (1280 + 64 * (j))
#define XB_XGEN(j)  (2304 + 64 * (j))
#define XB_TOP      3328
#define XB_TOPGEN   3392
#define XCD_BAR_WORDS 3456
#define XB_SPIN_CAP (1u << 18)

__device__ __forceinline__ unsigned xb_ld(unsigned* p)              { return __hip_atomic_load(p, __ATOMIC_RELAXED, __HIP_MEMORY_SCOPE_AGENT); }
__device__ __forceinline__ unsigned xb_add(unsigned* p, unsigned v) { return __hip_atomic_fetch_add(p, v, __ATOMIC_RELAXED, __HIP_MEMORY_SCOPE_AGENT); }
__device__ __forceinline__ unsigned xb_xcc_id() { return (unsigned)__builtin_amdgcn_s_getreg((3 << 11) | 20) & 0xFu; }
#define XB_SPIN(cond, bar) do { unsigned _sp = 0; while (cond) { __builtin_amdgcn_s_sleep(1); \
    if ((++_sp & 255u) == 0u) { if (xb_ld(&(bar)[XB_TMO])) break; if (_sp > XB_SPIN_CAP) { atomicAdd(&(bar)[XB_TMO], 1u); break; } } } } while (0)

struct XcdBarrier {
    unsigned* bar; unsigned x;
    volatile LAS unsigned* st;
};

__device__ __forceinline__ XcdBarrier xcd_barrier_post(unsigned* bar, volatile LAS unsigned* st) {
    XcdBarrier b; b.bar = bar; b.x = xb_xcc_id(); b.st = st;
    if (threadIdx.x == 0) (void)xb_add(&bar[XB_XCNT(b.x)], 1u);
    return b;
}
__device__ __forceinline__ void xcd_barrier_complete(unsigned* bar, unsigned x, unsigned& nloc, unsigned& nx) {
    const unsigned G = gridDim.x * gridDim.y * gridDim.z;
    unsigned sum, cnt, mine, sp = 0u;
    for (;;) {
        sum = 0u; cnt = 0u; mine = 0u;
#pragma unroll
        for (unsigned j = 0; j < 16; ++j) { const unsigned c = xb_ld(&bar[XB_XCNT(j)]); sum += c; cnt += (c > 0u) ? 1u : 0u; mine = (j == x) ? c : mine; }
        if (sum == G) break;
        __builtin_amdgcn_s_sleep(1);
        if ((++sp & 255u) == 0u) { if (xb_ld(&bar[XB_TMO])) break; if (sp > XB_SPIN_CAP) { atomicAdd(&bar[XB_TMO], 1u); break; } }
    }
    nloc = mine > 0u ? mine : 1u; nx = cnt > 0u ? cnt : 1u;
}

__device__ __forceinline__ void xcd_barrier(const XcdBarrier& b) {
    asm volatile("s_waitcnt vmcnt(0)" ::: "memory");
    __syncthreads();
    if (threadIdx.x == 0) {
        unsigned* bar = b.bar;
        __builtin_amdgcn_s_waitcnt(0);
        unsigned nloc = b.st[0], nx = b.st[1];
        if (nloc == 0u) { xcd_barrier_complete(bar, b.x, nloc, nx); b.st[0] = nloc; b.st[1] = nx; }
        const unsigned old = xb_add(&bar[XB_XSUB(b.x)], 1u);
        const unsigned gen = old / nloc;
        if (old + 1u == (gen + 1u) * nloc) {
            __builtin_amdgcn_fence(__ATOMIC_RELEASE, "agent");
            asm volatile("s_waitcnt vmcnt(0)" ::: "memory");
            const unsigned og = xb_add(&bar[XB_TOP], 1u);
            const unsigned tg = og / nx;
            if (og + 1u == (tg + 1u) * nx) xb_add(&bar[XB_TOPGEN], 1u);
            else XB_SPIN(xb_ld(&bar[XB_TOPGEN]) == tg, bar);
            __builtin_amdgcn_fence(__ATOMIC_ACQUIRE, "agent");
            xb_add(&bar[XB_XGEN(b.x)], 1u);
            asm volatile("s_waitcnt vmcnt(0)" ::: "memory");
        } else {
            XB_SPIN(xb_ld(&bar[XB_XGEN(b.x)]) == gen, bar);
            __builtin_amdgcn_fence(__ATOMIC_ACQUIRE, "agent");
            asm volatile("s_waitcnt vmcnt(0)" ::: "memory");
        }
    }
    __syncthreads();
}

constexpr int D = 1024, BATCH = 8, SEQ = 2048, DEPTH = 4, NMEM = 256;
constexpr int M = BATCH * SEQ;
constexpr int MM = BATCH * NMEM;
constexpr int ML_H = 4, ML_DK = 128, ML_DV = 256, ML_W = 3080;
constexpr int SB_H = 16, SB_DH = 64;
constexpr int XA_H = 4, XA_DH = 256;
constexpr int DFF = 2816;
constexpr float EPS = 1e-6f;
constexpr int NWAVES = 8;

constexpr size_t MiB = 1u << 20;
constexpr size_t WS_CTL = 0, CTL_ZERO_BYTES = 1 * MiB;
constexpr size_t WS_WG = 1 * MiB;
constexpr size_t WS_GATES = 1 * MiB + 512 * 1024;
constexpr size_t WS_MEMN = 2 * MiB;
constexpr size_t WS_W = 8 * MiB;
constexpr size_t WL_IN = 0, WL_OUT = WL_IN + (size_t)3072 * 1024, WL_QN = WL_OUT + (size_t)1024 * 1024, WL_OT = WL_QN + (size_t)1024 * 1024,
                 WL_GU = WL_OT + (size_t)1024 * 1024, WL_DN = WL_GU + (size_t)5632 * 1024, WL_SIZE = WL_DN + (size_t)1024 * 2816;
constexpr size_t WS_XWT = WS_W + 4 * WL_SIZE * 2;
static_assert(WS_XWT == 122 * MiB, "weight region size");
constexpr size_t WS_KV = WS_XWT + 32 * MiB;
constexpr size_t WS_XN = WS_KV + 32 * MiB;
constexpr size_t WS_MIX = WS_XN + 32 * MiB;
constexpr size_t WS_BIG = WS_MIX + 32 * MiB;
constexpr size_t WS_END = WS_BIG + 96 * MiB;
constexpr int CW_BAR = 4096;

constexpr int RING_OFF = 0, RING_BYTES = 131072;
constexpr int LDSCTL_OFF = RING_BYTES, MISC_OFF = LDSCTL_OFF + 320;
constexpr int LDS_BYTES = 147456;

__device__ __forceinline__ float wave_sum(float v) {
#pragma unroll
    for (int o = 1; o < 64; o <<= 1) v += __shfl_xor(v, o);
    return v;
}
__device__ __forceinline__ float wave_max(float v) {
#pragma unroll
    for (int o = 1; o < 64; o <<= 1) v = fmaxf(v, __shfl_xor(v, o));
    return v;
}
__device__ __forceinline__ float softplusf(float z) { return fmaxf(z, 0.f) + log1pf(__expf(-fabsf(z))); }
__device__ __forceinline__ float bf2f(unsigned short h) { return __uint_as_float((unsigned)h << 16); }
__device__ __forceinline__ float bflo(unsigned w) { return __uint_as_float(w << 16); }
__device__ __forceinline__ float bfhi(unsigned w) { return __uint_as_float(w & 0xffff0000u); }

struct Frame {
    LAS unsigned char* lds;
    int tid, lane, wave, G, gw, NGW;
    unsigned char* ws;
};
__device__ __forceinline__ const float* inp(const Frame& F, int i) {
    volatile LAS unsigned* t = (volatile LAS unsigned*)(F.lds + LDSCTL_OFF) + 2 * i;
    const unsigned lo = __builtin_amdgcn_readfirstlane(t[0]), hi = __builtin_amdgcn_readfirstlane(t[1]);
    return (const float*)(((unsigned long long)hi << 32) | lo);
}
__device__ __forceinline__ void relane(Frame& F) {
    int t = threadIdx.x; asm volatile("" : "+v"(t));
    F.tid = t; F.lane = t & 63; F.wave = __builtin_amdgcn_readfirstlane(t >> 6);
    int g = gridDim.x, b = blockIdx.x; asm volatile("" : "+s"(g), "+s"(b));
    F.G = g; F.gw = b * NWAVES + F.wave; F.NGW = g * NWAVES;
}

struct EpiStore {
    static constexpr bool PERM = true, AFTER_DRAIN = false;
    bf16* O; int ldc;
    __device__ __forceinline__ void operator()(const f32x4 (&acc)[2][2][4][2], const pg8::Unit& u, int wr, int wc, int fr, int fq) const {
        const int row0 = u.pm * 256 + wr * 64 + fr, col0 = u.pn * 256 + wc * 32 + 8 * fq;
#pragma unroll
        for (int ai = 0; ai < 2; ++ai)
#pragma unroll
            for (int m = 0; m < 4; ++m) { bf16* rowp = O + (size_t)(row0 + ai * 128 + m * 16) * ldc + col0;
#pragma unroll
                for (int bj = 0; bj < 2; ++bj) { const f32x4 v0 = acc[ai][bj][m][0], v1 = acc[ai][bj][m][1];
                    pg8::u32x4 w; w.x = pg8::cvt_pk_bf16(v0[0], v0[1]); w.y = pg8::cvt_pk_bf16(v0[2], v0[3]); w.z = pg8::cvt_pk_bf16(v1[0], v1[1]); w.w = pg8::cvt_pk_bf16(v1[2], v1[3]);
                    *(pg8::u32x4*)(rowp + bj * 128) = w; } }
    }
};
struct EpiSwiglu {
    static constexpr bool PERM = true, AFTER_DRAIN = false;
    bf16* O; int ldc;
    __device__ __forceinline__ void operator()(const f32x4 (&acc)[2][2][4][2], const pg8::Unit& u, int wr, int wc, int fr, int fq) const {
        const int row0 = u.pm * 256 + wr * 64 + fr, col0 = u.pn * 128 + wc * 32 + 8 * fq;
#pragma unroll
        for (int ai = 0; ai < 2; ++ai)
#pragma unroll
            for (int m = 0; m < 4; ++m) { bf16* rowp = O + (size_t)(row0 + ai * 128 + m * 16) * ldc + col0;
                float r[8];
#pragma unroll
                for (int n = 0; n < 2; ++n)
#pragma unroll
                    for (int e = 0; e < 4; ++e) { const float g = acc[ai][0][m][n][e], up = acc[ai][1][m][n][e]; r[n * 4 + e] = g * __builtin_amdgcn_rcpf(1.f + __expf(-g)) * up; }
                pg8::u32x4 w; w.x = pg8::cvt_pk_bf16(r[0], r[1]); w.y = pg8::cvt_pk_bf16(r[2], r[3]); w.z = pg8::cvt_pk_bf16(r[4], r[5]); w.w = pg8::cvt_pk_bf16(r[6], r[7]);
                *(pg8::u32x4*)rowp = w; }
    }
};

struct EpiSoftmax {
    static constexpr bool PERM = true, AFTER_DRAIN = true;
    bf16* O; int ldc;
    __device__ __forceinline__ void fused(f32x4 (&acc)[2][2][4][2], const pg8::Unit& u, int wr, int wc, int fr, int fq, LAS unsigned char* lds, int wid, int lane) const {
        typedef float f32x2v __attribute__((ext_vector_type(2)));
        constexpr float C2 = 0.0625f * 1.4426950408889634f;
        LAS f32x2v* ST = (LAS f32x2v*)lds;
#pragma unroll
        for (int ai = 0; ai < 2; ++ai)
#pragma unroll
            for (int m = 0; m < 4; ++m) {
                float mx = -INFINITY;
#pragma unroll
                for (int bj = 0; bj < 2; ++bj)
#pragma unroll
                    for (int n = 0; n < 2; ++n) { const f32x4 x = acc[ai][bj][m][n]; mx = fmaxf(mx, fmaxf(fmaxf(x[0], x[1]), fmaxf(x[2], x[3]))); }
                mx = fmaxf(mx, __shfl_xor(mx, 16)); mx = fmaxf(mx, __shfl_xor(mx, 32));
                float sum = 0.f;
#pragma unroll
                for (int bj = 0; bj < 2; ++bj)
#pragma unroll
                    for (int n = 0; n < 2; ++n) { f32x4 x = acc[ai][bj][m][n];
#pragma unroll
                        for (int e = 0; e < 4; ++e) { x[e] = __builtin_amdgcn_exp2f((x[e] - mx) * C2); sum += x[e]; }
                        acc[ai][bj][m][n] = x; }
                sum += __shfl_xor(sum, 16); sum += __shfl_xor(sum, 32);
                if (fq == 0) ST[(ai * 128 + wr * 64 + m * 16 + fr) * 4 + wc] = (f32x2v){mx, sum};
            }
        asm volatile("s_waitcnt lgkmcnt(0)" ::: "memory"); __builtin_amdgcn_s_barrier(); asm volatile("" ::: "memory");
        const int row0 = u.pm * 256 + wr * 64 + fr, col0 = u.pn * 256 + wc * 32 + 8 * fq;
#pragma unroll
        for (int ai = 0; ai < 2; ++ai)
#pragma unroll
            for (int m = 0; m < 4; ++m) {
                const LAS f32x2v* sp = ST + (ai * 128 + wr * 64 + m * 16 + fr) * 4;
                const f32x2v s0 = sp[0], s1 = sp[1], s2 = sp[2], s3 = sp[3];
                const float MX = fmaxf(fmaxf(s0.x, s1.x), fmaxf(s2.x, s3.x));
                const float L = s0.y * __builtin_amdgcn_exp2f((s0.x - MX) * C2) + s1.y * __builtin_amdgcn_exp2f((s1.x - MX) * C2) + s2.y * __builtin_amdgcn_exp2f((s2.x - MX) * C2) + s3.y * __builtin_amdgcn_exp2f((s3.x - MX) * C2);
                const float mine = (wc == 0) ? s0.x : (wc == 1) ? s1.x : (wc == 2) ? s2.x : s3.x;
                const float f = __builtin_amdgcn_exp2f((mine - MX) * C2) / L;
                bf16* rowp = O + (size_t)(row0 + ai * 128 + m * 16) * ldc + col0;
#pragma unroll
                for (int bj = 0; bj < 2; ++bj) { const f32x4 v0 = acc[ai][bj][m][0] * f, v1 = acc[ai][bj][m][1] * f;
                    pg8::u32x4 w; w.x = pg8::cvt_pk_bf16(v0[0], v0[1]); w.y = pg8::cvt_pk_bf16(v0[2], v0[3]); w.z = pg8::cvt_pk_bf16(v1[0], v1[1]); w.w = pg8::cvt_pk_bf16(v1[2], v1[3]);
                    *(pg8::u32x4*)(rowp + bj * 128) = w; }
            }
    }
};
struct OneUnit {
    __device__ __forceinline__ bool next(int i, pg8::Unit& u) const { if (i) return false; u.pm = 0; u.pn = 0; u.aoff = 0; u.boff = 0; return true; }
    __device__ __forceinline__ void a_ready(const pg8::Unit&) const {}
    __device__ __forceinline__ void done(const pg8::Unit&) const {}
};

__device__ __forceinline__ void transpose_item(const float* W, int ld, int K, bf16* WT, int k0, int n0, int drow, LAS float* scr, int lane) {
#pragma unroll 8
    for (int i = 0; i < 32; ++i) { const int kk = 2 * i + (lane >> 5); scr[kk * 33 + (lane & 31)] = W[(size_t)(k0 + kk) * ld + n0 + (lane & 31)]; }
    LDS_WAIT(); asm volatile("" ::: "memory");
    const int c = lane & 7;
#pragma unroll
    for (int j = 0; j < 4; ++j) { const int n = (lane >> 3) + 8 * j; const LAS float* s = scr + (8 * c) * 33 + n;
        v4u o; o.x = pk2(s[0 * 33], s[1 * 33]); o.y = pk2(s[2 * 33], s[3 * 33]); o.z = pk2(s[4 * 33], s[5 * 33]); o.w = pk2(s[6 * 33], s[7 * 33]);
        *(GAS v4u*)(WT + (size_t)(drow + n) * K + k0 + 8 * c) = o; }
    LDS_WAIT(); asm volatile("" ::: "memory");
}
__device__ __forceinline__ void p0_convert(Frame& F) {
    relane(F);
    LAS float* scr = (LAS float*)(F.lds + RING_OFF + F.wave * 16384);
    bf16* Wb = (bf16*)(F.ws + WS_W); bf16* Wkv = (bf16*)(F.ws + WS_XWT);
    constexpr int I_IN = 16 * 96, I_OUT = 16 * 32, I_Q = 16 * 32, I_O = 16 * 32, I_KV = 16 * 64, I_GU = 16 * 176, I_DN = 44 * 32;
    constexpr int I_LAYER = I_IN + I_OUT + I_Q + I_O + I_KV + I_GU + I_DN;
    for (int it = F.gw; it < 4 * I_LAYER; it += F.NGW) {
        const int l = it / I_LAYER, j = l >> 1; int r = it % I_LAYER;
        bf16* WL = Wb + (size_t)l * WL_SIZE;
        if (r < I_IN) { const int kb = r / 96, nb = r % 96;
            if (l & 1) transpose_item(inp(F, 8) + (size_t)j * D * 3072, 3072, D, WL + WL_IN, kb * 64, nb * 32, nb * 32, scr, F.lane);
            else       transpose_item(inp(F, 4) + (size_t)j * D * ML_W, ML_W, D, WL + WL_IN, kb * 64, nb * 32, nb * 32, scr, F.lane);
            continue; } r -= I_IN;
        if (r < I_OUT) { const int kb = r / 32, nb = r % 32;
            transpose_item(((l & 1) ? inp(F, 9) : inp(F, 7)) + (size_t)j * D * D, D, D, WL + WL_OUT, kb * 64, nb * 32, nb * 32, scr, F.lane); continue; } r -= I_OUT;
        if (r < I_Q) { const int e0 = r * 2048 + F.lane * 8;
#pragma unroll
            for (int q = 0; q < 4; ++q) { const GAS f32x4* sp = (const GAS f32x4*)(inp(F, 10) + (size_t)l * D * D + e0 + q * 512); const f32x4 x0 = sp[0], x1 = sp[1];
                v4u o; o.x = pk2(x0.x, x0.y); o.y = pk2(x0.z, x0.w); o.z = pk2(x1.x, x1.y); o.w = pk2(x1.z, x1.w); *(GAS v4u*)(WL + WL_QN + e0 + q * 512) = o; }
            continue; } r -= I_Q;
        if (r < I_O) { const int kb = r / 32, nb = r % 32; transpose_item(inp(F, 12) + (size_t)l * D * D, D, D, WL + WL_OT, kb * 64, nb * 32, nb * 32, scr, F.lane); continue; } r -= I_O;
        if (r < I_KV) { const int kb = r / 64, nb = r % 64; transpose_item(inp(F, 11) + (size_t)l * D * 2048, 2048, D, Wkv, kb * 64, nb * 32, l * 2048 + nb * 32, scr, F.lane); continue; } r -= I_KV;
        if (r < I_GU) { const int kb = r / 176, nb = r % 176; const int c0 = nb * 32; const int up = c0 >= DFF, jj = up ? c0 - DFF : c0;
            transpose_item(inp(F, 13) + (size_t)l * D * 2 * DFF, 2 * DFF, D, WL + WL_GU, kb * 64, c0, 256 * (jj >> 7) + 128 * up + (jj & 127), scr, F.lane); continue; } r -= I_GU;
        { const int kb = r / 32, nb = r % 32; transpose_item(inp(F, 14) + (size_t)l * DFF * D, D, DFF, WL + WL_DN, kb * 64, nb * 32, nb * 32, scr, F.lane); }
    }
    bf16* MEMN = (bf16*)(F.ws + WS_MEMN);
    for (int m = F.gw; m < MM; m += F.NGW) {
        const GAS f32x4* xr = (const GAS f32x4*)(inp(F, 1) + (size_t)m * D) + F.lane; const GAS f32x4* gr = (const GAS f32x4*)inp(F, 2) + F.lane;
        f32x4 v[4]; float s = 0.f;
#pragma unroll
        for (int q = 0; q < 4; ++q) { v[q] = xr[64 * q]; s += (v[q].x * v[q].x + v[q].y * v[q].y) + (v[q].z * v[q].z + v[q].w * v[q].w); }
        const float rs = rsqrtf(wave_sum(s) * (1.f / D) + EPS);
        GAS unsigned long long* o8 = (GAS unsigned long long*)(MEMN + (size_t)m * D) + F.lane;
#pragma unroll
        for (int q = 0; q < 4; ++q) { const f32x4 g = gr[64 * q]; o8[64 * q] = (unsigned long long)pk2(v[q].x * rs * g.x, v[q].y * rs * g.y) | ((unsigned long long)pk2(v[q].z * rs * g.z, v[q].w * rs * g.w) << 32); }
    }
}

__device__ __forceinline__ void row_phase(Frame& F, const float* xin, float* xout, const bf16* Y, const float* ga, const float* gb, bf16* XN, const float* WG, int wgs, const float* bg, float* GT) {
    relane(F);
    for (int m = F.gw; m < M; m += F.NGW) {
        const GAS f32x4* xr = (const GAS f32x4*)(xin + (size_t)m * D) + F.lane;
        f32x4 v[4];
#pragma unroll
        for (int q = 0; q < 4; ++q) v[q] = xr[64 * q];
        if (Y) {
            const GAS unsigned long long* yr = (const GAS unsigned long long*)(Y + (size_t)m * D) + F.lane;
            f32x4 y[4]; float s = 0.f;
#pragma unroll
            for (int q = 0; q < 4; ++q) { const unsigned long long w = yr[64 * q]; const unsigned lo = (unsigned)w, hi = (unsigned)(w >> 32);
                y[q] = (f32x4){bflo(lo), bfhi(lo), bflo(hi), bfhi(hi)}; s += (y[q].x * y[q].x + y[q].y * y[q].y) + (y[q].z * y[q].z + y[q].w * y[q].w); }
            const float rs = rsqrtf(wave_sum(s) * (1.f / D) + EPS);
            const GAS f32x4* gr = (const GAS f32x4*)ga + F.lane;
#pragma unroll
            for (int q = 0; q < 4; ++q) { const f32x4 g = gr[64 * q]; v[q] = v[q] + y[q] * rs * g; }
        }
        if (Y || xin != xout) { GAS f32x4* xo = (GAS f32x4*)(xout + (size_t)m * D) + F.lane;
#pragma unroll
            for (int q = 0; q < 4; ++q) xo[64 * q] = v[q]; }
        if (gb) {
            float s = 0.f;
#pragma unroll
            for (int q = 0; q < 4; ++q) s += (v[q].x * v[q].x + v[q].y * v[q].y) + (v[q].z * v[q].z + v[q].w * v[q].w);
            const float rs = rsqrtf(wave_sum(s) * (1.f / D) + EPS);
            const GAS f32x4* gr = (const GAS f32x4*)gb + F.lane;
            GAS unsigned long long* o8 = (GAS unsigned long long*)(XN + (size_t)m * D) + F.lane;
#pragma unroll
            for (int q = 0; q < 4; ++q) { const f32x4 g = gr[64 * q]; v[q] = v[q] * rs * g; o8[64 * q] = (unsigned long long)pk2(v[q].x, v[q].y) | ((unsigned long long)pk2(v[q].z, v[q].w) << 32); }
            if (WG) {
                float acc[8];
#pragma unroll
                for (int c = 0; c < 8; ++c) acc[c] = 0.f;
#pragma unroll
                for (int q = 0; q < 4; ++q)
#pragma unroll
                    for (int e = 0; e < 4; ++e) { const GAS f32x4* w = (const GAS f32x4*)(WG + (size_t)(4 * F.lane + 256 * q + e) * wgs); const f32x4 w0 = w[0], w1 = w[1]; const float h = v[q][e];
                        acc[0] += h * w0.x; acc[1] += h * w0.y; acc[2] += h * w0.z; acc[3] += h * w0.w; acc[4] += h * w1.x; acc[5] += h * w1.y; acc[6] += h * w1.z; acc[7] += h * w1.w; }
#pragma unroll
                for (int c = 0; c < 8; ++c) acc[c] = wave_sum(acc[c]);
                if (F.lane < 8) {
                    float a = 0.f;
#pragma unroll
                    for (int c = 0; c < 8; ++c) a = (F.lane == c) ? acc[c] : a;
                    a = 15.f * tanhf((a + bg[F.lane]) * (1.f / 15.f));
                    if (F.lane >= 4) a = -softplusf(-a);
                    GT[(size_t)m * 8 + F.lane] = a;
                }
            }
        }
    }
}

__device__ __forceinline__ void mlstm_scan_v1(Frame& F, const bf16* PROJ, const float* GT, bf16* MIX) {
    relane(F);
    const int vi = F.tid >> 4, kq = F.tid & 15;
    for (int task = blockIdx.x; task < BATCH * ML_H * 8; task += F.G) {
        const int bh = task >> 3, vs = task & 7, b = bh >> 2, h = bh & 3;
        float C[8], n[8], m = 0.f;
#pragma unroll
        for (int i = 0; i < 8; ++i) { C[i] = 0.f; n[i] = 0.f; }
        const bf16* p0 = PROJ + (size_t)b * SEQ * 3072;
        const float* g0 = GT + (size_t)b * SEQ * 8;
        v4u qn = *(const GAS v4u*)(p0 + h * 128 + kq * 8), kn = *(const GAS v4u*)(p0 + 512 + h * 128 + kq * 8);
        unsigned short vn = *(const GAS unsigned short*)(p0 + 1024 + h * 256 + vs * 32 + vi);
        float ign = g0[h], lfn = g0[4 + h];
        for (int t = 0; t < SEQ; ++t) {
            const v4u qc = qn, kc = kn; const float vv = bf2f(vn), ig = ign, lf = lfn;
            if (t + 1 < SEQ) { const bf16* p = p0 + (size_t)(t + 1) * 3072; qn = *(const GAS v4u*)(p + h * 128 + kq * 8); kn = *(const GAS v4u*)(p + 512 + h * 128 + kq * 8);
                vn = *(const GAS unsigned short*)(p + 1024 + h * 256 + vs * 32 + vi); ign = g0[(t + 1) * 8 + h]; lfn = g0[(t + 1) * 8 + 4 + h]; }
            const float mn = fmaxf(lf + m, ig), dec = __expf(lf + m - mn), wi = __expf(ig - mn); m = mn;
            const float qf[8] = {bflo(qc.x), bfhi(qc.x), bflo(qc.y), bfhi(qc.y), bflo(qc.z), bfhi(qc.z), bflo(qc.w), bfhi(qc.w)};
            const float kf[8] = {bflo(kc.x), bfhi(kc.x), bflo(kc.y), bfhi(kc.y), bflo(kc.z), bfhi(kc.z), bflo(kc.w), bfhi(kc.w)};
            float num = 0.f, den = 0.f;
#pragma unroll
            for (int i = 0; i < 8; ++i) { const float kk = kf[i] * 0.08838834764831845f;
                C[i] = dec * C[i] + wi * vv * kk; n[i] = dec * n[i] + wi * kk; num += C[i] * qf[i]; den += n[i] * qf[i]; }
#pragma unroll
            for (int o = 1; o < 16; o <<= 1) { num += __shfl_xor(num, o); den += __shfl_xor(den, o); }
            if (kq == 0) { const float r = num / fmaxf(fabsf(den), __expf(-mn)); ((GAS unsigned short*)MIX)[(size_t)(b * SEQ + t) * D + h * 256 + vs * 32 + vi] = (unsigned short)f2bf(r); }
        }
    }
}
__device__ __forceinline__ void mlstm_post_v1(Frame& F, const bf16* PROJ, const float* hg, bf16* MIX) {
    relane(F);
    for (int w = F.gw; w < M * ML_H; w += F.NGW) {
        const int tok = w >> 2, h = w & 3;
        GAS unsigned long long* r = (GAS unsigned long long*)(MIX + (size_t)tok * D + h * 256) + F.lane;
        const unsigned long long hw = *r, ow = *((const GAS unsigned long long*)(PROJ + (size_t)tok * 3072 + 2048 + h * 256) + F.lane);
        const float v[4] = {bflo((unsigned)hw), bfhi((unsigned)hw), bflo((unsigned)(hw >> 32)), bfhi((unsigned)(hw >> 32))};
        const float o[4] = {bflo((unsigned)ow), bfhi((unsigned)ow), bflo((unsigned)(ow >> 32)), bfhi((unsigned)(ow >> 32))};
        const float rs = rsqrtf(wave_sum((v[0] * v[0] + v[1] * v[1]) + (v[2] * v[2] + v[3] * v[3])) * (1.f / 256.f) + EPS);
        const f32x4 g = *((const GAS f32x4*)(hg + h * 256) + F.lane);
        float y[4];
#pragma unroll
        for (int e = 0; e < 4; ++e) y[e] = v[e] * rs * g[e] / (1.f + __expf(-o[e]));
        *r = (unsigned long long)pk2(y[0], y[1]) | ((unsigned long long)pk2(y[2], y[3]) << 32);
    }
}

__device__ __forceinline__ void sb_attn_v1(Frame& F, const bf16* QKV, bf16* MIX) {
    relane(F);
    for (int task = F.gw; task < BATCH * SB_H * 16; task += F.NGW) {
        const int bh = task >> 4, pr = task & 15, b = bh >> 4, h = bh & 15;
#pragma unroll 1
        for (int half = 0; half < 2; ++half) {
            const int tb = half ? 31 - pr : pr, t = tb * 64 + F.lane;
            float q[64], o[64];
            const GAS v4u* qp = (const GAS v4u*)(QKV + (size_t)(b * SEQ + t) * 3072 + h * 64);
#pragma unroll
            for (int c = 0; c < 8; ++c) { const v4u w = qp[c]; q[8 * c] = bflo(w.x) * 0.125f; q[8 * c + 1] = bfhi(w.x) * 0.125f; q[8 * c + 2] = bflo(w.y) * 0.125f; q[8 * c + 3] = bfhi(w.y) * 0.125f;
                q[8 * c + 4] = bflo(w.z) * 0.125f; q[8 * c + 5] = bfhi(w.z) * 0.125f; q[8 * c + 6] = bflo(w.w) * 0.125f; q[8 * c + 7] = bfhi(w.w) * 0.125f; }
#pragma unroll
            for (int d = 0; d < 64; ++d) o[d] = 0.f;
            float run = 0.f;
            for (int s = tb * 64 + 62; s >= 0; --s) {
                const GAS v4u* kp = (const GAS v4u*)(QKV + (size_t)(b * SEQ + s) * 3072 + 1024 + h * 64);
                float z = 0.f;
#pragma unroll
                for (int c = 0; c < 8; ++c) { const v4u w = kp[c]; z += q[8 * c] * bflo(w.x) + q[8 * c + 1] * bfhi(w.x) + q[8 * c + 2] * bflo(w.y) + q[8 * c + 3] * bfhi(w.y)
                        + q[8 * c + 4] * bflo(w.z) + q[8 * c + 5] * bfhi(w.z) + q[8 * c + 6] * bflo(w.w) + q[8 * c + 7] * bfhi(w.w); }
                if (s < t) {
                    const float sp = softplusf(z), a = __expf(z - sp + run); run -= sp;
                    const GAS v4u* vp = kp + 128;
#pragma unroll
                    for (int c = 0; c < 8; ++c) { const v4u w = vp[c]; o[8 * c] += a * bflo(w.x); o[8 * c + 1] += a * bfhi(w.x); o[8 * c + 2] += a * bflo(w.y); o[8 * c + 3] += a * bfhi(w.y);
                        o[8 * c + 4] += a * bflo(w.z); o[8 * c + 5] += a * bfhi(w.z); o[8 * c + 6] += a * bflo(w.w); o[8 * c + 7] += a * bfhi(w.w); }
                }
            }
            GAS v4u* op = (GAS v4u*)(MIX + (size_t)(b * SEQ + t) * D + h * 64);
#pragma unroll
            for (int c = 0; c < 8; ++c) { v4u w; w.x = pk2(o[8 * c], o[8 * c + 1]); w.y = pk2(o[8 * c + 2], o[8 * c + 3]); w.z = pk2(o[8 * c + 4], o[8 * c + 5]); w.w = pk2(o[8 * c + 6], o[8 * c + 7]); op[c] = w; }
        }
    }
}

namespace sbk {
typedef float f32x16 __attribute__((ext_vector_type(16)));
typedef short s16x4 __attribute__((ext_vector_type(4)));
typedef short v4i16_t __attribute__((ext_vector_type(4)));
__device__ __forceinline__ unsigned cvtpk(float lo, float hi) { typedef float f32x2_t __attribute__((ext_vector_type(2))); typedef __bf16 bf16x2_t __attribute__((ext_vector_type(2)));
    f32x2_t v = {lo, hi}; bf16x2_t b = __builtin_convertvector(v, bf16x2_t); return __builtin_bit_cast(unsigned, b); }
#define SB_MFMA(a, b, c) __builtin_amdgcn_mfma_f32_32x32x16_bf16((a), (b), (c), 0, 0, 0)
constexpr int KB0 = 0, VB0 = 16384;
constexpr float C2 = 0.125f * 1.4426950408889634f;

template <bool MASK>
__device__ __forceinline__ void tile(LAS unsigned char* kb, LAS unsigned char* vb, const bf16x8 (&qr)[4], f32x16 (&o)[2], float& carry, int nv, int lane, int r, int hh, const bf16x8 (&TRI)[2], const bf16x8 ONES) {
    f32x16 e[2];
    {   f32x16 p0, p1;
#pragma unroll
        for (int i = 0; i < 16; ++i) { p0[i] = 0.f; p1[i] = 0.f; }
#pragma unroll
        for (int ks = 0; ks < 4; ++ks) {
            const bf16x8 k0 = *(const LAS bf16x8*)(kb + r * 128 + (((2 * ks + hh) ^ (r & 7)) << 4));
            const bf16x8 k1 = *(const LAS bf16x8*)(kb + (r + 32) * 128 + (((2 * ks + hh) ^ (r & 7)) << 4));
            p0 = SB_MFMA(k0, qr[ks], p0); p1 = SB_MFMA(k1, qr[ks], p1);
        }
        e[0] = p0; e[1] = p1;
    }
    v4u Lhi[2][2], Llo[2][2];
    float sv = 0.f;
#pragma unroll
    for (int ib = 0; ib < 2; ++ib)
#pragma unroll
        for (int i = 0; i < 16; i += 2) {
            float L[2];
#pragma unroll
            for (int u = 0; u < 2; ++u) {
                const float w = e[ib][i + u] * C2;
                const float sp = fmaxf(w, 0.f) + __builtin_amdgcn_logf(1.f + __builtin_amdgcn_exp2f(-fabsf(w)));
                float Lm = -sp;
                if (MASK) { const int ci = ((i + u) & 3) + 8 * ((i + u) >> 2) + 32 * ib; Lm = (ci < nv) ? Lm : 0.f; }
                const float E = w - sp;
                if (ib == 0 && i + u == 0) sv = E - Lm;
                e[ib][i + u] = E + carry;
                L[u] = Lm;
            }
            const unsigned hw = cvtpk(L[0], L[1]);
            const unsigned lw = cvtpk(L[0] - bflo(hw), L[1] - bfhi(hw));
            const int ks2 = i >> 3, m = (i & 7) >> 1;
            Lhi[ib][ks2][m] = hw; Llo[ib][ks2][m] = lw;
        }
#define SB_F(x) __builtin_bit_cast(bf16x8, x)
    e[0] = SB_MFMA(TRI[0], SB_F(Lhi[0][0]), e[0]); e[0] = SB_MFMA(TRI[1], SB_F(Lhi[0][1]), e[0]);
    e[1] = SB_MFMA(TRI[0], SB_F(Lhi[1][0]), e[1]); e[1] = SB_MFMA(TRI[1], SB_F(Lhi[1][1]), e[1]);
    e[0] = SB_MFMA(ONES, SB_F(Lhi[1][0]), e[0]); e[0] = SB_MFMA(ONES, SB_F(Lhi[1][1]), e[0]);
    e[0] = SB_MFMA(TRI[0], SB_F(Llo[0][0]), e[0]); e[0] = SB_MFMA(TRI[1], SB_F(Llo[0][1]), e[0]);
    e[1] = SB_MFMA(TRI[0], SB_F(Llo[1][0]), e[1]); e[1] = SB_MFMA(TRI[1], SB_F(Llo[1][1]), e[1]);
    e[0] = SB_MFMA(ONES, SB_F(Llo[1][0]), e[0]); e[0] = SB_MFMA(ONES, SB_F(Llo[1][1]), e[0]);
    carry = __shfl(e[0][0] - sv, r);
    v4u pa[2][2];
#pragma unroll
    for (int ib = 0; ib < 2; ++ib)
#pragma unroll
        for (int i = 0; i < 16; i += 2) {
            float a[2];
#pragma unroll
            for (int u = 0; u < 2; ++u) {
                a[u] = __builtin_amdgcn_exp2f(e[ib][i + u]);
                if (MASK) { const int ci = ((i + u) & 3) + 8 * ((i + u) >> 2) + 32 * ib; a[u] = (ci < nv) ? a[u] : 0.f; }
            }
            pa[ib][i >> 3][(i & 7) >> 1] = cvtpk(a[0], a[1]);
        }
    const int q4 = (lane & 15) >> 2, p4 = lane & 3, g1 = (lane >> 4) & 1;
    LAS unsigned char* vl = vb + (4 * hh + q4) * 128 + (16 * g1 + 4 * p4) * 2;
#pragma unroll
    for (int ib = 0; ib < 2; ++ib)
#pragma unroll
        for (int ks2 = 0; ks2 < 2; ++ks2)
#pragma unroll
            for (int db = 0; db < 2; ++db) {
                LAS unsigned char* pv = vl + (32 * ib + 16 * ks2) * 128 + db * 64;
                const s16x4 lo = __builtin_bit_cast(s16x4, __builtin_amdgcn_ds_read_tr16_b64_v4i16((LAS v4i16_t*)pv));
                const s16x4 hi = __builtin_bit_cast(s16x4, __builtin_amdgcn_ds_read_tr16_b64_v4i16((LAS v4i16_t*)(pv + 8 * 128)));
                const bf16x8 vf = __builtin_shufflevector(lo, hi, 0, 1, 2, 3, 4, 5, 6, 7);
                o[db] = SB_MFMA(SB_F(pa[ib][ks2]), vf, o[db]);
            }
#undef SB_F
}

__device__ __forceinline__ void unit(int b, int h, int qb, const bf16* QKV, bf16* MIX, LAS unsigned char* lds, int tid) {
    const int lane = tid & 63, r = lane & 31, hh = lane >> 5, wid = __builtin_amdgcn_readfirstlane(tid >> 6);
    const size_t rowbase = (size_t)b * SEQ; const int q0 = qb * 256, trow = q0 + 32 * wid + r;
    bf16x8 qr[4];
#pragma unroll
    for (int ks = 0; ks < 4; ++ks) qr[ks] = *(const GAS bf16x8*)(QKV + (rowbase + trow) * 3072 + h * 64 + ks * 16 + hh * 8);
    bf16x8 TRI[2], ONES;
#pragma unroll
    for (int ks2 = 0; ks2 < 2; ++ks2)
#pragma unroll
        for (int j = 0; j < 8; ++j) TRI[ks2][j] = ((16 * ks2 + 8 * (j >> 2) + 4 * hh + (j & 3)) > r) ? (short)0x3F80 : (short)0;
#pragma unroll
    for (int j = 0; j < 8; ++j) ONES[j] = (short)0x3F80;
    const int srow = tid >> 3, sc = tid & 7;
    const bf16* kg = QKV + rowbase * 3072 + 1024 + h * 64 + (size_t)srow * 3072 + sc * 8;
    const int kdst = srow * 128 + ((sc ^ (srow & 7)) << 4), vdst = srow * 128 + sc * 16;
    const int NT = 4 * qb + 4;
    { const bf16* p = kg + (size_t)(NT - 1) * 64 * 3072; const v4u kx = *(const GAS v4u*)p, vx = *(const GAS v4u*)(p + 1024);
      *(LAS v4u*)(lds + KB0 + kdst) = kx; *(LAS v4u*)(lds + VB0 + vdst) = vx; }
    __syncthreads();
    f32x16 o[2];
#pragma unroll
    for (int i = 0; i < 16; ++i) { o[0][i] = 0.f; o[1][i] = 0.f; }
    float carry = 0.f;
    const int wmax = q0 + 32 * wid + 31, wmin = q0 + 32 * wid;
    for (int kt = NT - 1; kt >= 0; --kt) {
        const int cur = (NT - 1 - kt) & 1;
        v4u kx, vx;
        if (kt > 0) { const bf16* p = kg + (size_t)(kt - 1) * 64 * 3072; kx = *(const GAS v4u*)p; vx = *(const GAS v4u*)(p + 1024); }
        if (64 * kt < wmax) {
            const int nv = trow - 64 * kt - 4 * hh;
            if (64 * kt + 63 >= wmin) tile<true>(lds + KB0 + cur * 8192, lds + VB0 + cur * 8192, qr, o, carry, nv, lane, r, hh, TRI, ONES);
            else tile<false>(lds + KB0 + cur * 8192, lds + VB0 + cur * 8192, qr, o, carry, nv, lane, r, hh, TRI, ONES);
        }
        if (kt > 0) { *(LAS v4u*)(lds + KB0 + (cur ^ 1) * 8192 + kdst) = kx; *(LAS v4u*)(lds + VB0 + (cur ^ 1) * 8192 + vdst) = vx; }
        __syncthreads();
    }
    unsigned short* op = (unsigned short*)MIX + (rowbase + q0 + 32 * wid) * D + h * 64 + r;
#pragma unroll
    for (int db = 0; db < 2; ++db)
#pragma unroll
        for (int i = 0; i < 16; ++i) { const int row = (i & 3) + 8 * (i >> 2) + 4 * hh; ((GAS unsigned short*)op)[(size_t)row * D + 32 * db] = (unsigned short)f2bf(o[db][i]); }
}
#undef SB_MFMA
}
__device__ __forceinline__ void sb_attn_v2(Frame& F, const bf16* QKV, bf16* MIX) {
    relane(F);
    for (int v = blockIdx.x; v < 256; v += F.G) {
        const int bh = v >> 1, sel = v & 1;
#pragma unroll 1
        for (int u = 0; u < 4; ++u) {
            const int qb = sel ? ((u == 0) ? 6 : (u == 1) ? 1 : (u == 2) ? 4 : 3) : ((u == 0) ? 7 : (u == 1) ? 0 : (u == 2) ? 5 : 2);
            sbk::unit(bh >> 4, bh & 15, qb, QKV, MIX, F.lds + RING_OFF, F.tid);
        }
    }
}

template <int MR, int N, int K, bool ALIGN, class Epi> __device__ __forceinline__ void run_gemm(Frame& F, const bf16* A, int lda, const bf16* Bt, int ldb, int pmb, size_t b_batch, const Epi E) {
    int gd = gridDim.x, bi = blockIdx.x; asm volatile("" : "+s"(gd), "+s"(bi));
    pg8::Gemm g{A, Bt, MR, N, K, lda, ldb}; pg8::StaticOrder S; S.init(MR, N, gd, bi, lda, ldb, pmb, b_batch);
    pg8::gemm_phase<Epi, pg8::StaticOrder, ALIGN, true>(F.lds + RING_OFF, g, S, E);
}
__device__ __forceinline__ void xw_gemms(Frame& F, const bf16* KVl, const bf16* WQN, const bf16* WOT, bf16* XWTp) {
    int gd = gridDim.x, bi = blockIdx.x; asm volatile("" : "+s"(gd), "+s"(bi));
    for (int L = bi; L < 256; L += gd) {
        const int idx = L & 127, b = idx >> 4, h = (idx >> 2) & 3, t = idx & 3;
        OneUnit S; int kk = 256; asm volatile("" : "+s"(kk));
        if (L < 128) {
            pg8::Gemm g{KVl + (size_t)(b * NMEM) * 8192 + h * 256, WQN + (size_t)(t * 256) * D + h * 256, 256, 256, kk, 8192, D};
            EpiStore E{XWTp + (size_t)b * D * D + (size_t)(h * 256) * D + t * 256, D};
            pg8::gemm_phase<EpiStore, OneUnit, true, true>(F.lds + RING_OFF, g, S, E);
        } else {
            pg8::Gemm g{WOT + (size_t)(t * 256) * D + h * 256, KVl + (size_t)(b * NMEM) * 8192 + 1024 + h * 256, 256, 256, kk, D, 8192};
            EpiStore E{XWTp + (size_t)(8 + b) * D * D + (size_t)(t * 256) * D + h * 256, D};
            pg8::gemm_phase<EpiStore, OneUnit, true, true>(F.lds + RING_OFF, g, S, E);
        }
    }
}
struct Args { const float* in[15]; float* out; unsigned char* ws; int pad[2]; };
__global__ void __launch_bounds__(NWAVES * 64, 2) mega_fwd(Args args) {
    extern __shared__ __attribute__((aligned(16))) unsigned char lds[];
    Frame F;
    F.lds = (LAS unsigned char*)lds; F.ws = args.ws;
    relane(F);
    for (int u = F.tid; u < (LDS_BYTES - LDSCTL_OFF) / 4; u += NWAVES * 64) ((LAS unsigned*)(F.lds + LDSCTL_OFF))[u] = 0u;
    __syncthreads();
    if (F.tid < 16) { const unsigned long long p = (F.tid < 15) ? (unsigned long long)args.in[F.tid < 15 ? F.tid : 0] : (unsigned long long)args.out;
        ((LAS unsigned*)(F.lds + LDSCTL_OFF))[2 * F.tid] = (unsigned)p; ((LAS unsigned*)(F.lds + LDSCTL_OFF))[2 * F.tid + 1] = (unsigned)(p >> 32); }
    __syncthreads();
    gu32* ctl = (gu32*)(F.ws + WS_CTL);
    XcdBarrier bar = xcd_barrier_post((unsigned*)(ctl + CW_BAR), (volatile LAS unsigned*)(F.lds + MISC_OFF) + 8);
#define GRID_BAR() xcd_barrier(bar)

#define Wb ((bf16*)(F.ws + WS_W))
#define XWT ((bf16*)(F.ws + WS_XWT))
#define XN ((bf16*)(F.ws + WS_XN))
#define MIX ((bf16*)(F.ws + WS_MIX))
#define BIG ((bf16*)(F.ws + WS_BIG))
#define PB (BIG + (size_t)M * D)
#define KV ((bf16*)(F.ws + WS_KV))
#define MEMN ((bf16*)(F.ws + WS_MEMN))
#define GT ((float*)(F.ws + WS_GATES))
#define gains inp(F, 3)
#define XOUT ((float*)inp(F, 15))

    p0_convert(F);
    row_phase(F, inp(F, 0), XOUT, nullptr, nullptr, gains, XN, inp(F, 4) + 3072, ML_W, inp(F, 5), GT);
    GRID_BAR();
    run_gemm<MM, 8192, D, true>(F, MEMN, D, XWT, D, 0, 0, EpiStore{KV, 8192});

#pragma unroll 1
    for (int l = 0; l < DEPTH; ++l) {
#define WL (Wb + (size_t)l * WL_SIZE)
#define GL (gains + (size_t)l * 6 * D)
        const bool ml = (l & 1) == 0;
        run_gemm<M, 3072, D, true>(F, XN, D, WL + WL_IN, D, 0, 0, EpiStore{BIG, 3072}); GRID_BAR();
        if (ml) { mlstm_scan_v1(F, BIG, GT, MIX); GRID_BAR(); mlstm_post_v1(F, BIG, inp(F, 6) + (size_t)(l >> 1) * D, MIX); } else sb_attn_v2(F, BIG, MIX);
        GRID_BAR();
        run_gemm<M, D, D, true>(F, MIX, D, WL + WL_OUT, D, 0, 0, EpiStore{BIG, D});
        xw_gemms(F, KV + (size_t)l * 2048, WL + WL_QN, WL + WL_OT, XWT); GRID_BAR();
        row_phase(F, XOUT, XOUT, BIG, GL + D, GL + 2 * D, XN, nullptr, 0, nullptr, nullptr); GRID_BAR();
        run_gemm<M, D, D, false>(F, XN, D, XWT, D, 8, (size_t)D * D * 2, EpiSoftmax{PB, D}); GRID_BAR();
        run_gemm<M, D, D, true>(F, PB, D, XWT + (size_t)8 * D * D, D, 8, (size_t)D * D * 2, EpiStore{BIG, D}); GRID_BAR();
        row_phase(F, XOUT, XOUT, BIG, GL + 3 * D, GL + 4 * D, XN, nullptr, 0, nullptr, nullptr); GRID_BAR();
        run_gemm<M, 2 * DFF, D, true>(F, XN, D, WL + WL_GU, D, 0, 0, EpiSwiglu{BIG, DFF}); GRID_BAR();
        run_gemm<M, D, DFF, true>(F, BIG, DFF, WL + WL_DN, DFF, 0, 0, EpiStore{MIX, D}); GRID_BAR();
        { const bool last = (l + 1 == DEPTH), gates = !last && (((l + 1) & 1) == 0);
          row_phase(F, XOUT, XOUT, MIX, GL + 5 * D, last ? nullptr : GL + 6 * D, XN,
                    gates ? inp(F, 4) + (size_t)((l + 1) >> 1) * D * ML_W + 3072 : nullptr, ML_W, inp(F, 5) + ((l + 1) >> 1) * 8, GT);
          if (!last) GRID_BAR(); }
    }
}

extern "C" void kernel_launch(void* const* d_in, const int* in_sizes, int n_in, void* d_out, int out_size, void* d_ws, size_t ws_size, hipStream_t stream) {
    static int grid = 0;
    if (grid == 0) {
        if (n_in != 15 || out_size != M * D || ws_size < WS_END) { fprintf(stderr, "kernel_launch: unexpected shapes (n_in %d out %d ws %zu need %zu)\n", n_in, out_size, ws_size, (size_t)WS_END); grid = -1; return; }
        int dev = 0, cus = 0, per_cu = 0;
        if (hipGetDevice(&dev) != hipSuccess || hipDeviceGetAttribute(&cus, hipDeviceAttributeMultiprocessorCount, dev) != hipSuccess) { grid = -1; return; }
        if (hipFuncSetAttribute((const void*)mega_fwd, hipFuncAttributeMaxDynamicSharedMemorySize, LDS_BYTES) != hipSuccess) { fprintf(stderr, "kernel_launch: hipFuncSetAttribute failed\n"); grid = -1; return; }
        if (hipOccupancyMaxActiveBlocksPerMultiprocessor(&per_cu, (const void*)mega_fwd, NWAVES * 64, LDS_BYTES) != hipSuccess || per_cu < 1) fprintf(stderr, "kernel_launch: occupancy query reports %d\n", per_cu);
        (void)hipGetLastError();
        grid = cus;
    }
    if (grid < 0) return;
    if (hipMemsetAsync((char*)d_ws + WS_CTL, 0, CTL_ZERO_BYTES, stream) != hipSuccess) return;
    Args a{};
    for (int i = 0; i < 15; ++i) a.in[i] = (const float*)d_in[i];
    a.out = (float*)d_out; a.ws = (unsigned char*)d_ws;
    hipLaunchKernelGGL(mega_fwd, dim3(grid), dim3(NWAVES * 64), LDS_BYTES, stream, a);
}
```

```cpp
#include <hip/hip_runtime.h>
#include <cstdio>
#include <cstdint>
namespace pg8 {
#define PG8_LAS __attribute__((address_space(3)))
typedef unsigned short bf16_t;
typedef short bf16x8 __attribute__((ext_vector_type(8)));
typedef float f32x4 __attribute__((ext_vector_type(4)));
typedef unsigned u32x4 __attribute__((ext_vector_type(4)));
constexpr int BM = 256, BK = 64, HALF = 128, HTB = HALF * BK * 2  , STAGE_BYTES = 8 * HTB, NXCD = 8, WGM = 8;

__host__ __device__ __forceinline__ int lds_byte(int r, int c) { const int st = (r >> 4) * 2 + (c >> 5), rr = r & 15, cc = c & 31, ob = rr * 64 + cc * 2; return st * 1024 + (ob ^ (((ob >> 9) & 1) << 5)); }
__host__ __device__ __forceinline__ void stage_rc(int b, int& R, int& C) { const int st = b / 1024, sb = b % 1024, swz = sb ^ (((sb >> 9) & 1) << 5); R = (st >> 1) * 16 + swz / 64; C = (st & 1) * 32 + (swz % 64) / 2; }
__host__ __device__ __forceinline__ int perm32(int rho) { const int n = rho >> 4, i = rho & 15; return 8 * (i >> 2) + 4 * n + (i & 3); }

struct Unit { int pm, pn; size_t aoff, boff; };
struct Gemm { const bf16_t* A; const bf16_t* Bt; int M, N, K, lda, ldb; };

struct StaticOrder {
    int nM, nN, nwg, G, c, pmb; size_t a_rt, b_rt, b_batch;
    __host__ __device__ void init(int M, int N, int G_, int c_, int lda, int ldb, int pmb_ = 0, size_t b_batch_ = 0) { nM = M / BM; nN = N / BM; nwg = nM * nN; G = G_; c = c_; a_rt = (size_t)BM * lda * 2; b_rt = (size_t)BM * ldb * 2; pmb = pmb_; b_batch = b_batch_; }
    __host__ __device__ bool next(int i, Unit& u) const {
        const long L = (long)i * G + c; if (L >= nwg) return false;
        int wgid = (int)L; { const int q = nwg / NXCD, r = nwg % NXCD, xcd = wgid % NXCD, off = wgid / NXCD; wgid = (xcd < r ? xcd * (q + 1) : r * (q + 1) + (xcd - r) * q) + off; }
        const int nig = WGM * nN, gid = wgid / nig, fm = gid * WGM, gsz = (nM - fm) < WGM ? (nM - fm) : WGM;
        u.pm = fm + ((wgid % nig) % gsz); u.pn = (wgid % nig) / gsz; u.aoff = (size_t)u.pm * a_rt; u.boff = (size_t)u.pn * b_rt + (pmb ? (size_t)(u.pm / pmb) * b_batch : 0); return true;
    }
    __device__ __forceinline__ void a_ready(const Unit&) const {}
    __device__ __forceinline__ void done(const Unit&) const {}
};

__device__ __forceinline__ unsigned cvt_pk_bf16(float lo, float hi) { unsigned r; asm volatile("v_cvt_pk_bf16_f32 %0, %1, %2" : "=v"(r) : "v"(lo), "v"(hi)); return r; }
typedef float f32x2 __attribute__((ext_vector_type(2)));
__device__ __forceinline__ f32x2 gelu_pk(f32x2 v) {
    const f32x2 av = __builtin_elementwise_abs(v), d = av * 0.2316418882f + 1.0f;
    f32x2 t; t.x = __builtin_amdgcn_rcpf(d.x); t.y = __builtin_amdgcn_rcpf(d.y);
    f32x2 q = t * 0.5307027145f + (-0.7265760135f); q = q * t + 0.7107068705f; q = q * t + (-0.142248368f); q = q * t + 0.127414796f; q = q * t;
    const f32x2 s = (v * v) * (-0.72134752044f);
    f32x2 e; e.x = __builtin_amdgcn_exp2f(s.x); e.y = __builtin_amdgcn_exp2f(s.y);
    const f32x2 m = v * (q * e), r = v - m;
    f32x2 o; o.x = v.x < 0.f ? m.x : r.x; o.y = v.y < 0.f ? m.y : r.y; return o;
}

template <int ACT  > struct EpiBf16 {
    static constexpr bool PERM = true, AFTER_DRAIN = false; static_assert(ACT == 0 || ACT == 1, "EpiBf16: ACT is 0 (none) or 1 (gelu_pk)");
    bf16_t* O; int ldc; const float* bias; int split_cols; size_t split_stride; float scale0;
    __device__ __forceinline__ void operator()(const f32x4 (&acc)[2][2][4][2], const Unit& u, int wr, int wc, int fr, int fq) const {
        const int row0 = u.pm * BM + wr * 64 + fr; int colt = u.pn * BM; bf16_t* base = O;
        float sc = 1.f; if (split_cols) { const int t = colt / split_cols; base += (size_t)t * split_stride; colt -= t * split_cols; if (t == 0) sc = scale0; }
        const int col0 = colt + wc * 32 + 8 * fq, bcol0 = u.pn * BM + wc * 32 + 8 * fq;
        f32x4 bv[2][2];
#pragma unroll
        for (int bj = 0; bj < 2; ++bj)
#pragma unroll
            for (int n = 0; n < 2; ++n) bv[bj][n] = bias ? *(const f32x4*)(bias + bcol0 + bj * HALF + 4 * n) : (f32x4){0.f, 0.f, 0.f, 0.f};
#pragma unroll
        for (int ai = 0; ai < 2; ++ai)
#pragma unroll
            for (int m = 0; m < 4; ++m) { bf16_t* rowp = base + (size_t)(row0 + ai * HALF + m * 16) * ldc + col0;
#pragma unroll
                for (int bj = 0; bj < 2; ++bj) { f32x4 v0 = acc[ai][bj][m][0] + bv[bj][0], v1 = acc[ai][bj][m][1] + bv[bj][1];
                    if (ACT == 1) { f32x2 a = gelu_pk((f32x2){v0[0], v0[1]}), b = gelu_pk((f32x2){v0[2], v0[3]}), c = gelu_pk((f32x2){v1[0], v1[1]}), d = gelu_pk((f32x2){v1[2], v1[3]});
                        v0 = (f32x4){a.x, a.y, b.x, b.y}; v1 = (f32x4){c.x, c.y, d.x, d.y}; }
                    v0 = v0 * sc; v1 = v1 * sc; u32x4 w; w.x = cvt_pk_bf16(v0[0], v0[1]); w.y = cvt_pk_bf16(v0[2], v0[3]); w.z = cvt_pk_bf16(v1[0], v1[1]); w.w = cvt_pk_bf16(v1[2], v1[3]);
                    *(u32x4*)(rowp + bj * HALF) = w; } }
    }
};

struct PanelStats {
    unsigned* xbuf;
    unsigned* cnt;
    unsigned* tmo;
    int ntn; float eps;
    unsigned code;
    __device__ __forceinline__ bool run(const f32x4 (&v)[2][2][4][2], const Unit& u, int wr, int wc, int fr, int fq, PG8_LAS unsigned char* lds, int wid, int lane) const {
        typedef float f32x2v __attribute__((ext_vector_type(2)));
        PG8_LAS f32x2v* P = (PG8_LAS f32x2v*)lds;
        PG8_LAS f32x2v* S = (PG8_LAS f32x2v*)(lds + 8192);
        PG8_LAS unsigned* flag = (PG8_LAS unsigned*)(lds + 8192 + 2048);
#pragma unroll
        for (int ai = 0; ai < 2; ++ai)
#pragma unroll
            for (int m = 0; m < 4; ++m) {
                float s = 0.f;
#pragma unroll
                for (int bj = 0; bj < 2; ++bj)
#pragma unroll
                    for (int n = 0; n < 2; ++n) { const f32x4 x = v[ai][bj][m][n]; s += (x[0] + x[1]) + (x[2] + x[3]); }
                s += __shfl_xor(s, 16); s += __shfl_xor(s, 32);
                const float mw = s * (1.0f / 64.0f); float q = 0.f;
#pragma unroll
                for (int bj = 0; bj < 2; ++bj)
#pragma unroll
                    for (int n = 0; n < 2; ++n) { const f32x4 d = v[ai][bj][m][n] - mw; q += (d[0] * d[0] + d[1] * d[1]) + (d[2] * d[2] + d[3] * d[3]); }
                q += __shfl_xor(q, 16); q += __shfl_xor(q, 32);
                if (fq == 0) P[(ai * HALF + wr * 64 + m * 16 + fr) * 4 + wc] = (f32x2v){mw, q};
            }
        asm volatile("s_waitcnt lgkmcnt(0)" ::: "memory"); __builtin_amdgcn_s_barrier(); asm volatile("" ::: "memory");
#if defined(BROKEN_EXCHANGE_NO_WAIT)
#warning BROKEN CONTROL BUILD: the row-statistics exchange does not wait; results are wrong by design
        if (blockIdx.x >= 64) { const long long t0_ = clock64(); while (clock64() - t0_ < 60000) __builtin_amdgcn_s_sleep(8); }
#endif
        const int row = wid * 32 + (lane & 31);
        if (lane < 32) {
            const f32x2v a = P[row * 4 + 0], b = P[row * 4 + 1], c = P[row * 4 + 2], d = P[row * 4 + 3];
            const float mt = (a.x + b.x + c.x + d.x) * 0.25f;
            const float da = a.x - mt, db = b.x - mt, dc = c.x - mt, dd = d.x - mt;
            const float m2 = (a.y + b.y) + (c.y + d.y) + 64.0f * ((da * da + db * db) + (dc * dc + dd * dd));
            unsigned long long* slot = (unsigned long long*)xbuf + ((size_t)(u.pm * BM + row) * 4 + u.pn);
            __hip_atomic_store(slot, ((unsigned long long)__float_as_uint(m2) << 32) | __float_as_uint(mt), __ATOMIC_RELAXED, __HIP_MEMORY_SCOPE_AGENT);
        }
        asm volatile("s_waitcnt vmcnt(0)" ::: "memory");
        if (lane == 0) __hip_atomic_fetch_add(cnt + 64 * u.pm, 1u, __ATOMIC_RELAXED, __HIP_MEMORY_SCOPE_AGENT);
        if (wid == 0) {
            bool dead = false; const unsigned long long t0 = __builtin_amdgcn_s_memrealtime(); const unsigned want = 8u * (unsigned)ntn;
            for (;;) {
#if defined(BROKEN_EXCHANGE_NO_WAIT)
                break;
#endif
                if ((unsigned)__builtin_amdgcn_readfirstlane(__hip_atomic_load(cnt + 64 * u.pm, __ATOMIC_RELAXED, __HIP_MEMORY_SCOPE_AGENT)) >= want) break;
                if (__builtin_amdgcn_s_memrealtime() - t0 > 2000000ull) {
                    if (lane == 0) { unsigned expect = 0u; __hip_atomic_compare_exchange_strong(tmo + 1, &expect, code | (unsigned)(u.pm & 0xff), __ATOMIC_RELAXED, __ATOMIC_RELAXED, __HIP_MEMORY_SCOPE_AGENT);
                                     __hip_atomic_store(tmo, 1u, __ATOMIC_RELAXED, __HIP_MEMORY_SCOPE_AGENT); }
                    dead = true; break; }
                __builtin_amdgcn_s_sleep(2);
            }
            __builtin_amdgcn_fence(__ATOMIC_ACQUIRE, "agent");
            if (lane == 0) flag[0] = dead ? 1u : 0u;
        }
        asm volatile("s_waitcnt vmcnt(0) lgkmcnt(0)" ::: "memory"); __builtin_amdgcn_s_barrier(); asm volatile("" ::: "memory");
        const bool bad = flag[0] != 0u;
        if (lane < 32) {
            const unsigned long long* slot = (const unsigned long long*)xbuf + (size_t)(u.pm * BM + row) * 4; float mt[4], m2[4]; float ms = 0.f;
#pragma unroll
            for (int t = 0; t < 4; ++t) { if (t < ntn) { const unsigned long long w = __hip_atomic_load(slot + t, __ATOMIC_RELAXED, __HIP_MEMORY_SCOPE_AGENT); mt[t] = __uint_as_float((unsigned)w); m2[t] = __uint_as_float((unsigned)(w >> 32)); } else { mt[t] = 0.f; m2[t] = 0.f; } ms += mt[t]; }
            const float mean = ms / (float)ntn; float q = 0.f;
#pragma unroll
            for (int t = 0; t < 4; ++t) if (t < ntn) { const float dm = mt[t] - mean; q += m2[t] + 256.0f * dm * dm; }
            S[row] = (f32x2v){mean, 1.0f / sqrtf(q / (256.0f * (float)ntn) + eps)};
        }
        asm volatile("s_waitcnt lgkmcnt(0)" ::: "memory"); __builtin_amdgcn_s_barrier(); asm volatile("" ::: "memory");
        return bad;
    }
};
struct EpiLnRes {
    static constexpr bool PERM = false, AFTER_DRAIN = true;
    const float* base; float* out; int ldc; const float* bias; PanelStats st; unsigned poison;
    __device__ __forceinline__ void fused(f32x4 (&acc)[2][2][4][2], const Unit& u, int wr, int wc, int fr, int fq, PG8_LAS unsigned char* lds, int wid, int lane) const {
        typedef float f32x2v __attribute__((ext_vector_type(2)));
        const PG8_LAS f32x2v* S = (const PG8_LAS f32x2v*)(lds + 8192);
        const int col0 = u.pn * BM + wc * 32 + 4 * fq;
#pragma unroll
        for (int bj = 0; bj < 2; ++bj)
#pragma unroll
            for (int n = 0; n < 2; ++n) { const f32x4 bv = bias ? *(const f32x4*)(bias + col0 + bj * HALF + n * 16) : (f32x4){0.f, 0.f, 0.f, 0.f};
#pragma unroll
                for (int ai = 0; ai < 2; ++ai)
#pragma unroll
                    for (int m = 0; m < 4; ++m) acc[ai][bj][m][n] += bv; }
        f32x4 pre[4][2][2];
#pragma unroll
        for (int m = 0; m < 4; ++m) { const size_t off = (size_t)(u.pm * BM + wr * 64 + m * 16 + fr) * ldc + col0;
#pragma unroll
            for (int bj = 0; bj < 2; ++bj)
#pragma unroll
                for (int n = 0; n < 2; ++n) pre[m][bj][n] = *(const f32x4*)(base + off + bj * HALF + n * 16); }
        const bool bad = st.run(acc, u, wr, wc, fr, fq, lds, wid, lane) || poison != 0u;
        const float qnan = __builtin_nanf("");
#pragma unroll
        for (int ai = 0; ai < 2; ++ai)
#pragma unroll
            for (int m = 0; m < 4; ++m) { const int r = ai * HALF + wr * 64 + m * 16 + fr; const f32x2v sr = S[r]; const size_t off = (size_t)(u.pm * BM + r) * ldc + col0;
#pragma unroll
                for (int bj = 0; bj < 2; ++bj)
#pragma unroll
                    for (int n = 0; n < 2; ++n) { const f32x4 bs = ai == 0 ? pre[m][bj][n] : *(const f32x4*)(base + off + bj * HALF + n * 16); f32x4 o = bs + (acc[ai][bj][m][n] - sr.x) * sr.y;
                        if (bad) o = (f32x4){qnan, qnan, qnan, qnan}; *(f32x4*)(out + off + bj * HALF + n * 16) = o; }
                if (m & 1) asm volatile("" ::: "memory"); }
    }
};
struct EpiLnResLn {
    static constexpr bool PERM = false, AFTER_DRAIN = true;
    const float* base; float* out; bf16_t* xn; int ldc; const float* bias; PanelStats st1, st2; unsigned poison;
    __device__ __forceinline__ void fused(f32x4 (&acc)[2][2][4][2], const Unit& u, int wr, int wc, int fr, int fq, PG8_LAS unsigned char* lds, int wid, int lane) const {
        typedef float f32x2v __attribute__((ext_vector_type(2))); typedef unsigned u32x2v __attribute__((ext_vector_type(2)));
        const PG8_LAS f32x2v* S = (const PG8_LAS f32x2v*)(lds + 8192);
        const int col0 = u.pn * BM + wc * 32 + 4 * fq;
#pragma unroll
        for (int bj = 0; bj < 2; ++bj)
#pragma unroll
            for (int n = 0; n < 2; ++n) { const f32x4 bv = bias ? *(const f32x4*)(bias + col0 + bj * HALF + n * 16) : (f32x4){0.f, 0.f, 0.f, 0.f};
#pragma unroll
                for (int ai = 0; ai < 2; ++ai)
#pragma unroll
                    for (int m = 0; m < 4; ++m) acc[ai][bj][m][n] += bv; }
        bool bad = st1.run(acc, u, wr, wc, fr, fq, lds, wid, lane) || poison != 0u;
        const float qnan = __builtin_nanf("");
#pragma unroll
        for (int ai = 0; ai < 2; ++ai)
#pragma unroll
            for (int m = 0; m < 4; ++m) { const int r = ai * HALF + wr * 64 + m * 16 + fr; const f32x2v sr = S[r]; const size_t off = (size_t)(u.pm * BM + r) * ldc + col0;
#pragma unroll
                for (int bj = 0; bj < 2; ++bj)
#pragma unroll
                    for (int n = 0; n < 2; ++n) { const f32x4 bs = *(const f32x4*)(base + off + bj * HALF + n * 16); acc[ai][bj][m][n] = bs + (acc[ai][bj][m][n] - sr.x) * sr.y; }
                asm volatile("" : "+v"(acc[ai][0][m][0]), "+v"(acc[ai][0][m][1]), "+v"(acc[ai][1][m][0]), "+v"(acc[ai][1][m][1]));
                if (m & 1) asm volatile("" ::: "memory"); }
        const bool bad1 = bad;
        bad = st2.run(acc, u, wr, wc, fr, fq, lds, wid, lane) || bad;
#pragma unroll
        for (int ai = 0; ai < 2; ++ai)
#pragma unroll
            for (int m = 0; m < 4; ++m) { const int r = ai * HALF + wr * 64 + m * 16 + fr; const f32x2v sr = S[r]; const size_t off = (size_t)(u.pm * BM + r) * ldc + col0;
#pragma unroll
                for (int bj = 0; bj < 2; ++bj)
#pragma unroll
                    for (int n = 0; n < 2; ++n) { const f32x4 x1 = acc[ai][bj][m][n]; *(f32x4*)(out + off + bj * HALF + n * 16) = bad1 ? (f32x4){qnan, qnan, qnan, qnan} : x1;
                        const f32x4 o = (x1 - sr.x) * sr.y; u32x2v w; w.x = cvt_pk_bf16(o[0], o[1]); w.y = cvt_pk_bf16(o[2], o[3]);
                        if (bad) { w.x = 0x7fc07fc0u; w.y = 0x7fc07fc0u; } *(u32x2v*)(xn + off + bj * HALF + n * 16) = w; }
                asm volatile("" ::: "memory"); }
    }
};

template <class Epi, class Sched, bool ALIGN_EPI = false, bool SP2 = false>
__device__ __forceinline__ void gemm_phase(PG8_LAS unsigned char* lds, const Gemm g, const Sched& S, const Epi& E) {
    int tid_ = threadIdx.x; asm volatile("" : "+v"(tid_));
    const int tid = tid_, wid = __builtin_amdgcn_readfirstlane(tid >> 6), lane = tid & 63, wr = wid >> 2, wc = wid & 3, fr = lane & 15, fq = lane >> 4;
    const int K = g.K, nt = K / BK;
    unsigned voffA[2], voffB[2];
#pragma unroll
    for (int i = 0; i < 2; ++i) { int R, C; stage_rc(tid * 16 + i * 8192, R, C); const int Rb = Epi::PERM ? ((R & ~31) + perm32(R & 31)) : R;
        voffA[i] = (unsigned)(R * g.lda + C) * 2u; voffB[i] = (unsigned)(Rb * g.ldb + C) * 2u; }
    const size_t kstep = (size_t)(BK * 2);
    const size_t hstepA = (size_t)HALF * g.lda * 2, hstepB = (size_t)HALF * g.ldb * 2;
    const unsigned ldsw = (unsigned)wid * 1024u;
    const int aoff = lds_byte(wr * 64 + fr, fq * 8), boff = lds_byte(wc * 32 + fr, fq * 8);
#define PG8_SA(b, h) (((b) * 2 + (h)) * HTB)
#define PG8_SB(b, h) ((4 + (b) * 2 + (h)) * HTB)
#define PG8_STAGE(bufoff, gbase, voff) do { _Pragma("unroll") for (int _i = 0; _i < 2; ++_i) \
        __builtin_amdgcn_global_load_lds((const unsigned*)((const char*)(gbase) + (voff)[_i]), (PG8_LAS unsigned*)(lds + (bufoff) + ldsw + _i * 8192), 16, 0, 0); } while (0)
#define PG8_LDA(dst, b, h) do { _Pragma("unroll") for (int m = 0; m < 4; ++m) _Pragma("unroll") for (int k = 0; k < 2; ++k) dst[m][k] = *(const PG8_LAS bf16x8*)(lds + PG8_SA(b, h) + aoff + m * 2048 + k * 1024); } while (0)
#define PG8_LDB(dst, b, h) do { _Pragma("unroll") for (int n = 0; n < 2; ++n) _Pragma("unroll") for (int k = 0; k < 2; ++k) dst[n][k] = *(const PG8_LAS bf16x8*)(lds + PG8_SB(b, h) + boff + n * 2048 + k * 1024); } while (0)
#define PG8_MMA(ai, bj, At, Bt) do { __builtin_amdgcn_s_setprio(1); _Pragma("unroll") for (int m = 0; m < 4; ++m) _Pragma("unroll") for (int n = 0; n < 2; ++n) _Pragma("unroll") for (int k = 0; k < 2; ++k) \
        acc[ai][bj][m][n] = __builtin_amdgcn_mfma_f32_16x16x32_bf16(Bt[n][k], At[m][k], acc[ai][bj][m][n], 0, 0, 0); __builtin_amdgcn_s_setprio(0); } while (0)
#define PG8_WAIT_V(n) asm volatile("s_waitcnt vmcnt(" #n ")" ::: "memory")
#define PG8_WAIT_L(n) asm volatile("s_waitcnt lgkmcnt(" #n ")" ::: "memory")
#define PG8_BAR __builtin_amdgcn_s_barrier()
#define PG8_SCHED __builtin_amdgcn_sched_barrier(0)
    Unit cur, nxt; int ui = 0;
    if (!S.next(0, cur)) return;
    f32x4 acc[2][2][4][2];
#pragma unroll
    for (int a = 0; a < 2; ++a)
#pragma unroll
        for (int b = 0; b < 2; ++b)
#pragma unroll
            for (int m = 0; m < 4; ++m)
#pragma unroll
                for (int n = 0; n < 2; ++n) acc[a][b][m][n] = (f32x4){0.f, 0.f, 0.f, 0.f};
    bf16x8 At[4][2], B0[2][2], B1[2][2];
    const char* cA = (const char*)g.A + cur.aoff; const char* cB = (const char*)g.Bt + cur.boff;
    S.a_ready(cur);
    if constexpr (SP2) {
        PG8_STAGE(PG8_SB(0, 0), cB, voffB); PG8_STAGE(PG8_SB(0, 1), cB + hstepB, voffB); PG8_STAGE(PG8_SA(0, 0), cA, voffA); PG8_STAGE(PG8_SA(0, 1), cA + hstepA, voffA);
        if (wr == 1) PG8_BAR;
        PG8_WAIT_V(2); PG8_BAR;
        PG8_STAGE(PG8_SB(1, 0), cB + kstep, voffB); PG8_STAGE(PG8_SA(1, 0), cA + kstep, voffA); PG8_STAGE(PG8_SB(1, 1), cB + hstepB + kstep, voffB);
        PG8_WAIT_V(6); PG8_BAR;
    } else {
        PG8_STAGE(PG8_SB(0, 0), cB, voffB); PG8_STAGE(PG8_SA(0, 0), cA, voffA); PG8_STAGE(PG8_SB(0, 1), cB + hstepB, voffB); PG8_STAGE(PG8_SA(0, 1), cA + hstepA, voffA);
        if (wr == 1) PG8_BAR;
        PG8_WAIT_V(4); PG8_BAR;
        PG8_STAGE(PG8_SB(1, 0), cB + kstep, voffB); PG8_STAGE(PG8_SA(1, 0), cA + kstep, voffA); PG8_STAGE(PG8_SB(1, 1), cB + hstepB + kstep, voffB);
        PG8_WAIT_V(6); PG8_BAR;
    }
    for (;;) {
        const bool has_next = S.next(ui + 1, nxt);
        const char* nA = has_next ? (const char*)g.A + nxt.aoff : cA; const char* nB = has_next ? (const char*)g.Bt + nxt.boff : cB;
        for (int t = 0; t < nt; t += 2) {
            const bool last = (t == nt - 2);
            const char* a1 = cA + (size_t)(t + 1) * kstep;
            const char* a2 = last ? nA : cA + (size_t)(t + 2) * kstep; const char* b2 = last ? nB : cB + (size_t)(t + 2) * kstep;
            const char* a3 = a2 + kstep; const char* b3 = b2 + kstep;
            if (last && has_next) S.a_ready(nxt);
            if constexpr (SP2) {
            PG8_LDB(B0, 0, 0); PG8_LDB(B1, 0, 1); PG8_SCHED; PG8_LDA(At, 0, 0); PG8_STAGE(PG8_SA(1, 1), a1 + hstepA, voffA);
            PG8_WAIT_V(8); PG8_WAIT_L(0); PG8_BAR; PG8_MMA(0, 0, At, B0); PG8_MMA(0, 1, At, B1); PG8_BAR; PG8_SCHED;
            PG8_LDA(At, 0, 1); PG8_STAGE(PG8_SB(0, 0), b2, voffB); PG8_STAGE(PG8_SB(0, 1), b2 + hstepB, voffB); PG8_STAGE(PG8_SA(0, 0), a2, voffA);
            PG8_WAIT_V(8); PG8_WAIT_L(0); PG8_BAR; PG8_MMA(1, 0, At, B0); PG8_MMA(1, 1, At, B1); PG8_BAR; PG8_SCHED;
            PG8_LDB(B0, 1, 0); PG8_LDB(B1, 1, 1); PG8_SCHED; PG8_LDA(At, 1, 0); PG8_STAGE(PG8_SA(0, 1), a2 + hstepA, voffA);
            PG8_WAIT_V(8); PG8_WAIT_L(0); PG8_BAR; PG8_MMA(0, 0, At, B0); PG8_MMA(0, 1, At, B1); PG8_BAR; PG8_SCHED;
            PG8_LDA(At, 1, 1); PG8_STAGE(PG8_SB(1, 0), b3, voffB); PG8_STAGE(PG8_SB(1, 1), b3 + hstepB, voffB); PG8_STAGE(PG8_SA(1, 0), a3, voffA);
            PG8_WAIT_V(8); PG8_WAIT_L(0); PG8_BAR; PG8_MMA(1, 0, At, B0); PG8_MMA(1, 1, At, B1); PG8_BAR; PG8_SCHED;
            } else {
            PG8_LDB(B0, 0, 0); PG8_SCHED; PG8_LDA(At, 0, 0); PG8_STAGE(PG8_SA(1, 1), a1 + hstepA, voffA);
            PG8_WAIT_L(8); PG8_BAR; PG8_WAIT_L(0); PG8_MMA(0, 0, At, B0); PG8_BAR; PG8_SCHED;
            PG8_LDB(B1, 0, 1); PG8_STAGE(PG8_SB(0, 0), b2, voffB);
            PG8_BAR; PG8_WAIT_L(0); PG8_MMA(0, 1, At, B1); PG8_BAR;
            PG8_LDA(At, 0, 1); PG8_STAGE(PG8_SA(0, 0), a2, voffA);
            PG8_BAR; PG8_WAIT_L(0); PG8_MMA(1, 0, At, B0); PG8_BAR; PG8_SCHED;
            PG8_STAGE(PG8_SB(0, 1), b2 + hstepB, voffB);
            PG8_WAIT_V(6); PG8_BAR; PG8_MMA(1, 1, At, B1); PG8_BAR;
            PG8_LDB(B0, 1, 0); PG8_SCHED; PG8_LDA(At, 1, 0); PG8_STAGE(PG8_SA(0, 1), a2 + hstepA, voffA);
            PG8_WAIT_L(8); PG8_BAR; PG8_WAIT_L(0); PG8_MMA(0, 0, At, B0); PG8_BAR; PG8_SCHED;
            PG8_LDB(B1, 1, 1); PG8_STAGE(PG8_SB(1, 0), b3, voffB);
            PG8_BAR; PG8_WAIT_L(0); PG8_MMA(0, 1, At, B1); PG8_BAR;
            PG8_LDA(At, 1, 1); PG8_STAGE(PG8_SA(1, 0), a3, voffA);
            PG8_BAR; PG8_WAIT_L(0); PG8_MMA(1, 0, At, B0); PG8_BAR; PG8_SCHED;
            PG8_STAGE(PG8_SB(1, 1), b3 + hstepB, voffB);
            PG8_WAIT_V(6); PG8_BAR; PG8_MMA(1, 1, At, B1); PG8_BAR;
            }
        }
        if constexpr (ALIGN_EPI) { if (wr == 0) PG8_BAR; }
        if constexpr (!Epi::AFTER_DRAIN) { E(acc, cur, wr, wc, fr, fq); S.done(cur); }
        if (!has_next) break;
#pragma unroll
        for (int a = 0; a < 2; ++a)
#pragma unroll
            for (int b = 0; b < 2; ++b)
#pragma unroll
                for (int m = 0; m < 4; ++m)
#pragma unroll
                    for (int n = 0; n < 2; ++n) acc[a][b][m][n] = (f32x4){0.f, 0.f, 0.f, 0.f};
        cur = nxt; cA = nA; cB = nB; ++ui;
        if constexpr (ALIGN_EPI) { if (wr == 1) PG8_BAR; }
    }
    PG8_WAIT_V(0);
    if constexpr (!ALIGN_EPI) { if (wr == 0) PG8_BAR; }
    PG8_BAR;
    if constexpr (Epi::AFTER_DRAIN) { E.fused(acc, cur, wr, wc, fr, fq, lds, wid, lane); S.done(cur); }
#undef PG8_SA
#undef PG8_SB
#undef PG8_STAGE
#undef PG8_LDA
#undef PG8_LDB
#undef PG8_MMA
#undef PG8_WAIT_V
#undef PG8_WAIT_L
#undef PG8_BAR
#undef PG8_SCHED
}
}
#define GAS __attribute__((address_space(1)))
#define LAS __attribute__((address_space(3)))
typedef unsigned short bf16;
typedef unsigned v4u __attribute__((ext_vector_type(4)));
typedef float f32x4 __attribute__((ext_vector_type(4)));
typedef short bf16x8 __attribute__((ext_vector_type(8)));
typedef GAS unsigned gu32;
typedef GAS unsigned long long gu64;
#define RLX_AGENT __ATOMIC_RELAXED, __HIP_MEMORY_SCOPE_AGENT
#define LDS_WAIT() asm volatile("s_waitcnt lgkmcnt(0)" ::: "memory")
#define VM_WAIT() asm volatile("s_waitcnt vmcnt(0)" ::: "memory")
__device__ __forceinline__ unsigned long long rt() { return __builtin_amdgcn_s_memrealtime(); }
__device__ __forceinline__ unsigned f2bf(float f) { unsigned u = __builtin_bit_cast(unsigned, f); return (u + 0x7fffu + ((u >> 16) & 1u)) >> 16; }
__device__ __forceinline__ unsigned pk2(float lo, float hi) { return f2bf(lo) | (f2bf(hi) << 16); }

#define XB_TMO      128
#define XB_XCNT(j)  (256  + 64 * (j))
#define XB_XSUB(j)  (1280 + 64 * (j))
#define XB_XGEN(j)  (2304 + 64 * (j))
#define XB_TOP      3328
#define XB_TOPGEN   3392
#define XCD_BAR_WORDS 3456
#define XB_SPIN_CAP (1u << 18)

__device__ __forceinline__ unsigned xb_ld(unsigned* p)              { return __hip_atomic_load(p, __ATOMIC_RELAXED, __HIP_MEMORY_SCOPE_AGENT); }
__device__ __forceinline__ unsigned xb_add(unsigned* p, unsigned v) { return __hip_atomic_fetch_add(p, v, __ATOMIC_RELAXED, __HIP_MEMORY_SCOPE_AGENT); }
__device__ __forceinline__ unsigned xb_xcc_id() { return (unsigned)__builtin_amdgcn_s_getreg((3 << 11) | 20) & 0xFu; }
#define XB_SPIN(cond, bar) do { unsigned _sp = 0; while (cond) { __builtin_amdgcn_s_sleep(1); \
    if ((++_sp & 255u) == 0u) { if (xb_ld(&(bar)[XB_TMO])) break; if (_sp > XB_SPIN_CAP) { atomicAdd(&(bar)[XB_TMO], 1u); break; } } } } while (0)

struct XcdBarrier {
    unsigned* bar; unsigned x;
    volatile LAS unsigned* st;
};

__device__ __forceinline__ XcdBarrier xcd_barrier_post(unsigned* bar, volatile LAS unsigned* st) {
    XcdBarrier b; b.bar = bar; b.x = xb_xcc_id(); b.st = st;
    if (threadIdx.x == 0) (void)xb_add(&bar[XB_XCNT(b.x)], 1u);
    return b;
}
__device__ __forceinline__ void xcd_barrier_complete(unsigned* bar, unsigned x, unsigned& nloc, unsigned& nx) {
    const unsigned G = gridDim.x * gridDim.y * gridDim.z;
    unsigned sum, cnt, mine, sp = 0u;
    for (;;) {
        sum = 0u; cnt = 0u; mine = 0u;
#pragma unroll
        for (unsigned j = 0; j < 16; ++j) { const unsigned c = xb_ld(&bar[XB_XCNT(j)]); sum += c; cnt += (c > 0u) ? 1u : 0u; mine = (j == x) ? c : mine; }
        if (sum == G) break;
        __builtin_amdgcn_s_sleep(1);
        if ((++sp & 255u) == 0u) { if (xb_ld(&bar[XB_TMO])) break; if (sp > XB_SPIN_CAP) { atomicAdd(&bar[XB_TMO], 1u); break; } }
    }
    nloc = mine > 0u ? mine : 1u; nx = cnt > 0u ? cnt : 1u;
}

__device__ __forceinline__ void xcd_barrier(const XcdBarrier& b) {
    asm volatile("s_waitcnt vmcnt(0)" ::: "memory");
    __syncthreads();
    if (threadIdx.x == 0) {
        unsigned* bar = b.bar;
        __builtin_amdgcn_s_waitcnt(0);
        unsigned nloc = b.st[0], nx = b.st[1];
        if (nloc == 0u) { xcd_barrier_complete(bar, b.x, nloc, nx); b.st[0] = nloc; b.st[1] = nx; }
        const unsigned old = xb_add(&bar[XB_XSUB(b.x)], 1u);
        const unsigned gen = old / nloc;
        if (old + 1u == (gen + 1u) * nloc) {
            __builtin_amdgcn_fence(__ATOMIC_RELEASE, "agent");
            asm volatile("s_waitcnt vmcnt(0)" ::: "memory");
            const unsigned og = xb_add(&bar[XB_TOP], 1u);
            const unsigned tg = og / nx;
            if (og + 1u == (tg + 1u) * nx) xb_add(&bar[XB_TOPGEN], 1u);
            else XB_SPIN(xb_ld(&bar[XB_TOPGEN]) == tg, bar);
            __builtin_amdgcn_fence(__ATOMIC_ACQUIRE, "agent");
            xb_add(&bar[XB_XGEN(b.x)], 1u);
            asm volatile("s_waitcnt vmcnt(0)" ::: "memory");
        } else {
            XB_SPIN(xb_ld(&bar[XB_XGEN(b.x)]) == gen, bar);
            __builtin_amdgcn_fence(__ATOMIC_ACQUIRE, "agent");
            asm volatile("s_waitcnt vmcnt(0)" ::: "memory");
        }
    }
    __syncthreads();
}

constexpr int D = 1024, BATCH = 8, SEQ = 2048, DEPTH = 4, NMEM = 256;
constexpr int M = BATCH * SEQ;
constexpr int MM = BATCH * NMEM;
constexpr int ML_H = 4, ML_DK = 128, ML_DV = 256, ML_W = 3080;
constexpr int SB_H = 16, SB_DH = 64;
constexpr int XA_H = 4, XA_DH = 256;
constexpr int DFF = 2816;
constexpr float EPS = 1e-6f;
constexpr int NWAVES = 8;

constexpr size_t MiB = 1u << 20;
constexpr size_t WS_CTL = 0, CTL_ZERO_BYTES = 1 * MiB;
constexpr size_t WS_WG = 1 * MiB;
constexpr size_t WS_GATES = 1 * MiB + 512 * 1024;
constexpr size_t WS_MEMN = 2 * MiB;
constexpr size_t WS_NST = 6 * MiB, WS_SCAL = 6 * MiB + 512 * 1024, WS_MPREV = WS_SCAL + 16 * 1024;
constexpr size_t WS_W = 8 * MiB;
constexpr size_t WL_IN = 0, WL_OUT = WL_IN + (size_t)3072 * 1024, WL_QN = WL_OUT + (size_t)1024 * 1024, WL_OT = WL_QN + (size_t)1024 * 1024,
                 WL_GU = WL_OT + (size_t)1024 * 1024, WL_DN = WL_GU + (size_t)5632 * 1024, WL_SIZE = WL_DN + (size_t)1024 * 2816;
constexpr size_t WS_XWT = WS_W + 4 * WL_SIZE * 2;
static_assert(WS_XWT == 122 * MiB, "weight region size");
constexpr size_t WS_KV = WS_XWT + 32 * MiB;
constexpr size_t WS_XN = WS_KV + 32 * MiB;
constexpr size_t WS_MIX = WS_XN + 32 * MiB;
constexpr size_t WS_BIG = WS_MIX + 32 * MiB;
constexpr size_t WS_END = WS_BIG + 96 * MiB;
constexpr int CW_BAR = 4096;

constexpr int RING_OFF = 0, RING_BYTES = 131072;
constexpr int LDSCTL_OFF = RING_BYTES, MISC_OFF = LDSCTL_OFF + 320;
constexpr int LDS_BYTES = 147456;

__device__ __forceinline__ float wave_sum(float v) {
#pragma unroll
    for (int o = 1; o < 64; o <<= 1) v += __shfl_xor(v, o);
    return v;
}
__device__ __forceinline__ float wave_max(float v) {
#pragma unroll
    for (int o = 1; o < 64; o <<= 1) v = fmaxf(v, __shfl_xor(v, o));
    return v;
}
__device__ __forceinline__ float softplusf(float z) { return fmaxf(z, 0.f) + log1pf(__expf(-fabsf(z))); }
__device__ __forceinline__ float bf2f(unsigned short h) { return __uint_as_float((unsigned)h << 16); }
__device__ __forceinline__ float bflo(unsigned w) { return __uint_as_float(w << 16); }
__device__ __forceinline__ float bfhi(unsigned w) { return __uint_as_float(w & 0xffff0000u); }

struct Frame {
    LAS unsigned char* lds;
    int tid, lane, wave, G, gw, NGW;
    unsigned char* ws;
};
__device__ __forceinline__ const float* inp(const Frame& F, int i) {
    volatile LAS unsigned* t = (volatile LAS unsigned*)(F.lds + LDSCTL_OFF) + 2 * i;
    const unsigned lo = __builtin_amdgcn_readfirstlane(t[0]), hi = __builtin_amdgcn_readfirstlane(t[1]);
    return (const float*)(((unsigned long long)hi << 32) | lo);
}
__device__ __forceinline__ void relane(Frame& F) {
    int t = threadIdx.x; asm volatile("" : "+v"(t));
    F.tid = t; F.lane = t & 63; F.wave = __builtin_amdgcn_readfirstlane(t >> 6);
    int g = gridDim.x, b = blockIdx.x; asm volatile("" : "+s"(g), "+s"(b));
    F.G = g; F.gw = b * NWAVES + F.wave; F.NGW = g * NWAVES;
}

struct EpiStore {
    static constexpr bool PERM = true, AFTER_DRAIN = false;
    bf16* O; int ldc;
    __device__ __forceinline__ void operator()(const f32x4 (&acc)[2][2][4][2], const pg8::Unit& u, int wr, int wc, int fr, int fq) const {
        const int row0 = u.pm * 256 + wr * 64 + fr, col0 = u.pn * 256 + wc * 32 + 8 * fq;
#pragma unroll
        for (int ai = 0; ai < 2; ++ai)
#pragma unroll
            for (int m = 0; m < 4; ++m) { bf16* rowp = O + (size_t)(row0 + ai * 128 + m * 16) * ldc + col0;
#pragma unroll
                for (int bj = 0; bj < 2; ++bj) { const f32x4 v0 = acc[ai][bj][m][0], v1 = acc[ai][bj][m][1];
                    pg8::u32x4 w; w.x = pg8::cvt_pk_bf16(v0[0], v0[1]); w.y = pg8::cvt_pk_bf16(v0[2], v0[3]); w.z = pg8::cvt_pk_bf16(v1[0], v1[1]); w.w = pg8::cvt_pk_bf16(v1[2], v1[3]);
                    *(pg8::u32x4*)(rowp + bj * 128) = w; } }
    }
};
struct EpiSwiglu {
    static constexpr bool PERM = true, AFTER_DRAIN = false;
    bf16* O; int ldc;
    __device__ __forceinline__ void operator()(const f32x4 (&acc)[2][2][4][2], const pg8::Unit& u, int wr, int wc, int fr, int fq) const {
        const int row0 = u.pm * 256 + wr * 64 + fr, col0 = u.pn * 128 + wc * 32 + 8 * fq;
#pragma unroll
        for (int ai = 0; ai < 2; ++ai)
#pragma unroll
            for (int m = 0; m < 4; ++m) { bf16* rowp = O + (size_t)(row0 + ai * 128 + m * 16) * ldc + col0;
                float r[8];
#pragma unroll
                for (int n = 0; n < 2; ++n)
#pragma unroll
                    for (int e = 0; e < 4; ++e) { const float g = acc[ai][0][m][n][e], up = acc[ai][1][m][n][e]; r[n * 4 + e] = g * __builtin_amdgcn_rcpf(1.f + __expf(-g)) * up; }
                pg8::u32x4 w; w.x = pg8::cvt_pk_bf16(r[0], r[1]); w.y = pg8::cvt_pk_bf16(r[2], r[3]); w.z = pg8::cvt_pk_bf16(r[4], r[5]); w.w = pg8::cvt_pk_bf16(r[6], r[7]);
                *(pg8::u32x4*)rowp = w; }
    }
};

struct EpiSoftmax {
    static constexpr bool PERM = true, AFTER_DRAIN = true;
    bf16* O; int ldc;
    __device__ __forceinline__ void fused(f32x4 (&acc)[2][2][4][2], const pg8::Unit& u, int wr, int wc, int fr, int fq, LAS unsigned char* lds, int wid, int lane) const {
        typedef float f32x2v __attribute__((ext_vector_type(2)));
        constexpr float C2 = 0.0625f * 1.4426950408889634f;
        LAS f32x2v* ST = (LAS f32x2v*)lds;
#pragma unroll
        for (int ai = 0; ai < 2; ++ai)
#pragma unroll
            for (int m = 0; m < 4; ++m) {
                float mx = -INFINITY;
#pragma unroll
                for (int bj = 0; bj < 2; ++bj)
#pragma unroll
                    for (int n = 0; n < 2; ++n) { const f32x4 x = acc[ai][bj][m][n]; mx = fmaxf(mx, fmaxf(fmaxf(x[0], x[1]), fmaxf(x[2], x[3]))); }
                mx = fmaxf(mx, __shfl_xor(mx, 16)); mx = fmaxf(mx, __shfl_xor(mx, 32));
                float sum = 0.f;
#pragma unroll
                for (int bj = 0; bj < 2; ++bj)
#pragma unroll
                    for (int n = 0; n < 2; ++n) { f32x4 x = acc[ai][bj][m][n];
#pragma unroll
                        for (int e = 0; e < 4; ++e) { x[e] = __builtin_amdgcn_exp2f((x[e] - mx) * C2); sum += x[e]; }
                        acc[ai][bj][m][n] = x; }
                sum += __shfl_xor(sum, 16); sum += __shfl_xor(sum, 32);
                if (fq == 0) ST[(ai * 128 + wr * 64 + m * 16 + fr) * 4 + wc] = (f32x2v){mx, sum};
            }
        asm volatile("s_waitcnt lgkmcnt(0)" ::: "memory"); __builtin_amdgcn_s_barrier(); asm volatile("" ::: "memory");
        const int row0 = u.pm * 256 + wr * 64 + fr, col0 = u.pn * 256 + wc * 32 + 8 * fq;
#pragma unroll
        for (int ai = 0; ai < 2; ++ai)
#pragma unroll
            for (int m = 0; m < 4; ++m) {
                const LAS f32x2v* sp = ST + (ai * 128 + wr * 64 + m * 16 + fr) * 4;
                const f32x2v s0 = sp[0], s1 = sp[1], s2 = sp[2], s3 = sp[3];
                const float MX = fmaxf(fmaxf(s0.x, s1.x), fmaxf(s2.x, s3.x));
                const float L = s0.y * __builtin_amdgcn_exp2f((s0.x - MX) * C2) + s1.y * __builtin_amdgcn_exp2f((s1.x - MX) * C2) + s2.y * __builtin_amdgcn_exp2f((s2.x - MX) * C2) + s3.y * __builtin_amdgcn_exp2f((s3.x - MX) * C2);
                const float mine = (wc == 0) ? s0.x : (wc == 1) ? s1.x : (wc == 2) ? s2.x : s3.x;
                const float f = __builtin_amdgcn_exp2f((mine - MX) * C2) / L;
                bf16* rowp = O + (size_t)(row0 + ai * 128 + m * 16) * ldc + col0;
#pragma unroll
                for (int bj = 0; bj < 2; ++bj) { const f32x4 v0 = acc[ai][bj][m][0] * f, v1 = acc[ai][bj][m][1] * f;
                    pg8::u32x4 w; w.x = pg8::cvt_pk_bf16(v0[0], v0[1]); w.y = pg8::cvt_pk_bf16(v0[2], v0[3]); w.z = pg8::cvt_pk_bf16(v1[0], v1[1]); w.w = pg8::cvt_pk_bf16(v1[2], v1[3]);
                    *(pg8::u32x4*)(rowp + bj * 128) = w; }
            }
    }
};
struct OneUnit {
    __device__ __forceinline__ bool next(int i, pg8::Unit& u) const { if (i) return false; u.pm = 0; u.pn = 0; u.aoff = 0; u.boff = 0; return true; }
    __device__ __forceinline__ void a_ready(const pg8::Unit&) const {}
    __device__ __forceinline__ void done(const pg8::Unit&) const {}
};

__device__ __forceinline__ void transpose_item(const float* W, int ld, int K, bf16* WT, int k0, int n0, int drow, LAS float* scr, int lane) {
#pragma unroll 8
    for (int i = 0; i < 32; ++i) { const int kk = 2 * i + (lane >> 5); scr[kk * 33 + (lane & 31)] = W[(size_t)(k0 + kk) * ld + n0 + (lane & 31)]; }
    LDS_WAIT(); asm volatile("" ::: "memory");
    const int c = lane & 7;
#pragma unroll
    for (int j = 0; j < 4; ++j) { const int n = (lane >> 3) + 8 * j; const LAS float* s = scr + (8 * c) * 33 + n;
        v4u o; o.x = pk2(s[0 * 33], s[1 * 33]); o.y = pk2(s[2 * 33], s[3 * 33]); o.z = pk2(s[4 * 33], s[5 * 33]); o.w = pk2(s[6 * 33], s[7 * 33]);
        *(GAS v4u*)(WT + (size_t)(drow + n) * K + k0 + 8 * c) = o; }
    LDS_WAIT(); asm volatile("" ::: "memory");
}
__device__ __forceinline__ void p0_convert(Frame& F) {
    relane(F);
    LAS float* scr = (LAS float*)(F.lds + RING_OFF + F.wave * 16384);
    bf16* Wb = (bf16*)(F.ws + WS_W); bf16* Wkv = (bf16*)(F.ws + WS_XWT);
    constexpr int I_IN = 16 * 96, I_OUT = 16 * 32, I_Q = 16 * 32, I_O = 16 * 32, I_KV = 16 * 64, I_GU = 16 * 176, I_DN = 44 * 32;
    constexpr int I_LAYER = I_IN + I_OUT + I_Q + I_O + I_KV + I_GU + I_DN;
    for (int it = F.gw; it < 4 * I_LAYER; it += F.NGW) {
        const int l = it / I_LAYER, j = l >> 1; int r = it % I_LAYER;
        bf16* WL = Wb + (size_t)l * WL_SIZE;
        if (r < I_IN) { const int kb = r / 96, nb = r % 96;
            if (l & 1) transpose_item(inp(F, 8) + (size_t)j * D * 3072, 3072, D, WL + WL_IN, kb * 64, nb * 32, nb * 32, scr, F.lane);
            else       transpose_item(inp(F, 4) + (size_t)j * D * ML_W, ML_W, D, WL + WL_IN, kb * 64, nb * 32, nb * 32, scr, F.lane);
            continue; } r -= I_IN;
        if (r < I_OUT) { const int kb = r / 32, nb = r % 32;
            transpose_item(((l & 1) ? inp(F, 9) : inp(F, 7)) + (size_t)j * D * D, D, D, WL + WL_OUT, kb * 64, nb * 32, nb * 32, scr, F.lane); continue; } r -= I_OUT;
        if (r < I_Q) { const int e0 = r * 2048 + F.lane * 8;
#pragma unroll
            for (int q = 0; q < 4; ++q) { const GAS f32x4* sp = (const GAS f32x4*)(inp(F, 10) + (size_t)l * D * D + e0 + q * 512); const f32x4 x0 = sp[0], x1 = sp[1];
                v4u o; o.x = pk2(x0.x, x0.y); o.y = pk2(x0.z, x0.w); o.z = pk2(x1.x, x1.y); o.w = pk2(x1.z, x1.w); *(GAS v4u*)(WL + WL_QN + e0 + q * 512) = o; }
            continue; } r -= I_Q;
        if (r < I_O) { const int kb = r / 32, nb = r % 32; transpose_item(inp(F, 12) + (size_t)l * D * D, D, D, WL + WL_OT, kb * 64, nb * 32, nb * 32, scr, F.lane); continue; } r -= I_O;
        if (r < I_KV) { const int kb = r / 64, nb = r % 64; transpose_item(inp(F, 11) + (size_t)l * D * 2048, 2048, D, Wkv, kb * 64, nb * 32, l * 2048 + nb * 32, scr, F.lane); continue; } r -= I_KV;
        if (r < I_GU) { const int kb = r / 176, nb = r % 176; const int c0 = nb * 32; const int up = c0 >= DFF, jj = up ? c0 - DFF : c0;
            transpose_item(inp(F, 13) + (size_t)l * D * 2 * DFF, 2 * DFF, D, WL + WL_GU, kb * 64, c0, 256 * (jj >> 7) + 128 * up + (jj & 127), scr, F.lane); continue; } r -= I_GU;
        { const int kb = r / 32, nb = r % 32; transpose_item(inp(F, 14) + (size_t)l * DFF * D, D, DFF, WL + WL_DN, kb * 64, nb * 32, nb * 32, scr, F.lane); }
    }
    bf16* MEMN = (bf16*)(F.ws + WS_MEMN);
    for (int m = F.gw; m < MM; m += F.NGW) {
        const GAS f32x4* xr = (const GAS f32x4*)(inp(F, 1) + (size_t)m * D) + F.lane; const GAS f32x4* gr = (const GAS f32x4*)inp(F, 2) + F.lane;
        f32x4 v[4]; float s = 0.f;
#pragma unroll
        for (int q = 0; q < 4; ++q) { v[q] = xr[64 * q]; s += (v[q].x * v[q].x + v[q].y * v[q].y) + (v[q].z * v[q].z + v[q].w * v[q].w); }
        const float rs = rsqrtf(wave_sum(s) * (1.f / D) + EPS);
        GAS unsigned long long* o8 = (GAS unsigned long long*)(MEMN + (size_t)m * D) + F.lane;
#pragma unroll
        for (int q = 0; q < 4; ++q) { const f32x4 g = gr[64 * q]; o8[64 * q] = (unsigned long long)pk2(v[q].x * rs * g.x, v[q].y * rs * g.y) | ((unsigned long long)pk2(v[q].z * rs * g.z, v[q].w * rs * g.w) << 32); }
    }
}

__device__ __forceinline__ void row_phase(Frame& F, const float* xin, float* xout, const bf16* Y, const float* ga, const float* gb, bf16* XN, const float* WG, int wgs, const float* bg, float* GT) {
    relane(F);
    for (int m = F.gw; m < M; m += F.NGW) {
        const GAS f32x4* xr = (const GAS f32x4*)(xin + (size_t)m * D) + F.lane;
        f32x4 v[4];
#pragma unroll
        for (int q = 0; q < 4; ++q) v[q] = xr[64 * q];
        if (Y) {
            const GAS unsigned long long* yr = (const GAS unsigned long long*)(Y + (size_t)m * D) + F.lane;
            f32x4 y[4]; float s = 0.f;
#pragma unroll
            for (int q = 0; q < 4; ++q) { const unsigned long long w = yr[64 * q]; const unsigned lo = (unsigned)w, hi = (unsigned)(w >> 32);
                y[q] = (f32x4){bflo(lo), bfhi(lo), bflo(hi), bfhi(hi)}; s += (y[q].x * y[q].x + y[q].y * y[q].y) + (y[q].z * y[q].z + y[q].w * y[q].w); }
            const float rs = rsqrtf(wave_sum(s) * (1.f / D) + EPS);
            const GAS f32x4* gr = (const GAS f32x4*)ga + F.lane;
#pragma unroll
            for (int q = 0; q < 4; ++q) { const f32x4 g = gr[64 * q]; v[q] = v[q] + y[q] * rs * g; }
        }
        if (Y || xin != xout) { GAS f32x4* xo = (GAS f32x4*)(xout + (size_t)m * D) + F.lane;
#pragma unroll
            for (int q = 0; q < 4; ++q) xo[64 * q] = v[q]; }
        if (gb) {
            float s = 0.f;
#pragma unroll
            for (int q = 0; q < 4; ++q) s += (v[q].x * v[q].x + v[q].y * v[q].y) + (v[q].z * v[q].z + v[q].w * v[q].w);
            const float rs = rsqrtf(wave_sum(s) * (1.f / D) + EPS);
            const GAS f32x4* gr = (const GAS f32x4*)gb + F.lane;
            GAS unsigned long long* o8 = (GAS unsigned long long*)(XN + (size_t)m * D) + F.lane;
#pragma unroll
            for (int q = 0; q < 4; ++q) { const f32x4 g = gr[64 * q]; v[q] = v[q] * rs * g; o8[64 * q] = (unsigned long long)pk2(v[q].x, v[q].y) | ((unsigned long long)pk2(v[q].z, v[q].w) << 32); }
            if (WG) {
                float acc[8];
#pragma unroll
                for (int c = 0; c < 8; ++c) acc[c] = 0.f;
#pragma unroll
                for (int q = 0; q < 4; ++q)
#pragma unroll
                    for (int e = 0; e < 4; ++e) { const GAS f32x4* w = (const GAS f32x4*)(WG + (size_t)(4 * F.lane + 256 * q + e) * wgs); const f32x4 w0 = w[0], w1 = w[1]; const float h = v[q][e];
                        acc[0] += h * w0.x; acc[1] += h * w0.y; acc[2] += h * w0.z; acc[3] += h * w0.w; acc[4] += h * w1.x; acc[5] += h * w1.y; acc[6] += h * w1.z; acc[7] += h * w1.w; }
#pragma unroll
                for (int c = 0; c < 8; ++c) acc[c] = wave_sum(acc[c]);
                if (F.lane < 8) {
                    float a = 0.f;
#pragma unroll
                    for (int c = 0; c < 8; ++c) a = (F.lane == c) ? acc[c] : a;
                    a = 15.f * tanhf((a + bg[F.lane]) * (1.f / 15.f));
                    if (F.lane >= 4) a = -softplusf(-a);
                    GT[(size_t)m * 8 + F.lane] = a;
                }
            }
        }
    }
}

__device__ __forceinline__ void mlstm_scan_v1(Frame& F, const bf16* PROJ, const float* GT, bf16* MIX) {
    relane(F);
    const int vi = F.tid >> 4, kq = F.tid & 15;
    for (int task = blockIdx.x; task < BATCH * ML_H * 8; task += F.G) {
        const int bh = task >> 3, vs = task & 7, b = bh >> 2, h = bh & 3;
        float C[8], n[8], m = 0.f;
#pragma unroll
        for (int i = 0; i < 8; ++i) { C[i] = 0.f; n[i] = 0.f; }
        const bf16* p0 = PROJ + (size_t)b * SEQ * 3072;
        const float* g0 = GT + (size_t)b * SEQ * 8;
        v4u qn = *(const GAS v4u*)(p0 + h * 128 + kq * 8), kn = *(const GAS v4u*)(p0 + 512 + h * 128 + kq * 8);
        unsigned short vn = *(const GAS unsigned short*)(p0 + 1024 + h * 256 + vs * 32 + vi);
        float ign = g0[h], lfn = g0[4 + h];
        for (int t = 0; t < SEQ; ++t) {
            const v4u qc = qn, kc = kn; const float vv = bf2f(vn), ig = ign, lf = lfn;
            if (t + 1 < SEQ) { const bf16* p = p0 + (size_t)(t + 1) * 3072; qn = *(const GAS v4u*)(p + h * 128 + kq * 8); kn = *(const GAS v4u*)(p + 512 + h * 128 + kq * 8);
                vn = *(const GAS unsigned short*)(p + 1024 + h * 256 + vs * 32 + vi); ign = g0[(t + 1) * 8 + h]; lfn = g0[(t + 1) * 8 + 4 + h]; }
            const float mn = fmaxf(lf + m, ig), dec = __expf(lf + m - mn), wi = __expf(ig - mn); m = mn;
            const float qf[8] = {bflo(qc.x), bfhi(qc.x), bflo(qc.y), bfhi(qc.y), bflo(qc.z), bfhi(qc.z), bflo(qc.w), bfhi(qc.w)};
            const float kf[8] = {bflo(kc.x), bfhi(kc.x), bflo(kc.y), bfhi(kc.y), bflo(kc.z), bfhi(kc.z), bflo(kc.w), bfhi(kc.w)};
            float num = 0.f, den = 0.f;
#pragma unroll
            for (int i = 0; i < 8; ++i) { const float kk = kf[i] * 0.08838834764831845f;
                C[i] = dec * C[i] + wi * vv * kk; n[i] = dec * n[i] + wi * kk; num += C[i] * qf[i]; den += n[i] * qf[i]; }
#pragma unroll
            for (int o = 1; o < 16; o <<= 1) { num += __shfl_xor(num, o); den += __shfl_xor(den, o); }
            if (kq == 0) { const float r = num / fmaxf(fabsf(den), __expf(-mn)); ((GAS unsigned short*)MIX)[(size_t)(b * SEQ + t) * D + h * 256 + vs * 32 + vi] = (unsigned short)f2bf(r); }
        }
    }
}
__device__ __forceinline__ void mlstm_post_v1(Frame& F, const bf16* PROJ, const float* hg, bf16* MIX) {
    relane(F);
    for (int w = F.gw; w < M * ML_H; w += F.NGW) {
        const int tok = w >> 2, h = w & 3;
        GAS unsigned long long* r = (GAS unsigned long long*)(MIX + (size_t)tok * D + h * 256) + F.lane;
        const unsigned long long hw = *r, ow = *((const GAS unsigned long long*)(PROJ + (size_t)tok * 3072 + 2048 + h * 256) + F.lane);
        const float v[4] = {bflo((unsigned)hw), bfhi((unsigned)hw), bflo((unsigned)(hw >> 32)), bfhi((unsigned)(hw >> 32))};
        const float o[4] = {bflo((unsigned)ow), bfhi((unsigned)ow), bflo((unsigned)(ow >> 32)), bfhi((unsigned)(ow >> 32))};
        const float rs = rsqrtf(wave_sum((v[0] * v[0] + v[1] * v[1]) + (v[2] * v[2] + v[3] * v[3])) * (1.f / 256.f) + EPS);
        const f32x4 g = *((const GAS f32x4*)(hg + h * 256) + F.lane);
        float y[4];
#pragma unroll
        for (int e = 0; e < 4; ++e) y[e] = v[e] * rs * g[e] / (1.f + __expf(-o[e]));
        *r = (unsigned long long)pk2(y[0], y[1]) | ((unsigned long long)pk2(y[2], y[3]) << 32);
    }
}

__device__ __forceinline__ void sb_attn_v1(Frame& F, const bf16* QKV, bf16* MIX) {
    relane(F);
    for (int task = F.gw; task < BATCH * SB_H * 16; task += F.NGW) {
        const int bh = task >> 4, pr = task & 15, b = bh >> 4, h = bh & 15;
#pragma unroll 1
        for (int half = 0; half < 2; ++half) {
            const int tb = half ? 31 - pr : pr, t = tb * 64 + F.lane;
            float q[64], o[64];
            const GAS v4u* qp = (const GAS v4u*)(QKV + (size_t)(b * SEQ + t) * 3072 + h * 64);
#pragma unroll
            for (int c = 0; c < 8; ++c) { const v4u w = qp[c]; q[8 * c] = bflo(w.x) * 0.125f; q[8 * c + 1] = bfhi(w.x) * 0.125f; q[8 * c + 2] = bflo(w.y) * 0.125f; q[8 * c + 3] = bfhi(w.y) * 0.125f;
                q[8 * c + 4] = bflo(w.z) * 0.125f; q[8 * c + 5] = bfhi(w.z) * 0.125f; q[8 * c + 6] = bflo(w.w) * 0.125f; q[8 * c + 7] = bfhi(w.w) * 0.125f; }
#pragma unroll
            for (int d = 0; d < 64; ++d) o[d] = 0.f;
            float run = 0.f;
            for (int s = tb * 64 + 62; s >= 0; --s) {
                const GAS v4u* kp = (const GAS v4u*)(QKV + (size_t)(b * SEQ + s) * 3072 + 1024 + h * 64);
                float z = 0.f;
#pragma unroll
                for (int c = 0; c < 8; ++c) { const v4u w = kp[c]; z += q[8 * c] * bflo(w.x) + q[8 * c + 1] * bfhi(w.x) + q[8 * c + 2] * bflo(w.y) + q[8 * c + 3] * bfhi(w.y)
                        + q[8 * c + 4] * bflo(w.z) + q[8 * c + 5] * bfhi(w.z) + q[8 * c + 6] * bflo(w.w) + q[8 * c + 7] * bfhi(w.w); }
                if (s < t) {
                    const float sp = softplusf(z), a = __expf(z - sp + run); run -= sp;
                    const GAS v4u* vp = kp + 128;
#pragma unroll
                    for (int c = 0; c < 8; ++c) { const v4u w = vp[c]; o[8 * c] += a * bflo(w.x); o[8 * c + 1] += a * bfhi(w.x); o[8 * c + 2] += a * bflo(w.y); o[8 * c + 3] += a * bfhi(w.y);
                        o[8 * c + 4] += a * bflo(w.z); o[8 * c + 5] += a * bfhi(w.z); o[8 * c + 6] += a * bflo(w.w); o[8 * c + 7] += a * bfhi(w.w); }
                }
            }
            GAS v4u* op = (GAS v4u*)(MIX + (size_t)(b * SEQ + t) * D + h * 64);
#pragma unroll
            for (int c = 0; c < 8; ++c) { v4u w; w.x = pk2(o[8 * c], o[8 * c + 1]); w.y = pk2(o[8 * c + 2], o[8 * c + 3]); w.z = pk2(o[8 * c + 4], o[8 * c + 5]); w.w = pk2(o[8 * c + 6], o[8 * c + 7]); op[c] = w; }
        }
    }
}

namespace sbk {
typedef float f32x16 __attribute__((ext_vector_type(16)));
typedef short s16x4 __attribute__((ext_vector_type(4)));
typedef short v4i16_t __attribute__((ext_vector_type(4)));
__device__ __forceinline__ unsigned cvtpk(float lo, float hi) { typedef float f32x2_t __attribute__((ext_vector_type(2))); typedef __bf16 bf16x2_t __attribute__((ext_vector_type(2)));
    f32x2_t v = {lo, hi}; bf16x2_t b = __builtin_convertvector(v, bf16x2_t); return __builtin_bit_cast(unsigned, b); }
#define SB_MFMA(a, b, c) __builtin_amdgcn_mfma_f32_32x32x16_bf16((a), (b), (c), 0, 0, 0)
constexpr int KB0 = 0, VB0 = 16384;
constexpr float C2 = 0.125f * 1.4426950408889634f;

template <bool MASK>
__device__ __forceinline__ void tile(LAS unsigned char* kb, LAS unsigned char* vb, const bf16x8 (&qr)[4], f32x16 (&o)[2], float& carry, int nv, int lane, int r, int hh, const bf16x8 (&TRI)[2], const bf16x8 ONES) {
    f32x16 e[2];
    {   f32x16 p0, p1;
#pragma unroll
        for (int i = 0; i < 16; ++i) { p0[i] = 0.f; p1[i] = 0.f; }
#pragma unroll
        for (int ks = 0; ks < 4; ++ks) {
            const bf16x8 k0 = *(const LAS bf16x8*)(kb + r * 128 + (((2 * ks + hh) ^ (r & 7)) << 4));
            const bf16x8 k1 = *(const LAS bf16x8*)(kb + (r + 32) * 128 + (((2 * ks + hh) ^ (r & 7)) << 4));
            p0 = SB_MFMA(k0, qr[ks], p0); p1 = SB_MFMA(k1, qr[ks], p1);
        }
        e[0] = p0; e[1] = p1;
    }
    v4u Lhi[2][2], Llo[2][2];
    float sv = 0.f;
#pragma unroll
    for (int ib = 0; ib < 2; ++ib)
#pragma unroll
        for (int i = 0; i < 16; i += 2) {
            float L[2];
#pragma unroll
            for (int u = 0; u < 2; ++u) {
                const float w = e[ib][i + u] * C2;
                const float sp = fmaxf(w, 0.f) + __builtin_amdgcn_logf(1.f + __builtin_amdgcn_exp2f(-fabsf(w)));
                float Lm = -sp;
                if (MASK) { const int ci = ((i + u) & 3) + 8 * ((i + u) >> 2) + 32 * ib; Lm = (ci < nv) ? Lm : 0.f; }
                const float E = w - sp;
                if (ib == 0 && i + u == 0) sv = E - Lm;
                e[ib][i + u] = E + carry;
                L[u] = Lm;
            }
            const unsigned hw = cvtpk(L[0], L[1]);
            const unsigned lw = cvtpk(L[0] - bflo(hw), L[1] - bfhi(hw));
            const int ks2 = i >> 3, m = (i & 7) >> 1;
            Lhi[ib][ks2][m] = hw; Llo[ib][ks2][m] = lw;
        }
#define SB_F(x) __builtin_bit_cast(bf16x8, x)
    e[0] = SB_MFMA(TRI[0], SB_F(Lhi[0][0]), e[0]); e[0] = SB_MFMA(TRI[1], SB_F(Lhi[0][1]), e[0]);
    e[1] = SB_MFMA(TRI[0], SB_F(Lhi[1][0]), e[1]); e[1] = SB_MFMA(TRI[1], SB_F(Lhi[1][1]), e[1]);
    e[0] = SB_MFMA(ONES, SB_F(Lhi[1][0]), e[0]); e[0] = SB_MFMA(ONES, SB_F(Lhi[1][1]), e[0]);
    e[0] = SB_MFMA(TRI[0], SB_F(Llo[0][0]), e[0]); e[0] = SB_MFMA(TRI[1], SB_F(Llo[0][1]), e[0]);
    e[1] = SB_MFMA(TRI[0], SB_F(Llo[1][0]), e[1]); e[1] = SB_MFMA(TRI[1], SB_F(Llo[1][1]), e[1]);
    e[0] = SB_MFMA(ONES, SB_F(Llo[1][0]), e[0]); e[0] = SB_MFMA(ONES, SB_F(Llo[1][1]), e[0]);
    carry = __shfl(e[0][0] - sv, r);
    v4u pa[2][2];
#pragma unroll
    for (int ib = 0; ib < 2; ++ib)
#pragma unroll
        for (int i = 0; i < 16; i += 2) {
            float a[2];
#pragma unroll
            for (int u = 0; u < 2; ++u) {
                a[u] = __builtin_amdgcn_exp2f(e[ib][i + u]);
                if (MASK) { const int ci = ((i + u) & 3) + 8 * ((i + u) >> 2) + 32 * ib; a[u] = (ci < nv) ? a[u] : 0.f; }
            }
            pa[ib][i >> 3][(i & 7) >> 1] = cvtpk(a[0], a[1]);
        }
    const int q4 = (lane & 15) >> 2, p4 = lane & 3, g1 = (lane >> 4) & 1;
    LAS unsigned char* vl = vb + (4 * hh + q4) * 128 + (16 * g1 + 4 * p4) * 2;
#pragma unroll
    for (int ib = 0; ib < 2; ++ib)
#pragma unroll
        for (int ks2 = 0; ks2 < 2; ++ks2)
#pragma unroll
            for (int db = 0; db < 2; ++db) {
                LAS unsigned char* pv = vl + (32 * ib + 16 * ks2) * 128 + db * 64;
                const s16x4 lo = __builtin_bit_cast(s16x4, __builtin_amdgcn_ds_read_tr16_b64_v4i16((LAS v4i16_t*)pv));
                const s16x4 hi = __builtin_bit_cast(s16x4, __builtin_amdgcn_ds_read_tr16_b64_v4i16((LAS v4i16_t*)(pv + 8 * 128)));
                const bf16x8 vf = __builtin_shufflevector(lo, hi, 0, 1, 2, 3, 4, 5, 6, 7);
                o[db] = SB_MFMA(SB_F(pa[ib][ks2]), vf, o[db]);
            }
#undef SB_F
}

__device__ __forceinline__ void unit(int b, int h, int qb, const bf16* QKV, bf16* MIX, LAS unsigned char* lds, int tid) {
    const int lane = tid & 63, r = lane & 31, hh = lane >> 5, wid = __builtin_amdgcn_readfirstlane(tid >> 6);
    const size_t rowbase = (size_t)b * SEQ; const int q0 = qb * 256, trow = q0 + 32 * wid + r;
    bf16x8 qr[4];
#pragma unroll
    for (int ks = 0; ks < 4; ++ks) qr[ks] = *(const GAS bf16x8*)(QKV + (rowbase + trow) * 3072 + h * 64 + ks * 16 + hh * 8);
    bf16x8 TRI[2], ONES;
#pragma unroll
    for (int ks2 = 0; ks2 < 2; ++ks2)
#pragma unroll
        for (int j = 0; j < 8; ++j) TRI[ks2][j] = ((16 * ks2 + 8 * (j >> 2) + 4 * hh + (j & 3)) > r) ? (short)0x3F80 : (short)0;
#pragma unroll
    for (int j = 0; j < 8; ++j) ONES[j] = (short)0x3F80;
    const int srow = tid >> 3, sc = tid & 7;
    const bf16* kg = QKV + rowbase * 3072 + 1024 + h * 64 + (size_t)srow * 3072 + sc * 8;
    const int kdst = srow * 128 + ((sc ^ (srow & 7)) << 4), vdst = srow * 128 + sc * 16;
    const int NT = 4 * qb + 4;
    { const bf16* p = kg + (size_t)(NT - 1) * 64 * 3072; const v4u kx = *(const GAS v4u*)p, vx = *(const GAS v4u*)(p + 1024);
      *(LAS v4u*)(lds + KB0 + kdst) = kx; *(LAS v4u*)(lds + VB0 + vdst) = vx; }
    __syncthreads();
    f32x16 o[2];
#pragma unroll
    for (int i = 0; i < 16; ++i) { o[0][i] = 0.f; o[1][i] = 0.f; }
    float carry = 0.f;
    const int wmax = q0 + 32 * wid + 31, wmin = q0 + 32 * wid;
    for (int kt = NT - 1; kt >= 0; --kt) {
        const int cur = (NT - 1 - kt) & 1;
        v4u kx, vx;
        if (kt > 0) { const bf16* p = kg + (size_t)(kt - 1) * 64 * 3072; kx = *(const GAS v4u*)p; vx = *(const GAS v4u*)(p + 1024); }
        if (64 * kt < wmax) {
            const int nv = trow - 64 * kt - 4 * hh;
            if (64 * kt + 63 >= wmin) tile<true>(lds + KB0 + cur * 8192, lds + VB0 + cur * 8192, qr, o, carry, nv, lane, r, hh, TRI, ONES);
            else tile<false>(lds + KB0 + cur * 8192, lds + VB0 + cur * 8192, qr, o, carry, nv, lane, r, hh, TRI, ONES);
        }
        if (kt > 0) { *(LAS v4u*)(lds + KB0 + (cur ^ 1) * 8192 + kdst) = kx; *(LAS v4u*)(lds + VB0 + (cur ^ 1) * 8192 + vdst) = vx; }
        __syncthreads();
    }
    unsigned short* op = (unsigned short*)MIX + (rowbase + q0 + 32 * wid) * D + h * 64 + r;
#pragma unroll
    for (int db = 0; db < 2; ++db)
#pragma unroll
        for (int i = 0; i < 16; ++i) { const int row = (i & 3) + 8 * (i >> 2) + 4 * hh; ((GAS unsigned short*)op)[(size_t)row * D + 32 * db] = (unsigned short)f2bf(o[db][i]); }
}
#undef SB_MFMA
}
__device__ __forceinline__ void sb_attn_v2(Frame& F, const bf16* QKV, bf16* MIX) {
    relane(F);
    for (int v = blockIdx.x; v < 256; v += F.G) {
        const int bh = v >> 1, sel = v & 1;
#pragma unroll 1
        for (int u = 0; u < 4; ++u) {
            const int qb = sel ? ((u == 0) ? 6 : (u == 1) ? 1 : (u == 2) ? 4 : 3) : ((u == 0) ? 7 : (u == 1) ? 0 : (u == 2) ? 5 : 2);
            sbk::unit(bh >> 4, bh & 15, qb, QKV, MIX, F.lds + RING_OFF, F.tid);
        }
    }
}

namespace mlk {
typedef float f32x16 __attribute__((ext_vector_type(16)));
typedef short s16x4 __attribute__((ext_vector_type(4)));
typedef short v4i16_t __attribute__((ext_vector_type(4)));
#define ML_MFMA(a, b, c) __builtin_amdgcn_mfma_f32_32x32x16_bf16((a), (b), (c), 0, 0, 0)
__device__ __forceinline__ bf16x8 trpair(LAS unsigned char* p, int rowbytes4) {
    const s16x4 lo = __builtin_bit_cast(s16x4, __builtin_amdgcn_ds_read_tr16_b64_v4i16((LAS v4i16_t*)p));
    const s16x4 hi = __builtin_bit_cast(s16x4, __builtin_amdgcn_ds_read_tr16_b64_v4i16((LAS v4i16_t*)(p + rowbytes4)));
    return __builtin_shufflevector(lo, hi, 0, 1, 2, 3, 4, 5, 6, 7);
}
__device__ __forceinline__ float scan_add(float v, int lane) {
#pragma unroll
    for (int o = 1; o < 64; o <<= 1) { const float y = __shfl_up(v, o); if (lane >= o) v += y; }
    return v;
}
__device__ __forceinline__ float scan_max(float v, int lane) {
#pragma unroll
    for (int o = 1; o < 64; o <<= 1) { const float y = __shfl_up(v, o); if (lane >= o) v = fmaxf(v, y); }
    return v;
}
__device__ __forceinline__ void scale8(const v4u in, float w, v4u& out) {
    out.x = pk2(bflo(in.x) * w, bfhi(in.x) * w); out.y = pk2(bflo(in.y) * w, bfhi(in.y) * w); out.z = pk2(bflo(in.z) * w, bfhi(in.z) * w); out.w = pk2(bflo(in.w) * w, bfhi(in.w) * w);
}
constexpr float KSC = 0.08838834764831845f;

__device__ __forceinline__ void phaseA(Frame& F, const bf16* PROJ, const float* GT, bf16* ST, float* NST, float* SCAL) {
    relane(F);
    const int tid = F.tid, lane = F.lane, wv = F.wave, r = lane & 31, hh = lane >> 5, q4 = (lane & 15) >> 2, p4 = lane & 3, g1 = (lane >> 4) & 1;
    LAS unsigned char* KW = F.lds + RING_OFF; LAS unsigned char* VT = KW + 16384; LAS float* wk = (LAS float*)(KW + 49152);
    bf16x8 ONES;
#pragma unroll
    for (int j = 0; j < 8; ++j) ONES[j] = (short)0x3F80;
    for (int unit = blockIdx.x; unit < 1024; unit += F.G) {
        const int bh = unit >> 5, c = unit & 31, b = bh >> 2, h = bh & 3; const size_t row0 = (size_t)b * SEQ + c * 64;
        if (wv == 0) {
            const float lf = GT[(row0 + lane) * 8 + 4 + h], ig = GT[(row0 + lane) * 8 + h];
            const float bc = scan_add(lf, lane), bl = __shfl(bc, 63), g = bl - bc + ig, ml = wave_max(g);
            wk[lane] = __expf(g - ml) * KSC;
            if (lane == 0) { SCAL[unit * 2] = bl; SCAL[unit * 2 + 1] = ml; }
        }
        __syncthreads();
        { const int row = tid >> 3, c8 = tid & 7; const bf16* kp = PROJ + (row0 + row) * 3072 + 512 + h * 128 + c8 * 16;
          const v4u k0 = *(const GAS v4u*)kp, k1 = *(const GAS v4u*)(kp + 8); const bf16* vp = kp + 512 + h * 128 + c8 * 16;
          const v4u v0 = *(const GAS v4u*)vp, v1 = *(const GAS v4u*)(vp + 8), v2 = *(const GAS v4u*)(vp + 16), v3 = *(const GAS v4u*)(vp + 24);
          const float w = wk[row]; v4u o0, o1; scale8(k0, w, o0); scale8(k1, w, o1);
          *(LAS v4u*)(KW + row * 256 + c8 * 32) = o0; *(LAS v4u*)(KW + row * 256 + c8 * 32 + 16) = o1;
          LAS v4u* vd = (LAS v4u*)(VT + row * 512 + c8 * 64); vd[0] = v0; vd[1] = v1; vd[2] = v2; vd[3] = v3; }
        __syncthreads();
        f32x16 acc[4], nacc[4];
#pragma unroll
        for (int cb = 0; cb < 4; ++cb)
#pragma unroll
            for (int i = 0; i < 16; ++i) { acc[cb][i] = 0.f; nacc[cb][i] = 0.f; }
#pragma unroll
        for (int ks = 0; ks < 4; ++ks) {
            const bf16x8 af = trpair(VT + (16 * ks + 8 * hh + q4) * 512 + (32 * wv + 16 * g1 + 4 * p4) * 2, 4 * 512);
#pragma unroll
            for (int cb = 0; cb < 4; ++cb) {
                const bf16x8 bfr = trpair(KW + (16 * ks + 8 * hh + q4) * 256 + (32 * cb + 16 * g1 + 4 * p4) * 2, 4 * 256);
                acc[cb] = ML_MFMA(af, bfr, acc[cb]);
                if (wv == 0) nacc[cb] = ML_MFMA(ONES, bfr, nacc[cb]);
            }
        }
        GAS unsigned short* sp = (GAS unsigned short*)ST + (size_t)unit * 32768 + (size_t)(32 * wv) * 128 + r;
#pragma unroll
        for (int cb = 0; cb < 4; ++cb)
#pragma unroll
            for (int i = 0; i < 16; ++i) sp[((i & 3) + 8 * (i >> 2) + 4 * hh) * 128 + 32 * cb] = (unsigned short)f2bf(acc[cb][i]);
        if (wv == 0 && hh == 0) {
#pragma unroll
            for (int cb = 0; cb < 4; ++cb) NST[(size_t)unit * 128 + 32 * cb + r] = nacc[cb][0];
        }
        __syncthreads();
    }
}
__device__ __forceinline__ void phaseB(Frame& F, bf16* ST, float* NST, const float* SCAL, float* MPREV) {
    relane(F);
    for (int task = blockIdx.x * 512 + F.tid; task < 32 * 4096; task += F.G * 512) {
        const int bh = task >> 12, e0 = (task & 4095) * 8;
        float C[8], m = 0.f;
#pragma unroll
        for (int i = 0; i < 8; ++i) C[i] = 0.f;
        GAS v4u* p = (GAS v4u*)(ST + (size_t)bh * 32 * 32768 + e0);
        const float* sc = SCAL + (size_t)bh * 64;
#pragma unroll 4
        for (int c = 0; c < 32; ++c) {
            const v4u d = p[(size_t)c * 4096];
            const float bl = sc[2 * c], ml = sc[2 * c + 1], mn = fmaxf(bl + m, ml), dec = __expf(bl + m - mn), s = __expf(ml - mn);
            v4u o; o.x = pk2(C[0], C[1]); o.y = pk2(C[2], C[3]); o.z = pk2(C[4], C[5]); o.w = pk2(C[6], C[7]);
            p[(size_t)c * 4096] = o;
            if ((task & 4095) == 0) MPREV[bh * 32 + c] = m;
            C[0] = dec * C[0] + s * bflo(d.x); C[1] = dec * C[1] + s * bfhi(d.x); C[2] = dec * C[2] + s * bflo(d.y); C[3] = dec * C[3] + s * bfhi(d.y);
            C[4] = dec * C[4] + s * bflo(d.z); C[5] = dec * C[5] + s * bfhi(d.z); C[6] = dec * C[6] + s * bflo(d.w); C[7] = dec * C[7] + s * bfhi(d.w);
            m = mn;
        }
    }
    for (int task = blockIdx.x * 512 + F.tid; task < 32 * 128; task += F.G * 512) {
        const int bh = task >> 7, e = task & 127;
        float n = 0.f, m = 0.f; float* p = NST + (size_t)bh * 32 * 128 + e; const float* sc = SCAL + (size_t)bh * 64;
        for (int c = 0; c < 32; ++c) {
            const float d = p[c * 128], bl = sc[2 * c], ml = sc[2 * c + 1], mn = fmaxf(bl + m, ml);
            p[c * 128] = n; n = __expf(bl + m - mn) * n + __expf(ml - mn) * d; m = mn;
        }
    }
}
__device__ __forceinline__ void phaseC(Frame& F, bf16* PROJ, const float* GT, const bf16* ST, const float* NST, const float* MPREV, const float* hgain) {
    relane(F);
    const int tid = F.tid, lane = F.lane, wv = F.wave, r = lane & 31, hh = lane >> 5, q4 = (lane & 15) >> 2, p4 = lane & 3, g1 = (lane >> 4) & 1;
    LAS unsigned char* KT = F.lds + RING_OFF; LAS unsigned char* QT = KT + 16384; LAS unsigned char* VT = KT + 32768; LAS unsigned char* SD = KT + 65536;
    LAS float* sm = (LAS float*)(KT + 73728);
    LAS float* aa = sm; LAS float* ct2 = sm + 64; LAS float* inter = sm + 128; LAS float* emt = sm + 192; LAS float* nq = sm + 256; LAS float* npv = sm + 320; LAS float* densum = sm + 448; LAS float* ssq = sm + 576;
    LAS unsigned char* HT = KT;
    for (int unit = blockIdx.x; unit < 1024; unit += F.G) {
        const int bh = unit >> 5, c = unit & 31, b = bh >> 2, h = bh & 3; const size_t row0 = (size_t)b * SEQ + c * 64;
        { const int row = tid >> 3, c8 = tid & 7; const bf16* qp = PROJ + (row0 + row) * 3072 + h * 128 + c8 * 16;
          const v4u q0 = *(const GAS v4u*)qp, q1 = *(const GAS v4u*)(qp + 8), k0 = *(const GAS v4u*)(qp + 512), k1 = *(const GAS v4u*)(qp + 520);
          const bf16* vp = PROJ + (row0 + row) * 3072 + 1024 + h * 256 + c8 * 32;
          const v4u v0 = *(const GAS v4u*)vp, v1 = *(const GAS v4u*)(vp + 8), v2 = *(const GAS v4u*)(vp + 16), v3 = *(const GAS v4u*)(vp + 24);
          const int sw0 = ((2 * c8) ^ (row & 15)) << 4, sw1 = ((2 * c8 + 1) ^ (row & 15)) << 4;
          *(LAS v4u*)(QT + row * 256 + sw0) = q0; *(LAS v4u*)(QT + row * 256 + sw1) = q1; *(LAS v4u*)(KT + row * 256 + sw0) = k0; *(LAS v4u*)(KT + row * 256 + sw1) = k1;
          LAS v4u* vd = (LAS v4u*)(VT + row * 512 + c8 * 64); vd[0] = v0; vd[1] = v1; vd[2] = v2; vd[3] = v3; }
        const float mprev = MPREV[unit];
        if (wv == 0) {
            const float lf = GT[(row0 + lane) * 8 + 4 + h], ig = GT[(row0 + lane) * 8 + h];
            const float bc = scan_add(lf, lane), a = ig - bc, pm = scan_max(a, lane), ctv = -fmaxf(pm, mprev);
            aa[lane] = a; ct2[lane] = ctv - 2.4260151319598084f  ; inter[lane] = __expf(mprev + ctv); emt[lane] = __expf(ctv - bc);
        } else if (wv == 1) { npv[lane] = NST[(size_t)unit * 128 + lane]; npv[lane + 64] = NST[(size_t)unit * 128 + 64 + lane]; }
        bf16x8 cf[8];
        { const bf16* cp = ST + (size_t)unit * 32768 + (size_t)(32 * wv + r) * 128 + 8 * hh;
#pragma unroll
          for (int ks = 0; ks < 8; ++ks) cf[ks] = *(const GAS bf16x8*)(cp + 16 * ks); }
        __syncthreads();
        if (wv < 4) {
            const int sb = wv & 1, tb = wv >> 1, srow = 32 * sb + r, trow = 32 * tb + r;
            f32x16 s;
#pragma unroll
            for (int i = 0; i < 16; ++i) s[i] = 0.f;
#pragma unroll
            for (int ks = 0; ks < 8; ++ks) {
                const bf16x8 kf = *(const LAS bf16x8*)(KT + srow * 256 + (((2 * ks + hh) ^ (srow & 15)) << 4));
                const bf16x8 qf = *(const LAS bf16x8*)(QT + trow * 256 + (((2 * ks + hh) ^ (trow & 15)) << 4));
                s = ML_MFMA(kf, qf, s);
            }
            const float ctl = ct2[trow]; float dsum = 0.f;
#pragma unroll
            for (int g = 0; g < 4; ++g) {
                float v[4];
#pragma unroll
                for (int u = 0; u < 4; ++u) { const int sidx = 32 * sb + 8 * g + 4 * hh + u; const float d = __expf(aa[sidx] + ctl); v[u] = (sidx <= trow) ? s[4 * g + u] * d : 0.f; dsum += v[u]; }
                const unsigned long long w = (unsigned long long)pk2(v[0], v[1]) | ((unsigned long long)pk2(v[2], v[3]) << 32);
                *(LAS unsigned long long*)(SD + trow * 128 + (((4 * sb + g) ^ (trow & 7)) << 4) + hh * 8) = w;
            }
            dsum += __shfl_xor(dsum, 32);
            if (hh == 0) densum[sb * 64 + trow] = dsum;
        } else if (wv == 4) {
            float a = 0.f;
#pragma unroll
            for (int ch = 0; ch < 16; ++ch) { const v4u qw = *(const LAS v4u*)(QT + lane * 256 + ((ch ^ (lane & 15)) << 4)); const LAS float* np = npv + 8 * ch;
                a += np[0] * bflo(qw.x) + np[1] * bfhi(qw.x) + np[2] * bflo(qw.y) + np[3] * bfhi(qw.y) + np[4] * bflo(qw.z) + np[5] * bfhi(qw.z) + np[6] * bflo(qw.w) + np[7] * bfhi(qw.w); }
            nq[lane] = a;
        }
        __syncthreads();
        f32x16 hv[2];
        {   f32x16 accA[2], accB[2];
#pragma unroll
            for (int tb = 0; tb < 2; ++tb)
#pragma unroll
                for (int i = 0; i < 16; ++i) { accA[tb][i] = 0.f; accB[tb][i] = 0.f; }
#pragma unroll
            for (int ks = 0; ks < 4; ++ks) {
                const bf16x8 af = trpair(VT + (16 * ks + 8 * hh + q4) * 512 + (32 * wv + 16 * g1 + 4 * p4) * 2, 4 * 512);
#pragma unroll
                for (int tb = 0; tb < 2; ++tb) { const int trow = 32 * tb + r;
                    const bf16x8 sf = *(const LAS bf16x8*)(SD + trow * 128 + (((2 * ks + hh) ^ (trow & 7)) << 4));
                    accA[tb] = ML_MFMA(af, sf, accA[tb]); }
            }
#pragma unroll
            for (int ks = 0; ks < 8; ++ks)
#pragma unroll
                for (int tb = 0; tb < 2; ++tb) { const int trow = 32 * tb + r;
                    const bf16x8 qf = *(const LAS bf16x8*)(QT + trow * 256 + (((2 * ks + hh) ^ (trow & 15)) << 4));
                    accB[tb] = ML_MFMA(cf[ks], qf, accB[tb]); }
#pragma unroll
            for (int tb = 0; tb < 2; ++tb) { const int trow = 32 * tb + r;
                const float it = inter[trow], den = densum[trow] + densum[64 + trow] + it * nq[trow], rinv = 1.f / fmaxf(fabsf(den), emt[trow]);
                float q = 0.f;
#pragma unroll
                for (int i = 0; i < 16; ++i) { const float x = (accA[tb][i] + it * accB[tb][i]) * rinv; hv[tb][i] = x; q += x * x; }
                q += __shfl_xor(q, 32);
                if (hh == 0) ssq[wv * 64 + trow] = q; }
        }
        __syncthreads();
#pragma unroll
        for (int tb = 0; tb < 2; ++tb)
#pragma unroll
            for (int g = 0; g < 4; ++g) *(LAS f32x4*)(HT + (32 * tb + r) * 1040 + (32 * wv + 8 * g + 4 * hh) * 4) = (f32x4){hv[tb][4 * g], hv[tb][4 * g + 1], hv[tb][4 * g + 2], hv[tb][4 * g + 3]};
        __syncthreads();
        { const int t = tid >> 3, c8 = tid & 7; float sq = 0.f;
#pragma unroll
          for (int w = 0; w < 8; ++w) sq += ssq[w * 64 + t];
          const float rs = rsqrtf(sq * (1.f / 256.f) + EPS);
          bf16* orow = PROJ + (row0 + t) * 3072 + 1024 + h * 256 + c8 * 32;
#pragma unroll
          for (int q = 0; q < 4; ++q) {
              const f32x4 h0 = *(const LAS f32x4*)(HT + t * 1040 + (32 * c8 + 8 * q) * 4), h1 = *(const LAS f32x4*)(HT + t * 1040 + (32 * c8 + 8 * q + 4) * 4);
              const v4u og = *(const GAS v4u*)(orow + 1024 + 8 * q);
              const f32x4 g0 = *(const GAS f32x4*)(hgain + h * 256 + c8 * 32 + 8 * q), g1v = *(const GAS f32x4*)(hgain + h * 256 + c8 * 32 + 8 * q + 4);
              float y[8];
              y[0] = h0[0] * rs * g0[0] / (1.f + __expf(-bflo(og.x))); y[1] = h0[1] * rs * g0[1] / (1.f + __expf(-bfhi(og.x)));
              y[2] = h0[2] * rs * g0[2] / (1.f + __expf(-bflo(og.y))); y[3] = h0[3] * rs * g0[3] / (1.f + __expf(-bfhi(og.y)));
              y[4] = h1[0] * rs * g1v[0] / (1.f + __expf(-bflo(og.z))); y[5] = h1[1] * rs * g1v[1] / (1.f + __expf(-bfhi(og.z)));
              y[6] = h1[2] * rs * g1v[2] / (1.f + __expf(-bflo(og.w))); y[7] = h1[3] * rs * g1v[3] / (1.f + __expf(-bfhi(og.w)));
              v4u o; o.x = pk2(y[0], y[1]); o.y = pk2(y[2], y[3]); o.z = pk2(y[4], y[5]); o.w = pk2(y[6], y[7]);
              *(GAS v4u*)(orow + 8 * q) = o; } }
        __syncthreads();
    }
}
#undef ML_MFMA
}

template <int MR, int N, int K, bool ALIGN, class Epi> __device__ __forceinline__ void run_gemm(Frame& F, const bf16* A, int lda, const bf16* Bt, int ldb, int pmb, size_t b_batch, const Epi E) {
    int gd = gridDim.x, bi = blockIdx.x; asm volatile("" : "+s"(gd), "+s"(bi));
    pg8::Gemm g{A, Bt, MR, N, K, lda, ldb}; pg8::StaticOrder S; S.init(MR, N, gd, bi, lda, ldb, pmb, b_batch);
    pg8::gemm_phase<Epi, pg8::StaticOrder, ALIGN, true>(F.lds + RING_OFF, g, S, E);
}
__device__ __forceinline__ void xw_gemms(Frame& F, const bf16* KVl, const bf16* WQN, const bf16* WOT, bf16* XWTp) {
    int gd = gridDim.x, bi = blockIdx.x; asm volatile("" : "+s"(gd), "+s"(bi));
    for (int L = bi; L < 256; L += gd) {
        const int idx = L & 127, b = idx >> 4, h = (idx >> 2) & 3, t = idx & 3;
        OneUnit S; int kk = 256; asm volatile("" : "+s"(kk));
        if (L < 128) {
            pg8::Gemm g{KVl + (size_t)(b * NMEM) * 8192 + h * 256, WQN + (size_t)(t * 256) * D + h * 256, 256, 256, kk, 8192, D};
            EpiStore E{XWTp + (size_t)b * D * D + (size_t)(h * 256) * D + t * 256, D};
            pg8::gemm_phase<EpiStore, OneUnit, true, true>(F.lds + RING_OFF, g, S, E);
        } else {
            pg8::Gemm g{WOT + (size_t)(t * 256) * D + h * 256, KVl + (size_t)(b * NMEM) * 8192 + 1024 + h * 256, 256, 256, kk, D, 8192};
            EpiStore E{XWTp + (size_t)(8 + b) * D * D + (size_t)(t * 256) * D + h * 256, D};
            pg8::gemm_phase<EpiStore, OneUnit, true, true>(F.lds + RING_OFF, g, S, E);
        }
    }
}
struct Args { const float* in[15]; float* out; unsigned char* ws; int pad[2]; };
__global__ void __launch_bounds__(NWAVES * 64, 2) mega_fwd(Args args) {
    extern __shared__ __attribute__((aligned(16))) unsigned char lds[];
    Frame F;
    F.lds = (LAS unsigned char*)lds; F.ws = args.ws;
    relane(F);
    for (int u = F.tid; u < (LDS_BYTES - LDSCTL_OFF) / 4; u += NWAVES * 64) ((LAS unsigned*)(F.lds + LDSCTL_OFF))[u] = 0u;
    __syncthreads();
    if (F.tid < 16) { const unsigned long long p = (F.tid < 15) ? (unsigned long long)args.in[F.tid < 15 ? F.tid : 0] : (unsigned long long)args.out;
        ((LAS unsigned*)(F.lds + LDSCTL_OFF))[2 * F.tid] = (unsigned)p; ((LAS unsigned*)(F.lds + LDSCTL_OFF))[2 * F.tid + 1] = (unsigned)(p >> 32); }
    __syncthreads();
    gu32* ctl = (gu32*)(F.ws + WS_CTL);
    XcdBarrier bar = xcd_barrier_post((unsigned*)(ctl + CW_BAR), (volatile LAS unsigned*)(F.lds + MISC_OFF) + 8);
#define GRID_BAR() xcd_barrier(bar)

#define Wb ((bf16*)(F.ws + WS_W))
#define XWT ((bf16*)(F.ws + WS_XWT))
#define XN ((bf16*)(F.ws + WS_XN))
#define MIX ((bf16*)(F.ws + WS_MIX))
#define BIG ((bf16*)(F.ws + WS_BIG))
#define PB (BIG + (size_t)M * D)
#define KV ((bf16*)(F.ws + WS_KV))
#define MEMN ((bf16*)(F.ws + WS_MEMN))
#define GT ((float*)(F.ws + WS_GATES))
#define NSTP ((float*)(F.ws + WS_NST))
#define SCALP ((float*)(F.ws + WS_SCAL))
#define MPREVP ((float*)(F.ws + WS_MPREV))
#define gains inp(F, 3)
#define XOUT ((float*)inp(F, 15))

    p0_convert(F);
    row_phase(F, inp(F, 0), XOUT, nullptr, nullptr, gains, XN, inp(F, 4) + 3072, ML_W, inp(F, 5), GT);
    GRID_BAR();
    run_gemm<MM, 8192, D, true>(F, MEMN, D, XWT, D, 0, 0, EpiStore{KV, 8192});

#pragma unroll 1
    for (int l = 0; l < DEPTH; ++l) {
#define WL (Wb + (size_t)l * WL_SIZE)
#define GL (gains + (size_t)l * 6 * D)
        const bool ml = (l & 1) == 0;
        run_gemm<M, 3072, D, true>(F, XN, D, WL + WL_IN, D, 0, 0, EpiStore{BIG, 3072}); GRID_BAR();
        if (ml) {
            mlk::phaseA(F, BIG, GT, XN, NSTP, SCALP); GRID_BAR();
            mlk::phaseB(F, XN, NSTP, SCALP, MPREVP); GRID_BAR();
            mlk::phaseC(F, BIG, GT, XN, NSTP, MPREVP, inp(F, 6) + (size_t)(l >> 1) * D); GRID_BAR();
            run_gemm<M, D, D, true>(F, BIG + 1024, 3072, WL + WL_OUT, D, 0, 0, EpiStore{MIX, D});
        } else {
            sb_attn_v2(F, BIG, MIX); GRID_BAR();
            run_gemm<M, D, D, true>(F, MIX, D, WL + WL_OUT, D, 0, 0, EpiStore{BIG, D});
        }
        xw_gemms(F, KV + (size_t)l * 2048, WL + WL_QN, WL + WL_OT, XWT); GRID_BAR();
        row_phase(F, XOUT, XOUT, ml ? MIX : BIG, GL + D, GL + 2 * D, XN, nullptr, 0, nullptr, nullptr); GRID_BAR();
        run_gemm<M, D, D, false>(F, XN, D, XWT, D, 8, (size_t)D * D * 2, EpiSoftmax{PB, D}); GRID_BAR();
        run_gemm<M, D, D, true>(F, PB, D, XWT + (size_t)8 * D * D, D, 8, (size_t)D * D * 2, EpiStore{BIG, D}); GRID_BAR();
        row_phase(F, XOUT, XOUT, BIG, GL + 3 * D, GL + 4 * D, XN, nullptr, 0, nullptr, nullptr); GRID_BAR();
        run_gemm<M, 2 * DFF, D, true>(F, XN, D, WL + WL_GU, D, 0, 0, EpiSwiglu{BIG, DFF}); GRID_BAR();
        run_gemm<M, D, DFF, true>(F, BIG, DFF, WL + WL_DN, DFF, 0, 0, EpiStore{MIX, D}); GRID_BAR();
        { const bool last = (l + 1 == DEPTH), gates = !last && (((l + 1) & 1) == 0);
          row_phase(F, XOUT, XOUT, MIX, GL + 5 * D, last ? nullptr : GL + 6 * D, XN,
                    gates ? inp(F, 4) + (size_t)((l + 1) >> 1) * D * ML_W + 3072 : nullptr, ML_W, inp(F, 5) + ((l + 1) >> 1) * 8, GT);
          if (!last) GRID_BAR(); }
    }
}

extern "C" void kernel_launch(void* const* d_in, const int* in_sizes, int n_in, void* d_out, int out_size, void* d_ws, size_t ws_size, hipStream_t stream) {
    static int grid = 0;
    if (grid == 0) {
        if (n_in != 15 || out_size != M * D || ws_size < WS_END) { fprintf(stderr, "kernel_launch: unexpected shapes (n_in %d out %d ws %zu need %zu)\n", n_in, out_size, ws_size, (size_t)WS_END); grid = -1; return; }
        int dev = 0, cus = 0, per_cu = 0;
        if (hipGetDevice(&dev) != hipSuccess || hipDeviceGetAttribute(&cus, hipDeviceAttributeMultiprocessorCount, dev) != hipSuccess) { grid = -1; return; }
        if (hipFuncSetAttribute((const void*)mega_fwd, hipFuncAttributeMaxDynamicSharedMemorySize, LDS_BYTES) != hipSuccess) { fprintf(stderr, "kernel_launch: hipFuncSetAttribute failed\n"); grid = -1; return; }
        if (hipOccupancyMaxActiveBlocksPerMultiprocessor(&per_cu, (const void*)mega_fwd, NWAVES * 64, LDS_BYTES) != hipSuccess || per_cu < 1) fprintf(stderr, "kernel_launch: occupancy query reports %d\n", per_cu);
        (void)hipGetLastError();
        grid = cus;
    }
    if (grid < 0) return;
    if (hipMemsetAsync((char*)d_ws + WS_CTL, 0, CTL_ZERO_BYTES, stream) != hipSuccess) return;
    Args a{};
    for (int i = 0; i < 15; ++i) a.in[i] = (const float*)d_in[i];
    a.out = (float*)d_out; a.ws = (unsigned char*)d_ws;
    hipLaunchKernelGGL(mega_fwd, dim3(grid), dim3(NWAVES * 64), LDS_BYTES, stream, a);
}
```

```cpp
#include <hip/hip_runtime.h>
#include <cstdio>
#include <cstdint>
namespace pg8 {
#define PG8_LAS __attribute__((address_space(3)))
typedef unsigned short bf16_t;
typedef short bf16x8 __attribute__((ext_vector_type(8)));
typedef float f32x4 __attribute__((ext_vector_type(4)));
typedef unsigned u32x4 __attribute__((ext_vector_type(4)));
constexpr int BM = 256, BK = 64, HALF = 128, HTB = HALF * BK * 2  , STAGE_BYTES = 8 * HTB, NXCD = 8, WGM = 8;

__host__ __device__ __forceinline__ int lds_byte(int r, int c) { const int st = (r >> 4) * 2 + (c >> 5), rr = r & 15, cc = c & 31, ob = rr * 64 + cc * 2; return st * 1024 + (ob ^ (((ob >> 9) & 1) << 5)); }
__host__ __device__ __forceinline__ void stage_rc(int b, int& R, int& C) { const int st = b / 1024, sb = b % 1024, swz = sb ^ (((sb >> 9) & 1) << 5); R = (st >> 1) * 16 + swz / 64; C = (st & 1) * 32 + (swz % 64) / 2; }
__host__ __device__ __forceinline__ int perm32(int rho) { const int n = rho >> 4, i = rho & 15; return 8 * (i >> 2) + 4 * n + (i & 3); }

struct Unit { int pm, pn; size_t aoff, boff; };
struct Gemm { const bf16_t* A; const bf16_t* Bt; int M, N, K, lda, ldb; };

struct StaticOrder {
    int nM, nN, nwg, G, c, pmb; size_t a_rt, b_rt, b_batch;
    __host__ __device__ void init(int M, int N, int G_, int c_, int lda, int ldb, int pmb_ = 0, size_t b_batch_ = 0) { nM = M / BM; nN = N / BM; nwg = nM * nN; G = G_; c = c_; a_rt = (size_t)BM * lda * 2; b_rt = (size_t)BM * ldb * 2; pmb = pmb_; b_batch = b_batch_; }
    __host__ __device__ bool next(int i, Unit& u) const {
        const long L = (long)i * G + c; if (L >= nwg) return false;
        int wgid = (int)L; { const int q = nwg / NXCD, r = nwg % NXCD, xcd = wgid % NXCD, off = wgid / NXCD; wgid = (xcd < r ? xcd * (q + 1) : r * (q + 1) + (xcd - r) * q) + off; }
        const int nig = WGM * nN, gid = wgid / nig, fm = gid * WGM, gsz = (nM - fm) < WGM ? (nM - fm) : WGM;
        u.pm = fm + ((wgid % nig) % gsz); u.pn = (wgid % nig) / gsz; u.aoff = (size_t)u.pm * a_rt; u.boff = (size_t)u.pn * b_rt + (pmb ? (size_t)(u.pm / pmb) * b_batch : 0); return true;
    }
    __device__ __forceinline__ void a_ready(const Unit&) const {}
    __device__ __forceinline__ void done(const Unit&) const {}
};

__device__ __forceinline__ unsigned cvt_pk_bf16(float lo, float hi) { unsigned r; asm volatile("v_cvt_pk_bf16_f32 %0, %1, %2" : "=v"(r) : "v"(lo), "v"(hi)); return r; }
typedef float f32x2 __attribute__((ext_vector_type(2)));
__device__ __forceinline__ f32x2 gelu_pk(f32x2 v) {
    const f32x2 av = __builtin_elementwise_abs(v), d = av * 0.2316418882f + 1.0f;
    f32x2 t; t.x = __builtin_amdgcn_rcpf(d.x); t.y = __builtin_amdgcn_rcpf(d.y);
    f32x2 q = t * 0.5307027145f + (-0.7265760135f); q = q * t + 0.7107068705f; q = q * t + (-0.142248368f); q = q * t + 0.127414796f; q = q * t;
    const f32x2 s = (v * v) * (-0.72134752044f);
    f32x2 e; e.x = __builtin_amdgcn_exp2f(s.x); e.y = __builtin_amdgcn_exp2f(s.y);
    const f32x2 m = v * (q * e), r = v - m;
    f32x2 o; o.x = v.x < 0.f ? m.x : r.x; o.y = v.y < 0.f ? m.y : r.y; return o;
}

template <int ACT  > struct EpiBf16 {
    static constexpr bool PERM = true, AFTER_DRAIN = false; static_assert(ACT == 0 || ACT == 1, "EpiBf16: ACT is 0 (none) or 1 (gelu_pk)");
    bf16_t* O; int ldc; const float* bias; int split_cols; size_t split_stride; float scale0;
    __device__ __forceinline__ void operator()(const f32x4 (&acc)[2][2][4][2], const Unit& u, int wr, int wc, int fr, int fq) const {
        const int row0 = u.pm * BM + wr * 64 + fr; int colt = u.pn * BM; bf16_t* base = O;
        float sc = 1.f; if (split_cols) { const int t = colt / split_cols; base += (size_t)t * split_stride; colt -= t * split_cols; if (t == 0) sc = scale0; }
        const int col0 = colt + wc * 32 + 8 * fq, bcol0 = u.pn * BM + wc * 32 + 8 * fq;
        f32x4 bv[2][2];
#pragma unroll
        for (int bj = 0; bj < 2; ++bj)
#pragma unroll
            for (int n = 0; n < 2; ++n) bv[bj][n] = bias ? *(const f32x4*)(bias + bcol0 + bj * HALF + 4 * n) : (f32x4){0.f, 0.f, 0.f, 0.f};
#pragma unroll
        for (int ai = 0; ai < 2; ++ai)
#pragma unroll
            for (int m = 0; m < 4; ++m) { bf16_t* rowp = base + (size_t)(row0 + ai * HALF + m * 16) * ldc + col0;
#pragma unroll
                for (int bj = 0; bj < 2; ++bj) { f32x4 v0 = acc[ai][bj][m][0] + bv[bj][0], v1 = acc[ai][bj][m][1] + bv[bj][1];
                    if (ACT == 1) { f32x2 a = gelu_pk((f32x2){v0[0], v0[1]}), b = gelu_pk((f32x2){v0[2], v0[3]}), c = gelu_pk((f32x2){v1[0], v1[1]}), d = gelu_pk((f32x2){v1[2], v1[3]});
                        v0 = (f32x4){a.x, a.y, b.x, b.y}; v1 = (f32x4){c.x, c.y, d.x, d.y}; }
                    v0 = v0 * sc; v1 = v1 * sc; u32x4 w; w.x = cvt_pk_bf16(v0[0], v0[1]); w.y = cvt_pk_bf16(v0[2], v0[3]); w.z = cvt_pk_bf16(v1[0], v1[1]); w.w = cvt_pk_bf16(v1[2], v1[3]);
                    *(u32x4*)(rowp + bj * HALF) = w; } }
    }
};

struct PanelStats {
    unsigned* xbuf;
    unsigned* cnt;
    unsigned* tmo;
    int ntn; float eps;
    unsigned code;
    __device__ __forceinline__ bool run(const f32x4 (&v)[2][2][4][2], const Unit& u, int wr, int wc, int fr, int fq, PG8_LAS unsigned char* lds, int wid, int lane) const {
        typedef float f32x2v __attribute__((ext_vector_type(2)));
        PG8_LAS f32x2v* P = (PG8_LAS f32x2v*)lds;
        PG8_LAS f32x2v* S = (PG8_LAS f32x2v*)(lds + 8192);
        PG8_LAS unsigned* flag = (PG8_LAS unsigned*)(lds + 8192 + 2048);
#pragma unroll
        for (int ai = 0; ai < 2; ++ai)
#pragma unroll
            for (int m = 0; m < 4; ++m) {
                float s = 0.f;
#pragma unroll
                for (int bj = 0; bj < 2; ++bj)
#pragma unroll
                    for (int n = 0; n < 2; ++n) { const f32x4 x = v[ai][bj][m][n]; s += (x[0] + x[1]) + (x[2] + x[3]); }
                s += __shfl_xor(s, 16); s += __shfl_xor(s, 32);
                const float mw = s * (1.0f / 64.0f); float q = 0.f;
#pragma unroll
                for (int bj = 0; bj < 2; ++bj)
#pragma unroll
                    for (int n = 0; n < 2; ++n) { const f32x4 d = v[ai][bj][m][n] - mw; q += (d[0] * d[0] + d[1] * d[1]) + (d[2] * d[2] + d[3] * d[3]); }
                q += __shfl_xor(q, 16); q += __shfl_xor(q, 32);
                if (fq == 0) P[(ai * HALF + wr * 64 + m * 16 + fr) * 4 + wc] = (f32x2v){mw, q};
            }
        asm volatile("s_waitcnt lgkmcnt(0)" ::: "memory"); __builtin_amdgcn_s_barrier(); asm volatile("" ::: "memory");
#if defined(BROKEN_EXCHANGE_NO_WAIT)
#warning BROKEN CONTROL BUILD: the row-statistics exchange does not wait; results are wrong by design
        if (blockIdx.x >= 64) { const long long t0_ = clock64(); while (clock64() - t0_ < 60000) __builtin_amdgcn_s_sleep(8); }
#endif
        const int row = wid * 32 + (lane & 31);
        if (lane < 32) {
            const f32x2v a = P[row * 4 + 0], b = P[row * 4 + 1], c = P[row * 4 + 2], d = P[row * 4 + 3];
            const float mt = (a.x + b.x + c.x + d.x) * 0.25f;
            const float da = a.x - mt, db = b.x - mt, dc = c.x - mt, dd = d.x - mt;
            const float m2 = (a.y + b.y) + (c.y + d.y) + 64.0f * ((da * da + db * db) + (dc * dc + dd * dd));
            unsigned long long* slot = (unsigned long long*)xbuf + ((size_t)(u.pm * BM + row) * 4 + u.pn);
            __hip_atomic_store(slot, ((unsigned long long)__float_as_uint(m2) << 32) | __float_as_uint(mt), __ATOMIC_RELAXED, __HIP_MEMORY_SCOPE_AGENT);
        }
        asm volatile("s_waitcnt vmcnt(0)" ::: "memory");
        if (lane == 0) __hip_atomic_fetch_add(cnt + 64 * u.pm, 1u, __ATOMIC_RELAXED, __HIP_MEMORY_SCOPE_AGENT);
        if (wid == 0) {
            bool dead = false; const unsigned long long t0 = __builtin_amdgcn_s_memrealtime(); const unsigned want = 8u * (unsigned)ntn;
            for (;;) {
#if defined(BROKEN_EXCHANGE_NO_WAIT)
                break;
#endif
                if ((unsigned)__builtin_amdgcn_readfirstlane(__hip_atomic_load(cnt + 64 * u.pm, __ATOMIC_RELAXED, __HIP_MEMORY_SCOPE_AGENT)) >= want) break;
                if (__builtin_amdgcn_s_memrealtime() - t0 > 2000000ull) {
                    if (lane == 0) { unsigned expect = 0u; __hip_atomic_compare_exchange_strong(tmo + 1, &expect, code | (unsigned)(u.pm & 0xff), __ATOMIC_RELAXED, __ATOMIC_RELAXED, __HIP_MEMORY_SCOPE_AGENT);
                                     __hip_atomic_store(tmo, 1u, __ATOMIC_RELAXED, __HIP_MEMORY_SCOPE_AGENT); }
                    dead = true; break; }
                __builtin_amdgcn_s_sleep(2);
            }
            __builtin_amdgcn_fence(__ATOMIC_ACQUIRE, "agent");
            if (lane == 0) flag[0] = dead ? 1u : 0u;
        }
        asm volatile("s_waitcnt vmcnt(0) lgkmcnt(0)" ::: "memory"); __builtin_amdgcn_s_barrier(); asm volatile("" ::: "memory");
        const bool bad = flag[0] != 0u;
        if (lane < 32) {
            const unsigned long long* slot = (const unsigned long long*)xbuf + (size_t)(u.pm * BM + row) * 4; float mt[4], m2[4]; float ms = 0.f;
#pragma unroll
            for (int t = 0; t < 4; ++t) { if (t < ntn) { const unsigned long long w = __hip_atomic_load(slot + t, __ATOMIC_RELAXED, __HIP_MEMORY_SCOPE_AGENT); mt[t] = __uint_as_float((unsigned)w); m2[t] = __uint_as_float((unsigned)(w >> 32)); } else { mt[t] = 0.f; m2[t] = 0.f; } ms += mt[t]; }
            const float mean = ms / (float)ntn; float q = 0.f;
#pragma unroll
            for (int t = 0; t < 4; ++t) if (t < ntn) { const float dm = mt[t] - mean; q += m2[t] + 256.0f * dm * dm; }
            S[row] = (f32x2v){mean, 1.0f / sqrtf(q / (256.0f * (float)ntn) + eps)};
        }
        asm volatile("s_waitcnt lgkmcnt(0)" ::: "memory"); __builtin_amdgcn_s_barrier(); asm volatile("" ::: "memory");
        return bad;
    }
};
struct EpiLnRes {
    static constexpr bool PERM = false, AFTER_DRAIN = true;
    const float* base; float* out; int ldc; const float* bias; PanelStats st; unsigned poison;
    __device__ __forceinline__ void fused(f32x4 (&acc)[2][2][4][2], const Unit& u, int wr, int wc, int fr, int fq, PG8_LAS unsigned char* lds, int wid, int lane) const {
        typedef float f32x2v __attribute__((ext_vector_type(2)));
        const PG8_LAS f32x2v* S = (const PG8_LAS f32x2v*)(lds + 8192);
        const int col0 = u.pn * BM + wc * 32 + 4 * fq;
#pragma unroll
        for (int bj = 0; bj < 2; ++bj)
#pragma unroll
            for (int n = 0; n < 2; ++n) { const f32x4 bv = bias ? *(const f32x4*)(bias + col0 + bj * HALF + n * 16) : (f32x4){0.f, 0.f, 0.f, 0.f};
#pragma unroll
                for (int ai = 0; ai < 2; ++ai)
#pragma unroll
                    for (int m = 0; m < 4; ++m) acc[ai][bj][m][n] += bv; }
        f32x4 pre[4][2][2];
#pragma unroll
        for (int m = 0; m < 4; ++m) { const size_t off = (size_t)(u.pm * BM + wr * 64 + m * 16 + fr) * ldc + col0;
#pragma unroll
            for (int bj = 0; bj < 2; ++bj)
#pragma unroll
                for (int n = 0; n < 2; ++n) pre[m][bj][n] = *(const f32x4*)(base + off + bj * HALF + n * 16); }
        const bool bad = st.run(acc, u, wr, wc, fr, fq, lds, wid, lane) || poison != 0u;
        const float qnan = __builtin_nanf("");
#pragma unroll
        for (int ai = 0; ai < 2; ++ai)
#pragma unroll
            for (int m = 0; m < 4; ++m) { const int r = ai * HALF + wr * 64 + m * 16 + fr; const f32x2v sr = S[r]; const size_t off = (size_t)(u.pm * BM + r) * ldc + col0;
#pragma unroll
                for (int bj = 0; bj < 2; ++bj)
#pragma unroll
                    for (int n = 0; n < 2; ++n) { const f32x4 bs = ai == 0 ? pre[m][bj][n] : *(const f32x4*)(base + off + bj * HALF + n * 16); f32x4 o = bs + (acc[ai][bj][m][n] - sr.x) * sr.y;
                        if (bad) o = (f32x4){qnan, qnan, qnan, qnan}; *(f32x4*)(out + off + bj * HALF + n * 16) = o; }
                if (m & 1) asm volatile("" ::: "memory"); }
    }
};
struct EpiLnResLn {
    static constexpr bool PERM = false, AFTER_DRAIN = true;
    const float* base; float* out; bf16_t* xn; int ldc; const float* bias; PanelStats st1, st2; unsigned poison;
    __device__ __forceinline__ void fused(f32x4 (&acc)[2][2][4][2], const Unit& u, int wr, int wc, int fr, int fq, PG8_LAS unsigned char* lds, int wid, int lane) const {
        typedef float f32x2v __attribute__((ext_vector_type(2))); typedef unsigned u32x2v __attribute__((ext_vector_type(2)));
        const PG8_LAS f32x2v* S = (const PG8_LAS f32x2v*)(lds + 8192);
        const int col0 = u.pn * BM + wc * 32 + 4 * fq;
#pragma unroll
        for (int bj = 0; bj < 2; ++bj)
#pragma unroll
            for (int n = 0; n < 2; ++n) { const f32x4 bv = bias ? *(const f32x4*)(bias + col0 + bj * HALF + n * 16) : (f32x4){0.f, 0.f, 0.f, 0.f};
#pragma unroll
                for (int ai = 0; ai < 2; ++ai)
#pragma unroll
                    for (int m = 0; m < 4; ++m) acc[ai][bj][m][n] += bv; }
        bool bad = st1.run(acc, u, wr, wc, fr, fq, lds, wid, lane) || poison != 0u;
        const float qnan = __builtin_nanf("");
#pragma unroll
        for (int ai = 0; ai < 2; ++ai)
#pragma unroll
            for (int m = 0; m < 4; ++m) { const int r = ai * HALF + wr * 64 + m * 16 + fr; const f32x2v sr = S[r]; const size_t off = (size_t)(u.pm * BM + r) * ldc + col0;
#pragma unroll
                for (int bj = 0; bj < 2; ++bj)
#pragma unroll
                    for (int n = 0; n < 2; ++n) { const f32x4 bs = *(const f32x4*)(base + off + bj * HALF + n * 16); acc[ai][bj][m][n] = bs + (acc[ai][bj][m][n] - sr.x) * sr.y; }
                asm volatile("" : "+v"(acc[ai][0][m][0]), "+v"(acc[ai][0][m][1]), "+v"(acc[ai][1][m][0]), "+v"(acc[ai][1][m][1]));
                if (m & 1) asm volatile("" ::: "memory"); }
        const bool bad1 = bad;
        bad = st2.run(acc, u, wr, wc, fr, fq, lds, wid, lane) || bad;
#pragma unroll
        for (int ai = 0; ai < 2; ++ai)
#pragma unroll
            for (int m = 0; m < 4; ++m) { const int r = ai * HALF + wr * 64 + m * 16 + fr; const f32x2v sr = S[r]; const size_t off = (size_t)(u.pm * BM + r) * ldc + col0;
#pragma unroll
                for (int bj = 0; bj < 2; ++bj)
#pragma unroll
                    for (int n = 0; n < 2; ++n) { const f32x4 x1 = acc[ai][bj][m][n]; *(f32x4*)(out + off + bj * HALF + n * 16) = bad1 ? (f32x4){qnan, qnan, qnan, qnan} : x1;
                        const f32x4 o = (x1 - sr.x) * sr.y; u32x2v w; w.x = cvt_pk_bf16(o[0], o[1]); w.y = cvt_pk_bf16(o[2], o[3]);
                        if (bad) { w.x = 0x7fc07fc0u; w.y = 0x7fc07fc0u; } *(u32x2v*)(xn + off + bj * HALF + n * 16) = w; }
                asm volatile("" ::: "memory"); }
    }
};

template <class Epi, class Sched, bool ALIGN_EPI = false, bool SP2 = false>
__device__ __forceinline__ void gemm_phase(PG8_LAS unsigned char* lds, const Gemm g, const Sched& S, const Epi& E) {
    int tid_ = threadIdx.x; asm volatile("" : "+v"(tid_));
    const int tid = tid_, wid = __builtin_amdgcn_readfirstlane(tid >> 6), lane = tid & 63, wr = wid >> 2, wc = wid & 3, fr = lane & 15, fq = lane >> 4;
    const int K = g.K, nt = K / BK;
    unsigned voffA[2], voffB[2];
#pragma unroll
    for (int i = 0; i < 2; ++i) { int R, C; stage_rc(tid * 16 + i * 8192, R, C); const int Rb = Epi::PERM ? ((R & ~31) + perm32(R & 31)) : R;
        voffA[i] = (unsigned)(R * g.lda + C) * 2u; voffB[i] = (unsigned)(Rb * g.ldb + C) * 2u; }
    const size_t kstep = (size_t)(BK * 2);
    const size_t hstepA = (size_t)HALF * g.lda * 2, hstepB = (size_t)HALF * g.ldb * 2;
    const unsigned ldsw = (unsigned)wid * 1024u;
    const int aoff = lds_byte(wr * 64 + fr, fq * 8), boff = lds_byte(wc * 32 + fr, fq * 8);
#define PG8_SA(b, h) (((b) * 2 + (h)) * HTB)
#define PG8_SB(b, h) ((4 + (b) * 2 + (h)) * HTB)
#define PG8_STAGE(bufoff, gbase, voff) do { _Pragma("unroll") for (int _i = 0; _i < 2; ++_i) \
        __builtin_amdgcn_global_load_lds((const unsigned*)((const char*)(gbase) + (voff)[_i]), (PG8_LAS unsigned*)(lds + (bufoff) + ldsw + _i * 8192), 16, 0, 0); } while (0)
#define PG8_LDA(dst, b, h) do { _Pragma("unroll") for (int m = 0; m < 4; ++m) _Pragma("unroll") for (int k = 0; k < 2; ++k) dst[m][k] = *(const PG8_LAS bf16x8*)(lds + PG8_SA(b, h) + aoff + m * 2048 + k * 1024); } while (0)
#define PG8_LDB(dst, b, h) do { _Pragma("unroll") for (int n = 0; n < 2; ++n) _Pragma("unroll") for (int k = 0; k < 2; ++k) dst[n][k] = *(const PG8_LAS bf16x8*)(lds + PG8_SB(b, h) + boff + n * 2048 + k * 1024); } while (0)
#define PG8_MMA(ai, bj, At, Bt) do { __builtin_amdgcn_s_setprio(1); _Pragma("unroll") for (int m = 0; m < 4; ++m) _Pragma("unroll") for (int n = 0; n < 2; ++n) _Pragma("unroll") for (int k = 0; k < 2; ++k) \
        acc[ai][bj][m][n] = __builtin_amdgcn_mfma_f32_16x16x32_bf16(Bt[n][k], At[m][k], acc[ai][bj][m][n], 0, 0, 0); __builtin_amdgcn_s_setprio(0); } while (0)
#define PG8_WAIT_V(n) asm volatile("s_waitcnt vmcnt(" #n ")" ::: "memory")
#define PG8_WAIT_L(n) asm volatile("s_waitcnt lgkmcnt(" #n ")" ::: "memory")
#define PG8_BAR __builtin_amdgcn_s_barrier()
#define PG8_SCHED __builtin_amdgcn_sched_barrier(0)
    Unit cur, nxt; int ui = 0;
    if (!S.next(0, cur)) return;
    f32x4 acc[2][2][4][2];
#pragma unroll
    for (int a = 0; a < 2; ++a)
#pragma unroll
        for (int b = 0; b < 2; ++b)
#pragma unroll
            for (int m = 0; m < 4; ++m)
#pragma unroll
                for (int n = 0; n < 2; ++n) acc[a][b][m][n] = (f32x4){0.f, 0.f, 0.f, 0.f};
    bf16x8 At[4][2], B0[2][2], B1[2][2];
    const char* cA = (const char*)g.A + cur.aoff; const char* cB = (const char*)g.Bt + cur.boff;
    S.a_ready(cur);
    if constexpr (SP2) {
        PG8_STAGE(PG8_SB(0, 0), cB, voffB); PG8_STAGE(PG8_SB(0, 1), cB + hstepB, voffB); PG8_STAGE(PG8_SA(0, 0), cA, voffA); PG8_STAGE(PG8_SA(0, 1), cA + hstepA, voffA);
        if (wr == 1) PG8_BAR;
        PG8_WAIT_V(2); PG8_BAR;
        PG8_STAGE(PG8_SB(1, 0), cB + kstep, voffB); PG8_STAGE(PG8_SA(1, 0), cA + kstep, voffA); PG8_STAGE(PG8_SB(1, 1), cB + hstepB + kstep, voffB);
        PG8_WAIT_V(6); PG8_BAR;
    } else {
        PG8_STAGE(PG8_SB(0, 0), cB, voffB); PG8_STAGE(PG8_SA(0, 0), cA, voffA); PG8_STAGE(PG8_SB(0, 1), cB + hstepB, voffB); PG8_STAGE(PG8_SA(0, 1), cA + hstepA, voffA);
        if (wr == 1) PG8_BAR;
        PG8_WAIT_V(4); PG8_BAR;
        PG8_STAGE(PG8_SB(1, 0), cB + kstep, voffB); PG8_STAGE(PG8_SA(1, 0), cA + kstep, voffA); PG8_STAGE(PG8_SB(1, 1), cB + hstepB + kstep, voffB);
        PG8_WAIT_V(6); PG8_BAR;
    }
    for (;;) {
        const bool has_next = S.next(ui + 1, nxt);
        const char* nA = has_next ? (const char*)g.A + nxt.aoff : cA; const char* nB = has_next ? (const char*)g.Bt + nxt.boff : cB;
        for (int t = 0; t < nt; t += 2) {
            const bool last = (t == nt - 2);
            const char* a1 = cA + (size_t)(t + 1) * kstep;
            const char* a2 = last ? nA : cA + (size_t)(t + 2) * kstep; const char* b2 = last ? nB : cB + (size_t)(t + 2) * kstep;
            const char* a3 = a2 + kstep; const char* b3 = b2 + kstep;
            if (last && has_next) S.a_ready(nxt);
            if constexpr (SP2) {
            PG8_LDB(B0, 0, 0); PG8_LDB(B1, 0, 1); PG8_SCHED; PG8_LDA(At, 0, 0); PG8_STAGE(PG8_SA(1, 1), a1 + hstepA, voffA);
            PG8_WAIT_V(8); PG8_WAIT_L(0); PG8_BAR; PG8_MMA(0, 0, At, B0); PG8_MMA(0, 1, At, B1); PG8_BAR; PG8_SCHED;
            PG8_LDA(At, 0, 1); PG8_STAGE(PG8_SB(0, 0), b2, voffB); PG8_STAGE(PG8_SB(0, 1), b2 + hstepB, voffB); PG8_STAGE(PG8_SA(0, 0), a2, voffA);
            PG8_WAIT_V(8); PG8_WAIT_L(0); PG8_BAR; PG8_MMA(1, 0, At, B0); PG8_MMA(1, 1, At, B1); PG8_BAR; PG8_SCHED;
            PG8_LDB(B0, 1, 0); PG8_LDB(B1, 1, 1); PG8_SCHED; PG8_LDA(At, 1, 0); PG8_STAGE(PG8_SA(0, 1), a2 + hstepA, voffA);
            PG8_WAIT_V(8); PG8_WAIT_L(0); PG8_BAR; PG8_MMA(0, 0, At, B0); PG8_MMA(0, 1, At, B1); PG8_BAR; PG8_SCHED;
            PG8_LDA(At, 1, 1); PG8_STAGE(PG8_SB(1, 0), b3, voffB); PG8_STAGE(PG8_SB(1, 1), b3 + hstepB, voffB); PG8_STAGE(PG8_SA(1, 0), a3, voffA);
            PG8_WAIT_V(8); PG8_WAIT_L(0); PG8_BAR; PG8_MMA(1, 0, At, B0); PG8_MMA(1, 1, At, B1); PG8_BAR; PG8_SCHED;
            } else {
            PG8_LDB(B0, 0, 0); PG8_SCHED; PG8_LDA(At, 0, 0); PG8_STAGE(PG8_SA(1, 1), a1 + hstepA, voffA);
            PG8_WAIT_L(8); PG8_BAR; PG8_WAIT_L(0); PG8_MMA(0, 0, At, B0); PG8_BAR; PG8_SCHED;
            PG8_LDB(B1, 0, 1); PG8_STAGE(PG8_SB(0, 0), b2, voffB);
            PG8_BAR; PG8_WAIT_L(0); PG8_MMA(0, 1, At, B1); PG8_BAR;
            PG8_LDA(At, 0, 1); PG8_STAGE(PG8_SA(0, 0), a2, voffA);
            PG8_BAR; PG8_WAIT_L(0); PG8_MMA(1, 0, At, B0); PG8_BAR; PG8_SCHED;
            PG8_STAGE(PG8_SB(0, 1), b2 + hstepB, voffB);
            PG8_WAIT_V(6); PG8_BAR; PG8_MMA(1, 1, At, B1); PG8_BAR;
            PG8_LDB(B0, 1, 0); PG8_SCHED; PG8_LDA(At, 1, 0); PG8_STAGE(PG8_SA(0, 1), a2 + hstepA, voffA);
            PG8_WAIT_L(8); PG8_BAR; PG8_WAIT_L(0); PG8_MMA(0, 0, At, B0); PG8_BAR; PG8_SCHED;
            PG8_LDB(B1, 1, 1); PG8_STAGE(PG8_SB(1, 0), b3, voffB);
            PG8_BAR; PG8_WAIT_L(0); PG8_MMA(0, 1, At, B1); PG8_BAR;
            PG8_LDA(At, 1, 1); PG8_STAGE(PG8_SA(1, 0), a3, voffA);
            PG8_BAR; PG8_WAIT_L(0); PG8_MMA(1, 0, At, B0); PG8_BAR; PG8_SCHED;
            PG8_STAGE(PG8_SB(1, 1), b3 + hstepB, voffB);
            PG8_WAIT_V(6); PG8_BAR; PG8_MMA(1, 1, At, B1); PG8_BAR;
            }
        }
        if constexpr (ALIGN_EPI) { if (wr == 0) PG8_BAR; }
        if constexpr (!Epi::AFTER_DRAIN) { E(acc, cur, wr, wc, fr, fq); S.done(cur); }
        if (!has_next) break;
#pragma unroll
        for (int a = 0; a < 2; ++a)
#pragma unroll
            for (int b = 0; b < 2; ++b)
#pragma unroll
                for (int m = 0; m < 4; ++m)
#pragma unroll
                    for (int n = 0; n < 2; ++n) acc[a][b][m][n] = (f32x4){0.f, 0.f, 0.f, 0.f};
        cur = nxt; cA = nA; cB = nB; ++ui;
        if constexpr (ALIGN_EPI) { if (wr == 1) PG8_BAR; }
    }
    PG8_WAIT_V(0);
    if constexpr (!ALIGN_EPI) { if (wr == 0) PG8_BAR; }
    PG8_BAR;
    if constexpr (Epi::AFTER_DRAIN) { E.fused(acc, cur, wr, wc, fr, fq, lds, wid, lane); S.done(cur); }
#undef PG8_SA
#undef PG8_SB
#undef PG8_STAGE
#undef PG8_LDA
#undef PG8_LDB
#undef PG8_MMA
#undef PG8_WAIT_V
#undef PG8_WAIT_L
#undef PG8_BAR
#undef PG8_SCHED
}
}
#define GAS __attribute__((address_space(1)))
#define LAS __attribute__((address_space(3)))
typedef unsigned short bf16;
typedef unsigned v4u __attribute__((ext_vector_type(4)));
typedef float f32x4 __attribute__((ext_vector_type(4)));
typedef short bf16x8 __attribute__((ext_vector_type(8)));
typedef GAS unsigned gu32;
typedef GAS unsigned long long gu64;
#define RLX_AGENT __ATOMIC_RELAXED, __HIP_MEMORY_SCOPE_AGENT
#define LDS_WAIT() asm volatile("s_waitcnt lgkmcnt(0)" ::: "memory")
#define VM_WAIT() asm volatile("s_waitcnt vmcnt(0)" ::: "memory")
__device__ __forceinline__ unsigned long long rt() { return __builtin_amdgcn_s_memrealtime(); }
__device__ __forceinline__ unsigned f2bf(float f) { unsigned u = __builtin_bit_cast(unsigned, f); return (u + 0x7fffu + ((u >> 16) & 1u)) >> 16; }
__device__ __forceinline__ unsigned pk2(float lo, float hi) { return f2bf(lo) | (f2bf(hi) << 16); }

#define XB_TMO      128
#define XB_XCNT(j)  (256  + 64 * (j))
#define XB_XSUB(j)  (1280 + 64 * (j))
#define XB_XGEN(j)  (2304 + 64 * (j))
#define XB_TOP      3328
#define XB_TOPGEN   3392
#define XCD_BAR_WORDS 3456
#define XB_SPIN_CAP (1u << 18)

__device__ __forceinline__ unsigned xb_ld(unsigned* p)              { return __hip_atomic_load(p, __ATOMIC_RELAXED, __HIP_MEMORY_SCOPE_AGENT); }
__device__ __forceinline__ unsigned xb_add(unsigned* p, unsigned v) { return __hip_atomic_fetch_add(p, v, __ATOMIC_RELAXED, __HIP_MEMORY_SCOPE_AGENT); }
__device__ __forceinline__ unsigned xb_xcc_id() { return (unsigned)__builtin_amdgcn_s_getreg((3 << 11) | 20) & 0xFu; }
#define XB_SPIN(cond, bar) do { unsigned _sp = 0; while (cond) { __builtin_amdgcn_s_sleep(1); \
    if ((++_sp & 255u) == 0u) { if (xb_ld(&(bar)[XB_TMO])) break; if (_sp > XB_SPIN_CAP) { atomicAdd(&(bar)[XB_TMO], 1u); break; } } } } while (0)

struct XcdBarrier {
    unsigned* bar; unsigned x;
    volatile LAS unsigned* st;
};

__device__ __forceinline__ XcdBarrier xcd_barrier_post(unsigned* bar, volatile LAS unsigned* st) {
    XcdBarrier b; b.bar = bar; b.x = xb_xcc_id(); b.st = st;
    if (threadIdx.x == 0) (void)xb_add(&bar[XB_XCNT(b.x)], 1u);
    return b;
}
__device__ __forceinline__ void xcd_barrier_complete(unsigned* bar, unsigned x, unsigned& nloc, unsigned& nx) {
    const unsigned G = gridDim.x * gridDim.y * gridDim.z;
    unsigned sum, cnt, mine, sp = 0u;
    for (;;) {
        sum = 0u; cnt = 0u; mine = 0u;
#pragma unroll
        for (unsigned j = 0; j < 16; ++j) { const unsigned c = xb_ld(&bar[XB_XCNT(j)]); sum += c; cnt += (c > 0u) ? 1u : 0u; mine = (j == x) ? c : mine; }
        if (sum == G) break;
        __builtin_amdgcn_s_sleep(1);
        if ((++sp & 255u) == 0u) { if (xb_ld(&bar[XB_TMO])) break; if (sp > XB_SPIN_CAP) { atomicAdd(&bar[XB_TMO], 1u); break; } }
    }
    nloc = mine > 0u ? mine : 1u; nx = cnt > 0u ? cnt : 1u;
}

__device__ __forceinline__ void xcd_barrier(const XcdBarrier& b) {
    asm volatile("s_waitcnt vmcnt(0)" ::: "memory");
    __syncthreads();
    if (threadIdx.x == 0) {
        unsigned* bar = b.bar;
        __builtin_amdgcn_s_waitcnt(0);
        unsigned nloc = b.st[0], nx = b.st[1];
        if (nloc == 0u) { xcd_barrier_complete(bar, b.x, nloc, nx); b.st[0] = nloc; b.st[1] = nx; }
        const unsigned old = xb_add(&bar[XB_XSUB(b.x)], 1u);
        const unsigned gen = old / nloc;
        if (old + 1u == (gen + 1u) * nloc) {
            __builtin_amdgcn_fence(__ATOMIC_RELEASE, "agent");
            asm volatile("s_waitcnt vmcnt(0)" ::: "memory");
            const unsigned og = xb_add(&bar[XB_TOP], 1u);
            const unsigned tg = og / nx;
            if (og + 1u == (tg + 1u) * nx) xb_add(&bar[XB_TOPGEN], 1u);
            else XB_SPIN(xb_ld(&bar[XB_TOPGEN]) == tg, bar);
            __builtin_amdgcn_fence(__ATOMIC_ACQUIRE, "agent");
            xb_add(&bar[XB_XGEN(b.x)], 1u);
            asm volatile("s_waitcnt vmcnt(0)" ::: "memory");
        } else {
            XB_SPIN(xb_ld(&bar[XB_XGEN(b.x)]) == gen, bar);
            __builtin_amdgcn_fence(__ATOMIC_ACQUIRE, "agent");
            asm volatile("s_waitcnt vmcnt(0)" ::: "memory");
        }
    }
    __syncthreads();
}

constexpr int D = 1024, BATCH = 8, SEQ = 2048, DEPTH = 4, NMEM = 256;
constexpr int M = BATCH * SEQ;
constexpr int MM = BATCH * NMEM;
constexpr int ML_H = 4, ML_DK = 128, ML_DV = 256, ML_W = 3080;
constexpr int SB_H = 16, SB_DH = 64;
constexpr int XA_H = 4, XA_DH = 256;
constexpr int DFF = 2816;
constexpr float EPS = 1e-6f;
constexpr int NWAVES = 8;

constexpr size_t MiB = 1u << 20;
constexpr size_t WS_CTL = 0, CTL_ZERO_BYTES = 1 * MiB;
constexpr size_t WS_WG = 1 * MiB;
constexpr size_t WS_GATES = 1 * MiB + 512 * 1024;
constexpr size_t WS_MEMN = 2 * MiB;
constexpr size_t WS_NST = 6 * MiB, WS_SCAL = 6 * MiB + 512 * 1024, WS_MPREV = WS_SCAL + 16 * 1024;
constexpr size_t WS_W = 8 * MiB;
constexpr size_t WL_IN = 0, WL_OUT = WL_IN + (size_t)3072 * 1024, WL_QN = WL_OUT + (size_t)1024 * 1024, WL_OT = WL_QN + (size_t)1024 * 1024,
                 WL_GU = WL_OT + (size_t)1024 * 1024, WL_DN = WL_GU + (size_t)5632 * 1024, WL_SIZE = WL_DN + (size_t)1024 * 2816;
constexpr size_t WS_XWT = WS_W + 4 * WL_SIZE * 2;
static_assert(WS_XWT == 122 * MiB, "weight region size");
constexpr size_t WS_KV = WS_XWT + 32 * MiB;
constexpr size_t WS_XN = WS_KV + 32 * MiB;
constexpr size_t WS_MIX = WS_XN + 32 * MiB;
constexpr size_t WS_BIG = WS_MIX + 32 * MiB;
constexpr size_t WS_END = WS_BIG + 96 * MiB;
constexpr int CW_BAR = 4096;

constexpr int RING_OFF = 0, RING_BYTES = 131072;
constexpr int LDSCTL_OFF = RING_BYTES, MISC_OFF = LDSCTL_OFF + 320;
constexpr int LDS_BYTES = 147456;

__device__ __forceinline__ float wave_sum(float v) {
#pragma unroll
    for (int o = 1; o < 64; o <<= 1) v += __shfl_xor(v, o);
    return v;
}
__device__ __forceinline__ float wave_max(float v) {
#pragma unroll
    for (int o = 1; o < 64; o <<= 1) v = fmaxf(v, __shfl_xor(v, o));
    return v;
}
__device__ __forceinline__ float softplusf(float z) { return fmaxf(z, 0.f) + log1pf(__expf(-fabsf(z))); }
__device__ __forceinline__ float bf2f(unsigned short h) { return __uint_as_float((unsigned)h << 16); }
__device__ __forceinline__ float bflo(unsigned w) { return __uint_as_float(w << 16); }
__device__ __forceinline__ float bfhi(unsigned w) { return __uint_as_float(w & 0xffff0000u); }

struct Frame {
    LAS unsigned char* lds;
    int tid, lane, wave, G, gw, NGW;
    unsigned char* ws;
};
__device__ __forceinline__ const float* inp(const Frame& F, int i) {
    volatile LAS unsigned* t = (volatile LAS unsigned*)(F.lds + LDSCTL_OFF) + 2 * i;
    const unsigned lo = __builtin_amdgcn_readfirstlane(t[0]), hi = __builtin_amdgcn_readfirstlane(t[1]);
    return (const float*)(((unsigned long long)hi << 32) | lo);
}
__device__ __forceinline__ void relane(Frame& F) {
    int t = threadIdx.x; asm volatile("" : "+v"(t));
    F.tid = t; F.lane = t & 63; F.wave = __builtin_amdgcn_readfirstlane(t >> 6);
    int g = gridDim.x, b = blockIdx.x; asm volatile("" : "+s"(g), "+s"(b));
    F.G = g; F.gw = b * NWAVES + F.wave; F.NGW = g * NWAVES;
}

struct EpiStore {
    static constexpr bool PERM = true, AFTER_DRAIN = false;
    bf16* O; int ldc;
    __device__ __forceinline__ void operator()(const f32x4 (&acc)[2][2][4][2], const pg8::Unit& u, int wr, int wc, int fr, int fq) const {
        const int row0 = u.pm * 256 + wr * 64 + fr, col0 = u.pn * 256 + wc * 32 + 8 * fq;
#pragma unroll
        for (int ai = 0; ai < 2; ++ai)
#pragma unroll
            for (int m = 0; m < 4; ++m) { bf16* rowp = O + (size_t)(row0 + ai * 128 + m * 16) * ldc + col0;
#pragma unroll
                for (int bj = 0; bj < 2; ++bj) { const f32x4 v0 = acc[ai][bj][m][0], v1 = acc[ai][bj][m][1];
                    pg8::u32x4 w; w.x = pg8::cvt_pk_bf16(v0[0], v0[1]); w.y = pg8::cvt_pk_bf16(v0[2], v0[3]); w.z = pg8::cvt_pk_bf16(v1[0], v1[1]); w.w = pg8::cvt_pk_bf16(v1[2], v1[3]);
                    *(pg8::u32x4*)(rowp + bj * 128) = w; } }
    }
};
struct EpiSwiglu {
    static constexpr bool PERM = true, AFTER_DRAIN = false;
    bf16* O; int ldc;
    __device__ __forceinline__ void operator()(const f32x4 (&acc)[2][2][4][2], const pg8::Unit& u, int wr, int wc, int fr, int fq) const {
        const int row0 = u.pm * 256 + wr * 64 + fr, col0 = u.pn * 128 + wc * 32 + 8 * fq;
#pragma unroll
        for (int ai = 0; ai < 2; ++ai)
#pragma unroll
            for (int m = 0; m < 4; ++m) { bf16* rowp = O + (size_t)(row0 + ai * 128 + m * 16) * ldc + col0;
                float r[8];
#pragma unroll
                for (int n = 0; n < 2; ++n)
#pragma unroll
                    for (int e = 0; e < 4; ++e) { const float g = acc[ai][0][m][n][e], up = acc[ai][1][m][n][e]; r[n * 4 + e] = g * __builtin_amdgcn_rcpf(1.f + __expf(-g)) * up; }
                pg8::u32x4 w; w.x = pg8::cvt_pk_bf16(r[0], r[1]); w.y = pg8::cvt_pk_bf16(r[2], r[3]); w.z = pg8::cvt_pk_bf16(r[4], r[5]); w.w = pg8::cvt_pk_bf16(r[6], r[7]);
                *(pg8::u32x4*)rowp = w; }
    }
};

struct EpiSoftmax {
    static constexpr bool PERM = true, AFTER_DRAIN = true;
    bf16* O; int ldc;
    __device__ __forceinline__ void fused(f32x4 (&acc)[2][2][4][2], const pg8::Unit& u, int wr, int wc, int fr, int fq, LAS unsigned char* lds, int wid, int lane) const {
        typedef float f32x2v __attribute__((ext_vector_type(2)));
        constexpr float C2 = 0.0625f * 1.4426950408889634f;
        LAS f32x2v* ST = (LAS f32x2v*)lds;
#pragma unroll
        for (int ai = 0; ai < 2; ++ai)
#pragma unroll
            for (int m = 0; m < 4; ++m) {
                float mx = -INFINITY;
#pragma unroll
                for (int bj = 0; bj < 2; ++bj)
#pragma unroll
                    for (int n = 0; n < 2; ++n) { const f32x4 x = acc[ai][bj][m][n]; mx = fmaxf(mx, fmaxf(fmaxf(x[0], x[1]), fmaxf(x[2], x[3]))); }
                mx = fmaxf(mx, __shfl_xor(mx, 16)); mx = fmaxf(mx, __shfl_xor(mx, 32));
                float sum = 0.f;
#pragma unroll
                for (int bj = 0; bj < 2; ++bj)
#pragma unroll
                    for (int n = 0; n < 2; ++n) { f32x4 x = acc[ai][bj][m][n];
#pragma unroll
                        for (int e = 0; e < 4; ++e) { x[e] = __builtin_amdgcn_exp2f((x[e] - mx) * C2); sum += x[e]; }
                        acc[ai][bj][m][n] = x; }
                sum += __shfl_xor(sum, 16); sum += __shfl_xor(sum, 32);
                if (fq == 0) ST[(ai * 128 + wr * 64 + m * 16 + fr) * 4 + wc] = (f32x2v){mx, sum};
            }
        asm volatile("s_waitcnt lgkmcnt(0)" ::: "memory"); __builtin_amdgcn_s_barrier(); asm volatile("" ::: "memory");
        const int row0 = u.pm * 256 + wr * 64 + fr, col0 = u.pn * 256 + wc * 32 + 8 * fq;
#pragma unroll
        for (int ai = 0; ai < 2; ++ai)
#pragma unroll
            for (int m = 0; m < 4; ++m) {
                const LAS f32x2v* sp = ST + (ai * 128 + wr * 64 + m * 16 + fr) * 4;
                const f32x2v s0 = sp[0], s1 = sp[1], s2 = sp[2], s3 = sp[3];
                const float MX = fmaxf(fmaxf(s0.x, s1.x), fmaxf(s2.x, s3.x));
                const float L = s0.y * __builtin_amdgcn_exp2f((s0.x - MX) * C2) + s1.y * __builtin_amdgcn_exp2f((s1.x - MX) * C2) + s2.y * __builtin_amdgcn_exp2f((s2.x - MX) * C2) + s3.y * __builtin_amdgcn_exp2f((s3.x - MX) * C2);
                const float mine = (wc == 0) ? s0.x : (wc == 1) ? s1.x : (wc == 2) ? s2.x : s3.x;
                const float f = __builtin_amdgcn_exp2f((mine - MX) * C2) / L;
                bf16* rowp = O + (size_t)(row0 + ai * 128 + m * 16) * ldc + col0;
#pragma unroll
                for (int bj = 0; bj < 2; ++bj) { const f32x4 v0 = acc[ai][bj][m][0] * f, v1 = acc[ai][bj][m][1] * f;
                    pg8::u32x4 w; w.x = pg8::cvt_pk_bf16(v0[0], v0[1]); w.y = pg8::cvt_pk_bf16(v0[2], v0[3]); w.z = pg8::cvt_pk_bf16(v1[0], v1[1]); w.w = pg8::cvt_pk_bf16(v1[2], v1[3]);
                    *(pg8::u32x4*)(rowp + bj * 128) = w; }
            }
    }
};
struct OneUnit {
    __device__ __forceinline__ bool next(int i, pg8::Unit& u) const { if (i) return false; u.pm = 0; u.pn = 0; u.aoff = 0; u.boff = 0; return true; }
    __device__ __forceinline__ void a_ready(const pg8::Unit&) const {}
    __device__ __forceinline__ void done(const pg8::Unit&) const {}
};

__device__ __forceinline__ void transpose_item(const float* W, int ld, int K, bf16* WT, int k0, int n0, int drow, LAS float* scr, int lane) {
    LAS unsigned short* t16 = (LAS unsigned short*)scr;
    const int kr = lane >> 3, c4 = lane & 7;
    f32x4 v[8];
#pragma unroll
    for (int i = 0; i < 8; ++i) v[i] = *(const GAS f32x4*)(W + (size_t)(k0 + kr + 8 * i) * ld + n0 + 4 * c4);
#pragma unroll
    for (int i = 0; i < 8; ++i)
#pragma unroll
        for (int j = 0; j < 4; ++j) t16[(4 * c4 + j) * 72 + kr + 8 * i] = (unsigned short)f2bf(v[i][j]);
    LDS_WAIT(); asm volatile("" ::: "memory");
#pragma unroll
    for (int q = 0; q < 4; ++q) { const int n = kr + 8 * q; const v4u o = *(const LAS v4u*)(t16 + n * 72 + 8 * c4);
        *(GAS v4u*)(WT + (size_t)(drow + n) * K + k0 + 8 * c4) = o; }
    LDS_WAIT(); asm volatile("" ::: "memory");
}
__device__ __forceinline__ void p0_convert(Frame& F) {
    relane(F);
    LAS float* scr = (LAS float*)(F.lds + RING_OFF + F.wave * 16384);
    bf16* Wb = (bf16*)(F.ws + WS_W); bf16* Wkv = (bf16*)(F.ws + WS_XWT);
    constexpr int I_IN = 16 * 96, I_OUT = 16 * 32, I_Q = 16 * 32, I_O = 16 * 32, I_KV = 16 * 64, I_GU = 16 * 176, I_DN = 44 * 32;
    constexpr int I_LAYER = I_IN + I_OUT + I_Q + I_O + I_KV + I_GU + I_DN;
    for (int it = F.gw; it < 4 * I_LAYER; it += F.NGW) {
        const int l = it / I_LAYER, j = l >> 1; int r = it % I_LAYER;
        bf16* WL = Wb + (size_t)l * WL_SIZE;
        if (r < I_IN) { const int kb = r / 96, nb = r % 96;
            if (l & 1) transpose_item(inp(F, 8) + (size_t)j * D * 3072, 3072, D, WL + WL_IN, kb * 64, nb * 32, nb * 32, scr, F.lane);
            else       transpose_item(inp(F, 4) + (size_t)j * D * ML_W, ML_W, D, WL + WL_IN, kb * 64, nb * 32, nb * 32, scr, F.lane);
            continue; } r -= I_IN;
        if (r < I_OUT) { const int kb = r / 32, nb = r % 32;
            transpose_item(((l & 1) ? inp(F, 9) : inp(F, 7)) + (size_t)j * D * D, D, D, WL + WL_OUT, kb * 64, nb * 32, nb * 32, scr, F.lane); continue; } r -= I_OUT;
        if (r < I_Q) { const int e0 = r * 2048 + F.lane * 8;
#pragma unroll
            for (int q = 0; q < 4; ++q) { const GAS f32x4* sp = (const GAS f32x4*)(inp(F, 10) + (size_t)l * D * D + e0 + q * 512); const f32x4 x0 = sp[0], x1 = sp[1];
                v4u o; o.x = pk2(x0.x, x0.y); o.y = pk2(x0.z, x0.w); o.z = pk2(x1.x, x1.y); o.w = pk2(x1.z, x1.w); *(GAS v4u*)(WL + WL_QN + e0 + q * 512) = o; }
            continue; } r -= I_Q;
        if (r < I_O) { const int kb = r / 32, nb = r % 32; transpose_item(inp(F, 12) + (size_t)l * D * D, D, D, WL + WL_OT, kb * 64, nb * 32, nb * 32, scr, F.lane); continue; } r -= I_O;
        if (r < I_KV) { const int kb = r / 64, nb = r % 64; transpose_item(inp(F, 11) + (size_t)l * D * 2048, 2048, D, Wkv, kb * 64, nb * 32, l * 2048 + nb * 32, scr, F.lane); continue; } r -= I_KV;
        if (r < I_GU) { const int kb = r / 176, nb = r % 176; const int c0 = nb * 32; const int up = c0 >= DFF, jj = up ? c0 - DFF : c0;
            transpose_item(inp(F, 13) + (size_t)l * D * 2 * DFF, 2 * DFF, D, WL + WL_GU, kb * 64, c0, 256 * (jj >> 7) + 128 * up + (jj & 127), scr, F.lane); continue; } r -= I_GU;
        { const int kb = r / 32, nb = r % 32; transpose_item(inp(F, 14) + (size_t)l * DFF * D, D, DFF, WL + WL_DN, kb * 64, nb * 32, nb * 32, scr, F.lane); }
    }
    bf16* MEMN = (bf16*)(F.ws + WS_MEMN);
    for (int m = F.gw; m < MM; m += F.NGW) {
        const GAS f32x4* xr = (const GAS f32x4*)(inp(F, 1) + (size_t)m * D) + F.lane; const GAS f32x4* gr = (const GAS f32x4*)inp(F, 2) + F.lane;
        f32x4 v[4]; float s = 0.f;
#pragma unroll
        for (int q = 0; q < 4; ++q) { v[q] = xr[64 * q]; s += (v[q].x * v[q].x + v[q].y * v[q].y) + (v[q].z * v[q].z + v[q].w * v[q].w); }
        const float rs = rsqrtf(wave_sum(s) * (1.f / D) + EPS);
        GAS unsigned long long* o8 = (GAS unsigned long long*)(MEMN + (size_t)m * D) + F.lane;
#pragma unroll
        for (int q = 0; q < 4; ++q) { const f32x4 g = gr[64 * q]; o8[64 * q] = (unsigned long long)pk2(v[q].x * rs * g.x, v[q].y * rs * g.y) | ((unsigned long long)pk2(v[q].z * rs * g.z, v[q].w * rs * g.w) << 32); }
    }
}

__device__ __forceinline__ void row_phase(Frame& F, const float* xin, float* xout, const bf16* Y, const float* ga, const float* gb, bf16* XN, const float* WG, int wgs, const float* bg, float* GT) {
    relane(F);
    f32x4 v[4]; unsigned long long yw[4];
    int m = F.gw;
    if (m < M) { const GAS f32x4* xr = (const GAS f32x4*)(xin + (size_t)m * D) + F.lane;
#pragma unroll
        for (int q = 0; q < 4; ++q) v[q] = xr[64 * q];
        if (Y) { const GAS unsigned long long* yr = (const GAS unsigned long long*)(Y + (size_t)m * D) + F.lane;
#pragma unroll
            for (int q = 0; q < 4; ++q) yw[q] = yr[64 * q]; } }
    for (; m < M; m += F.NGW) {
        f32x4 vn[4]; unsigned long long ywn[4];
        const int mn = m + F.NGW;
        if (mn < M) { const GAS f32x4* xr = (const GAS f32x4*)(xin + (size_t)mn * D) + F.lane;
#pragma unroll
            for (int q = 0; q < 4; ++q) vn[q] = xr[64 * q];
            if (Y) { const GAS unsigned long long* yr = (const GAS unsigned long long*)(Y + (size_t)mn * D) + F.lane;
#pragma unroll
                for (int q = 0; q < 4; ++q) ywn[q] = yr[64 * q]; } }
        if (Y) {
            f32x4 y[4]; float s = 0.f;
#pragma unroll
            for (int q = 0; q < 4; ++q) { const unsigned lo = (unsigned)yw[q], hi = (unsigned)(yw[q] >> 32);
                y[q] = (f32x4){bflo(lo), bfhi(lo), bflo(hi), bfhi(hi)}; s += (y[q].x * y[q].x + y[q].y * y[q].y) + (y[q].z * y[q].z + y[q].w * y[q].w); }
            const float rs = rsqrtf(wave_sum(s) * (1.f / D) + EPS);
            const GAS f32x4* gr = (const GAS f32x4*)ga + F.lane;
#pragma unroll
            for (int q = 0; q < 4; ++q) { const f32x4 g = gr[64 * q]; v[q] = v[q] + y[q] * rs * g; }
        }
        if (Y || xin != xout) { GAS f32x4* xo = (GAS f32x4*)(xout + (size_t)m * D) + F.lane;
#pragma unroll
            for (int q = 0; q < 4; ++q) xo[64 * q] = v[q]; }
        if (gb) {
            float s = 0.f;
#pragma unroll
            for (int q = 0; q < 4; ++q) s += (v[q].x * v[q].x + v[q].y * v[q].y) + (v[q].z * v[q].z + v[q].w * v[q].w);
            const float rs = rsqrtf(wave_sum(s) * (1.f / D) + EPS);
            const GAS f32x4* gr = (const GAS f32x4*)gb + F.lane;
            GAS unsigned long long* o8 = (GAS unsigned long long*)(XN + (size_t)m * D) + F.lane;
#pragma unroll
            for (int q = 0; q < 4; ++q) { const f32x4 g = gr[64 * q]; v[q] = v[q] * rs * g; o8[64 * q] = (unsigned long long)pk2(v[q].x, v[q].y) | ((unsigned long long)pk2(v[q].z, v[q].w) << 32); }
            if (WG) {
                float acc[8];
#pragma unroll
                for (int c = 0; c < 8; ++c) acc[c] = 0.f;
#pragma unroll
                for (int q = 0; q < 4; ++q)
#pragma unroll
                    for (int e = 0; e < 4; ++e) { const GAS f32x4* w = (const GAS f32x4*)(WG + (size_t)(4 * F.lane + 256 * q + e) * wgs); const f32x4 w0 = w[0], w1 = w[1]; const float h = v[q][e];
                        acc[0] += h * w0.x; acc[1] += h * w0.y; acc[2] += h * w0.z; acc[3] += h * w0.w; acc[4] += h * w1.x; acc[5] += h * w1.y; acc[6] += h * w1.z; acc[7] += h * w1.w; }
#pragma unroll
                for (int c = 0; c < 8; ++c) acc[c] = wave_sum(acc[c]);
                if (F.lane < 8) {
                    float a = 0.f;
#pragma unroll
                    for (int c = 0; c < 8; ++c) a = (F.lane == c) ? acc[c] : a;
                    a = 15.f * tanhf((a + bg[F.lane]) * (1.f / 15.f));
                    if (F.lane >= 4) a = -softplusf(-a);
                    GT[(size_t)m * 8 + F.lane] = a;
                }
            }
        }
#pragma unroll
        for (int q = 0; q < 4; ++q) { v[q] = vn[q]; yw[q] = ywn[q]; }
    }
}

namespace sbk {
typedef float f32x16 __attribute__((ext_vector_type(16)));
typedef short s16x4 __attribute__((ext_vector_type(4)));
typedef short v4i16_t __attribute__((ext_vector_type(4)));
__device__ __forceinline__ unsigned cvtpk(float lo, float hi) { typedef float f32x2_t __attribute__((ext_vector_type(2))); typedef __bf16 bf16x2_t __attribute__((ext_vector_type(2)));
    f32x2_t v = {lo, hi}; bf16x2_t b = __builtin_convertvector(v, bf16x2_t); return __builtin_bit_cast(unsigned, b); }
#define SB_MFMA(a, b, c) __builtin_amdgcn_mfma_f32_32x32x16_bf16((a), (b), (c), 0, 0, 0)
constexpr int KB0 = 0, VB0 = 16384;
constexpr float C2 = 0.125f * 1.4426950408889634f;

template <bool MASK>
__device__ __forceinline__ void tile(LAS unsigned char* kb, LAS unsigned char* vb, const bf16x8 (&qr)[4], f32x16 (&o)[2], float& carry, int nv, int lane, int r, int hh, const bf16x8 (&TRI)[2], const bf16x8 ONES) {
    f32x16 e[2];
    {   f32x16 p0, p1;
#pragma unroll
        for (int i = 0; i < 16; ++i) { p0[i] = 0.f; p1[i] = 0.f; }
#pragma unroll
        for (int ks = 0; ks < 4; ++ks) {
            const bf16x8 k0 = *(const LAS bf16x8*)(kb + r * 128 + (((2 * ks + hh) ^ (r & 7)) << 4));
            const bf16x8 k1 = *(const LAS bf16x8*)(kb + (r + 32) * 128 + (((2 * ks + hh) ^ (r & 7)) << 4));
            p0 = SB_MFMA(k0, qr[ks], p0); p1 = SB_MFMA(k1, qr[ks], p1);
        }
        e[0] = p0; e[1] = p1;
    }
    v4u Lhi[2][2], Llo[2][2];
    float sv = 0.f;
#pragma unroll
    for (int ib = 0; ib < 2; ++ib)
#pragma unroll
        for (int i = 0; i < 16; i += 2) {
            float L[2];
#pragma unroll
            for (int u = 0; u < 2; ++u) {
                const float w = e[ib][i + u] * C2;
                const float sp = fmaxf(w, 0.f) + __builtin_amdgcn_logf(1.f + __builtin_amdgcn_exp2f(-fabsf(w)));
                float Lm = -sp;
                if (MASK) { const int ci = ((i + u) & 3) + 8 * ((i + u) >> 2) + 32 * ib; Lm = (ci < nv) ? Lm : 0.f; }
                const float E = w - sp;
                if (ib == 0 && i + u == 0) sv = E - Lm;
                e[ib][i + u] = E + carry;
                L[u] = Lm;
            }
            const unsigned hw = cvtpk(L[0], L[1]);
            const unsigned lw = cvtpk(L[0] - bflo(hw), L[1] - bfhi(hw));
            const int ks2 = i >> 3, m = (i & 7) >> 1;
            Lhi[ib][ks2][m] = hw; Llo[ib][ks2][m] = lw;
        }
#define SB_F(x) __builtin_bit_cast(bf16x8, x)
    e[0] = SB_MFMA(TRI[0], SB_F(Lhi[0][0]), e[0]); e[0] = SB_MFMA(TRI[1], SB_F(Lhi[0][1]), e[0]);
    e[1] = SB_MFMA(TRI[0], SB_F(Lhi[1][0]), e[1]); e[1] = SB_MFMA(TRI[1], SB_F(Lhi[1][1]), e[1]);
    e[0] = SB_MFMA(ONES, SB_F(Lhi[1][0]), e[0]); e[0] = SB_MFMA(ONES, SB_F(Lhi[1][1]), e[0]);
    e[0] = SB_MFMA(TRI[0], SB_F(Llo[0][0]), e[0]); e[0] = SB_MFMA(TRI[1], SB_F(Llo[0][1]), e[0]);
    e[1] = SB_MFMA(TRI[0], SB_F(Llo[1][0]), e[1]); e[1] = SB_MFMA(TRI[1], SB_F(Llo[1][1]), e[1]);
    e[0] = SB_MFMA(ONES, SB_F(Llo[1][0]), e[0]); e[0] = SB_MFMA(ONES, SB_F(Llo[1][1]), e[0]);
    carry = __shfl(e[0][0] - sv, r);
    v4u pa[2][2];
#pragma unroll
    for (int ib = 0; ib < 2; ++ib)
#pragma unroll
        for (int i = 0; i < 16; i += 2) {
            float a[2];
#pragma unroll
            for (int u = 0; u < 2; ++u) {
                a[u] = __builtin_amdgcn_exp2f(e[ib][i + u]);
                if (MASK) { const int ci = ((i + u) & 3) + 8 * ((i + u) >> 2) + 32 * ib; a[u] = (ci < nv) ? a[u] : 0.f; }
            }
            pa[ib][i >> 3][(i & 7) >> 1] = cvtpk(a[0], a[1]);
        }
    const int q4 = (lane & 15) >> 2, p4 = lane & 3, g1 = (lane >> 4) & 1;
    LAS unsigned char* vl = vb + (4 * hh + q4) * 128 + (16 * g1 + 4 * p4) * 2;
#pragma unroll
    for (int ib = 0; ib < 2; ++ib)
#pragma unroll
        for (int ks2 = 0; ks2 < 2; ++ks2)
#pragma unroll
            for (int db = 0; db < 2; ++db) {
                LAS unsigned char* pv = vl + (32 * ib + 16 * ks2) * 128 + db * 64;
                const s16x4 lo = __builtin_bit_cast(s16x4, __builtin_amdgcn_ds_read_tr16_b64_v4i16((LAS v4i16_t*)pv));
                const s16x4 hi = __builtin_bit_cast(s16x4, __builtin_amdgcn_ds_read_tr16_b64_v4i16((LAS v4i16_t*)(pv + 8 * 128)));
                const bf16x8 vf = __builtin_shufflevector(lo, hi, 0, 1, 2, 3, 4, 5, 6, 7);
                o[db] = SB_MFMA(SB_F(pa[ib][ks2]), vf, o[db]);
            }
#undef SB_F
}

__device__ __forceinline__ void unit(int b, int h, int qb, const bf16* QKV, bf16* MIX, LAS unsigned char* lds, int tid) {
    const int lane = tid & 63, r = lane & 31, hh = lane >> 5, wid = __builtin_amdgcn_readfirstlane(tid >> 6);
    const size_t rowbase = (size_t)b * SEQ; const int q0 = qb * 256, trow = q0 + 32 * wid + r;
    bf16x8 qr[4];
#pragma unroll
    for (int ks = 0; ks < 4; ++ks) qr[ks] = *(const GAS bf16x8*)(QKV + (rowbase + trow) * 3072 + h * 64 + ks * 16 + hh * 8);
    bf16x8 TRI[2], ONES;
#pragma unroll
    for (int ks2 = 0; ks2 < 2; ++ks2)
#pragma unroll
        for (int j = 0; j < 8; ++j) TRI[ks2][j] = ((16 * ks2 + 8 * (j >> 2) + 4 * hh + (j & 3)) > r) ? (short)0x3F80 : (short)0;
#pragma unroll
    for (int j = 0; j < 8; ++j) ONES[j] = (short)0x3F80;
    const int srow = tid >> 3, sc = tid & 7;
    const bf16* kg = QKV + rowbase * 3072 + 1024 + h * 64 + (size_t)srow * 3072 + sc * 8;
    const int kdst = srow * 128 + ((sc ^ (srow & 7)) << 4), vdst = srow * 128 + sc * 16;
    const int NT = 4 * qb + 4;
    { const bf16* p = kg + (size_t)(NT - 1) * 64 * 3072; const v4u kx = *(const GAS v4u*)p, vx = *(const GAS v4u*)(p + 1024);
      *(LAS v4u*)(lds + KB0 + kdst) = kx; *(LAS v4u*)(lds + VB0 + vdst) = vx; }
    __syncthreads();
    f32x16 o[2];
#pragma unroll
    for (int i = 0; i < 16; ++i) { o[0][i] = 0.f; o[1][i] = 0.f; }
    float carry = 0.f;
    const int wmax = q0 + 32 * wid + 31, wmin = q0 + 32 * wid;
    for (int kt = NT - 1; kt >= 0; --kt) {
        const int cur = (NT - 1 - kt) & 1;
        v4u kx, vx;
        if (kt > 0) { const bf16* p = kg + (size_t)(kt - 1) * 64 * 3072; kx = *(const GAS v4u*)p; vx = *(const GAS v4u*)(p + 1024); }
        if (64 * kt < wmax) {
            const int nv = trow - 64 * kt - 4 * hh;
            if (64 * kt + 63 >= wmin) tile<true>(lds + KB0 + cur * 8192, lds + VB0 + cur * 8192, qr, o, carry, nv, lane, r, hh, TRI, ONES);
            else tile<false>(lds + KB0 + cur * 8192, lds + VB0 + cur * 8192, qr, o, carry, nv, lane, r, hh, TRI, ONES);
        }
        if (kt > 0) { *(LAS v4u*)(lds + KB0 + (cur ^ 1) * 8192 + kdst) = kx; *(LAS v4u*)(lds + VB0 + (cur ^ 1) * 8192 + vdst) = vx; }
        __syncthreads();
    }
    unsigned short* op = (unsigned short*)MIX + (rowbase + q0 + 32 * wid) * D + h * 64 + r;
#pragma unroll
    for (int db = 0; db < 2; ++db)
#pragma unroll
        for (int i = 0; i < 16; ++i) { const int row = (i & 3) + 8 * (i >> 2) + 4 * hh; ((GAS unsigned short*)op)[(size_t)row * D + 32 * db] = (unsigned short)f2bf(o[db][i]); }
}
#undef SB_MFMA
}
__device__ __forceinline__ void sb_attn_v2(Frame& F, const bf16* QKV, bf16* MIX) {
    relane(F);
    for (int v = blockIdx.x; v < 256; v += F.G) {
        const int bh = v >> 1, sel = v & 1;
#pragma unroll 1
        for (int u = 0; u < 4; ++u) {
            const int qb = sel ? ((u == 0) ? 6 : (u == 1) ? 1 : (u == 2) ? 4 : 3) : ((u == 0) ? 7 : (u == 1) ? 0 : (u == 2) ? 5 : 2);
            sbk::unit(bh >> 4, bh & 15, qb, QKV, MIX, F.lds + RING_OFF, F.tid);
        }
    }
}

namespace mlk {
typedef float f32x16 __attribute__((ext_vector_type(16)));
typedef short s16x4 __attribute__((ext_vector_type(4)));
typedef short v4i16_t __attribute__((ext_vector_type(4)));
#define ML_MFMA(a, b, c) __builtin_amdgcn_mfma_f32_32x32x16_bf16((a), (b), (c), 0, 0, 0)
__device__ __forceinline__ bf16x8 trpair(LAS unsigned char* p, int rowbytes4) {
    const s16x4 lo = __builtin_bit_cast(s16x4, __builtin_amdgcn_ds_read_tr16_b64_v4i16((LAS v4i16_t*)p));
    const s16x4 hi = __builtin_bit_cast(s16x4, __builtin_amdgcn_ds_read_tr16_b64_v4i16((LAS v4i16_t*)(p + rowbytes4)));
    return __builtin_shufflevector(lo, hi, 0, 1, 2, 3, 4, 5, 6, 7);
}
__device__ __forceinline__ float scan_add(float v, int lane) {
#pragma unroll
    for (int o = 1; o < 64; o <<= 1) { const float y = __shfl_up(v, o); if (lane >= o) v += y; }
    return v;
}
__device__ __forceinline__ float scan_max(float v, int lane) {
#pragma unroll
    for (int o = 1; o < 64; o <<= 1) { const float y = __shfl_up(v, o); if (lane >= o) v = fmaxf(v, y); }
    return v;
}
__device__ __forceinline__ void scale8(const v4u in, float w, v4u& out) {
    out.x = pk2(bflo(in.x) * w, bfhi(in.x) * w); out.y = pk2(bflo(in.y) * w, bfhi(in.y) * w); out.z = pk2(bflo(in.z) * w, bfhi(in.z) * w); out.w = pk2(bflo(in.w) * w, bfhi(in.w) * w);
}
constexpr float KSC = 0.08838834764831845f;

__device__ __forceinline__ void phaseA(Frame& F, const bf16* PROJ, const float* GT, bf16* ST, float* NST, float* SCAL) {
    relane(F);
    const int tid = F.tid, lane = F.lane, wv = F.wave, r = lane & 31, hh = lane >> 5, q4 = (lane & 15) >> 2, p4 = lane & 3, g1 = (lane >> 4) & 1;
    LAS unsigned char* KW = F.lds + RING_OFF; LAS unsigned char* VT = KW + 16384; LAS float* wk = (LAS float*)(KW + 49152);
    bf16x8 ONES;
#pragma unroll
    for (int j = 0; j < 8; ++j) ONES[j] = (short)0x3F80;
    for (int unit = blockIdx.x; unit < 1024; unit += F.G) {
        const int bh = unit >> 5, c = unit & 31, b = bh >> 2, h = bh & 3; const size_t row0 = (size_t)b * SEQ + c * 64;
        if (wv == 0) {
            const float lf = GT[(row0 + lane) * 8 + 4 + h], ig = GT[(row0 + lane) * 8 + h];
            const float bc = scan_add(lf, lane), bl = __shfl(bc, 63), g = bl - bc + ig, ml = wave_max(g);
            wk[lane] = __expf(g - ml) * KSC;
            if (lane == 0) { SCAL[unit * 2] = bl; SCAL[unit * 2 + 1] = ml; }
        }
        __syncthreads();
        { const int row = tid >> 3, c8 = tid & 7; const bf16* kp = PROJ + (row0 + row) * 3072 + 512 + h * 128 + c8 * 16;
          const v4u k0 = *(const GAS v4u*)kp, k1 = *(const GAS v4u*)(kp + 8); const bf16* vp = kp + 512 + h * 128 + c8 * 16;
          const v4u v0 = *(const GAS v4u*)vp, v1 = *(const GAS v4u*)(vp + 8), v2 = *(const GAS v4u*)(vp + 16), v3 = *(const GAS v4u*)(vp + 24);
          const float w = wk[row]; v4u o0, o1; scale8(k0, w, o0); scale8(k1, w, o1);
          *(LAS v4u*)(KW + row * 256 + c8 * 32) = o0; *(LAS v4u*)(KW + row * 256 + c8 * 32 + 16) = o1;
          LAS v4u* vd = (LAS v4u*)(VT + row * 512 + c8 * 64); vd[0] = v0; vd[1] = v1; vd[2] = v2; vd[3] = v3; }
        __syncthreads();
        f32x16 acc[4], nacc[4];
#pragma unroll
        for (int cb = 0; cb < 4; ++cb)
#pragma unroll
            for (int i = 0; i < 16; ++i) { acc[cb][i] = 0.f; nacc[cb][i] = 0.f; }
#pragma unroll
        for (int ks = 0; ks < 4; ++ks) {
            const bf16x8 af = trpair(VT + (16 * ks + 8 * hh + q4) * 512 + (32 * wv + 16 * g1 + 4 * p4) * 2, 4 * 512);
#pragma unroll
            for (int cb = 0; cb < 4; ++cb) {
                const bf16x8 bfr = trpair(KW + (16 * ks + 8 * hh + q4) * 256 + (32 * cb + 16 * g1 + 4 * p4) * 2, 4 * 256);
                acc[cb] = ML_MFMA(af, bfr, acc[cb]);
                if (wv == 0) nacc[cb] = ML_MFMA(ONES, bfr, nacc[cb]);
            }
        }
        GAS unsigned short* sp = (GAS unsigned short*)ST + (size_t)unit * 32768 + (size_t)(32 * wv) * 128 + r;
#pragma unroll
        for (int cb = 0; cb < 4; ++cb)
#pragma unroll
            for (int i = 0; i < 16; ++i) sp[((i & 3) + 8 * (i >> 2) + 4 * hh) * 128 + 32 * cb] = (unsigned short)f2bf(acc[cb][i]);
        if (wv == 0 && hh == 0) {
#pragma unroll
            for (int cb = 0; cb < 4; ++cb) NST[(size_t)unit * 128 + 32 * cb + r] = nacc[cb][0];
        }
        __syncthreads();
    }
}
__device__ __forceinline__ void phaseB(Frame& F, bf16* ST, float* NST, const float* SCAL, float* MPREV) {
    relane(F);
    for (int task = blockIdx.x * 512 + F.tid; task < 32 * 4096; task += F.G * 512) {
        const int bh = task >> 12, e0 = (task & 4095) * 8;
        float C[8], m = 0.f;
#pragma unroll
        for (int i = 0; i < 8; ++i) C[i] = 0.f;
        GAS v4u* p = (GAS v4u*)(ST + (size_t)bh * 32 * 32768 + e0);
        const float* sc = SCAL + (size_t)bh * 64;
#pragma unroll 4
        for (int c = 0; c < 32; ++c) {
            const v4u d = p[(size_t)c * 4096];
            const float bl = sc[2 * c], ml = sc[2 * c + 1], mn = fmaxf(bl + m, ml), dec = __expf(bl + m - mn), s = __expf(ml - mn);
            v4u o; o.x = pk2(C[0], C[1]); o.y = pk2(C[2], C[3]); o.z = pk2(C[4], C[5]); o.w = pk2(C[6], C[7]);
            p[(size_t)c * 4096] = o;
            if ((task & 4095) == 0) MPREV[bh * 32 + c] = m;
            C[0] = dec * C[0] + s * bflo(d.x); C[1] = dec * C[1] + s * bfhi(d.x); C[2] = dec * C[2] + s * bflo(d.y); C[3] = dec * C[3] + s * bfhi(d.y);
            C[4] = dec * C[4] + s * bflo(d.z); C[5] = dec * C[5] + s * bfhi(d.z); C[6] = dec * C[6] + s * bflo(d.w); C[7] = dec * C[7] + s * bfhi(d.w);
            m = mn;
        }
    }
    for (int task = blockIdx.x * 512 + F.tid; task < 32 * 128; task += F.G * 512) {
        const int bh = task >> 7, e = task & 127;
        float n = 0.f, m = 0.f; float* p = NST + (size_t)bh * 32 * 128 + e; const float* sc = SCAL + (size_t)bh * 64;
        for (int c = 0; c < 32; ++c) {
            const float d = p[c * 128], bl = sc[2 * c], ml = sc[2 * c + 1], mn = fmaxf(bl + m, ml);
            p[c * 128] = n; n = __expf(bl + m - mn) * n + __expf(ml - mn) * d; m = mn;
        }
    }
}
__device__ __forceinline__ void phaseC(Frame& F, bf16* PROJ, const float* GT, const bf16* ST, const float* NST, const float* MPREV, const float* hgain) {
    relane(F);
    const int tid = F.tid, lane = F.lane, wv = F.wave, r = lane & 31, hh = lane >> 5, q4 = (lane & 15) >> 2, p4 = lane & 3, g1 = (lane >> 4) & 1;
    LAS unsigned char* KT = F.lds + RING_OFF; LAS unsigned char* QT = KT + 16384; LAS unsigned char* VT = KT + 32768; LAS unsigned char* SD = KT + 65536;
    LAS float* sm = (LAS float*)(KT + 73728);
    LAS float* aa = sm; LAS float* ct2 = sm + 64; LAS float* inter = sm + 128; LAS float* emt = sm + 192; LAS float* nq = sm + 256; LAS float* npv = sm + 320; LAS float* densum = sm + 448; LAS float* ssq = sm + 576;
    LAS unsigned char* HT = KT;
    for (int unit = blockIdx.x; unit < 1024; unit += F.G) {
        const int bh = unit >> 5, c = unit & 31, b = bh >> 2, h = bh & 3; const size_t row0 = (size_t)b * SEQ + c * 64;
        { const int row = tid >> 3, c8 = tid & 7; const bf16* qp = PROJ + (row0 + row) * 3072 + h * 128 + c8 * 16;
          const v4u q0 = *(const GAS v4u*)qp, q1 = *(const GAS v4u*)(qp + 8), k0 = *(const GAS v4u*)(qp + 512), k1 = *(const GAS v4u*)(qp + 520);
          const bf16* vp = PROJ + (row0 + row) * 3072 + 1024 + h * 256 + c8 * 32;
          const v4u v0 = *(const GAS v4u*)vp, v1 = *(const GAS v4u*)(vp + 8), v2 = *(const GAS v4u*)(vp + 16), v3 = *(const GAS v4u*)(vp + 24);
          const int sw0 = ((2 * c8) ^ (row & 15)) << 4, sw1 = ((2 * c8 + 1) ^ (row & 15)) << 4;
          *(LAS v4u*)(QT + row * 256 + sw0) = q0; *(LAS v4u*)(QT + row * 256 + sw1) = q1; *(LAS v4u*)(KT + row * 256 + sw0) = k0; *(LAS v4u*)(KT + row * 256 + sw1) = k1;
          LAS v4u* vd = (LAS v4u*)(VT + row * 512 + c8 * 64); vd[0] = v0; vd[1] = v1; vd[2] = v2; vd[3] = v3; }
        const float mprev = MPREV[unit];
        if (wv == 0) {
            const float lf = GT[(row0 + lane) * 8 + 4 + h], ig = GT[(row0 + lane) * 8 + h];
            const float bc = scan_add(lf, lane), a = ig - bc, pm = scan_max(a, lane), ctv = -fmaxf(pm, mprev);
            aa[lane] = a; ct2[lane] = ctv - 2.4260151319598084f  ; inter[lane] = __expf(mprev + ctv); emt[lane] = __expf(ctv - bc);
        } else if (wv == 1) { npv[lane] = NST[(size_t)unit * 128 + lane]; npv[lane + 64] = NST[(size_t)unit * 128 + 64 + lane]; }
        bf16x8 cf[8];
        { const bf16* cp = ST + (size_t)unit * 32768 + (size_t)(32 * wv + r) * 128 + 8 * hh;
#pragma unroll
          for (int ks = 0; ks < 8; ++ks) cf[ks] = *(const GAS bf16x8*)(cp + 16 * ks); }
        __syncthreads();
        if (wv < 4) {
            const int sb = wv & 1, tb = wv >> 1, srow = 32 * sb + r, trow = 32 * tb + r;
            f32x16 s;
#pragma unroll
            for (int i = 0; i < 16; ++i) s[i] = 0.f;
#pragma unroll
            for (int ks = 0; ks < 8; ++ks) {
                const bf16x8 kf = *(const LAS bf16x8*)(KT + srow * 256 + (((2 * ks + hh) ^ (srow & 15)) << 4));
                const bf16x8 qf = *(const LAS bf16x8*)(QT + trow * 256 + (((2 * ks + hh) ^ (trow & 15)) << 4));
                s = ML_MFMA(kf, qf, s);
            }
            const float ctl = ct2[trow]; float dsum = 0.f;
#pragma unroll
            for (int g = 0; g < 4; ++g) {
                float v[4];
#pragma unroll
                for (int u = 0; u < 4; ++u) { const int sidx = 32 * sb + 8 * g + 4 * hh + u; const float d = __expf(aa[sidx] + ctl); v[u] = (sidx <= trow) ? s[4 * g + u] * d : 0.f; dsum += v[u]; }
                const unsigned long long w = (unsigned long long)pk2(v[0], v[1]) | ((unsigned long long)pk2(v[2], v[3]) << 32);
                *(LAS unsigned long long*)(SD + trow * 128 + (((4 * sb + g) ^ (trow & 7)) << 4) + hh * 8) = w;
            }
            dsum += __shfl_xor(dsum, 32);
            if (hh == 0) densum[sb * 64 + trow] = dsum;
        } else if (wv == 4) {
            float a = 0.f;
#pragma unroll
            for (int ch = 0; ch < 16; ++ch) { const v4u qw = *(const LAS v4u*)(QT + lane * 256 + ((ch ^ (lane & 15)) << 4)); const LAS float* np = npv + 8 * ch;
                a += np[0] * bflo(qw.x) + np[1] * bfhi(qw.x) + np[2] * bflo(qw.y) + np[3] * bfhi(qw.y) + np[4] * bflo(qw.z) + np[5] * bfhi(qw.z) + np[6] * bflo(qw.w) + np[7] * bfhi(qw.w); }
            nq[lane] = a;
        }
        __syncthreads();
        f32x16 hv[2];
        {   f32x16 accA[2], accB[2];
#pragma unroll
            for (int tb = 0; tb < 2; ++tb)
#pragma unroll
                for (int i = 0; i < 16; ++i) { accA[tb][i] = 0.f; accB[tb][i] = 0.f; }
#pragma unroll
            for (int ks = 0; ks < 4; ++ks) {
                const bf16x8 af = trpair(VT + (16 * ks + 8 * hh + q4) * 512 + (32 * wv + 16 * g1 + 4 * p4) * 2, 4 * 512);
#pragma unroll
                for (int tb = 0; tb < 2; ++tb) { const int trow = 32 * tb + r;
                    const bf16x8 sf = *(const LAS bf16x8*)(SD + trow * 128 + (((2 * ks + hh) ^ (trow & 7)) << 4));
                    accA[tb] = ML_MFMA(af, sf, accA[tb]); }
            }
#pragma unroll
            for (int ks = 0; ks < 8; ++ks)
#pragma unroll
                for (int tb = 0; tb < 2; ++tb) { const int trow = 32 * tb + r;
                    const bf16x8 qf = *(const LAS bf16x8*)(QT + trow * 256 + (((2 * ks + hh) ^ (trow & 15)) << 4));
                    accB[tb] = ML_MFMA(cf[ks], qf, accB[tb]); }
#pragma unroll
            for (int tb = 0; tb < 2; ++tb) { const int trow = 32 * tb + r;
                const float it = inter[trow], den = densum[trow] + densum[64 + trow] + it * nq[trow], rinv = 1.f / fmaxf(fabsf(den), emt[trow]);
                float q = 0.f;
#pragma unroll
                for (int i = 0; i < 16; ++i) { const float x = (accA[tb][i] + it * accB[tb][i]) * rinv; hv[tb][i] = x; q += x * x; }
                q += __shfl_xor(q, 32);
                if (hh == 0) ssq[wv * 64 + trow] = q; }
        }
        __syncthreads();
#pragma unroll
        for (int tb = 0; tb < 2; ++tb)
#pragma unroll
            for (int g = 0; g < 4; ++g) *(LAS f32x4*)(HT + (32 * tb + r) * 1040 + (32 * wv + 8 * g + 4 * hh) * 4) = (f32x4){hv[tb][4 * g], hv[tb][4 * g + 1], hv[tb][4 * g + 2], hv[tb][4 * g + 3]};
        __syncthreads();
        { const int t = tid >> 3, c8 = tid & 7; float sq = 0.f;
#pragma unroll
          for (int w = 0; w < 8; ++w) sq += ssq[w * 64 + t];
          const float rs = rsqrtf(sq * (1.f / 256.f) + EPS);
          bf16* orow = PROJ + (row0 + t) * 3072 + 1024 + h * 256 + c8 * 32;
#pragma unroll
          for (int q = 0; q < 4; ++q) {
              const f32x4 h0 = *(const LAS f32x4*)(HT + t * 1040 + (32 * c8 + 8 * q) * 4), h1 = *(const LAS f32x4*)(HT + t * 1040 + (32 * c8 + 8 * q + 4) * 4);
              const v4u og = *(const GAS v4u*)(orow + 1024 + 8 * q);
              const f32x4 g0 = *(const GAS f32x4*)(hgain + h * 256 + c8 * 32 + 8 * q), g1v = *(const GAS f32x4*)(hgain + h * 256 + c8 * 32 + 8 * q + 4);
              float y[8];
              y[0] = h0[0] * rs * g0[0] / (1.f + __expf(-bflo(og.x))); y[1] = h0[1] * rs * g0[1] / (1.f + __expf(-bfhi(og.x)));
              y[2] = h0[2] * rs * g0[2] / (1.f + __expf(-bflo(og.y))); y[3] = h0[3] * rs * g0[3] / (1.f + __expf(-bfhi(og.y)));
              y[4] = h1[0] * rs * g1v[0] / (1.f + __expf(-bflo(og.z))); y[5] = h1[1] * rs * g1v[1] / (1.f + __expf(-bfhi(og.z)));
              y[6] = h1[2] * rs * g1v[2] / (1.f + __expf(-bflo(og.w))); y[7] = h1[3] * rs * g1v[3] / (1.f + __expf(-bfhi(og.w)));
              v4u o; o.x = pk2(y[0], y[1]); o.y = pk2(y[2], y[3]); o.z = pk2(y[4], y[5]); o.w = pk2(y[6], y[7]);
              *(GAS v4u*)(orow + 8 * q) = o; } }
        __syncthreads();
    }
}
#undef ML_MFMA
}

template <int MR, int N, int K, bool ALIGN, class Epi> __device__ __forceinline__ void run_gemm(Frame& F, const bf16* A, int lda, const bf16* Bt, int ldb, int pmb, size_t b_batch, const Epi E) {
    int gd = gridDim.x, bi = blockIdx.x; asm volatile("" : "+s"(gd), "+s"(bi));
    pg8::Gemm g{A, Bt, MR, N, K, lda, ldb}; pg8::StaticOrder S; S.init(MR, N, gd, bi, lda, ldb, pmb, b_batch);
    pg8::gemm_phase<Epi, pg8::StaticOrder, ALIGN, true>(F.lds + RING_OFF, g, S, E);
}
__device__ __forceinline__ void xw_gemms(Frame& F, const bf16* KVl, const bf16* WQN, const bf16* WOT, bf16* XWTp) {
    int gd = gridDim.x, bi = blockIdx.x; asm volatile("" : "+s"(gd), "+s"(bi));
    for (int L = bi; L < 256; L += gd) {
        const int idx = L & 127, b = idx >> 4, h = (idx >> 2) & 3, t = idx & 3;
        OneUnit S; int kk = 256; asm volatile("" : "+s"(kk));
        if (L < 128) {
            pg8::Gemm g{KVl + (size_t)(b * NMEM) * 8192 + h * 256, WQN + (size_t)(t * 256) * D + h * 256, 256, 256, kk, 8192, D};
            EpiStore E{XWTp + (size_t)b * D * D + (size_t)(h * 256) * D + t * 256, D};
            pg8::gemm_phase<EpiStore, OneUnit, true, true>(F.lds + RING_OFF, g, S, E);
        } else {
            pg8::Gemm g{WOT + (size_t)(t * 256) * D + h * 256, KVl + (size_t)(b * NMEM) * 8192 + 1024 + h * 256, 256, 256, kk, D, 8192};
            EpiStore E{XWTp + (size_t)(8 + b) * D * D + (size_t)(t * 256) * D + h * 256, D};
            pg8::gemm_phase<EpiStore, OneUnit, true, true>(F.lds + RING_OFF, g, S, E);
        }
    }
}
struct Args { const float* in[15]; float* out; unsigned char* ws; int pad[2]; };
__global__ void __launch_bounds__(NWAVES * 64, 2) mega_fwd(Args args) {
    extern __shared__ __attribute__((aligned(16))) unsigned char lds[];
    Frame F;
    F.lds = (LAS unsigned char*)lds; F.ws = args.ws;
    relane(F);
    for (int u = F.tid; u < (LDS_BYTES - LDSCTL_OFF) / 4; u += NWAVES * 64) ((LAS unsigned*)(F.lds + LDSCTL_OFF))[u] = 0u;
    __syncthreads();
    if (F.tid < 16) { const unsigned long long p = (F.tid < 15) ? (unsigned long long)args.in[F.tid < 15 ? F.tid : 0] : (unsigned long long)args.out;
        ((LAS unsigned*)(F.lds + LDSCTL_OFF))[2 * F.tid] = (unsigned)p; ((LAS unsigned*)(F.lds + LDSCTL_OFF))[2 * F.tid + 1] = (unsigned)(p >> 32); }
    __syncthreads();
    gu32* ctl = (gu32*)(F.ws + WS_CTL);
    XcdBarrier bar = xcd_barrier_post((unsigned*)(ctl + CW_BAR), (volatile LAS unsigned*)(F.lds + MISC_OFF) + 8);
#define GRID_BAR() xcd_barrier(bar)
#ifndef PROBE_CAT
#define PROBE_CAT 0
#endif
#define TPROBE ((volatile LAS unsigned long long*)(F.lds + MISC_OFF + 64))
#define GBAR(cat) do { xcd_barrier(bar); if (PROBE_CAT != 0 && blockIdx.x == 0 && threadIdx.x == 0) { const unsigned long long now_ = rt(); if ((cat) == PROBE_CAT) TPROBE[1] += now_ - TPROBE[0]; TPROBE[0] = now_; } } while (0)

#define Wb ((bf16*)(F.ws + WS_W))
#define XWT ((bf16*)(F.ws + WS_XWT))
#define XN ((bf16*)(F.ws + WS_XN))
#define MIX ((bf16*)(F.ws + WS_MIX))
#define BIG ((bf16*)(F.ws + WS_BIG))
#define PB (BIG + (size_t)M * D)
#define KV ((bf16*)(F.ws + WS_KV))
#define MEMN ((bf16*)(F.ws + WS_MEMN))
#define GT ((float*)(F.ws + WS_GATES))
#define NSTP ((float*)(F.ws + WS_NST))
#define SCALP ((float*)(F.ws + WS_SCAL))
#define MPREVP ((float*)(F.ws + WS_MPREV))
#define gains inp(F, 3)
#define XOUT ((float*)inp(F, 15))

    if (PROBE_CAT != 0 && blockIdx.x == 0 && threadIdx.x == 0) { TPROBE[0] = rt(); TPROBE[1] = 0ull; }
    p0_convert(F);
    row_phase(F, inp(F, 0), XOUT, nullptr, nullptr, gains, XN, inp(F, 4) + 3072, ML_W, inp(F, 5), GT);
    GBAR(4);
    run_gemm<MM, 8192, D, true>(F, MEMN, D, XWT, D, 0, 0, EpiStore{KV, 8192});

#pragma unroll 1
    for (int l = 0; l < DEPTH; ++l) {
#define WL (Wb + (size_t)l * WL_SIZE)
#define GL (gains + (size_t)l * 6 * D)
        const bool ml = (l & 1) == 0;
        run_gemm<M, 3072, D, true>(F, XN, D, WL + WL_IN, D, 0, 0, EpiStore{BIG, 3072}); GBAR(5);
        if (ml) {
            mlk::phaseA(F, BIG, GT, XN, NSTP, SCALP); GBAR(2);
            mlk::phaseB(F, XN, NSTP, SCALP, MPREVP); GBAR(2);
            mlk::phaseC(F, BIG, GT, XN, NSTP, MPREVP, inp(F, 6) + (size_t)(l >> 1) * D); GBAR(2);
            run_gemm<M, D, D, true>(F, BIG + 1024, 3072, WL + WL_OUT, D, 0, 0, EpiStore{MIX, D});
        } else {
            sb_attn_v2(F, BIG, MIX); GBAR(3);
            run_gemm<M, D, D, true>(F, MIX, D, WL + WL_OUT, D, 0, 0, EpiStore{BIG, D});
        }
        xw_gemms(F, KV + (size_t)l * 2048, WL + WL_QN, WL + WL_OT, XWT); GBAR(6);
        row_phase(F, XOUT, XOUT, ml ? MIX : BIG, GL + D, GL + 2 * D, XN, nullptr, 0, nullptr, nullptr); GBAR(1);
        run_gemm<M, D, D, false>(F, XN, D, XWT, D, 8, (size_t)D * D * 2, EpiSoftmax{PB, D}); GBAR(7);
        run_gemm<M, D, D, true>(F, PB, D, XWT + (size_t)8 * D * D, D, 8, (size_t)D * D * 2, EpiStore{BIG, D}); GBAR(7);
        row_phase(F, XOUT, XOUT, BIG, GL + 3 * D, GL + 4 * D, XN, nullptr, 0, nullptr, nullptr); GBAR(1);
        run_gemm<M, 2 * DFF, D, true>(F, XN, D, WL + WL_GU, D, 0, 0, EpiSwiglu{BIG, DFF}); GBAR(8);
        run_gemm<M, D, DFF, true>(F, BIG, DFF, WL + WL_DN, DFF, 0, 0, EpiStore{MIX, D}); GBAR(8);
        { const bool last = (l + 1 == DEPTH), gates = !last && (((l + 1) & 1) == 0);
          row_phase(F, XOUT, XOUT, MIX, GL + 5 * D, last ? nullptr : GL + 6 * D, XN,
                    gates ? inp(F, 4) + (size_t)((l + 1) >> 1) * D * ML_W + 3072 : nullptr, ML_W, inp(F, 5) + ((l + 1) >> 1) * 8, GT);
          if (!last) GBAR(1); }
    }
    if (PROBE_CAT != 0 && blockIdx.x == 0 && threadIdx.x == 0) {
        unsigned long long now_ = rt(); if (PROBE_CAT == 1) TPROBE[1] += now_ - TPROBE[0];
        const unsigned long long until = now_ + 20ull * TPROBE[1];
        while (rt() < until) __builtin_amdgcn_s_sleep(32);
    }
}

extern "C" void kernel_launch(void* const* d_in, const int* in_sizes, int n_in, void* d_out, int out_size, void* d_ws, size_t ws_size, hipStream_t stream) {
    static int grid = 0;
    if (grid == 0) {
        if (n_in != 15 || out_size != M * D || ws_size < WS_END) { fprintf(stderr, "kernel_launch: unexpected shapes (n_in %d out %d ws %zu need %zu)\n", n_in, out_size, ws_size, (size_t)WS_END); grid = -1; return; }
        int dev = 0, cus = 0, per_cu = 0;
        if (hipGetDevice(&dev) != hipSuccess || hipDeviceGetAttribute(&cus, hipDeviceAttributeMultiprocessorCount, dev) != hipSuccess) { grid = -1; return; }
        if (hipFuncSetAttribute((const void*)mega_fwd, hipFuncAttributeMaxDynamicSharedMemorySize, LDS_BYTES) != hipSuccess) { fprintf(stderr, "kernel_launch: hipFuncSetAttribute failed\n"); grid = -1; return; }
        if (hipOccupancyMaxActiveBlocksPerMultiprocessor(&per_cu, (const void*)mega_fwd, NWAVES * 64, LDS_BYTES) != hipSuccess || per_cu < 1) fprintf(stderr, "kernel_launch: occupancy query reports %d\n", per_cu);
        (void)hipGetLastError();
        grid = cus;
    }
    if (grid < 0) return;
    if (hipMemsetAsync((char*)d_ws + WS_CTL, 0, CTL_ZERO_BYTES, stream) != hipSuccess) return;
    Args a{};
    for (int i = 0; i < 15; ++i) a.in[i] = (const float*)d_in[i];
    a.out = (float*)d_out; a.ws = (unsigned char*)d_ws;
    hipLaunchKernelGGL(mega_fwd, dim3(grid), dim3(NWAVES * 64), LDS_BYTES, stream, a);
}
```

```cpp
#include <hip/hip_runtime.h>
#include <cstdio>
#include <cstdint>
namespace pg8 {
#define PG8_LAS __attribute__((address_space(3)))
typedef unsigned short bf16_t;
typedef short bf16x8 __attribute__((ext_vector_type(8)));
typedef float f32x4 __attribute__((ext_vector_type(4)));
typedef unsigned u32x4 __attribute__((ext_vector_type(4)));
constexpr int BM = 256, BK = 64, HALF = 128, HTB = HALF * BK * 2  , STAGE_BYTES = 8 * HTB, NXCD = 8, WGM = 8;

__host__ __device__ __forceinline__ int lds_byte(int r, int c) { const int st = (r >> 4) * 2 + (c >> 5), rr = r & 15, cc = c & 31, ob = rr * 64 + cc * 2; return st * 1024 + (ob ^ (((ob >> 9) & 1) << 5)); }
__host__ __device__ __forceinline__ void stage_rc(int b, int& R, int& C) { const int st = b / 1024, sb = b % 1024, swz = sb ^ (((sb >> 9) & 1) << 5); R = (st >> 1) * 16 + swz / 64; C = (st & 1) * 32 + (swz % 64) / 2; }
__host__ __device__ __forceinline__ int perm32(int rho) { const int n = rho >> 4, i = rho & 15; return 8 * (i >> 2) + 4 * n + (i & 3); }

struct Unit { int pm, pn; size_t aoff, boff; };
struct Gemm { const bf16_t* A; const bf16_t* Bt; int M, N, K, lda, ldb; };

struct StaticOrder {
    int nM, nN, nwg, G, c, pmb; size_t a_rt, b_rt, b_batch;
    __host__ __device__ void init(int M, int N, int G_, int c_, int lda, int ldb, int pmb_ = 0, size_t b_batch_ = 0) { nM = M / BM; nN = N / BM; nwg = nM * nN; G = G_; c = c_; a_rt = (size_t)BM * lda * 2; b_rt = (size_t)BM * ldb * 2; pmb = pmb_; b_batch = b_batch_; }
    __host__ __device__ bool next(int i, Unit& u) const {
        const long L = (long)i * G + c; if (L >= nwg) return false;
        int wgid = (int)L; { const int q = nwg / NXCD, r = nwg % NXCD, xcd = wgid % NXCD, off = wgid / NXCD; wgid = (xcd < r ? xcd * (q + 1) : r * (q + 1) + (xcd - r) * q) + off; }
        const int nig = WGM * nN, gid = wgid / nig, fm = gid * WGM, gsz = (nM - fm) < WGM ? (nM - fm) : WGM;
        u.pm = fm + ((wgid % nig) % gsz); u.pn = (wgid % nig) / gsz; u.aoff = (size_t)u.pm * a_rt; u.boff = (size_t)u.pn * b_rt + (pmb ? (size_t)(u.pm / pmb) * b_batch : 0); return true;
    }
    __device__ __forceinline__ void a_ready(const Unit&) const {}
    __device__ __forceinline__ void done(const Unit&) const {}
};

__device__ __forceinline__ unsigned cvt_pk_bf16(float lo, float hi) { unsigned r; asm volatile("v_cvt_pk_bf16_f32 %0, %1, %2" : "=v"(r) : "v"(lo), "v"(hi)); return r; }
typedef float f32x2 __attribute__((ext_vector_type(2)));
__device__ __forceinline__ f32x2 gelu_pk(f32x2 v) {
    const f32x2 av = __builtin_elementwise_abs(v), d = av * 0.2316418882f + 1.0f;
    f32x2 t; t.x = __builtin_amdgcn_rcpf(d.x); t.y = __builtin_amdgcn_rcpf(d.y);
    f32x2 q = t * 0.5307027145f + (-0.7265760135f); q = q * t + 0.7107068705f; q = q * t + (-0.142248368f); q = q * t + 0.127414796f; q = q * t;
    const f32x2 s = (v * v) * (-0.72134752044f);
    f32x2 e; e.x = __builtin_amdgcn_exp2f(s.x); e.y = __builtin_amdgcn_exp2f(s.y);
    const f32x2 m = v * (q * e), r = v - m;
    f32x2 o; o.x = v.x < 0.f ? m.x : r.x; o.y = v.y < 0.f ? m.y : r.y; return o;
}

template <int ACT  > struct EpiBf16 {
    static constexpr bool PERM = true, AFTER_DRAIN = false; static_assert(ACT == 0 || ACT == 1, "EpiBf16: ACT is 0 (none) or 1 (gelu_pk)");
    bf16_t* O; int ldc; const float* bias; int split_cols; size_t split_stride; float scale0;
    __device__ __forceinline__ void operator()(const f32x4 (&acc)[2][2][4][2], const Unit& u, int wr, int wc, int fr, int fq) const {
        const int row0 = u.pm * BM + wr * 64 + fr; int colt = u.pn * BM; bf16_t* base = O;
        float sc = 1.f; if (split_cols) { const int t = colt / split_cols; base += (size_t)t * split_stride; colt -= t * split_cols; if (t == 0) sc = scale0; }
        const int col0 = colt + wc * 32 + 8 * fq, bcol0 = u.pn * BM + wc * 32 + 8 * fq;
        f32x4 bv[2][2];
#pragma unroll
        for (int bj = 0; bj < 2; ++bj)
#pragma unroll
            for (int n = 0; n < 2; ++n) bv[bj][n] = bias ? *(const f32x4*)(bias + bcol0 + bj * HALF + 4 * n) : (f32x4){0.f, 0.f, 0.f, 0.f};
#pragma unroll
        for (int ai = 0; ai < 2; ++ai)
#pragma unroll
            for (int m = 0; m < 4; ++m) { bf16_t* rowp = base + (size_t)(row0 + ai * HALF + m * 16) * ldc + col0;
#pragma unroll
                for (int bj = 0; bj < 2; ++bj) { f32x4 v0 = acc[ai][bj][m][0] + bv[bj][0], v1 = acc[ai][bj][m][1] + bv[bj][1];
                    if (ACT == 1) { f32x2 a = gelu_pk((f32x2){v0[0], v0[1]}), b = gelu_pk((f32x2){v0[2], v0[3]}), c = gelu_pk((f32x2){v1[0], v1[1]}), d = gelu_pk((f32x2){v1[2], v1[3]});
                        v0 = (f32x4){a.x, a.y, b.x, b.y}; v1 = (f32x4){c.x, c.y, d.x, d.y}; }
                    v0 = v0 * sc; v1 = v1 * sc; u32x4 w; w.x = cvt_pk_bf16(v0[0], v0[1]); w.y = cvt_pk_bf16(v0[2], v0[3]); w.z = cvt_pk_bf16(v1[0], v1[1]); w.w = cvt_pk_bf16(v1[2], v1[3]);
                    *(u32x4*)(rowp + bj * HALF) = w; } }
    }
};

struct PanelStats {
    unsigned* xbuf;
    unsigned* cnt;
    unsigned* tmo;
    int ntn; float eps;
    unsigned code;
    __device__ __forceinline__ bool run(const f32x4 (&v)[2][2][4][2], const Unit& u, int wr, int wc, int fr, int fq, PG8_LAS unsigned char* lds, int wid, int lane) const {
        typedef float f32x2v __attribute__((ext_vector_type(2)));
        PG8_LAS f32x2v* P = (PG8_LAS f32x2v*)lds;
        PG8_LAS f32x2v* S = (PG8_LAS f32x2v*)(lds + 8192);
        PG8_LAS unsigned* flag = (PG8_LAS unsigned*)(lds + 8192 + 2048);
#pragma unroll
        for (int ai = 0; ai < 2; ++ai)
#pragma unroll
            for (int m = 0; m < 4; ++m) {
                float s = 0.f;
#pragma unroll
                for (int bj = 0; bj < 2; ++bj)
#pragma unroll
                    for (int n = 0; n < 2; ++n) { const f32x4 x = v[ai][bj][m][n]; s += (x[0] + x[1]) + (x[2] + x[3]); }
                s += __shfl_xor(s, 16); s += __shfl_xor(s, 32);
                const float mw = s * (1.0f / 64.0f); float q = 0.f;
#pragma unroll
                for (int bj = 0; bj < 2; ++bj)
#pragma unroll
                    for (int n = 0; n < 2; ++n) { const f32x4 d = v[ai][bj][m][n] - mw; q += (d[0] * d[0] + d[1] * d[1]) + (d[2] * d[2] + d[3] * d[3]); }
                q += __shfl_xor(q, 16); q += __shfl_xor(q, 32);
                if (fq == 0) P[(ai * HALF + wr * 64 + m * 16 + fr) * 4 + wc] = (f32x2v){mw, q};
            }
        asm volatile("s_waitcnt lgkmcnt(0)" ::: "memory"); __builtin_amdgcn_s_barrier(); asm volatile("" ::: "memory");
#if defined(BROKEN_EXCHANGE_NO_WAIT)
#warning BROKEN CONTROL BUILD: the row-statistics exchange does not wait; results are wrong by design
        if (blockIdx.x >= 64) { const long long t0_ = clock64(); while (clock64() - t0_ < 60000) __builtin_amdgcn_s_sleep(8); }
#endif
        const int row = wid * 32 + (lane & 31);
        if (lane < 32) {
            const f32x2v a = P[row * 4 + 0], b = P[row * 4 + 1], c = P[row * 4 + 2], d = P[row * 4 + 3];
            const float mt = (a.x + b.x + c.x + d.x) * 0.25f;
            const float da = a.x - mt, db = b.x - mt, dc = c.x - mt, dd = d.x - mt;
            const float m2 = (a.y + b.y) + (c.y + d.y) + 64.0f * ((da * da + db * db) + (dc * dc + dd * dd));
            unsigned long long* slot = (unsigned long long*)xbuf + ((size_t)(u.pm * BM + row) * 4 + u.pn);
            __hip_atomic_store(slot, ((unsigned long long)__float_as_uint(m2) << 32) | __float_as_uint(mt), __ATOMIC_RELAXED, __HIP_MEMORY_SCOPE_AGENT);
        }
        asm volatile("s_waitcnt vmcnt(0)" ::: "memory");
        if (lane == 0) __hip_atomic_fetch_add(cnt + 64 * u.pm, 1u, __ATOMIC_RELAXED, __HIP_MEMORY_SCOPE_AGENT);
        if (wid == 0) {
            bool dead = false; const unsigned long long t0 = __builtin_amdgcn_s_memrealtime(); const unsigned want = 8u * (unsigned)ntn;
            for (;;) {
#if defined(BROKEN_EXCHANGE_NO_WAIT)
                break;
#endif
                if ((unsigned)__builtin_amdgcn_readfirstlane(__hip_atomic_load(cnt + 64 * u.pm, __ATOMIC_RELAXED, __HIP_MEMORY_SCOPE_AGENT)) >= want) break;
                if (__builtin_amdgcn_s_memrealtime() - t0 > 2000000ull) {
                    if (lane == 0) { unsigned expect = 0u; __hip_atomic_compare_exchange_strong(tmo + 1, &expect, code | (unsigned)(u.pm & 0xff), __ATOMIC_RELAXED, __ATOMIC_RELAXED, __HIP_MEMORY_SCOPE_AGENT);
                                     __hip_atomic_store(tmo, 1u, __ATOMIC_RELAXED, __HIP_MEMORY_SCOPE_AGENT); }
                    dead = true; break; }
                __builtin_amdgcn_s_sleep(2);
            }
            __builtin_amdgcn_fence(__ATOMIC_ACQUIRE, "agent");
            if (lane == 0) flag[0] = dead ? 1u : 0u;
        }
        asm volatile("s_waitcnt vmcnt(0) lgkmcnt(0)" ::: "memory"); __builtin_amdgcn_s_barrier(); asm volatile("" ::: "memory");
        const bool bad = flag[0] != 0u;
        if (lane < 32) {
            const unsigned long long* slot = (const unsigned long long*)xbuf + (size_t)(u.pm * BM + row) * 4; float mt[4], m2[4]; float ms = 0.f;
#pragma unroll
            for (int t = 0; t < 4; ++t) { if (t < ntn) { const unsigned long long w = __hip_atomic_load(slot + t, __ATOMIC_RELAXED, __HIP_MEMORY_SCOPE_AGENT); mt[t] = __uint_as_float((unsigned)w); m2[t] = __uint_as_float((unsigned)(w >> 32)); } else { mt[t] = 0.f; m2[t] = 0.f; } ms += mt[t]; }
            const float mean = ms / (float)ntn; float q = 0.f;
#pragma unroll
            for (int t = 0; t < 4; ++t) if (t < ntn) { const float dm = mt[t] - mean; q += m2[t] + 256.0f * dm * dm; }
            S[row] = (f32x2v){mean, 1.0f / sqrtf(q / (256.0f * (float)ntn) + eps)};
        }
        asm volatile("s_waitcnt lgkmcnt(0)" ::: "memory"); __builtin_amdgcn_s_barrier(); asm volatile("" ::: "memory");
        return bad;
    }
};
struct EpiLnRes {
    static constexpr bool PERM = false, AFTER_DRAIN = true;
    const float* base; float* out; int ldc; const float* bias; PanelStats st; unsigned poison;
    __device__ __forceinline__ void fused(f32x4 (&acc)[2][2][4][2], const Unit& u, int wr, int wc, int fr, int fq, PG8_LAS unsigned char* lds, int wid, int lane) const {
        typedef float f32x2v __attribute__((ext_vector_type(2)));
        const PG8_LAS f32x2v* S = (const PG8_LAS f32x2v*)(lds + 8192);
        const int col0 = u.pn * BM + wc * 32 + 4 * fq;
#pragma unroll
        for (int bj = 0; bj < 2; ++bj)
#pragma unroll
            for (int n = 0; n < 2; ++n) { const f32x4 bv = bias ? *(const f32x4*)(bias + col0 + bj * HALF + n * 16) : (f32x4){0.f, 0.f, 0.f, 0.f};
#pragma unroll
                for (int ai = 0; ai < 2; ++ai)
#pragma unroll
                    for (int m = 0; m < 4; ++m) acc[ai][bj][m][n] += bv; }
        f32x4 pre[4][2][2];
#pragma unroll
        for (int m = 0; m < 4; ++m) { const size_t off = (size_t)(u.pm * BM + wr * 64 + m * 16 + fr) * ldc + col0;
#pragma unroll
            for (int bj = 0; bj < 2; ++bj)
#pragma unroll
                for (int n = 0; n < 2; ++n) pre[m][bj][n] = *(const f32x4*)(base + off + bj * HALF + n * 16); }
        const bool bad = st.run(acc, u, wr, wc, fr, fq, lds, wid, lane) || poison != 0u;
        const float qnan = __builtin_nanf("");
#pragma unroll
        for (int ai = 0; ai < 2; ++ai)
#pragma unroll
            for (int m = 0; m < 4; ++m) { const int r = ai * HALF + wr * 64 + m * 16 + fr; const f32x2v sr = S[r]; const size_t off = (size_t)(u.pm * BM + r) * ldc + col0;
#pragma unroll
                for (int bj = 0; bj < 2; ++bj)
#pragma unroll
                    for (int n = 0; n < 2; ++n) { const f32x4 bs = ai == 0 ? pre[m][bj][n] : *(const f32x4*)(base + off + bj * HALF + n * 16); f32x4 o = bs + (acc[ai][bj][m][n] - sr.x) * sr.y;
                        if (bad) o = (f32x4){qnan, qnan, qnan, qnan}; *(f32x4*)(out + off + bj * HALF + n * 16) = o; }
                if (m & 1) asm volatile("" ::: "memory"); }
    }
};
struct EpiLnResLn {
    static constexpr bool PERM = false, AFTER_DRAIN = true;
    const float* base; float* out; bf16_t* xn; int ldc; const float* bias; PanelStats st1, st2; unsigned poison;
    __device__ __forceinline__ void fused(f32x4 (&acc)[2][2][4][2], const Unit& u, int wr, int wc, int fr, int fq, PG8_LAS unsigned char* lds, int wid, int lane) const {
        typedef float f32x2v __attribute__((ext_vector_type(2))); typedef unsigned u32x2v __attribute__((ext_vector_type(2)));
        const PG8_LAS f32x2v* S = (const PG8_LAS f32x2v*)(lds + 8192);
        const int col0 = u.pn * BM + wc * 32 + 4 * fq;
#pragma unroll
        for (int bj = 0; bj < 2; ++bj)
#pragma unroll
            for (int n = 0; n < 2; ++n) { const f32x4 bv = bias ? *(const f32x4*)(bias + col0 + bj * HALF + n * 16) : (f32x4){0.f, 0.f, 0.f, 0.f};
#pragma unroll
                for (int ai = 0; ai < 2; ++ai)
#pragma unroll
                    for (int m = 0; m < 4; ++m) acc[ai][bj][m][n] += bv; }
        bool bad = st1.run(acc, u, wr, wc, fr, fq, lds, wid, lane) || poison != 0u;
        const float qnan = __builtin_nanf("");
#pragma unroll
        for (int ai = 0; ai < 2; ++ai)
#pragma unroll
            for (int m = 0; m < 4; ++m) { const int r = ai * HALF + wr * 64 + m * 16 + fr; const f32x2v sr = S[r]; const size_t off = (size_t)(u.pm * BM + r) * ldc + col0;
#pragma unroll
                for (int bj = 0; bj < 2; ++bj)
#pragma unroll
                    for (int n = 0; n < 2; ++n) { const f32x4 bs = *(const f32x4*)(base + off + bj * HALF + n * 16); acc[ai][bj][m][n] = bs + (acc[ai][bj][m][n] - sr.x) * sr.y; }
                asm volatile("" : "+v"(acc[ai][0][m][0]), "+v"(acc[ai][0][m][1]), "+v"(acc[ai][1][m][0]), "+v"(acc[ai][1][m][1]));
                if (m & 1) asm volatile("" ::: "memory"); }
        const bool bad1 = bad;
        bad = st2.run(acc, u, wr, wc, fr, fq, lds, wid, lane) || bad;
#pragma unroll
        for (int ai = 0; ai < 2; ++ai)
#pragma unroll
            for (int m = 0; m < 4; ++m) { const int r = ai * HALF + wr * 64 + m * 16 + fr; const f32x2v sr = S[r]; const size_t off = (size_t)(u.pm * BM + r) * ldc + col0;
#pragma unroll
                for (int bj = 0; bj < 2; ++bj)
#pragma unroll
                    for (int n = 0; n < 2; ++n) { const f32x4 x1 = acc[ai][bj][m][n]; *(f32x4*)(out + off + bj * HALF + n * 16) = bad1 ? (f32x4){qnan, qnan, qnan, qnan} : x1;
                        const f32x4 o = (x1 - sr.x) * sr.y; u32x2v w; w.x = cvt_pk_bf16(o[0], o[1]); w.y = cvt_pk_bf16(o[2], o[3]);
                        if (bad) { w.x = 0x7fc07fc0u; w.y = 0x7fc07fc0u; } *(u32x2v*)(xn + off + bj * HALF + n * 16) = w; }
                asm volatile("" ::: "memory"); }
    }
};

template <class Epi, class Sched, bool ALIGN_EPI = false, bool SP2 = false>
__device__ __forceinline__ void gemm_phase(PG8_LAS unsigned char* lds, const Gemm g, const Sched& S, const Epi& E) {
    int tid_ = threadIdx.x; asm volatile("" : "+v"(tid_));
    const int tid = tid_, wid = __builtin_amdgcn_readfirstlane(tid >> 6), lane = tid & 63, wr = wid >> 2, wc = wid & 3, fr = lane & 15, fq = lane >> 4;
    const int K = g.K, nt = K / BK;
    unsigned voffA[2], voffB[2];
#pragma unroll
    for (int i = 0; i < 2; ++i) { int R, C; stage_rc(tid * 16 + i * 8192, R, C); const int Rb = Epi::PERM ? ((R & ~31) + perm32(R & 31)) : R;
        voffA[i] = (unsigned)(R * g.lda + C) * 2u; voffB[i] = (unsigned)(Rb * g.ldb + C) * 2u; }
    const size_t kstep = (size_t)(BK * 2);
    const size_t hstepA = (size_t)HALF * g.lda * 2, hstepB = (size_t)HALF * g.ldb * 2;
    const unsigned ldsw = (unsigned)wid * 1024u;
    const int aoff = lds_byte(wr * 64 + fr, fq * 8), boff = lds_byte(wc * 32 + fr, fq * 8);
#define PG8_SA(b, h) (((b) * 2 + (h)) * HTB)
#define PG8_SB(b, h) ((4 + (b) * 2 + (h)) * HTB)
#define PG8_STAGE(bufoff, gbase, voff) do { _Pragma("unroll") for (int _i = 0; _i < 2; ++_i) \
        __builtin_amdgcn_global_load_lds((const unsigned*)((const char*)(gbase) + (voff)[_i]), (PG8_LAS unsigned*)(lds + (bufoff) + ldsw + _i * 8192), 16, 0, 0); } while (0)
#define PG8_LDA(dst, b, h) do { _Pragma("unroll") for (int m = 0; m < 4; ++m) _Pragma("unroll") for (int k = 0; k < 2; ++k) dst[m][k] = *(const PG8_LAS bf16x8*)(lds + PG8_SA(b, h) + aoff + m * 2048 + k * 1024); } while (0)
#define PG8_LDB(dst, b, h) do { _Pragma("unroll") for (int n = 0; n < 2; ++n) _Pragma("unroll") for (int k = 0; k < 2; ++k) dst[n][k] = *(const PG8_LAS bf16x8*)(lds + PG8_SB(b, h) + boff + n * 2048 + k * 1024); } while (0)
#define PG8_MMA(ai, bj, At, Bt) do { __builtin_amdgcn_s_setprio(1); _Pragma("unroll") for (int m = 0; m < 4; ++m) _Pragma("unroll") for (int n = 0; n < 2; ++n) _Pragma("unroll") for (int k = 0; k < 2; ++k) \
        acc[ai][bj][m][n] = __builtin_amdgcn_mfma_f32_16x16x32_bf16(Bt[n][k], At[m][k], acc[ai][bj][m][n], 0, 0, 0); __builtin_amdgcn_s_setprio(0); } while (0)
#define PG8_WAIT_V(n) asm volatile("s_waitcnt vmcnt(" #n ")" ::: "memory")
#define PG8_WAIT_L(n) asm volatile("s_waitcnt lgkmcnt(" #n ")" ::: "memory")
#define PG8_BAR __builtin_amdgcn_s_barrier()
#define PG8_SCHED __builtin_amdgcn_sched_barrier(0)
    Unit cur, nxt; int ui = 0;
    if (!S.next(0, cur)) return;
    f32x4 acc[2][2][4][2];
#pragma unroll
    for (int a = 0; a < 2; ++a)
#pragma unroll
        for (int b = 0; b < 2; ++b)
#pragma unroll
            for (int m = 0; m < 4; ++m)
#pragma unroll
                for (int n = 0; n < 2; ++n) acc[a][b][m][n] = (f32x4){0.f, 0.f, 0.f, 0.f};
    bf16x8 At[4][2], B0[2][2], B1[2][2];
    const char* cA = (const char*)g.A + cur.aoff; const char* cB = (const char*)g.Bt + cur.boff;
    S.a_ready(cur);
    if constexpr (SP2) {
        PG8_STAGE(PG8_SB(0, 0), cB, voffB); PG8_STAGE(PG8_SB(0, 1), cB + hstepB, voffB); PG8_STAGE(PG8_SA(0, 0), cA, voffA); PG8_STAGE(PG8_SA(0, 1), cA + hstepA, voffA);
        if (wr == 1) PG8_BAR;
        PG8_WAIT_V(2); PG8_BAR;
        PG8_STAGE(PG8_SB(1, 0), cB + kstep, voffB); PG8_STAGE(PG8_SA(1, 0), cA + kstep, voffA); PG8_STAGE(PG8_SB(1, 1), cB + hstepB + kstep, voffB);
        PG8_WAIT_V(6); PG8_BAR;
    } else {
        PG8_STAGE(PG8_SB(0, 0), cB, voffB); PG8_STAGE(PG8_SA(0, 0), cA, voffA); PG8_STAGE(PG8_SB(0, 1), cB + hstepB, voffB); PG8_STAGE(PG8_SA(0, 1), cA + hstepA, voffA);
        if (wr == 1) PG8_BAR;
        PG8_WAIT_V(4); PG8_BAR;
        PG8_STAGE(PG8_SB(1, 0), cB + kstep, voffB); PG8_STAGE(PG8_SA(1, 0), cA + kstep, voffA); PG8_STAGE(PG8_SB(1, 1), cB + hstepB + kstep, voffB);
        PG8_WAIT_V(6); PG8_BAR;
    }
    for (;;) {
        const bool has_next = S.next(ui + 1, nxt);
        const char* nA = has_next ? (const char*)g.A + nxt.aoff : cA; const char* nB = has_next ? (const char*)g.Bt + nxt.boff : cB;
        for (int t = 0; t < nt; t += 2) {
            const bool last = (t == nt - 2);
            const char* a1 = cA + (size_t)(t + 1) * kstep;
            const char* a2 = last ? nA : cA + (size_t)(t + 2) * kstep; const char* b2 = last ? nB : cB + (size_t)(t + 2) * kstep;
            const char* a3 = a2 + kstep; const char* b3 = b2 + kstep;
            if (last && has_next) S.a_ready(nxt);
            if constexpr (SP2) {
            PG8_LDB(B0, 0, 0); PG8_LDB(B1, 0, 1); PG8_SCHED; PG8_LDA(At, 0, 0); PG8_STAGE(PG8_SA(1, 1), a1 + hstepA, voffA);
            PG8_WAIT_V(8); PG8_WAIT_L(0); PG8_BAR; PG8_MMA(0, 0, At, B0); PG8_MMA(0, 1, At, B1); PG8_BAR; PG8_SCHED;
            PG8_LDA(At, 0, 1); PG8_STAGE(PG8_SB(0, 0), b2, voffB); PG8_STAGE(PG8_SB(0, 1), b2 + hstepB, voffB); PG8_STAGE(PG8_SA(0, 0), a2, voffA);
            PG8_WAIT_V(8); PG8_WAIT_L(0); PG8_BAR; PG8_MMA(1, 0, At, B0); PG8_MMA(1, 1, At, B1); PG8_BAR; PG8_SCHED;
            PG8_LDB(B0, 1, 0); PG8_LDB(B1, 1, 1); PG8_SCHED; PG8_LDA(At, 1, 0); PG8_STAGE(PG8_SA(0, 1), a2 + hstepA, voffA);
            PG8_WAIT_V(8); PG8_WAIT_L(0); PG8_BAR; PG8_MMA(0, 0, At, B0); PG8_MMA(0, 1, At, B1); PG8_BAR; PG8_SCHED;
            PG8_LDA(At, 1, 1); PG8_STAGE(PG8_SB(1, 0), b3, voffB); PG8_STAGE(PG8_SB(1, 1), b3 + hstepB, voffB); PG8_STAGE(PG8_SA(1, 0), a3, voffA);
            PG8_WAIT_V(8); PG8_WAIT_L(0); PG8_BAR; PG8_MMA(1, 0, At, B0); PG8_MMA(1, 1, At, B1); PG8_BAR; PG8_SCHED;
            } else {
            PG8_LDB(B0, 0, 0); PG8_SCHED; PG8_LDA(At, 0, 0); PG8_STAGE(PG8_SA(1, 1), a1 + hstepA, voffA);
            PG8_WAIT_L(8); PG8_BAR; PG8_WAIT_L(0); PG8_MMA(0, 0, At, B0); PG8_BAR; PG8_SCHED;
            PG8_LDB(B1, 0, 1); PG8_STAGE(PG8_SB(0, 0), b2, voffB);
            PG8_BAR; PG8_WAIT_L(0); PG8_MMA(0, 1, At, B1); PG8_BAR;
            PG8_LDA(At, 0, 1); PG8_STAGE(PG8_SA(0, 0), a2, voffA);
            PG8_BAR; PG8_WAIT_L(0); PG8_MMA(1, 0, At, B0); PG8_BAR; PG8_SCHED;
            PG8_STAGE(PG8_SB(0, 1), b2 + hstepB, voffB);
            PG8_WAIT_V(6); PG8_BAR; PG8_MMA(1, 1, At, B1); PG8_BAR;
            PG8_LDB(B0, 1, 0); PG8_SCHED; PG8_LDA(At, 1, 0); PG8_STAGE(PG8_SA(0, 1), a2 + hstepA, voffA);
            PG8_WAIT_L(8); PG8_BAR; PG8_WAIT_L(0); PG8_MMA(0, 0, At, B0); PG8_BAR; PG8_SCHED;
            PG8_LDB(B1, 1, 1); PG8_STAGE(PG8_SB(1, 0), b3, voffB);
            PG8_BAR; PG8_WAIT_L(0); PG8_MMA(0, 1, At, B1); PG8_BAR;
            PG8_LDA(At, 1, 1); PG8_STAGE(PG8_SA(1, 0), a3, voffA);
            PG8_BAR; PG8_WAIT_L(0); PG8_MMA(1, 0, At, B0); PG8_BAR; PG8_SCHED;
            PG8_STAGE(PG8_SB(1, 1), b3 + hstepB, voffB);
            PG8_WAIT_V(6); PG8_BAR; PG8_MMA(1, 1, At, B1); PG8_BAR;
            }
        }
        if constexpr (ALIGN_EPI) { if (wr == 0) PG8_BAR; }
        if constexpr (!Epi::AFTER_DRAIN) { E(acc, cur, wr, wc, fr, fq); S.done(cur); }
        if (!has_next) break;
#pragma unroll
        for (int a = 0; a < 2; ++a)
#pragma unroll
            for (int b = 0; b < 2; ++b)
#pragma unroll
                for (int m = 0; m < 4; ++m)
#pragma unroll
                    for (int n = 0; n < 2; ++n) acc[a][b][m][n] = (f32x4){0.f, 0.f, 0.f, 0.f};
        cur = nxt; cA = nA; cB = nB; ++ui;
        if constexpr (ALIGN_EPI) { if (wr == 1) PG8_BAR; }
    }
    PG8_WAIT_V(0);
    if constexpr (!ALIGN_EPI) { if (wr == 0) PG8_BAR; }
    PG8_BAR;
    if constexpr (Epi::AFTER_DRAIN) { E.fused(acc, cur, wr, wc, fr, fq, lds, wid, lane); S.done(cur); }
#undef PG8_SA
#undef PG8_SB
#undef PG8_STAGE
#undef PG8_LDA
#undef PG8_LDB
#undef PG8_MMA
#undef PG8_WAIT_V
#undef PG8_WAIT_L
#undef PG8_BAR
#undef PG8_SCHED
}
}
#define GAS __attribute__((address_space(1)))
#define LAS __attribute__((address_space(3)))
typedef unsigned short bf16;
typedef unsigned v4u __attribute__((ext_vector_type(4)));
typedef float f32x4 __attribute__((ext_vector_type(4)));
typedef short bf16x8 __attribute__((ext_vector_type(8)));
typedef GAS unsigned gu32;
typedef GAS unsigned long long gu64;
#define RLX_AGENT __ATOMIC_RELAXED, __HIP_MEMORY_SCOPE_AGENT
#define LDS_WAIT() asm volatile("s_waitcnt lgkmcnt(0)" ::: "memory")
#define VM_WAIT() asm volatile("s_waitcnt vmcnt(0)" ::: "memory")
__device__ __forceinline__ unsigned long long rt() { return __builtin_amdgcn_s_memrealtime(); }
__device__ __forceinline__ unsigned f2bf(float f) { unsigned u = __builtin_bit_cast(unsigned, f); return (u + 0x7fffu + ((u >> 16) & 1u)) >> 16; }
__device__ __forceinline__ unsigned pk2(float lo, float hi) { return f2bf(lo) | (f2bf(hi) << 16); }

#define XB_TMO      128
#define XB_XCNT(j)  (256  + 64 * (j))
#define XB_XSUB(j)  (1280 + 64 * (j))
#define XB_XGEN(j)  (2304 + 64 * (j))
#define XB_TOP      3328
#define XB_TOPGEN   3392
#define XCD_BAR_WORDS 3456
#define XB_SPIN_CAP (1u << 18)

__device__ __forceinline__ unsigned xb_ld(unsigned* p)              { return __hip_atomic_load(p, __ATOMIC_RELAXED, __HIP_MEMORY_SCOPE_AGENT); }
__device__ __forceinline__ unsigned xb_add(unsigned* p, unsigned v) { return __hip_atomic_fetch_add(p, v, __ATOMIC_RELAXED, __HIP_MEMORY_SCOPE_AGENT); }
__device__ __forceinline__ unsigned xb_xcc_id() { return (unsigned)__builtin_amdgcn_s_getreg((3 << 11) | 20) & 0xFu; }
#define XB_SPIN(cond, bar) do { unsigned _sp = 0; while (cond) { __builtin_amdgcn_s_sleep(1); \
    if ((++_sp & 255u) == 0u) { if (xb_ld(&(bar)[XB_TMO])) break; if (_sp > XB_SPIN_CAP) { atomicAdd(&(bar)[XB_TMO], 1u); break; } } } } while (0)

struct XcdBarrier {
    unsigned* bar; unsigned x;
    volatile LAS unsigned* st;
};

__device__ __forceinline__ XcdBarrier xcd_barrier_post(unsigned* bar, volatile LAS unsigned* st) {
    XcdBarrier b; b.bar = bar; b.x = xb_xcc_id(); b.st = st;
    if (threadIdx.x == 0) (void)xb_add(&bar[XB_XCNT(b.x)], 1u);
    return b;
}
__device__ __forceinline__ void xcd_barrier_complete(unsigned* bar, unsigned x, unsigned& nloc, unsigned& nx) {
    const unsigned G = gridDim.x * gridDim.y * gridDim.z;
    unsigned sum, cnt, mine, sp = 0u;
    for (;;) {
        sum = 0u; cnt = 0u; mine = 0u;
#pragma unroll
        for (unsigned j = 0; j < 16; ++j) { const unsigned c = xb_ld(&bar[XB_XCNT(j)]); sum += c; cnt += (c > 0u) ? 1u : 0u; mine = (j == x) ? c : mine; }
        if (sum == G) break;
        __builtin_amdgcn_s_sleep(1);
        if ((++sp & 255u) == 0u) { if (xb_ld(&bar[XB_TMO])) break; if (sp > XB_SPIN_CAP) { atomicAdd(&bar[XB_TMO], 1u); break; } }
    }
    nloc = mine > 0u ? mine : 1u; nx = cnt > 0u ? cnt : 1u;
}

__device__ __forceinline__ void xcd_barrier(const XcdBarrier& b) {
    asm volatile("s_waitcnt vmcnt(0)" ::: "memory");
    __syncthreads();
    if (threadIdx.x == 0) {
        unsigned* bar = b.bar;
        __builtin_amdgcn_s_waitcnt(0);
        unsigned nloc = b.st[0], nx = b.st[1];
        if (nloc == 0u) { xcd_barrier_complete(bar, b.x, nloc, nx); b.st[0] = nloc; b.st[1] = nx; }
        const unsigned old = xb_add(&bar[XB_XSUB(b.x)], 1u);
        const unsigned gen = old / nloc;
        if (old + 1u == (gen + 1u) * nloc) {
            __builtin_amdgcn_fence(__ATOMIC_RELEASE, "agent");
            asm volatile("s_waitcnt vmcnt(0)" ::: "memory");
            const unsigned og = xb_add(&bar[XB_TOP], 1u);
            const unsigned tg = og / nx;
            if (og + 1u == (tg + 1u) * nx) xb_add(&bar[XB_TOPGEN], 1u);
            else XB_SPIN(xb_ld(&bar[XB_TOPGEN]) == tg, bar);
            __builtin_amdgcn_fence(__ATOMIC_ACQUIRE, "agent");
            xb_add(&bar[XB_XGEN(b.x)], 1u);
            asm volatile("s_waitcnt vmcnt(0)" ::: "memory");
        } else {
            XB_SPIN(xb_ld(&bar[XB_XGEN(b.x)]) == gen, bar);
            __builtin_amdgcn_fence(__ATOMIC_ACQUIRE, "agent");
            asm volatile("s_waitcnt vmcnt(0)" ::: "memory");
        }
    }
    __syncthreads();
}

constexpr int D = 1024, BATCH = 8, SEQ = 2048, DEPTH = 4, NMEM = 256;
constexpr int M = BATCH * SEQ;
constexpr int MM = BATCH * NMEM;
constexpr int ML_H = 4, ML_DK = 128, ML_DV = 256, ML_W = 3080;
constexpr int SB_H = 16, SB_DH = 64;
constexpr int XA_H = 4, XA_DH = 256;
constexpr int DFF = 2816;
constexpr float EPS = 1e-6f;
constexpr int NWAVES = 8;

constexpr size_t MiB = 1u << 20;
constexpr size_t WS_CTL = 0, CTL_ZERO_BYTES = 1 * MiB;
constexpr size_t WS_WG = 1 * MiB;
constexpr size_t WS_GATES = 1 * MiB + 512 * 1024;
constexpr size_t WS_MEMN = 2 * MiB;
constexpr size_t WS_NST = 6 * MiB, WS_SCAL = 6 * MiB + 512 * 1024, WS_MPREV = WS_SCAL + 16 * 1024;
constexpr size_t WS_W = 8 * MiB;
constexpr size_t WL_IN = 0, WL_OUT = WL_IN + (size_t)3072 * 1024, WL_QN = WL_OUT + (size_t)1024 * 1024, WL_OT = WL_QN + (size_t)1024 * 1024,
                 WL_GU = WL_OT + (size_t)1024 * 1024, WL_DN = WL_GU + (size_t)5632 * 1024, WL_SIZE = WL_DN + (size_t)1024 * 2816;
constexpr size_t WS_XWT = WS_W + 4 * WL_SIZE * 2;
static_assert(WS_XWT == 122 * MiB, "weight region size");
constexpr size_t WS_KV = WS_XWT + 32 * MiB;
constexpr size_t WS_XN = WS_KV + 32 * MiB;
constexpr size_t WS_MIX = WS_XN + 32 * MiB;
constexpr size_t WS_BIG = WS_MIX + 32 * MiB;
constexpr size_t WS_END = WS_BIG + 96 * MiB;
constexpr int CW_BAR = 4096;

constexpr int RING_OFF = 0, RING_BYTES = 131072;
constexpr int LDSCTL_OFF = RING_BYTES, MISC_OFF = LDSCTL_OFF + 320;
constexpr int LDS_BYTES = 147456;

__device__ __forceinline__ float wave_sum(float v) {
#pragma unroll
    for (int o = 1; o < 64; o <<= 1) v += __shfl_xor(v, o);
    return v;
}
__device__ __forceinline__ float wave_max(float v) {
#pragma unroll
    for (int o = 1; o < 64; o <<= 1) v = fmaxf(v, __shfl_xor(v, o));
    return v;
}
__device__ __forceinline__ float softplusf(float z) { return fmaxf(z, 0.f) + log1pf(__expf(-fabsf(z))); }
__device__ __forceinline__ float bf2f(unsigned short h) { return __uint_as_float((unsigned)h << 16); }
__device__ __forceinline__ float bflo(unsigned w) { return __uint_as_float(w << 16); }
__device__ __forceinline__ float bfhi(unsigned w) { return __uint_as_float(w & 0xffff0000u); }

struct Frame {
    LAS unsigned char* lds;
    int tid, lane, wave, G, gw, NGW;
    unsigned char* ws;
};
__device__ __forceinline__ const float* inp(const Frame& F, int i) {
    volatile LAS unsigned* t = (volatile LAS unsigned*)(F.lds + LDSCTL_OFF) + 2 * i;
    const unsigned lo = __builtin_amdgcn_readfirstlane(t[0]), hi = __builtin_amdgcn_readfirstlane(t[1]);
    return (const float*)(((unsigned long long)hi << 32) | lo);
}
__device__ __forceinline__ void relane(Frame& F) {
    int t = threadIdx.x; asm volatile("" : "+v"(t));
    F.tid = t; F.lane = t & 63; F.wave = __builtin_amdgcn_readfirstlane(t >> 6);
    int g = gridDim.x, b = blockIdx.x; asm volatile("" : "+s"(g), "+s"(b));
    F.G = g; F.gw = b * NWAVES + F.wave; F.NGW = g * NWAVES;
}

struct EpiStore {
    static constexpr bool PERM = true, AFTER_DRAIN = false;
    bf16* O; int ldc;
    __device__ __forceinline__ void operator()(const f32x4 (&acc)[2][2][4][2], const pg8::Unit& u, int wr, int wc, int fr, int fq) const {
        const int row0 = u.pm * 256 + wr * 64 + fr, col0 = u.pn * 256 + wc * 32 + 8 * fq;
#pragma unroll
        for (int ai = 0; ai < 2; ++ai)
#pragma unroll
            for (int m = 0; m < 4; ++m) { bf16* rowp = O + (size_t)(row0 + ai * 128 + m * 16) * ldc + col0;
#pragma unroll
                for (int bj = 0; bj < 2; ++bj) { const f32x4 v0 = acc[ai][bj][m][0], v1 = acc[ai][bj][m][1];
                    pg8::u32x4 w; w.x = pg8::cvt_pk_bf16(v0[0], v0[1]); w.y = pg8::cvt_pk_bf16(v0[2], v0[3]); w.z = pg8::cvt_pk_bf16(v1[0], v1[1]); w.w = pg8::cvt_pk_bf16(v1[2], v1[3]);
                    *(pg8::u32x4*)(rowp + bj * 128) = w; } }
    }
};
struct EpiSwiglu {
    static constexpr bool PERM = true, AFTER_DRAIN = false;
    bf16* O; int ldc;
    __device__ __forceinline__ void operator()(const f32x4 (&acc)[2][2][4][2], const pg8::Unit& u, int wr, int wc, int fr, int fq) const {
        const int row0 = u.pm * 256 + wr * 64 + fr, col0 = u.pn * 128 + wc * 32 + 8 * fq;
#pragma unroll
        for (int ai = 0; ai < 2; ++ai)
#pragma unroll
            for (int m = 0; m < 4; ++m) { bf16* rowp = O + (size_t)(row0 + ai * 128 + m * 16) * ldc + col0;
                float r[8];
#pragma unroll
                for (int n = 0; n < 2; ++n)
#pragma unroll
                    for (int e = 0; e < 4; ++e) { const float g = acc[ai][0][m][n][e], up = acc[ai][1][m][n][e]; r[n * 4 + e] = g * __builtin_amdgcn_rcpf(1.f + __expf(-g)) * up; }
                pg8::u32x4 w; w.x = pg8::cvt_pk_bf16(r[0], r[1]); w.y = pg8::cvt_pk_bf16(r[2], r[3]); w.z = pg8::cvt_pk_bf16(r[4], r[5]); w.w = pg8::cvt_pk_bf16(r[6], r[7]);
                *(pg8::u32x4*)rowp = w; }
    }
};

struct EpiSoftmax {
    static constexpr bool PERM = true, AFTER_DRAIN = true;
    bf16* O; int ldc;
    __device__ __forceinline__ void fused(f32x4 (&acc)[2][2][4][2], const pg8::Unit& u, int wr, int wc, int fr, int fq, LAS unsigned char* lds, int wid, int lane) const {
        typedef float f32x2v __attribute__((ext_vector_type(2)));
        constexpr float C2 = 0.0625f * 1.4426950408889634f;
        LAS f32x2v* ST = (LAS f32x2v*)lds;
#pragma unroll
        for (int ai = 0; ai < 2; ++ai)
#pragma unroll
            for (int m = 0; m < 4; ++m) {
                float mx = -INFINITY;
#pragma unroll
                for (int bj = 0; bj < 2; ++bj)
#pragma unroll
                    for (int n = 0; n < 2; ++n) { const f32x4 x = acc[ai][bj][m][n]; mx = fmaxf(mx, fmaxf(fmaxf(x[0], x[1]), fmaxf(x[2], x[3]))); }
                mx = fmaxf(mx, __shfl_xor(mx, 16)); mx = fmaxf(mx, __shfl_xor(mx, 32));
                float sum = 0.f;
#pragma unroll
                for (int bj = 0; bj < 2; ++bj)
#pragma unroll
                    for (int n = 0; n < 2; ++n) { f32x4 x = acc[ai][bj][m][n];
#pragma unroll
                        for (int e = 0; e < 4; ++e) { x[e] = __builtin_amdgcn_exp2f((x[e] - mx) * C2); sum += x[e]; }
                        acc[ai][bj][m][n] = x; }
                sum += __shfl_xor(sum, 16); sum += __shfl_xor(sum, 32);
                if (fq == 0) ST[(ai * 128 + wr * 64 + m * 16 + fr) * 4 + wc] = (f32x2v){mx, sum};
            }
        asm volatile("s_waitcnt lgkmcnt(0)" ::: "memory"); __builtin_amdgcn_s_barrier(); asm volatile("" ::: "memory");
        const int row0 = u.pm * 256 + wr * 64 + fr, col0 = u.pn * 256 + wc * 32 + 8 * fq;
#pragma unroll
        for (int ai = 0; ai < 2; ++ai)
#pragma unroll
            for (int m = 0; m < 4; ++m) {
                const LAS f32x2v* sp = ST + (ai * 128 + wr * 64 + m * 16 + fr) * 4;
                const f32x2v s0 = sp[0], s1 = sp[1], s2 = sp[2], s3 = sp[3];
                const float MX = fmaxf(fmaxf(s0.x, s1.x), fmaxf(s2.x, s3.x));
                const float L = s0.y * __builtin_amdgcn_exp2f((s0.x - MX) * C2) + s1.y * __builtin_amdgcn_exp2f((s1.x - MX) * C2) + s2.y * __builtin_amdgcn_exp2f((s2.x - MX) * C2) + s3.y * __builtin_amdgcn_exp2f((s3.x - MX) * C2);
                const float mine = (wc == 0) ? s0.x : (wc == 1) ? s1.x : (wc == 2) ? s2.x : s3.x;
                const float f = __builtin_amdgcn_exp2f((mine - MX) * C2) / L;
                bf16* rowp = O + (size_t)(row0 + ai * 128 + m * 16) * ldc + col0;
#pragma unroll
                for (int bj = 0; bj < 2; ++bj) { const f32x4 v0 = acc[ai][bj][m][0] * f, v1 = acc[ai][bj][m][1] * f;
                    pg8::u32x4 w; w.x = pg8::cvt_pk_bf16(v0[0], v0[1]); w.y = pg8::cvt_pk_bf16(v0[2], v0[3]); w.z = pg8::cvt_pk_bf16(v1[0], v1[1]); w.w = pg8::cvt_pk_bf16(v1[2], v1[3]);
                    *(pg8::u32x4*)(rowp + bj * 128) = w; }
            }
    }
};
struct OneUnit {
    __device__ __forceinline__ bool next(int i, pg8::Unit& u) const { if (i) return false; u.pm = 0; u.pn = 0; u.aoff = 0; u.boff = 0; return true; }
    __device__ __forceinline__ void a_ready(const pg8::Unit&) const {}
    __device__ __forceinline__ void done(const pg8::Unit&) const {}
};

__device__ __forceinline__ void transpose_item(const float* W, int ld, int K, bf16* WT, int k0, int n0, int drow, LAS float* scr, int lane) {
    LAS unsigned short* t16 = (LAS unsigned short*)scr;
    const int kr = lane >> 3, c4 = lane & 7;
    f32x4 v[8];
#pragma unroll
    for (int i = 0; i < 8; ++i) v[i] = *(const GAS f32x4*)(W + (size_t)(k0 + kr + 8 * i) * ld + n0 + 4 * c4);
#pragma unroll
    for (int i = 0; i < 8; ++i)
#pragma unroll
        for (int j = 0; j < 4; ++j) t16[(4 * c4 + j) * 72 + kr + 8 * i] = (unsigned short)f2bf(v[i][j]);
    LDS_WAIT(); asm volatile("" ::: "memory");
#pragma unroll
    for (int q = 0; q < 4; ++q) { const int n = kr + 8 * q; const v4u o = *(const LAS v4u*)(t16 + n * 72 + 8 * c4);
        *(GAS v4u*)(WT + (size_t)(drow + n) * K + k0 + 8 * c4) = o; }
    LDS_WAIT(); asm volatile("" ::: "memory");
}
__device__ __forceinline__ void p0_convert(Frame& F) {
    relane(F);
    LAS float* scr = (LAS float*)(F.lds + RING_OFF + F.wave * 16384);
    bf16* Wb = (bf16*)(F.ws + WS_W); bf16* Wkv = (bf16*)(F.ws + WS_XWT);
    constexpr int I_IN = 16 * 96, I_OUT = 16 * 32, I_Q = 16 * 32, I_O = 16 * 32, I_KV = 16 * 64, I_GU = 16 * 176, I_DN = 44 * 32;
    constexpr int I_LAYER = I_IN + I_OUT + I_Q + I_O + I_KV + I_GU + I_DN;
    for (int it = F.gw; it < 4 * I_LAYER; it += F.NGW) {
        const int l = it / I_LAYER, j = l >> 1; int r = it % I_LAYER;
        bf16* WL = Wb + (size_t)l * WL_SIZE;
        if (r < I_IN) { const int kb = r / 96, nb = r % 96;
            if (l & 1) transpose_item(inp(F, 8) + (size_t)j * D * 3072, 3072, D, WL + WL_IN, kb * 64, nb * 32, nb * 32, scr, F.lane);
            else       transpose_item(inp(F, 4) + (size_t)j * D * ML_W, ML_W, D, WL + WL_IN, kb * 64, nb * 32, nb * 32, scr, F.lane);
            continue; } r -= I_IN;
        if (r < I_OUT) { const int kb = r / 32, nb = r % 32;
            transpose_item(((l & 1) ? inp(F, 9) : inp(F, 7)) + (size_t)j * D * D, D, D, WL + WL_OUT, kb * 64, nb * 32, nb * 32, scr, F.lane); continue; } r -= I_OUT;
        if (r < I_Q) { const int e0 = r * 2048 + F.lane * 8;
#pragma unroll
            for (int q = 0; q < 4; ++q) { const GAS f32x4* sp = (const GAS f32x4*)(inp(F, 10) + (size_t)l * D * D + e0 + q * 512); const f32x4 x0 = sp[0], x1 = sp[1];
                v4u o; o.x = pk2(x0.x, x0.y); o.y = pk2(x0.z, x0.w); o.z = pk2(x1.x, x1.y); o.w = pk2(x1.z, x1.w); *(GAS v4u*)(WL + WL_QN + e0 + q * 512) = o; }
            continue; } r -= I_Q;
        if (r < I_O) { const int kb = r / 32, nb = r % 32; transpose_item(inp(F, 12) + (size_t)l * D * D, D, D, WL + WL_OT, kb * 64, nb * 32, nb * 32, scr, F.lane); continue; } r -= I_O;
        if (r < I_KV) { const int kb = r / 64, nb = r % 64; transpose_item(inp(F, 11) + (size_t)l * D * 2048, 2048, D, Wkv, kb * 64, nb * 32, l * 2048 + nb * 32, scr, F.lane); continue; } r -= I_KV;
        if (r < I_GU) { const int kb = r / 176, nb = r % 176; const int c0 = nb * 32; const int up = c0 >= DFF, jj = up ? c0 - DFF : c0;
            transpose_item(inp(F, 13) + (size_t)l * D * 2 * DFF, 2 * DFF, D, WL + WL_GU, kb * 64, c0, 256 * (jj >> 7) + 128 * up + (jj & 127), scr, F.lane); continue; } r -= I_GU;
        { const int kb = r / 32, nb = r % 32; transpose_item(inp(F, 14) + (size_t)l * DFF * D, D, DFF, WL + WL_DN, kb * 64, nb * 32, nb * 32, scr, F.lane); }
    }
    bf16* MEMN = (bf16*)(F.ws + WS_MEMN);
    for (int m = F.gw; m < MM; m += F.NGW) {
        const GAS f32x4* xr = (const GAS f32x4*)(inp(F, 1) + (size_t)m * D) + F.lane; const GAS f32x4* gr = (const GAS f32x4*)inp(F, 2) + F.lane;
        f32x4 v[4]; float s = 0.f;
#pragma unroll
        for (int q = 0; q < 4; ++q) { v[q] = xr[64 * q]; s += (v[q].x * v[q].x + v[q].y * v[q].y) + (v[q].z * v[q].z + v[q].w * v[q].w); }
        const float rs = rsqrtf(wave_sum(s) * (1.f / D) + EPS);
        GAS unsigned long long* o8 = (GAS unsigned long long*)(MEMN + (size_t)m * D) + F.lane;
#pragma unroll
        for (int q = 0; q < 4; ++q) { const f32x4 g = gr[64 * q]; o8[64 * q] = (unsigned long long)pk2(v[q].x * rs * g.x, v[q].y * rs * g.y) | ((unsigned long long)pk2(v[q].z * rs * g.z, v[q].w * rs * g.w) << 32); }
    }
}

__device__ __forceinline__ void row_phase(Frame& F, const float* xin, float* xout, const bf16* Y, const float* ga, const float* gb, bf16* XN, const float* WG, int wgs, const float* bg, float* GT) {
    relane(F);
    constexpr int NR = 4;
    for (int m0 = F.gw; m0 < M; m0 += NR * F.NGW) {
        f32x4 v[NR][4]; unsigned long long yw[NR][4];
#pragma unroll
        for (int k = 0; k < NR; ++k) { const int m = m0 + k * F.NGW;
            if (m < M) { const GAS f32x4* xr = (const GAS f32x4*)(xin + (size_t)m * D) + F.lane;
#pragma unroll
                for (int q = 0; q < 4; ++q) v[k][q] = xr[64 * q];
                if (Y) { const GAS unsigned long long* yr = (const GAS unsigned long long*)(Y + (size_t)m * D) + F.lane;
#pragma unroll
                    for (int q = 0; q < 4; ++q) yw[k][q] = yr[64 * q]; } } }
#pragma unroll
        for (int k = 0; k < NR; ++k) { const int m = m0 + k * F.NGW;
            if (m >= M) break;
            if (Y) {
                f32x4 y[4]; float s = 0.f;
#pragma unroll
                for (int q = 0; q < 4; ++q) { const unsigned lo = (unsigned)yw[k][q], hi = (unsigned)(yw[k][q] >> 32);
                    y[q] = (f32x4){bflo(lo), bfhi(lo), bflo(hi), bfhi(hi)}; s += (y[q].x * y[q].x + y[q].y * y[q].y) + (y[q].z * y[q].z + y[q].w * y[q].w); }
                const float rs = rsqrtf(wave_sum(s) * (1.f / D) + EPS);
                const GAS f32x4* gr = (const GAS f32x4*)ga + F.lane;
#pragma unroll
                for (int q = 0; q < 4; ++q) { const f32x4 g = gr[64 * q]; v[k][q] = v[k][q] + y[q] * rs * g; }
            }
            if (Y || xin != xout) { GAS f32x4* xo = (GAS f32x4*)(xout + (size_t)m * D) + F.lane;
#pragma unroll
                for (int q = 0; q < 4; ++q) xo[64 * q] = v[k][q]; }
            if (gb) {
                float s = 0.f;
#pragma unroll
                for (int q = 0; q < 4; ++q) s += (v[k][q].x * v[k][q].x + v[k][q].y * v[k][q].y) + (v[k][q].z * v[k][q].z + v[k][q].w * v[k][q].w);
                const float rs = rsqrtf(wave_sum(s) * (1.f / D) + EPS);
                const GAS f32x4* gr = (const GAS f32x4*)gb + F.lane;
                GAS unsigned long long* o8 = (GAS unsigned long long*)(XN + (size_t)m * D) + F.lane;
#pragma unroll
                for (int q = 0; q < 4; ++q) { const f32x4 g = gr[64 * q]; v[k][q] = v[k][q] * rs * g; o8[64 * q] = (unsigned long long)pk2(v[k][q].x, v[k][q].y) | ((unsigned long long)pk2(v[k][q].z, v[k][q].w) << 32); }
                if (WG) {
                    float acc[8];
#pragma unroll
                    for (int c = 0; c < 8; ++c) acc[c] = 0.f;
#pragma unroll
                    for (int q = 0; q < 4; ++q)
#pragma unroll
                        for (int e = 0; e < 4; ++e) { const GAS f32x4* w = (const GAS f32x4*)(WG + (size_t)(4 * F.lane + 256 * q + e) * wgs); const f32x4 w0 = w[0], w1 = w[1]; const float h = v[k][q][e];
                            acc[0] += h * w0.x; acc[1] += h * w0.y; acc[2] += h * w0.z; acc[3] += h * w0.w; acc[4] += h * w1.x; acc[5] += h * w1.y; acc[6] += h * w1.z; acc[7] += h * w1.w; }
#pragma unroll
                    for (int c = 0; c < 8; ++c) acc[c] = wave_sum(acc[c]);
                    if (F.lane < 8) {
                        float a = 0.f;
#pragma unroll
                        for (int c = 0; c < 8; ++c) a = (F.lane == c) ? acc[c] : a;
                        a = 15.f * tanhf((a + bg[F.lane]) * (1.f / 15.f));
                        if (F.lane >= 4) a = -softplusf(-a);
                        GT[(size_t)m * 8 + F.lane] = a;
                    }
                }
            }
        }
    }
}

namespace sbk {
typedef float f32x16 __attribute__((ext_vector_type(16)));
typedef short s16x4 __attribute__((ext_vector_type(4)));
typedef short v4i16_t __attribute__((ext_vector_type(4)));
__device__ __forceinline__ unsigned cvtpk(float lo, float hi) { typedef float f32x2_t __attribute__((ext_vector_type(2))); typedef __bf16 bf16x2_t __attribute__((ext_vector_type(2)));
    f32x2_t v = {lo, hi}; bf16x2_t b = __builtin_convertvector(v, bf16x2_t); return __builtin_bit_cast(unsigned, b); }
#define SB_MFMA(a, b, c) __builtin_amdgcn_mfma_f32_32x32x16_bf16((a), (b), (c), 0, 0, 0)
constexpr int KB0 = 0, VB0 = 16384;
constexpr float C2 = 0.125f * 1.4426950408889634f;

template <bool MASK>
__device__ __forceinline__ void tile(LAS unsigned char* kb, LAS unsigned char* vb, const bf16x8 (&qr)[4], f32x16 (&o)[2], float& carry, int nv, int lane, int r, int hh, const bf16x8 (&TRI)[2], const bf16x8 ONES) {
    f32x16 e[2];
    {   f32x16 p0, p1;
#pragma unroll
        for (int i = 0; i < 16; ++i) { p0[i] = 0.f; p1[i] = 0.f; }
#pragma unroll
        for (int ks = 0; ks < 4; ++ks) {
            const bf16x8 k0 = *(const LAS bf16x8*)(kb + r * 128 + (((2 * ks + hh) ^ (r & 7)) << 4));
            const bf16x8 k1 = *(const LAS bf16x8*)(kb + (r + 32) * 128 + (((2 * ks + hh) ^ (r & 7)) << 4));
            p0 = SB_MFMA(k0, qr[ks], p0); p1 = SB_MFMA(k1, qr[ks], p1);
        }
        e[0] = p0; e[1] = p1;
    }
    v4u Lhi[2][2], Llo[2][2];
    float sv = 0.f;
#pragma unroll
    for (int ib = 0; ib < 2; ++ib)
#pragma unroll
        for (int i = 0; i < 16; i += 2) {
            float L[2];
#pragma unroll
            for (int u = 0; u < 2; ++u) {
                const float w = e[ib][i + u] * C2;
                const float sp = fmaxf(w, 0.f) + __builtin_amdgcn_logf(1.f + __builtin_amdgcn_exp2f(-fabsf(w)));
                float Lm = -sp;
                if (MASK) { const int ci = ((i + u) & 3) + 8 * ((i + u) >> 2) + 32 * ib; Lm = (ci < nv) ? Lm : 0.f; }
                const float E = w - sp;
                if (ib == 0 && i + u == 0) sv = E - Lm;
                e[ib][i + u] = E + carry;
                L[u] = Lm;
            }
            const unsigned hw = cvtpk(L[0], L[1]);
            const unsigned lw = cvtpk(L[0] - bflo(hw), L[1] - bfhi(hw));
            const int ks2 = i >> 3, m = (i & 7) >> 1;
            Lhi[ib][ks2][m] = hw; Llo[ib][ks2][m] = lw;
        }
#define SB_F(x) __builtin_bit_cast(bf16x8, x)
    e[0] = SB_MFMA(TRI[0], SB_F(Lhi[0][0]), e[0]); e[0] = SB_MFMA(TRI[1], SB_F(Lhi[0][1]), e[0]);
    e[1] = SB_MFMA(TRI[0], SB_F(Lhi[1][0]), e[1]); e[1] = SB_MFMA(TRI[1], SB_F(Lhi[1][1]), e[1]);
    e[0] = SB_MFMA(ONES, SB_F(Lhi[1][0]), e[0]); e[0] = SB_MFMA(ONES, SB_F(Lhi[1][1]), e[0]);
    e[0] = SB_MFMA(TRI[0], SB_F(Llo[0][0]), e[0]); e[0] = SB_MFMA(TRI[1], SB_F(Llo[0][1]), e[0]);
    e[1] = SB_MFMA(TRI[0], SB_F(Llo[1][0]), e[1]); e[1] = SB_MFMA(TRI[1], SB_F(Llo[1][1]), e[1]);
    e[0] = SB_MFMA(ONES, SB_F(Llo[1][0]), e[0]); e[0] = SB_MFMA(ONES, SB_F(Llo[1][1]), e[0]);
    carry = __shfl(e[0][0] - sv, r);
    v4u pa[2][2];
#pragma unroll
    for (int ib = 0; ib < 2; ++ib)
#pragma unroll
        for (int i = 0; i < 16; i += 2) {
            float a[2];
#pragma unroll
            for (int u = 0; u < 2; ++u) {
                a[u] = __builtin_amdgcn_exp2f(e[ib][i + u]);
                if (MASK) { const int ci = ((i + u) & 3) + 8 * ((i + u) >> 2) + 32 * ib; a[u] = (ci < nv) ? a[u] : 0.f; }
            }
            pa[ib][i >> 3][(i & 7) >> 1] = cvtpk(a[0], a[1]);
        }
    const int q4 = (lane & 15) >> 2, p4 = lane & 3, g1 = (lane >> 4) & 1;
    LAS unsigned char* vl = vb + (4 * hh + q4) * 128 + (16 * g1 + 4 * p4) * 2;
#pragma unroll
    for (int ib = 0; ib < 2; ++ib)
#pragma unroll
        for (int ks2 = 0; ks2 < 2; ++ks2)
#pragma unroll
            for (int db = 0; db < 2; ++db) {
                LAS unsigned char* pv = vl + (32 * ib + 16 * ks2) * 128 + db * 64;
                const s16x4 lo = __builtin_bit_cast(s16x4, __builtin_amdgcn_ds_read_tr16_b64_v4i16((LAS v4i16_t*)pv));
                const s16x4 hi = __builtin_bit_cast(s16x4, __builtin_amdgcn_ds_read_tr16_b64_v4i16((LAS v4i16_t*)(pv + 8 * 128)));
                const bf16x8 vf = __builtin_shufflevector(lo, hi, 0, 1, 2, 3, 4, 5, 6, 7);
                o[db] = SB_MFMA(SB_F(pa[ib][ks2]), vf, o[db]);
            }
#undef SB_F
}

__device__ __forceinline__ void unit(int b, int h, int qb, const bf16* QKV, bf16* MIX, LAS unsigned char* lds, int tid) {
    const int lane = tid & 63, r = lane & 31, hh = lane >> 5, wid = __builtin_amdgcn_readfirstlane(tid >> 6);
    const size_t rowbase = (size_t)b * SEQ; const int q0 = qb * 256, trow = q0 + 32 * wid + r;
    bf16x8 qr[4];
#pragma unroll
    for (int ks = 0; ks < 4; ++ks) qr[ks] = *(const GAS bf16x8*)(QKV + (rowbase + trow) * 3072 + h * 64 + ks * 16 + hh * 8);
    bf16x8 TRI[2], ONES;
#pragma unroll
    for (int ks2 = 0; ks2 < 2; ++ks2)
#pragma unroll
        for (int j = 0; j < 8; ++j) TRI[ks2][j] = ((16 * ks2 + 8 * (j >> 2) + 4 * hh + (j & 3)) > r) ? (short)0x3F80 : (short)0;
#pragma unroll
    for (int j = 0; j < 8; ++j) ONES[j] = (short)0x3F80;
    const int srow = tid >> 3, sc = tid & 7;
    const bf16* kg = QKV + rowbase * 3072 + 1024 + h * 64 + (size_t)srow * 3072 + sc * 8;
    const int kdst = srow * 128 + ((sc ^ (srow & 7)) << 4), vdst = srow * 128 + sc * 16;
    const int NT = 4 * qb + 4;
    { const bf16* p = kg + (size_t)(NT - 1) * 64 * 3072; const v4u kx = *(const GAS v4u*)p, vx = *(const GAS v4u*)(p + 1024);
      *(LAS v4u*)(lds + KB0 + kdst) = kx; *(LAS v4u*)(lds + VB0 + vdst) = vx; }
    __syncthreads();
    f32x16 o[2];
#pragma unroll
    for (int i = 0; i < 16; ++i) { o[0][i] = 0.f; o[1][i] = 0.f; }
    float carry = 0.f;
    const int wmax = q0 + 32 * wid + 31, wmin = q0 + 32 * wid;
    for (int kt = NT - 1; kt >= 0; --kt) {
        const int cur = (NT - 1 - kt) & 1;
        v4u kx, vx;
        if (kt > 0) { const bf16* p = kg + (size_t)(kt - 1) * 64 * 3072; kx = *(const GAS v4u*)p; vx = *(const GAS v4u*)(p + 1024); }
        if (64 * kt < wmax) {
            const int nv = trow - 64 * kt - 4 * hh;
            if (64 * kt + 63 >= wmin) tile<true>(lds + KB0 + cur * 8192, lds + VB0 + cur * 8192, qr, o, carry, nv, lane, r, hh, TRI, ONES);
            else tile<false>(lds + KB0 + cur * 8192, lds + VB0 + cur * 8192, qr, o, carry, nv, lane, r, hh, TRI, ONES);
        }
        if (kt > 0) { *(LAS v4u*)(lds + KB0 + (cur ^ 1) * 8192 + kdst) = kx; *(LAS v4u*)(lds + VB0 + (cur ^ 1) * 8192 + vdst) = vx; }
        __syncthreads();
    }
    unsigned short* op = (unsigned short*)MIX + (rowbase + q0 + 32 * wid) * D + h * 64 + r;
#pragma unroll
    for (int db = 0; db < 2; ++db)
#pragma unroll
        for (int i = 0; i < 16; ++i) { const int row = (i & 3) + 8 * (i >> 2) + 4 * hh; ((GAS unsigned short*)op)[(size_t)row * D + 32 * db] = (unsigned short)f2bf(o[db][i]); }
}
#undef SB_MFMA
}
__device__ __forceinline__ void sb_attn_v2(Frame& F, const bf16* QKV, bf16* MIX) {
    relane(F);
    for (int v = blockIdx.x; v < 256; v += F.G) {
        const int bh = v >> 1, sel = v & 1;
#pragma unroll 1
        for (int u = 0; u < 4; ++u) {
            const int qb = sel ? ((u == 0) ? 6 : (u == 1) ? 1 : (u == 2) ? 4 : 3) : ((u == 0) ? 7 : (u == 1) ? 0 : (u == 2) ? 5 : 2);
            sbk::unit(bh >> 4, bh & 15, qb, QKV, MIX, F.lds + RING_OFF, F.tid);
        }
    }
}

namespace mlk {
typedef float f32x16 __attribute__((ext_vector_type(16)));
typedef short s16x4 __attribute__((ext_vector_type(4)));
typedef short v4i16_t __attribute__((ext_vector_type(4)));
#define ML_MFMA(a, b, c) __builtin_amdgcn_mfma_f32_32x32x16_bf16((a), (b), (c), 0, 0, 0)
__device__ __forceinline__ bf16x8 trpair(LAS unsigned char* p, int rowbytes4) {
    const s16x4 lo = __builtin_bit_cast(s16x4, __builtin_amdgcn_ds_read_tr16_b64_v4i16((LAS v4i16_t*)p));
    const s16x4 hi = __builtin_bit_cast(s16x4, __builtin_amdgcn_ds_read_tr16_b64_v4i16((LAS v4i16_t*)(p + rowbytes4)));
    return __builtin_shufflevector(lo, hi, 0, 1, 2, 3, 4, 5, 6, 7);
}
__device__ __forceinline__ float scan_add(float v, int lane) {
#pragma unroll
    for (int o = 1; o < 64; o <<= 1) { const float y = __shfl_up(v, o); if (lane >= o) v += y; }
    return v;
}
__device__ __forceinline__ float scan_max(float v, int lane) {
#pragma unroll
    for (int o = 1; o < 64; o <<= 1) { const float y = __shfl_up(v, o); if (lane >= o) v = fmaxf(v, y); }
    return v;
}
__device__ __forceinline__ void scale8(const v4u in, float w, v4u& out) {
    out.x = pk2(bflo(in.x) * w, bfhi(in.x) * w); out.y = pk2(bflo(in.y) * w, bfhi(in.y) * w); out.z = pk2(bflo(in.z) * w, bfhi(in.z) * w); out.w = pk2(bflo(in.w) * w, bfhi(in.w) * w);
}
constexpr float KSC = 0.08838834764831845f;

__device__ __forceinline__ void phaseA(Frame& F, const bf16* PROJ, const float* GT, bf16* ST, float* NST, float* SCAL) {
    relane(F);
    const int tid = F.tid, lane = F.lane, wv = F.wave, r = lane & 31, hh = lane >> 5, q4 = (lane & 15) >> 2, p4 = lane & 3, g1 = (lane >> 4) & 1;
    LAS unsigned char* KW = F.lds + RING_OFF; LAS unsigned char* VT = KW + 16384; LAS float* wk = (LAS float*)(KW + 49152);
    bf16x8 ONES;
#pragma unroll
    for (int j = 0; j < 8; ++j) ONES[j] = (short)0x3F80;
    for (int unit = blockIdx.x; unit < 1024; unit += F.G) {
        const int bh = unit >> 5, c = unit & 31, b = bh >> 2, h = bh & 3; const size_t row0 = (size_t)b * SEQ + c * 64;
        if (wv == 0) {
            const float lf = GT[(row0 + lane) * 8 + 4 + h], ig = GT[(row0 + lane) * 8 + h];
            const float bc = scan_add(lf, lane), bl = __shfl(bc, 63), g = bl - bc + ig, ml = wave_max(g);
            wk[lane] = __expf(g - ml) * KSC;
            if (lane == 0) { SCAL[unit * 2] = bl; SCAL[unit * 2 + 1] = ml; }
        }
        __syncthreads();
        { const int row = tid >> 3, c8 = tid & 7; const bf16* kp = PROJ + (row0 + row) * 3072 + 512 + h * 128 + c8 * 16;
          const v4u k0 = *(const GAS v4u*)kp, k1 = *(const GAS v4u*)(kp + 8); const bf16* vp = kp + 512 + h * 128 + c8 * 16;
          const v4u v0 = *(const GAS v4u*)vp, v1 = *(const GAS v4u*)(vp + 8), v2 = *(const GAS v4u*)(vp + 16), v3 = *(const GAS v4u*)(vp + 24);
          const float w = wk[row]; v4u o0, o1; scale8(k0, w, o0); scale8(k1, w, o1);
          *(LAS v4u*)(KW + row * 256 + c8 * 32) = o0; *(LAS v4u*)(KW + row * 256 + c8 * 32 + 16) = o1;
          LAS v4u* vd = (LAS v4u*)(VT + row * 512 + c8 * 64); vd[0] = v0; vd[1] = v1; vd[2] = v2; vd[3] = v3; }
        __syncthreads();
        f32x16 acc[4], nacc[4];
#pragma unroll
        for (int cb = 0; cb < 4; ++cb)
#pragma unroll
            for (int i = 0; i < 16; ++i) { acc[cb][i] = 0.f; nacc[cb][i] = 0.f; }
#pragma unroll
        for (int ks = 0; ks < 4; ++ks) {
            const bf16x8 af = trpair(VT + (16 * ks + 8 * hh + q4) * 512 + (32 * wv + 16 * g1 + 4 * p4) * 2, 4 * 512);
#pragma unroll
            for (int cb = 0; cb < 4; ++cb) {
                const bf16x8 bfr = trpair(KW + (16 * ks + 8 * hh + q4) * 256 + (32 * cb + 16 * g1 + 4 * p4) * 2, 4 * 256);
                acc[cb] = ML_MFMA(af, bfr, acc[cb]);
                if (wv == 0) nacc[cb] = ML_MFMA(ONES, bfr, nacc[cb]);
            }
        }
        GAS unsigned short* sp = (GAS unsigned short*)ST + (size_t)unit * 32768 + (size_t)(32 * wv) * 128 + r;
#pragma unroll
        for (int cb = 0; cb < 4; ++cb)
#pragma unroll
            for (int i = 0; i < 16; ++i) sp[((i & 3) + 8 * (i >> 2) + 4 * hh) * 128 + 32 * cb] = (unsigned short)f2bf(acc[cb][i]);
        if (wv == 0 && hh == 0) {
#pragma unroll
            for (int cb = 0; cb < 4; ++cb) NST[(size_t)unit * 128 + 32 * cb + r] = nacc[cb][0];
        }
        __syncthreads();
    }
}
__device__ __forceinline__ void phaseB(Frame& F, bf16* ST, float* NST, const float* SCAL, float* MPREV) {
    relane(F);
    for (int task = blockIdx.x * 512 + F.tid; task < 32 * 4096; task += F.G * 512) {
        const int bh = task >> 12, e0 = (task & 4095) * 8;
        float C[8], m = 0.f;
#pragma unroll
        for (int i = 0; i < 8; ++i) C[i] = 0.f;
        GAS v4u* p = (GAS v4u*)(ST + (size_t)bh * 32 * 32768 + e0);
        const float* sc = SCAL + (size_t)bh * 64;
#pragma unroll 4
        for (int c = 0; c < 32; ++c) {
            const v4u d = p[(size_t)c * 4096];
            const float bl = sc[2 * c], ml = sc[2 * c + 1], mn = fmaxf(bl + m, ml), dec = __expf(bl + m - mn), s = __expf(ml - mn);
            v4u o; o.x = pk2(C[0], C[1]); o.y = pk2(C[2], C[3]); o.z = pk2(C[4], C[5]); o.w = pk2(C[6], C[7]);
            p[(size_t)c * 4096] = o;
            if ((task & 4095) == 0) MPREV[bh * 32 + c] = m;
            C[0] = dec * C[0] + s * bflo(d.x); C[1] = dec * C[1] + s * bfhi(d.x); C[2] = dec * C[2] + s * bflo(d.y); C[3] = dec * C[3] + s * bfhi(d.y);
            C[4] = dec * C[4] + s * bflo(d.z); C[5] = dec * C[5] + s * bfhi(d.z); C[6] = dec * C[6] + s * bflo(d.w); C[7] = dec * C[7] + s * bfhi(d.w);
            m = mn;
        }
    }
    for (int task = blockIdx.x * 512 + F.tid; task < 32 * 128; task += F.G * 512) {
        const int bh = task >> 7, e = task & 127;
        float n = 0.f, m = 0.f; float* p = NST + (size_t)bh * 32 * 128 + e; const float* sc = SCAL + (size_t)bh * 64;
        for (int c = 0; c < 32; ++c) {
            const float d = p[c * 128], bl = sc[2 * c], ml = sc[2 * c + 1], mn = fmaxf(bl + m, ml);
            p[c * 128] = n; n = __expf(bl + m - mn) * n + __expf(ml - mn) * d; m = mn;
        }
    }
}
__device__ __forceinline__ void phaseC(Frame& F, bf16* PROJ, const float* GT, const bf16* ST, const float* NST, const float* MPREV, const float* hgain) {
    relane(F);
    const int tid = F.tid, lane = F.lane, wv = F.wave, r = lane & 31, hh = lane >> 5, q4 = (lane & 15) >> 2, p4 = lane & 3, g1 = (lane >> 4) & 1;
    LAS unsigned char* KT = F.lds + RING_OFF; LAS unsigned char* QT = KT + 16384; LAS unsigned char* VT = KT + 32768; LAS unsigned char* SD = KT + 65536;
    LAS float* sm = (LAS float*)(KT + 73728);
    LAS float* aa = sm; LAS float* ct2 = sm + 64; LAS float* inter = sm + 128; LAS float* emt = sm + 192; LAS float* nq = sm + 256; LAS float* npv = sm + 320; LAS float* densum = sm + 448; LAS float* ssq = sm + 576;
    LAS unsigned char* HT = KT;
    for (int unit = blockIdx.x; unit < 1024; unit += F.G) {
        const int bh = unit >> 5, c = unit & 31, b = bh >> 2, h = bh & 3; const size_t row0 = (size_t)b * SEQ + c * 64;
        { const int row = tid >> 3, c8 = tid & 7; const bf16* qp = PROJ + (row0 + row) * 3072 + h * 128 + c8 * 16;
          const v4u q0 = *(const GAS v4u*)qp, q1 = *(const GAS v4u*)(qp + 8), k0 = *(const GAS v4u*)(qp + 512), k1 = *(const GAS v4u*)(qp + 520);
          const bf16* vp = PROJ + (row0 + row) * 3072 + 1024 + h * 256 + c8 * 32;
          const v4u v0 = *(const GAS v4u*)vp, v1 = *(const GAS v4u*)(vp + 8), v2 = *(const GAS v4u*)(vp + 16), v3 = *(const GAS v4u*)(vp + 24);
          const int sw0 = ((2 * c8) ^ (row & 15)) << 4, sw1 = ((2 * c8 + 1) ^ (row & 15)) << 4;
          *(LAS v4u*)(QT + row * 256 + sw0) = q0; *(LAS v4u*)(QT + row * 256 + sw1) = q1; *(LAS v4u*)(KT + row * 256 + sw0) = k0; *(LAS v4u*)(KT + row * 256 + sw1) = k1;
          LAS v4u* vd = (LAS v4u*)(VT + row * 512 + c8 * 64); vd[0] = v0; vd[1] = v1; vd[2] = v2; vd[3] = v3; }
        const float mprev = MPREV[unit];
        if (wv == 0) {
            const float lf = GT[(row0 + lane) * 8 + 4 + h], ig = GT[(row0 + lane) * 8 + h];
            const float bc = scan_add(lf, lane), a = ig - bc, pm = scan_max(a, lane), ctv = -fmaxf(pm, mprev);
            aa[lane] = a; ct2[lane] = ctv - 2.4260151319598084f  ; inter[lane] = __expf(mprev + ctv); emt[lane] = __expf(ctv - bc);
        } else if (wv == 1) { npv[lane] = NST[(size_t)unit * 128 + lane]; npv[lane + 64] = NST[(size_t)unit * 128 + 64 + lane]; }
        bf16x8 cf[8];
        { const bf16* cp = ST + (size_t)unit * 32768 + (size_t)(32 * wv + r) * 128 + 8 * hh;
#pragma unroll
          for (int ks = 0; ks < 8; ++ks) cf[ks] = *(const GAS bf16x8*)(cp + 16 * ks); }
        __syncthreads();
        if (wv < 4) {
            const int sb = wv & 1, tb = wv >> 1, srow = 32 * sb + r, trow = 32 * tb + r;
            f32x16 s;
#pragma unroll
            for (int i = 0; i < 16; ++i) s[i] = 0.f;
#pragma unroll
            for (int ks = 0; ks < 8; ++ks) {
                const bf16x8 kf = *(const LAS bf16x8*)(KT + srow * 256 + (((2 * ks + hh) ^ (srow & 15)) << 4));
                const bf16x8 qf = *(const LAS bf16x8*)(QT + trow * 256 + (((2 * ks + hh) ^ (trow & 15)) << 4));
                s = ML_MFMA(kf, qf, s);
            }
            const float ctl = ct2[trow]; float dsum = 0.f;
#pragma unroll
            for (int g = 0; g < 4; ++g) {
                float v[4];
#pragma unroll
                for (int u = 0; u < 4; ++u) { const int sidx = 32 * sb + 8 * g + 4 * hh + u; const float d = __expf(aa[sidx] + ctl); v[u] = (sidx <= trow) ? s[4 * g + u] * d : 0.f; dsum += v[u]; }
                const unsigned long long w = (unsigned long long)pk2(v[0], v[1]) | ((unsigned long long)pk2(v[2], v[3]) << 32);
                *(LAS unsigned long long*)(SD + trow * 128 + (((4 * sb + g) ^ (trow & 7)) << 4) + hh * 8) = w;
            }
            dsum += __shfl_xor(dsum, 32);
            if (hh == 0) densum[sb * 64 + trow] = dsum;
        } else if (wv == 4) {
            float a = 0.f;
#pragma unroll
            for (int ch = 0; ch < 16; ++ch) { const v4u qw = *(const LAS v4u*)(QT + lane * 256 + ((ch ^ (lane & 15)) << 4)); const LAS float* np = npv + 8 * ch;
                a += np[0] * bflo(qw.x) + np[1] * bfhi(qw.x) + np[2] * bflo(qw.y) + np[3] * bfhi(qw.y) + np[4] * bflo(qw.z) + np[5] * bfhi(qw.z) + np[6] * bflo(qw.w) + np[7] * bfhi(qw.w); }
            nq[lane] = a;
        }
        __syncthreads();
        f32x16 hv[2];
        {   f32x16 accA[2], accB[2];
#pragma unroll
            for (int tb = 0; tb < 2; ++tb)
#pragma unroll
                for (int i = 0; i < 16; ++i) { accA[tb][i] = 0.f; accB[tb][i] = 0.f; }
#pragma unroll
            for (int ks = 0; ks < 4; ++ks) {
                const bf16x8 af = trpair(VT + (16 * ks + 8 * hh + q4) * 512 + (32 * wv + 16 * g1 + 4 * p4) * 2, 4 * 512);
#pragma unroll
                for (int tb = 0; tb < 2; ++tb) { const int trow = 32 * tb + r;
                    const bf16x8 sf = *(const LAS bf16x8*)(SD + trow * 128 + (((2 * ks + hh) ^ (trow & 7)) << 4));
                    accA[tb] = ML_MFMA(af, sf, accA[tb]); }
            }
#pragma unroll
            for (int ks = 0; ks < 8; ++ks)
#pragma unroll
                for (int tb = 0; tb < 2; ++tb) { const int trow = 32 * tb + r;
                    const bf16x8 qf = *(const LAS bf16x8*)(QT + trow * 256 + (((2 * ks + hh) ^ (trow & 15)) << 4));
                    accB[tb] = ML_MFMA(cf[ks], qf, accB[tb]); }
#pragma unroll
            for (int tb = 0; tb < 2; ++tb) { const int trow = 32 * tb + r;
                const float it = inter[trow], den = densum[trow] + densum[64 + trow] + it * nq[trow], rinv = 1.f / fmaxf(fabsf(den), emt[trow]);
                float q = 0.f;
#pragma unroll
                for (int i = 0; i < 16; ++i) { const float x = (accA[tb][i] + it * accB[tb][i]) * rinv; hv[tb][i] = x; q += x * x; }
                q += __shfl_xor(q, 32);
                if (hh == 0) ssq[wv * 64 + trow] = q; }
        }
        __syncthreads();
#pragma unroll
        for (int tb = 0; tb < 2; ++tb)
#pragma unroll
            for (int g = 0; g < 4; ++g) *(LAS f32x4*)(HT + (32 * tb + r) * 1040 + (32 * wv + 8 * g + 4 * hh) * 4) = (f32x4){hv[tb][4 * g], hv[tb][4 * g + 1], hv[tb][4 * g + 2], hv[tb][4 * g + 3]};
        __syncthreads();
        { const int t = tid >> 3, c8 = tid & 7; float sq = 0.f;
#pragma unroll
          for (int w = 0; w < 8; ++w) sq += ssq[w * 64 + t];
          const float rs = rsqrtf(sq * (1.f / 256.f) + EPS);
          bf16* orow = PROJ + (row0 + t) * 3072 + 1024 + h * 256 + c8 * 32;
#pragma unroll
          for (int q = 0; q < 4; ++q) {
              const f32x4 h0 = *(const LAS f32x4*)(HT + t * 1040 + (32 * c8 + 8 * q) * 4), h1 = *(const LAS f32x4*)(HT + t * 1040 + (32 * c8 + 8 * q + 4) * 4);
              const v4u og = *(const GAS v4u*)(orow + 1024 + 8 * q);
              const f32x4 g0 = *(const GAS f32x4*)(hgain + h * 256 + c8 * 32 + 8 * q), g1v = *(const GAS f32x4*)(hgain + h * 256 + c8 * 32 + 8 * q + 4);
              float y[8];
              y[0] = h0[0] * rs * g0[0] / (1.f + __expf(-bflo(og.x))); y[1] = h0[1] * rs * g0[1] / (1.f + __expf(-bfhi(og.x)));
              y[2] = h0[2] * rs * g0[2] / (1.f + __expf(-bflo(og.y))); y[3] = h0[3] * rs * g0[3] / (1.f + __expf(-bfhi(og.y)));
              y[4] = h1[0] * rs * g1v[0] / (1.f + __expf(-bflo(og.z))); y[5] = h1[1] * rs * g1v[1] / (1.f + __expf(-bfhi(og.z)));
              y[6] = h1[2] * rs * g1v[2] / (1.f + __expf(-bflo(og.w))); y[7] = h1[3] * rs * g1v[3] / (1.f + __expf(-bfhi(og.w)));
              v4u o; o.x = pk2(y[0], y[1]); o.y = pk2(y[2], y[3]); o.z = pk2(y[4], y[5]); o.w = pk2(y[6], y[7]);
              *(GAS v4u*)(orow + 8 * q) = o; } }
        __syncthreads();
    }
}
#undef ML_MFMA
}

template <int MR, int N, int K, bool ALIGN, class Epi> __device__ __forceinline__ void run_gemm(Frame& F, const bf16* A, int lda, const bf16* Bt, int ldb, int pmb, size_t b_batch, const Epi E) {
    int gd = gridDim.x, bi = blockIdx.x; asm volatile("" : "+s"(gd), "+s"(bi));
    pg8::Gemm g{A, Bt, MR, N, K, lda, ldb}; pg8::StaticOrder S; S.init(MR, N, gd, bi, lda, ldb, pmb, b_batch);
    pg8::gemm_phase<Epi, pg8::StaticOrder, ALIGN, true>(F.lds + RING_OFF, g, S, E);
}
__device__ __forceinline__ void xw_gemms(Frame& F, const bf16* KVl, const bf16* WQN, const bf16* WOT, bf16* XWTp) {
    int gd = gridDim.x, bi = blockIdx.x; asm volatile("" : "+s"(gd), "+s"(bi));
    for (int L = bi; L < 256; L += gd) {
        const int idx = L & 127, b = idx >> 4, h = (idx >> 2) & 3, t = idx & 3;
        OneUnit S; int kk = 256; asm volatile("" : "+s"(kk));
        if (L < 128) {
            pg8::Gemm g{KVl + (size_t)(b * NMEM) * 8192 + h * 256, WQN + (size_t)(t * 256) * D + h * 256, 256, 256, kk, 8192, D};
            EpiStore E{XWTp + (size_t)b * D * D + (size_t)(h * 256) * D + t * 256, D};
            pg8::gemm_phase<EpiStore, OneUnit, true, true>(F.lds + RING_OFF, g, S, E);
        } else {
            pg8::Gemm g{WOT + (size_t)(t * 256) * D + h * 256, KVl + (size_t)(b * NMEM) * 8192 + 1024 + h * 256, 256, 256, kk, D, 8192};
            EpiStore E{XWTp + (size_t)(8 + b) * D * D + (size_t)(t * 256) * D + h * 256, D};
            pg8::gemm_phase<EpiStore, OneUnit, true, true>(F.lds + RING_OFF, g, S, E);
        }
    }
}
struct Args { const float* in[15]; float* out; unsigned char* ws; int pad[2]; };
__global__ void __launch_bounds__(NWAVES * 64, 2) mega_fwd(Args args) {
    extern __shared__ __attribute__((aligned(16))) unsigned char lds[];
    Frame F;
    F.lds = (LAS unsigned char*)lds; F.ws = args.ws;
    relane(F);
    for (int u = F.tid; u < (LDS_BYTES - LDSCTL_OFF) / 4; u += NWAVES * 64) ((LAS unsigned*)(F.lds + LDSCTL_OFF))[u] = 0u;
    __syncthreads();
    if (F.tid < 16) { const unsigned long long p = (F.tid < 15) ? (unsigned long long)args.in[F.tid < 15 ? F.tid : 0] : (unsigned long long)args.out;
        ((LAS unsigned*)(F.lds + LDSCTL_OFF))[2 * F.tid] = (unsigned)p; ((LAS unsigned*)(F.lds + LDSCTL_OFF))[2 * F.tid + 1] = (unsigned)(p >> 32); }
    __syncthreads();
    gu32* ctl = (gu32*)(F.ws + WS_CTL);
    XcdBarrier bar = xcd_barrier_post((unsigned*)(ctl + CW_BAR), (volatile LAS unsigned*)(F.lds + MISC_OFF) + 8);
#define GRID_BAR() xcd_barrier(bar)
#ifndef PROBE_CAT
#define PROBE_CAT 0
#endif
#define TPROBE ((volatile LAS unsigned long long*)(F.lds + MISC_OFF + 64))
#define GBAR(cat) do { xcd_barrier(bar); if (PROBE_CAT != 0 && blockIdx.x == 0 && threadIdx.x == 0) { const unsigned long long now_ = rt(); if ((cat) == PROBE_CAT) TPROBE[1] += now_ - TPROBE[0]; TPROBE[0] = now_; } } while (0)

#define Wb ((bf16*)(F.ws + WS_W))
#define XWT ((bf16*)(F.ws + WS_XWT))
#define XN ((bf16*)(F.ws + WS_XN))
#define MIX ((bf16*)(F.ws + WS_MIX))
#define BIG ((bf16*)(F.ws + WS_BIG))
#define PB (BIG + (size_t)M * D)
#define KV ((bf16*)(F.ws + WS_KV))
#define MEMN ((bf16*)(F.ws + WS_MEMN))
#define GT ((float*)(F.ws + WS_GATES))
#define NSTP ((float*)(F.ws + WS_NST))
#define SCALP ((float*)(F.ws + WS_SCAL))
#define MPREVP ((float*)(F.ws + WS_MPREV))
#define gains inp(F, 3)
#define XOUT ((float*)inp(F, 15))

    if (PROBE_CAT != 0 && blockIdx.x == 0 && threadIdx.x == 0) { TPROBE[0] = rt(); TPROBE[1] = 0ull; }
    p0_convert(F);
    row_phase(F, inp(F, 0), XOUT, nullptr, nullptr, gains, XN, inp(F, 4) + 3072, ML_W, inp(F, 5), GT);
    GBAR(4);
    run_gemm<MM, 8192, D, true>(F, MEMN, D, XWT, D, 0, 0, EpiStore{KV, 8192});

#pragma unroll 1
    for (int l = 0; l < DEPTH; ++l) {
#define WL (Wb + (size_t)l * WL_SIZE)
#define GL (gains + (size_t)l * 6 * D)
        const bool ml = (l & 1) == 0;
        run_gemm<M, 3072, D, true>(F, XN, D, WL + WL_IN, D, 0, 0, EpiStore{BIG, 3072}); GBAR(5);
        if (ml) {
            mlk::phaseA(F, BIG, GT, XN, NSTP, SCALP); GBAR(2);
            mlk::phaseB(F, XN, NSTP, SCALP, MPREVP); GBAR(2);
            mlk::phaseC(F, BIG, GT, XN, NSTP, MPREVP, inp(F, 6) + (size_t)(l >> 1) * D); GBAR(2);
            run_gemm<M, D, D, true>(F, BIG + 1024, 3072, WL + WL_OUT, D, 0, 0, EpiStore{MIX, D});
        } else {
            sb_attn_v2(F, BIG, MIX); GBAR(3);
            run_gemm<M, D, D, true>(F, MIX, D, WL + WL_OUT, D, 0, 0, EpiStore{BIG, D});
        }
        xw_gemms(F, KV + (size_t)l * 2048, WL + WL_QN, WL + WL_OT, XWT); GBAR(6);
        row_phase(F, XOUT, XOUT, ml ? MIX : BIG, GL + D, GL + 2 * D, XN, nullptr, 0, nullptr, nullptr); GBAR(1);
        run_gemm<M, D, D, false>(F, XN, D, XWT, D, 8, (size_t)D * D * 2, EpiSoftmax{PB, D}); GBAR(7);
        run_gemm<M, D, D, true>(F, PB, D, XWT + (size_t)8 * D * D, D, 8, (size_t)D * D * 2, EpiStore{BIG, D}); GBAR(7);
        row_phase(F, XOUT, XOUT, BIG, GL + 3 * D, GL + 4 * D, XN, nullptr, 0, nullptr, nullptr); GBAR(1);
        run_gemm<M, 2 * DFF, D, true>(F, XN, D, WL + WL_GU, D, 0, 0, EpiSwiglu{BIG, DFF}); GBAR(8);
        run_gemm<M, D, DFF, true>(F, BIG, DFF, WL + WL_DN, DFF, 0, 0, EpiStore{MIX, D}); GBAR(8);
        { const bool last = (l + 1 == DEPTH), gates = !last && (((l + 1) & 1) == 0);
          row_phase(F, XOUT, XOUT, MIX, GL + 5 * D, last ? nullptr : GL + 6 * D, XN,
                    gates ? inp(F, 4) + (size_t)((l + 1) >> 1) * D * ML_W + 3072 : nullptr, ML_W, inp(F, 5) + ((l + 1) >> 1) * 8, GT);
          if (!last) GBAR(1); }
    }
    if (PROBE_CAT != 0 && blockIdx.x == 0 && threadIdx.x == 0) {
        unsigned long long now_ = rt(); if (PROBE_CAT == 1) TPROBE[1] += now_ - TPROBE[0];
        const unsigned long long until = now_ + 20ull * TPROBE[1];
        while (rt() < until) __builtin_amdgcn_s_sleep(32);
    }
}

extern "C" void kernel_launch(void* const* d_in, const int* in_sizes, int n_in, void* d_out, int out_size, void* d_ws, size_t ws_size, hipStream_t stream) {
    static int grid = 0;
    if (grid == 0) {
        if (n_in != 15 || out_size != M * D || ws_size < WS_END) { fprintf(stderr, "kernel_launch: unexpected shapes (n_in %d out %d ws %zu need %zu)\n", n_in, out_size, ws_size, (size_t)WS_END); grid = -1; return; }
        int dev = 0, cus = 0, per_cu = 0;
        if (hipGetDevice(&dev) != hipSuccess || hipDeviceGetAttribute(&cus, hipDeviceAttributeMultiprocessorCount, dev) != hipSuccess) { grid = -1; return; }
        if (hipFuncSetAttribute((const void*)mega_fwd, hipFuncAttributeMaxDynamicSharedMemorySize, LDS_BYTES) != hipSuccess) { fprintf(stderr, "kernel_launch: hipFuncSetAttribute failed\n"); grid = -1; return; }
        if (hipOccupancyMaxActiveBlocksPerMultiprocessor(&per_cu, (const void*)mega_fwd, NWAVES * 64, LDS_BYTES) != hipSuccess || per_cu < 1) fprintf(stderr, "kernel_launch: occupancy query reports %d\n", per_cu);
        (void)hipGetLastError();
        grid = cus;
    }
    if (grid < 0) return;
    if (hipMemsetAsync((char*)d_ws + WS_CTL, 0, CTL_ZERO_BYTES, stream) != hipSuccess) return;
    Args a{};
    for (int i = 0; i < 15; ++i) a.in[i] = (const float*)d_in[i];
    a.out = (float*)d_out; a.ws = (unsigned char*)d_ws;
    hipLaunchKernelGGL(mega_fwd, dim3(grid), dim3(NWAVES * 64), LDS_BYTES, stream, a);
}
```

```cpp
#include <hip/hip_runtime.h>
#include <cstdio>
#include <cstdint>
namespace pg8 {
#define PG8_LAS __attribute__((address_space(3)))
typedef unsigned short bf16_t;
typedef short bf16x8 __attribute__((ext_vector_type(8)));
typedef float f32x4 __attribute__((ext_vector_type(4)));
typedef unsigned u32x4 __attribute__((ext_vector_type(4)));
constexpr int BM = 256, BK = 64, HALF = 128, HTB = HALF * BK * 2  , STAGE_BYTES = 8 * HTB, NXCD = 8, WGM = 8;

__host__ __device__ __forceinline__ int lds_byte(int r, int c) { const int st = (r >> 4) * 2 + (c >> 5), rr = r & 15, cc = c & 31, ob = rr * 64 + cc * 2; return st * 1024 + (ob ^ (((ob >> 9) & 1) << 5)); }
__host__ __device__ __forceinline__ void stage_rc(int b, int& R, int& C) { const int st = b / 1024, sb = b % 1024, swz = sb ^ (((sb >> 9) & 1) << 5); R = (st >> 1) * 16 + swz / 64; C = (st & 1) * 32 + (swz % 64) / 2; }
__host__ __device__ __forceinline__ int perm32(int rho) { const int n = rho >> 4, i = rho & 15; return 8 * (i >> 2) + 4 * n + (i & 3); }

struct Unit { int pm, pn; size_t aoff, boff; };
struct Gemm { const bf16_t* A; const bf16_t* Bt; int M, N, K, lda, ldb; };

struct StaticOrder {
    int nM, nN, nwg, G, c, pmb; size_t a_rt, b_rt, b_batch;
    __host__ __device__ void init(int M, int N, int G_, int c_, int lda, int ldb, int pmb_ = 0, size_t b_batch_ = 0) { nM = M / BM; nN = N / BM; nwg = nM * nN; G = G_; c = c_; a_rt = (size_t)BM * lda * 2; b_rt = (size_t)BM * ldb * 2; pmb = pmb_; b_batch = b_batch_; }
    __host__ __device__ bool next(int i, Unit& u) const {
        const long L = (long)i * G + c; if (L >= nwg) return false;
        int wgid = (int)L; { const int q = nwg / NXCD, r = nwg % NXCD, xcd = wgid % NXCD, off = wgid / NXCD; wgid = (xcd < r ? xcd * (q + 1) : r * (q + 1) + (xcd - r) * q) + off; }
        const int nig = WGM * nN, gid = wgid / nig, fm = gid * WGM, gsz = (nM - fm) < WGM ? (nM - fm) : WGM;
        u.pm = fm + ((wgid % nig) % gsz); u.pn = (wgid % nig) / gsz; u.aoff = (size_t)u.pm * a_rt; u.boff = (size_t)u.pn * b_rt + (pmb ? (size_t)(u.pm / pmb) * b_batch : 0); return true;
    }
    __device__ __forceinline__ void a_ready(const Unit&) const {}
    __device__ __forceinline__ void done(const Unit&) const {}
};

__device__ __forceinline__ unsigned cvt_pk_bf16(float lo, float hi) { unsigned r; asm volatile("v_cvt_pk_bf16_f32 %0, %1, %2" : "=v"(r) : "v"(lo), "v"(hi)); return r; }
typedef float f32x2 __attribute__((ext_vector_type(2)));
__device__ __forceinline__ f32x2 gelu_pk(f32x2 v) {
    const f32x2 av = __builtin_elementwise_abs(v), d = av * 0.2316418882f + 1.0f;
    f32x2 t; t.x = __builtin_amdgcn_rcpf(d.x); t.y = __builtin_amdgcn_rcpf(d.y);
    f32x2 q = t * 0.5307027145f + (-0.7265760135f); q = q * t + 0.7107068705f; q = q * t + (-0.142248368f); q = q * t + 0.127414796f; q = q * t;
    const f32x2 s = (v * v) * (-0.72134752044f);
    f32x2 e; e.x = __builtin_amdgcn_exp2f(s.x); e.y = __builtin_amdgcn_exp2f(s.y);
    const f32x2 m = v * (q * e), r = v - m;
    f32x2 o; o.x = v.x < 0.f ? m.x : r.x; o.y = v.y < 0.f ? m.y : r.y; return o;
}

template <int ACT  > struct EpiBf16 {
    static constexpr bool PERM = true, AFTER_DRAIN = false; static_assert(ACT == 0 || ACT == 1, "EpiBf16: ACT is 0 (none) or 1 (gelu_pk)");
    bf16_t* O; int ldc; const float* bias; int split_cols; size_t split_stride; float scale0;
    __device__ __forceinline__ void operator()(const f32x4 (&acc)[2][2][4][2], const Unit& u, int wr, int wc, int fr, int fq) const {
        const int row0 = u.pm * BM + wr * 64 + fr; int colt = u.pn * BM; bf16_t* base = O;
        float sc = 1.f; if (split_cols) { const int t = colt / split_cols; base += (size_t)t * split_stride; colt -= t * split_cols; if (t == 0) sc = scale0; }
        const int col0 = colt + wc * 32 + 8 * fq, bcol0 = u.pn * BM + wc * 32 + 8 * fq;
        f32x4 bv[2][2];
#pragma unroll
        for (int bj = 0; bj < 2; ++bj)
#pragma unroll
            for (int n = 0; n < 2; ++n) bv[bj][n] = bias ? *(const f32x4*)(bias + bcol0 + bj * HALF + 4 * n) : (f32x4){0.f, 0.f, 0.f, 0.f};
#pragma unroll
        for (int ai = 0; ai < 2; ++ai)
#pragma unroll
            for (int m = 0; m < 4; ++m) { bf16_t* rowp = base + (size_t)(row0 + ai * HALF + m * 16) * ldc + col0;
#pragma unroll
                for (int bj = 0; bj < 2; ++bj) { f32x4 v0 = acc[ai][bj][m][0] + bv[bj][0], v1 = acc[ai][bj][m][1] + bv[bj][1];
                    if (ACT == 1) { f32x2 a = gelu_pk((f32x2){v0[0], v0[1]}), b = gelu_pk((f32x2){v0[2], v0[3]}), c = gelu_pk((f32x2){v1[0], v1[1]}), d = gelu_pk((f32x2){v1[2], v1[3]});
                        v0 = (f32x4){a.x, a.y, b.x, b.y}; v1 = (f32x4){c.x, c.y, d.x, d.y}; }
                    v0 = v0 * sc; v1 = v1 * sc; u32x4 w; w.x = cvt_pk_bf16(v0[0], v0[1]); w.y = cvt_pk_bf16(v0[2], v0[3]); w.z = cvt_pk_bf16(v1[0], v1[1]); w.w = cvt_pk_bf16(v1[2], v1[3]);
                    *(u32x4*)(rowp + bj * HALF) = w; } }
    }
};

struct PanelStats {
    unsigned* xbuf;
    unsigned* cnt;
    unsigned* tmo;
    int ntn; float eps;
    unsigned code;
    __device__ __forceinline__ bool run(const f32x4 (&v)[2][2][4][2], const Unit& u, int wr, int wc, int fr, int fq, PG8_LAS unsigned char* lds, int wid, int lane) const {
        typedef float f32x2v __attribute__((ext_vector_type(2)));
        PG8_LAS f32x2v* P = (PG8_LAS f32x2v*)lds;
        PG8_LAS f32x2v* S = (PG8_LAS f32x2v*)(lds + 8192);
        PG8_LAS unsigned* flag = (PG8_LAS unsigned*)(lds + 8192 + 2048);
#pragma unroll
        for (int ai = 0; ai < 2; ++ai)
#pragma unroll
            for (int m = 0; m < 4; ++m) {
                float s = 0.f;
#pragma unroll
                for (int bj = 0; bj < 2; ++bj)
#pragma unroll
                    for (int n = 0; n < 2; ++n) { const f32x4 x = v[ai][bj][m][n]; s += (x[0] + x[1]) + (x[2] + x[3]); }
                s += __shfl_xor(s, 16); s += __shfl_xor(s, 32);
                const float mw = s * (1.0f / 64.0f); float q = 0.f;
#pragma unroll
                for (int bj = 0; bj < 2; ++bj)
#pragma unroll
                    for (int n = 0; n < 2; ++n) { const f32x4 d = v[ai][bj][m][n] - mw; q += (d[0] * d[0] + d[1] * d[1]) + (d[2] * d[2] + d[3] * d[3]); }
                q += __shfl_xor(q, 16); q += __shfl_xor(q, 32);
                if (fq == 0) P[(ai * HALF + wr * 64 + m * 16 + fr) * 4 + wc] = (f32x2v){mw, q};
            }
        asm volatile("s_waitcnt lgkmcnt(0)" ::: "memory"); __builtin_amdgcn_s_barrier(); asm volatile("" ::: "memory");
#if defined(BROKEN_EXCHANGE_NO_WAIT)
#warning BROKEN CONTROL BUILD: the row-statistics exchange does not wait; results are wrong by design
        if (blockIdx.x >= 64) { const long long t0_ = clock64(); while (clock64() - t0_ < 60000) __builtin_amdgcn_s_sleep(8); }
#endif
        const int row = wid * 32 + (lane & 31);
        if (lane < 32) {
            const f32x2v a = P[row * 4 + 0], b = P[row * 4 + 1], c = P[row * 4 + 2], d = P[row * 4 + 3];
            const float mt = (a.x + b.x + c.x + d.x) * 0.25f;
            const float da = a.x - mt, db = b.x - mt, dc = c.x - mt, dd = d.x - mt;
            const float m2 = (a.y + b.y) + (c.y + d.y) + 64.0f * ((da * da + db * db) + (dc * dc + dd * dd));
            unsigned long long* slot = (unsigned long long*)xbuf + ((size_t)(u.pm * BM + row) * 4 + u.pn);
            __hip_atomic_store(slot, ((unsigned long long)__float_as_uint(m2) << 32) | __float_as_uint(mt), __ATOMIC_RELAXED, __HIP_MEMORY_SCOPE_AGENT);
        }
        asm volatile("s_waitcnt vmcnt(0)" ::: "memory");
        if (lane == 0) __hip_atomic_fetch_add(cnt + 64 * u.pm, 1u, __ATOMIC_RELAXED, __HIP_MEMORY_SCOPE_AGENT);
        if (wid == 0) {
            bool dead = false; const unsigned long long t0 = __builtin_amdgcn_s_memrealtime(); const unsigned want = 8u * (unsigned)ntn;
            for (;;) {
#if defined(BROKEN_EXCHANGE_NO_WAIT)
                break;
#endif
                if ((unsigned)__builtin_amdgcn_readfirstlane(__hip_atomic_load(cnt + 64 * u.pm, __ATOMIC_RELAXED, __HIP_MEMORY_SCOPE_AGENT)) >= want) break;
                if (__builtin_amdgcn_s_memrealtime() - t0 > 2000000ull) {
                    if (lane == 0) { unsigned expect = 0u; __hip_atomic_compare_exchange_strong(tmo + 1, &expect, code | (unsigned)(u.pm & 0xff), __ATOMIC_RELAXED, __ATOMIC_RELAXED, __HIP_MEMORY_SCOPE_AGENT);
                                     __hip_atomic_store(tmo, 1u, __ATOMIC_RELAXED, __HIP_MEMORY_SCOPE_AGENT); }
                    dead = true; break; }
                __builtin_amdgcn_s_sleep(2);
            }
            __builtin_amdgcn_fence(__ATOMIC_ACQUIRE, "agent");
            if (lane == 0) flag[0] = dead ? 1u : 0u;
        }
        asm volatile("s_waitcnt vmcnt(0) lgkmcnt(0)" ::: "memory"); __builtin_amdgcn_s_barrier(); asm volatile("" ::: "memory");
        const bool bad = flag[0] != 0u;
        if (lane < 32) {
            const unsigned long long* slot = (const unsigned long long*)xbuf + (size_t)(u.pm * BM + row) * 4; float mt[4], m2[4]; float ms = 0.f;
#pragma unroll
            for (int t = 0; t < 4; ++t) { if (t < ntn) { const unsigned long long w = __hip_atomic_load(slot + t, __ATOMIC_RELAXED, __HIP_MEMORY_SCOPE_AGENT); mt[t] = __uint_as_float((unsigned)w); m2[t] = __uint_as_float((unsigned)(w >> 32)); } else { mt[t] = 0.f; m2[t] = 0.f; } ms += mt[t]; }
            const float mean = ms / (float)ntn; float q = 0.f;
#pragma unroll
            for (int t = 0; t < 4; ++t) if (t < ntn) { const float dm = mt[t] - mean; q += m2[t] + 256.0f * dm * dm; }
            S[row] = (f32x2v){mean, 1.0f / sqrtf(q / (256.0f * (float)ntn) + eps)};
        }
        asm volatile("s_waitcnt lgkmcnt(0)" ::: "memory"); __builtin_amdgcn_s_barrier(); asm volatile("" ::: "memory");
        return bad;
    }
};
struct EpiLnRes {
    static constexpr bool PERM = false, AFTER_DRAIN = true;
    const float* base; float* out; int ldc; const float* bias; PanelStats st; unsigned poison;
    __device__ __forceinline__ void fused(f32x4 (&acc)[2][2][4][2], const Unit& u, int wr, int wc, int fr, int fq, PG8_LAS unsigned char* lds, int wid, int lane) const {
        typedef float f32x2v __attribute__((ext_vector_type(2)));
        const PG8_LAS f32x2v* S = (const PG8_LAS f32x2v*)(lds + 8192);
        const int col0 = u.pn * BM + wc * 32 + 4 * fq;
#pragma unroll
        for (int bj = 0; bj < 2; ++bj)
#pragma unroll
            for (int n = 0; n < 2; ++n) { const f32x4 bv = bias ? *(const f32x4*)(bias + col0 + bj * HALF + n * 16) : (f32x4){0.f, 0.f, 0.f, 0.f};
#pragma unroll
                for (int ai = 0; ai < 2; ++ai)
#pragma unroll
                    for (int m = 0; m < 4; ++m) acc[ai][bj][m][n] += bv; }
        f32x4 pre[4][2][2];
#pragma unroll
        for (int m = 0; m < 4; ++m) { const size_t off = (size_t)(u.pm * BM + wr * 64 + m * 16 + fr) * ldc + col0;
#pragma unroll
            for (int bj = 0; bj < 2; ++bj)
#pragma unroll
                for (int n = 0; n < 2; ++n) pre[m][bj][n] = *(const f32x4*)(base + off + bj * HALF + n * 16); }
        const bool bad = st.run(acc, u, wr, wc, fr, fq, lds, wid, lane) || poison != 0u;
        const float qnan = __builtin_nanf("");
#pragma unroll
        for (int ai = 0; ai < 2; ++ai)
#pragma unroll
            for (int m = 0; m < 4; ++m) { const int r = ai * HALF + wr * 64 + m * 16 + fr; const f32x2v sr = S[r]; const size_t off = (size_t)(u.pm * BM + r) * ldc + col0;
#pragma unroll
                for (int bj = 0; bj < 2; ++bj)
#pragma unroll
                    for (int n = 0; n < 2; ++n) { const f32x4 bs = ai == 0 ? pre[m][bj][n] : *(const f32x4*)(base + off + bj * HALF + n * 16); f32x4 o = bs + (acc[ai][bj][m][n] - sr.x) * sr.y;
                        if (bad) o = (f32x4){qnan, qnan, qnan, qnan}; *(f32x4*)(out + off + bj * HALF + n * 16) = o; }
                if (m & 1) asm volatile("" ::: "memory"); }
    }
};
struct EpiLnResLn {
    static constexpr bool PERM = false, AFTER_DRAIN = true;
    const float* base; float* out; bf16_t* xn; int ldc; const float* bias; PanelStats st1, st2; unsigned poison;
    __device__ __forceinline__ void fused(f32x4 (&acc)[2][2][4][2], const Unit& u, int wr, int wc, int fr, int fq, PG8_LAS unsigned char* lds, int wid, int lane) const {
        typedef float f32x2v __attribute__((ext_vector_type(2))); typedef unsigned u32x2v __attribute__((ext_vector_type(2)));
        const PG8_LAS f32x2v* S = (const PG8_LAS f32x2v*)(lds + 8192);
        const int col0 = u.pn * BM + wc * 32 + 4 * fq;
#pragma unroll
        for (int bj = 0; bj < 2; ++bj)
#pragma unroll
            for (int n = 0; n < 2; ++n) { const f32x4 bv = bias ? *(const f32x4*)(bias + col0 + bj * HALF + n * 16) : (f32x4){0.f, 0.f, 0.f, 0.f};
#pragma unroll
                for (int ai = 0; ai < 2; ++ai)
#pragma unroll
                    for (int m = 0; m < 4; ++m) acc[ai][bj][m][n] += bv; }
        bool bad = st1.run(acc, u, wr, wc, fr, fq, lds, wid, lane) || poison != 0u;
        const float qnan = __builtin_nanf("");
#pragma unroll
        for (int ai = 0; ai < 2; ++ai)
#pragma unroll
            for (int m = 0; m < 4; ++m) { const int r = ai * HALF + wr * 64 + m * 16 + fr; const f32x2v sr = S[r]; const size_t off = (size_t)(u.pm * BM + r) * ldc + col0;
#pragma unroll
                for (int bj = 0; bj < 2; ++bj)
#pragma unroll
                    for (int n = 0; n < 2; ++n) { const f32x4 bs = *(const f32x4*)(base + off + bj * HALF + n * 16); acc[ai][bj][m][n] = bs + (acc[ai][bj][m][n] - sr.x) * sr.y; }
                asm volatile("" : "+v"(acc[ai][0][m][0]), "+v"(acc[ai][0][m][1]), "+v"(acc[ai][1][m][0]), "+v"(acc[ai][1][m][1]));
                if (m & 1) asm volatile("" ::: "memory"); }
        const bool bad1 = bad;
        bad = st2.run(acc, u, wr, wc, fr, fq, lds, wid, lane) || bad;
#pragma unroll
        for (int ai = 0; ai < 2; ++ai)
#pragma unroll
            for (int m = 0; m < 4; ++m) { const int r = ai * HALF + wr * 64 + m * 16 + fr; const f32x2v sr = S[r]; const size_t off = (size_t)(u.pm * BM + r) * ldc + col0;
#pragma unroll
                for (int bj = 0; bj < 2; ++bj)
#pragma unroll
                    for (int n = 0; n < 2; ++n) { const f32x4 x1 = acc[ai][bj][m][n]; *(f32x4*)(out + off + bj * HALF + n * 16) = bad1 ? (f32x4){qnan, qnan, qnan, qnan} : x1;
                        const f32x4 o = (x1 - sr.x) * sr.y; u32x2v w; w.x = cvt_pk_bf16(o[0], o[1]); w.y = cvt_pk_bf16(o[2], o[3]);
                        if (bad) { w.x = 0x7fc07fc0u; w.y = 0x7fc07fc0u; } *(u32x2v*)(xn + off + bj * HALF + n * 16) = w; }
                asm volatile("" ::: "memory"); }
    }
};

template <class Epi, class Sched, bool ALIGN_EPI = false, bool SP2 = false>
__device__ __forceinline__ void gemm_phase(PG8_LAS unsigned char* lds, const Gemm g, const Sched& S, const Epi& E) {
    int tid_ = threadIdx.x; asm volatile("" : "+v"(tid_));
    const int tid = tid_, wid = __builtin_amdgcn_readfirstlane(tid >> 6), lane = tid & 63, wr = wid >> 2, wc = wid & 3, fr = lane & 15, fq = lane >> 4;
    const int K = g.K, nt = K / BK;
    unsigned voffA[2], voffB[2];
#pragma unroll
    for (int i = 0; i < 2; ++i) { int R, C; stage_rc(tid * 16 + i * 8192, R, C); const int Rb = Epi::PERM ? ((R & ~31) + perm32(R & 31)) : R;
        voffA[i] = (unsigned)(R * g.lda + C) * 2u; voffB[i] = (unsigned)(Rb * g.ldb + C) * 2u; }
    const size_t kstep = (size_t)(BK * 2);
    const size_t hstepA = (size_t)HALF * g.lda * 2, hstepB = (size_t)HALF * g.ldb * 2;
    const unsigned ldsw = (unsigned)wid * 1024u;
    const int aoff = lds_byte(wr * 64 + fr, fq * 8), boff = lds_byte(wc * 32 + fr, fq * 8);
#define PG8_SA(b, h) (((b) * 2 + (h)) * HTB)
#define PG8_SB(b, h) ((4 + (b) * 2 + (h)) * HTB)
#define PG8_STAGE(bufoff, gbase, voff) do { _Pragma("unroll") for (int _i = 0; _i < 2; ++_i) \
        __builtin_amdgcn_global_load_lds((const unsigned*)((const char*)(gbase) + (voff)[_i]), (PG8_LAS unsigned*)(lds + (bufoff) + ldsw + _i * 8192), 16, 0, 0); } while (0)
#define PG8_LDA(dst, b, h) do { _Pragma("unroll") for (int m = 0; m < 4; ++m) _Pragma("unroll") for (int k = 0; k < 2; ++k) dst[m][k] = *(const PG8_LAS bf16x8*)(lds + PG8_SA(b, h) + aoff + m * 2048 + k * 1024); } while (0)
#define PG8_LDB(dst, b, h) do { _Pragma("unroll") for (int n = 0; n < 2; ++n) _Pragma("unroll") for (int k = 0; k < 2; ++k) dst[n][k] = *(const PG8_LAS bf16x8*)(lds + PG8_SB(b, h) + boff + n * 2048 + k * 1024); } while (0)
#define PG8_MMA(ai, bj, At, Bt) do { __builtin_amdgcn_s_setprio(1); _Pragma("unroll") for (int m = 0; m < 4; ++m) _Pragma("unroll") for (int n = 0; n < 2; ++n) _Pragma("unroll") for (int k = 0; k < 2; ++k) \
        acc[ai][bj][m][n] = __builtin_amdgcn_mfma_f32_16x16x32_bf16(Bt[n][k], At[m][k], acc[ai][bj][m][n], 0, 0, 0); __builtin_amdgcn_s_setprio(0); } while (0)
#define PG8_WAIT_V(n) asm volatile("s_waitcnt vmcnt(" #n ")" ::: "memory")
#define PG8_WAIT_L(n) asm volatile("s_waitcnt lgkmcnt(" #n ")" ::: "memory")
#define PG8_BAR __builtin_amdgcn_s_barrier()
#define PG8_SCHED __builtin_amdgcn_sched_barrier(0)
    Unit cur, nxt; int ui = 0;
    if (!S.next(0, cur)) return;
    f32x4 acc[2][2][4][2];
#pragma unroll
    for (int a = 0; a < 2; ++a)
#pragma unroll
        for (int b = 0; b < 2; ++b)
#pragma unroll
            for (int m = 0; m < 4; ++m)
#pragma unroll
                for (int n = 0; n < 2; ++n) acc[a][b][m][n] = (f32x4){0.f, 0.f, 0.f, 0.f};
    bf16x8 At[4][2], B0[2][2], B1[2][2];
    const char* cA = (const char*)g.A + cur.aoff; const char* cB = (const char*)g.Bt + cur.boff;
    S.a_ready(cur);
    if constexpr (SP2) {
        PG8_STAGE(PG8_SB(0, 0), cB, voffB); PG8_STAGE(PG8_SB(0, 1), cB + hstepB, voffB); PG8_STAGE(PG8_SA(0, 0), cA, voffA); PG8_STAGE(PG8_SA(0, 1), cA + hstepA, voffA);
        if (wr == 1) PG8_BAR;
        PG8_WAIT_V(2); PG8_BAR;
        PG8_STAGE(PG8_SB(1, 0), cB + kstep, voffB); PG8_STAGE(PG8_SA(1, 0), cA + kstep, voffA); PG8_STAGE(PG8_SB(1, 1), cB + hstepB + kstep, voffB);
        PG8_WAIT_V(6); PG8_BAR;
    } else {
        PG8_STAGE(PG8_SB(0, 0), cB, voffB); PG8_STAGE(PG8_SA(0, 0), cA, voffA); PG8_STAGE(PG8_SB(0, 1), cB + hstepB, voffB); PG8_STAGE(PG8_SA(0, 1), cA + hstepA, voffA);
        if (wr == 1) PG8_BAR;
        PG8_WAIT_V(4); PG8_BAR;
        PG8_STAGE(PG8_SB(1, 0), cB + kstep, voffB); PG8_STAGE(PG8_SA(1, 0), cA + kstep, voffA); PG8_STAGE(PG8_SB(1, 1), cB + hstepB + kstep, voffB);
        PG8_WAIT_V(6); PG8_BAR;
    }
    for (;;) {
        const bool has_next = S.next(ui + 1, nxt);
        const char* nA = has_next ? (const char*)g.A + nxt.aoff : cA; const char* nB = has_next ? (const char*)g.Bt + nxt.boff : cB;
        for (int t = 0; t < nt; t += 2) {
            const bool last = (t == nt - 2);
            const char* a1 = cA + (size_t)(t + 1) * kstep;
            const char* a2 = last ? nA : cA + (size_t)(t + 2) * kstep; const char* b2 = last ? nB : cB + (size_t)(t + 2) * kstep;
            const char* a3 = a2 + kstep; const char* b3 = b2 + kstep;
            if (last && has_next) S.a_ready(nxt);
            if constexpr (SP2) {
            PG8_LDB(B0, 0, 0); PG8_LDB(B1, 0, 1); PG8_SCHED; PG8_LDA(At, 0, 0); PG8_STAGE(PG8_SA(1, 1), a1 + hstepA, voffA);
            PG8_WAIT_V(8); PG8_WAIT_L(0); PG8_BAR; PG8_MMA(0, 0, At, B0); PG8_MMA(0, 1, At, B1); PG8_BAR; PG8_SCHED;
            PG8_LDA(At, 0, 1); PG8_STAGE(PG8_SB(0, 0), b2, voffB); PG8_STAGE(PG8_SB(0, 1), b2 + hstepB, voffB); PG8_STAGE(PG8_SA(0, 0), a2, voffA);
            PG8_WAIT_V(8); PG8_WAIT_L(0); PG8_BAR; PG8_MMA(1, 0, At, B0); PG8_MMA(1, 1, At, B1); PG8_BAR; PG8_SCHED;
            PG8_LDB(B0, 1, 0); PG8_LDB(B1, 1, 1); PG8_SCHED; PG8_LDA(At, 1, 0); PG8_STAGE(PG8_SA(0, 1), a2 + hstepA, voffA);
            PG8_WAIT_V(8); PG8_WAIT_L(0); PG8_BAR; PG8_MMA(0, 0, At, B0); PG8_MMA(0, 1, At, B1); PG8_BAR; PG8_SCHED;
            PG8_LDA(At, 1, 1); PG8_STAGE(PG8_SB(1, 0), b3, voffB); PG8_STAGE(PG8_SB(1, 1), b3 + hstepB, voffB); PG8_STAGE(PG8_SA(1, 0), a3, voffA);
            PG8_WAIT_V(8); PG8_WAIT_L(0); PG8_BAR; PG8_MMA(1, 0, At, B0); PG8_MMA(1, 1, At, B1); PG8_BAR; PG8_SCHED;
            } else {
            PG8_LDB(B0, 0, 0); PG8_SCHED; PG8_LDA(At, 0, 0); PG8_STAGE(PG8_SA(1, 1), a1 + hstepA, voffA);
            PG8_WAIT_L(8); PG8_BAR; PG8_WAIT_L(0); PG8_MMA(0, 0, At, B0); PG8_BAR; PG8_SCHED;
            PG8_LDB(B1, 0, 1); PG8_STAGE(PG8_SB(0, 0), b2, voffB);
            PG8_BAR; PG8_WAIT_L(0); PG8_MMA(0, 1, At, B1); PG8_BAR;
            PG8_LDA(At, 0, 1); PG8_STAGE(PG8_SA(0, 0), a2, voffA);
            PG8_BAR; PG8_WAIT_L(0); PG8_MMA(1, 0, At, B0); PG8_BAR; PG8_SCHED;
            PG8_STAGE(PG8_SB(0, 1), b2 + hstepB, voffB);
            PG8_WAIT_V(6); PG8_BAR; PG8_MMA(1, 1, At, B1); PG8_BAR;
            PG8_LDB(B0, 1, 0); PG8_SCHED; PG8_LDA(At, 1, 0); PG8_STAGE(PG8_SA(0, 1), a2 + hstepA, voffA);
            PG8_WAIT_L(8); PG8_BAR; PG8_WAIT_L(0); PG8_MMA(0, 0, At, B0); PG8_BAR; PG8_SCHED;
            PG8_LDB(B1, 1, 1); PG8_STAGE(PG8_SB(1, 0), b3, voffB);
            PG8_BAR; PG8_WAIT_L(0); PG8_MMA(0, 1, At, B1); PG8_BAR;
            PG8_LDA(At, 1, 1); PG8_STAGE(PG8_SA(1, 0), a3, voffA);
            PG8_BAR; PG8_WAIT_L(0); PG8_MMA(1, 0, At, B0); PG8_BAR; PG8_SCHED;
            PG8_STAGE(PG8_SB(1, 1), b3 + hstepB, voffB);
            PG8_WAIT_V(6); PG8_BAR; PG8_MMA(1, 1, At, B1); PG8_BAR;
            }
        }
        if constexpr (ALIGN_EPI) { if (wr == 0) PG8_BAR; }
        if constexpr (!Epi::AFTER_DRAIN) { E(acc, cur, wr, wc, fr, fq); S.done(cur); }
        if (!has_next) break;
#pragma unroll
        for (int a = 0; a < 2; ++a)
#pragma unroll
            for (int b = 0; b < 2; ++b)
#pragma unroll
                for (int m = 0; m < 4; ++m)
#pragma unroll
                    for (int n = 0; n < 2; ++n) acc[a][b][m][n] = (f32x4){0.f, 0.f, 0.f, 0.f};
        cur = nxt; cA = nA; cB = nB; ++ui;
        if constexpr (ALIGN_EPI) { if (wr == 1) PG8_BAR; }
    }
    PG8_WAIT_V(0);
    if constexpr (!ALIGN_EPI) { if (wr == 0) PG8_BAR; }
    PG8_BAR;
    if constexpr (Epi::AFTER_DRAIN) { E.fused(acc, cur, wr, wc, fr, fq, lds, wid, lane); S.done(cur); }
#undef PG8_SA
#undef PG8_SB
#undef PG8_STAGE
#undef PG8_LDA
#undef PG8_LDB
#undef PG8_MMA
#undef PG8_WAIT_V
#undef PG8_WAIT_L
#undef PG8_BAR
#undef PG8_SCHED
}
}
#define GAS __attribute__((address_space(1)))
#define LAS __attribute__((address_space(3)))
typedef unsigned short bf16;
typedef unsigned v4u __attribute__((ext_vector_type(4)));
typedef float f32x4 __attribute__((ext_vector_type(4)));
typedef short bf16x8 __attribute__((ext_vector_type(8)));
typedef GAS unsigned gu32;
typedef GAS unsigned long long gu64;
#define RLX_AGENT __ATOMIC_RELAXED, __HIP_MEMORY_SCOPE_AGENT
#define LDS_WAIT() asm volatile("s_waitcnt lgkmcnt(0)" ::: "memory")
#define VM_WAIT() asm volatile("s_waitcnt vmcnt(0)" ::: "memory")
__device__ __forceinline__ unsigned long long rt() { return __builtin_amdgcn_s_memrealtime(); }
__device__ __forceinline__ unsigned f2bf(float f) { unsigned u = __builtin_bit_cast(unsigned, f); return (u + 0x7fffu + ((u >> 16) & 1u)) >> 16; }
__device__ __forceinline__ unsigned pk2(float lo, float hi) { return f2bf(lo) | (f2bf(hi) << 16); }

#define XB_TMO      128
#define XB_XCNT(j)  (256  + 64 * (j))
#define XB_XSUB(j)  (1280 + 64 * (j))
#define XB_XGEN(j)  (2304 + 64 * (j))
#define XB_TOP      3328
#define XB_TOPGEN   3392
#define XCD_BAR_WORDS 3456
#define XB_SPIN_CAP (1u << 18)

__device__ __forceinline__ unsigned xb_ld(unsigned* p)              { return __hip_atomic_load(p, __ATOMIC_RELAXED, __HIP_MEMORY_SCOPE_AGENT); }
__device__ __forceinline__ unsigned xb_add(unsigned* p, unsigned v) { return __hip_atomic_fetch_add(p, v, __ATOMIC_RELAXED, __HIP_MEMORY_SCOPE_AGENT); }
__device__ __forceinline__ unsigned xb_xcc_id() { return (unsigned)__builtin_amdgcn_s_getreg((3 << 11) | 20) & 0xFu; }
#define XB_SPIN(cond, bar) do { unsigned _sp = 0; while (cond) { __builtin_amdgcn_s_sleep(1); \
    if ((++_sp & 255u) == 0u) { if (xb_ld(&(bar)[XB_TMO])) break; if (_sp > XB_SPIN_CAP) { atomicAdd(&(bar)[XB_TMO], 1u); break; } } } } while (0)

struct XcdBarrier {
    unsigned* bar; unsigned x;
    volatile LAS unsigned* st;
};

__device__ __forceinline__ XcdBarrier xcd_barrier_post(unsigned* bar, volatile LAS unsigned* st) {
    XcdBarrier b; b.bar = bar; b.x = xb_xcc_id(); b.st = st;
    if (threadIdx.x == 0) (void)xb_add(&bar[XB_XCNT(b.x)], 1u);
    return b;
}
__device__ __forceinline__ void xcd_barrier_complete(unsigned* bar, unsigned x, unsigned& nloc, unsigned& nx) {
    const unsigned G = gridDim.x * gridDim.y * gridDim.z;
    unsigned sum, cnt, mine, sp = 0u;
    for (;;) {
        sum = 0u; cnt = 0u; mine = 0u;
#pragma unroll
        for (unsigned j = 0; j < 16; ++j) { const unsigned c = xb_ld(&bar[XB_XCNT(j)]); sum += c; cnt += (c > 0u) ? 1u : 0u; mine = (j == x) ? c : mine; }
        if (sum == G) break;
        __builtin_amdgcn_s_sleep(1);
        if ((++sp & 255u) == 0u) { if (xb_ld(&bar[XB_TMO])) break; if (sp > XB_SPIN_CAP) { atomicAdd(&bar[XB_TMO], 1u); break; } }
    }
    nloc = mine > 0u ? mine : 1u; nx = cnt > 0u ? cnt : 1u;
}

__device__ __forceinline__ void xcd_barrier(const XcdBarrier& b) {
    asm volatile("s_waitcnt vmcnt(0)" ::: "memory");
    __syncthreads();
    if (threadIdx.x == 0) {
        unsigned* bar = b.bar;
        __builtin_amdgcn_s_waitcnt(0);
        unsigned nloc = b.st[0], nx = b.st[1];
        if (nloc == 0u) { xcd_barrier_complete(bar, b.x, nloc, nx); b.st[0] = nloc; b.st[1] = nx; }
        const unsigned old = xb_add(&bar[XB_XSUB(b.x)], 1u);
        const unsigned gen = old / nloc;
        if (old + 1u == (gen + 1u) * nloc) {
            __builtin_amdgcn_fence(__ATOMIC_RELEASE, "agent");
            asm volatile("s_waitcnt vmcnt(0)" ::: "memory");
            const unsigned og = xb_add(&bar[XB_TOP], 1u);
            const unsigned tg = og / nx;
            if (og + 1u == (tg + 1u) * nx) xb_add(&bar[XB_TOPGEN], 1u);
            else XB_SPIN(xb_ld(&bar[XB_TOPGEN]) == tg, bar);
            __builtin_amdgcn_fence(__ATOMIC_ACQUIRE, "agent");
            xb_add(&bar[XB_XGEN(b.x)], 1u);
            asm volatile("s_waitcnt vmcnt(0)" ::: "memory");
        } else {
            XB_SPIN(xb_ld(&bar[XB_XGEN(b.x)]) == gen, bar);
            __builtin_amdgcn_fence(__ATOMIC_ACQUIRE, "agent");
            asm volatile("s_waitcnt vmcnt(0)" ::: "memory");
        }
    }
    __syncthreads();
}

constexpr int D = 1024, BATCH = 8, SEQ = 2048, DEPTH = 4, NMEM = 256;
constexpr int M = BATCH * SEQ;
constexpr int MM = BATCH * NMEM;
constexpr int ML_H = 4, ML_DK = 128, ML_DV = 256, ML_W = 3080;
constexpr int SB_H = 16, SB_DH = 64;
constexpr int XA_H = 4, XA_DH = 256;
constexpr int DFF = 2816;
constexpr float EPS = 1e-6f;
constexpr int NWAVES = 8;

constexpr size_t MiB = 1u << 20;
constexpr size_t WS_CTL = 0, CTL_ZERO_BYTES = 1 * MiB;
constexpr size_t WS_WG = 1 * MiB;
constexpr size_t WS_GATES = 1 * MiB + 512 * 1024;
constexpr size_t WS_MEMN = 2 * MiB;
constexpr size_t WS_NST = 6 * MiB, WS_SCAL = 6 * MiB + 512 * 1024, WS_MPREV = WS_SCAL + 16 * 1024;
constexpr size_t WS_W = 8 * MiB;
constexpr size_t WL_IN = 0, WL_OUT = WL_IN + (size_t)3072 * 1024, WL_QN = WL_OUT + (size_t)1024 * 1024, WL_OT = WL_QN + (size_t)1024 * 1024,
                 WL_GU = WL_OT + (size_t)1024 * 1024, WL_DN = WL_GU + (size_t)5632 * 1024, WL_SIZE = WL_DN + (size_t)1024 * 2816;
constexpr size_t WS_XWT = WS_W + 4 * WL_SIZE * 2;
static_assert(WS_XWT == 122 * MiB, "weight region size");
constexpr size_t WS_KV = WS_XWT + 32 * MiB;
constexpr size_t WS_XN = WS_KV + 32 * MiB;
constexpr size_t WS_MIX = WS_XN + 32 * MiB;
constexpr size_t WS_BIG = WS_MIX + 32 * MiB;
constexpr size_t WS_END = WS_BIG + 96 * MiB;
constexpr int CW_BAR = 4096;

constexpr int RING_OFF = 0, RING_BYTES = 131072;
constexpr int LDSCTL_OFF = RING_BYTES, MISC_OFF = LDSCTL_OFF + 320;
constexpr int LDS_BYTES = 147456;

__device__ __forceinline__ float wave_sum(float v) {
#pragma unroll
    for (int o = 1; o < 64; o <<= 1) v += __shfl_xor(v, o);
    return v;
}
__device__ __forceinline__ float wave_max(float v) {
#pragma unroll
    for (int o = 1; o < 64; o <<= 1) v = fmaxf(v, __shfl_xor(v, o));
    return v;
}
__device__ __forceinline__ float softplusf(float z) { return fmaxf(z, 0.f) + log1pf(__expf(-fabsf(z))); }
__device__ __forceinline__ float bf2f(unsigned short h) { return __uint_as_float((unsigned)h << 16); }
__device__ __forceinline__ float bflo(unsigned w) { return __uint_as_float(w << 16); }
__device__ __forceinline__ float bfhi(unsigned w) { return __uint_as_float(w & 0xffff0000u); }

struct Frame {
    LAS unsigned char* lds;
    int tid, lane, wave, G, gw, NGW;
    unsigned char* ws;
};
__device__ __forceinline__ const float* inp(const Frame& F, int i) {
    volatile LAS unsigned* t = (volatile LAS unsigned*)(F.lds + LDSCTL_OFF) + 2 * i;
    const unsigned lo = __builtin_amdgcn_readfirstlane(t[0]), hi = __builtin_amdgcn_readfirstlane(t[1]);
    return (const float*)(((unsigned long long)hi << 32) | lo);
}
__device__ __forceinline__ void relane(Frame& F) {
    int t = threadIdx.x; asm volatile("" : "+v"(t));
    F.tid = t; F.lane = t & 63; F.wave = __builtin_amdgcn_readfirstlane(t >> 6);
    int g = gridDim.x, b = blockIdx.x; asm volatile("" : "+s"(g), "+s"(b));
    F.G = g; F.gw = b * NWAVES + F.wave; F.NGW = g * NWAVES;
}

struct EpiStore {
    static constexpr bool PERM = true, AFTER_DRAIN = false;
    bf16* O; int ldc; int qtiles; float qscale;
    __device__ __forceinline__ void operator()(const f32x4 (&acc)[2][2][4][2], const pg8::Unit& u, int wr, int wc, int fr, int fq) const {
        const int row0 = u.pm * 256 + wr * 64 + fr, col0 = u.pn * 256 + wc * 32 + 8 * fq;
        const float sc = (u.pn < qtiles) ? qscale : 1.f;
#pragma unroll
        for (int ai = 0; ai < 2; ++ai)
#pragma unroll
            for (int m = 0; m < 4; ++m) { bf16* rowp = O + (size_t)(row0 + ai * 128 + m * 16) * ldc + col0;
#pragma unroll
                for (int bj = 0; bj < 2; ++bj) { const f32x4 v0 = acc[ai][bj][m][0] * sc, v1 = acc[ai][bj][m][1] * sc;
                    pg8::u32x4 w; w.x = pg8::cvt_pk_bf16(v0[0], v0[1]); w.y = pg8::cvt_pk_bf16(v0[2], v0[3]); w.z = pg8::cvt_pk_bf16(v1[0], v1[1]); w.w = pg8::cvt_pk_bf16(v1[2], v1[3]);
                    *(pg8::u32x4*)(rowp + bj * 128) = w; } }
    }
};
struct EpiSwiglu {
    static constexpr bool PERM = true, AFTER_DRAIN = false;
    bf16* O; int ldc;
    __device__ __forceinline__ void operator()(const f32x4 (&acc)[2][2][4][2], const pg8::Unit& u, int wr, int wc, int fr, int fq) const {
        const int row0 = u.pm * 256 + wr * 64 + fr, col0 = u.pn * 128 + wc * 32 + 8 * fq;
#pragma unroll
        for (int ai = 0; ai < 2; ++ai)
#pragma unroll
            for (int m = 0; m < 4; ++m) { bf16* rowp = O + (size_t)(row0 + ai * 128 + m * 16) * ldc + col0;
                float r[8];
#pragma unroll
                for (int n = 0; n < 2; ++n)
#pragma unroll
                    for (int e = 0; e < 4; ++e) { const float g = acc[ai][0][m][n][e], up = acc[ai][1][m][n][e]; r[n * 4 + e] = g * __builtin_amdgcn_rcpf(1.f + __expf(-g)) * up; }
                pg8::u32x4 w; w.x = pg8::cvt_pk_bf16(r[0], r[1]); w.y = pg8::cvt_pk_bf16(r[2], r[3]); w.z = pg8::cvt_pk_bf16(r[4], r[5]); w.w = pg8::cvt_pk_bf16(r[6], r[7]);
                *(pg8::u32x4*)rowp = w; }
    }
};

struct EpiSoftmax {
    static constexpr bool PERM = true, AFTER_DRAIN = true;
    bf16* O; int ldc;
    __device__ __forceinline__ void fused(f32x4 (&acc)[2][2][4][2], const pg8::Unit& u, int wr, int wc, int fr, int fq, LAS unsigned char* lds, int wid, int lane) const {
        typedef float f32x2v __attribute__((ext_vector_type(2)));
        constexpr float C2 = 0.0625f * 1.4426950408889634f;
        LAS f32x2v* ST = (LAS f32x2v*)lds;
#pragma unroll
        for (int ai = 0; ai < 2; ++ai)
#pragma unroll
            for (int m = 0; m < 4; ++m) {
                float mx = -INFINITY;
#pragma unroll
                for (int bj = 0; bj < 2; ++bj)
#pragma unroll
                    for (int n = 0; n < 2; ++n) { const f32x4 x = acc[ai][bj][m][n]; mx = fmaxf(mx, fmaxf(fmaxf(x[0], x[1]), fmaxf(x[2], x[3]))); }
                mx = fmaxf(mx, __shfl_xor(mx, 16)); mx = fmaxf(mx, __shfl_xor(mx, 32));
                float sum = 0.f;
#pragma unroll
                for (int bj = 0; bj < 2; ++bj)
#pragma unroll
                    for (int n = 0; n < 2; ++n) { f32x4 x = acc[ai][bj][m][n];
#pragma unroll
                        for (int e = 0; e < 4; ++e) { x[e] = __builtin_amdgcn_exp2f((x[e] - mx) * C2); sum += x[e]; }
                        acc[ai][bj][m][n] = x; }
                sum += __shfl_xor(sum, 16); sum += __shfl_xor(sum, 32);
                if (fq == 0) ST[(ai * 128 + wr * 64 + m * 16 + fr) * 4 + wc] = (f32x2v){mx, sum};
            }
        asm volatile("s_waitcnt lgkmcnt(0)" ::: "memory"); __builtin_amdgcn_s_barrier(); asm volatile("" ::: "memory");
        const int row0 = u.pm * 256 + wr * 64 + fr, col0 = u.pn * 256 + wc * 32 + 8 * fq;
#pragma unroll
        for (int ai = 0; ai < 2; ++ai)
#pragma unroll
            for (int m = 0; m < 4; ++m) {
                const LAS f32x2v* sp = ST + (ai * 128 + wr * 64 + m * 16 + fr) * 4;
                const f32x2v s0 = sp[0], s1 = sp[1], s2 = sp[2], s3 = sp[3];
                const float MX = fmaxf(fmaxf(s0.x, s1.x), fmaxf(s2.x, s3.x));
                const float L = s0.y * __builtin_amdgcn_exp2f((s0.x - MX) * C2) + s1.y * __builtin_amdgcn_exp2f((s1.x - MX) * C2) + s2.y * __builtin_amdgcn_exp2f((s2.x - MX) * C2) + s3.y * __builtin_amdgcn_exp2f((s3.x - MX) * C2);
                const float mine = (wc == 0) ? s0.x : (wc == 1) ? s1.x : (wc == 2) ? s2.x : s3.x;
                const float f = __builtin_amdgcn_exp2f((mine - MX) * C2) / L;
                bf16* rowp = O + (size_t)(row0 + ai * 128 + m * 16) * ldc + col0;
#pragma unroll
                for (int bj = 0; bj < 2; ++bj) { const f32x4 v0 = acc[ai][bj][m][0] * f, v1 = acc[ai][bj][m][1] * f;
                    pg8::u32x4 w; w.x = pg8::cvt_pk_bf16(v0[0], v0[1]); w.y = pg8::cvt_pk_bf16(v0[2], v0[3]); w.z = pg8::cvt_pk_bf16(v1[0], v1[1]); w.w = pg8::cvt_pk_bf16(v1[2], v1[3]);
                    *(pg8::u32x4*)(rowp + bj * 128) = w; }
            }
    }
};
struct OneUnit {
    __device__ __forceinline__ bool next(int i, pg8::Unit& u) const { if (i) return false; u.pm = 0; u.pn = 0; u.aoff = 0; u.boff = 0; return true; }
    __device__ __forceinline__ void a_ready(const pg8::Unit&) const {}
    __device__ __forceinline__ void done(const pg8::Unit&) const {}
};

__device__ __forceinline__ void transpose_item(const float* W, int ld, int K, bf16* WT, int k0, int n0, int drow, LAS float* scr, int lane) {
    LAS unsigned short* t16 = (LAS unsigned short*)scr;
    const int kr = lane >> 3, c4 = lane & 7;
    f32x4 v[8];
#pragma unroll
    for (int i = 0; i < 8; ++i) v[i] = *(const GAS f32x4*)(W + (size_t)(k0 + kr + 8 * i) * ld + n0 + 4 * c4);
#pragma unroll
    for (int i = 0; i < 8; ++i)
#pragma unroll
        for (int j = 0; j < 4; ++j) t16[(4 * c4 + j) * 72 + kr + 8 * i] = (unsigned short)f2bf(v[i][j]);
    LDS_WAIT(); asm volatile("" ::: "memory");
#pragma unroll
    for (int q = 0; q < 4; ++q) { const int n = kr + 8 * q; const v4u o = *(const LAS v4u*)(t16 + n * 72 + 8 * c4);
        *(GAS v4u*)(WT + (size_t)(drow + n) * K + k0 + 8 * c4) = o; }
    LDS_WAIT(); asm volatile("" ::: "memory");
}
__device__ __forceinline__ void p0_convert(Frame& F) {
    relane(F);
    LAS float* scr = (LAS float*)(F.lds + RING_OFF + F.wave * 16384);
    bf16* Wb = (bf16*)(F.ws + WS_W); bf16* Wkv = (bf16*)(F.ws + WS_XWT);
    constexpr int I_IN = 16 * 96, I_OUT = 16 * 32, I_Q = 16 * 32, I_O = 16 * 32, I_KV = 16 * 64, I_GU = 16 * 176, I_DN = 44 * 32;
    constexpr int I_LAYER = I_IN + I_OUT + I_Q + I_O + I_KV + I_GU + I_DN;
    for (int it = F.gw; it < 4 * I_LAYER; it += F.NGW) {
        const int l = it / I_LAYER, j = l >> 1; int r = it % I_LAYER;
        bf16* WL = Wb + (size_t)l * WL_SIZE;
        if (r < I_IN) { const int kb = r / 96, nb = r % 96;
            if (l & 1) transpose_item(inp(F, 8) + (size_t)j * D * 3072, 3072, D, WL + WL_IN, kb * 64, nb * 32, nb * 32, scr, F.lane);
            else       transpose_item(inp(F, 4) + (size_t)j * D * ML_W, ML_W, D, WL + WL_IN, kb * 64, nb * 32, nb * 32, scr, F.lane);
            continue; } r -= I_IN;
        if (r < I_OUT) { const int kb = r / 32, nb = r % 32;
            transpose_item(((l & 1) ? inp(F, 9) : inp(F, 7)) + (size_t)j * D * D, D, D, WL + WL_OUT, kb * 64, nb * 32, nb * 32, scr, F.lane); continue; } r -= I_OUT;
        if (r < I_Q) { const int e0 = r * 2048 + F.lane * 8;
#pragma unroll
            for (int q = 0; q < 4; ++q) { const GAS f32x4* sp = (const GAS f32x4*)(inp(F, 10) + (size_t)l * D * D + e0 + q * 512); const f32x4 x0 = sp[0], x1 = sp[1];
                v4u o; o.x = pk2(x0.x, x0.y); o.y = pk2(x0.z, x0.w); o.z = pk2(x1.x, x1.y); o.w = pk2(x1.z, x1.w); *(GAS v4u*)(WL + WL_QN + e0 + q * 512) = o; }
            continue; } r -= I_Q;
        if (r < I_O) { const int kb = r / 32, nb = r % 32; transpose_item(inp(F, 12) + (size_t)l * D * D, D, D, WL + WL_OT, kb * 64, nb * 32, nb * 32, scr, F.lane); continue; } r -= I_O;
        if (r < I_KV) { const int kb = r / 64, nb = r % 64; transpose_item(inp(F, 11) + (size_t)l * D * 2048, 2048, D, Wkv, kb * 64, nb * 32, l * 2048 + nb * 32, scr, F.lane); continue; } r -= I_KV;
        if (r < I_GU) { const int kb = r / 176, nb = r % 176; const int c0 = nb * 32; const int up = c0 >= DFF, jj = up ? c0 - DFF : c0;
            transpose_item(inp(F, 13) + (size_t)l * D * 2 * DFF, 2 * DFF, D, WL + WL_GU, kb * 64, c0, 256 * (jj >> 7) + 128 * up + (jj & 127), scr, F.lane); continue; } r -= I_GU;
        { const int kb = r / 32, nb = r % 32; transpose_item(inp(F, 14) + (size_t)l * DFF * D, D, DFF, WL + WL_DN, kb * 64, nb * 32, nb * 32, scr, F.lane); }
    }
    bf16* MEMN = (bf16*)(F.ws + WS_MEMN);
    for (int m = F.gw; m < MM; m += F.NGW) {
        const GAS f32x4* xr = (const GAS f32x4*)(inp(F, 1) + (size_t)m * D) + F.lane; const GAS f32x4* gr = (const GAS f32x4*)inp(F, 2) + F.lane;
        f32x4 v[4]; float s = 0.f;
#pragma unroll
        for (int q = 0; q < 4; ++q) { v[q] = xr[64 * q]; s += (v[q].x * v[q].x + v[q].y * v[q].y) + (v[q].z * v[q].z + v[q].w * v[q].w); }
        const float rs = rsqrtf(wave_sum(s) * (1.f / D) + EPS);
        GAS unsigned long long* o8 = (GAS unsigned long long*)(MEMN + (size_t)m * D) + F.lane;
#pragma unroll
        for (int q = 0; q < 4; ++q) { const f32x4 g = gr[64 * q]; o8[64 * q] = (unsigned long long)pk2(v[q].x * rs * g.x, v[q].y * rs * g.y) | ((unsigned long long)pk2(v[q].z * rs * g.z, v[q].w * rs * g.w) << 32); }
    }
}

__device__ __forceinline__ void row_phase(Frame& F, const float* xin, float* xout, const bf16* Y, const float* ga, const float* gb, bf16* XN, const float* WG, int wgs, const float* bg, float* GT) {
    relane(F);
    constexpr int NR = 4;
    for (int m0 = F.gw; m0 < M; m0 += NR * F.NGW) {
        f32x4 v[NR][4]; unsigned long long yw[NR][4];
#pragma unroll
        for (int k = 0; k < NR; ++k) { const int m = m0 + k * F.NGW;
            if (m < M) { const GAS f32x4* xr = (const GAS f32x4*)(xin + (size_t)m * D) + F.lane;
#pragma unroll
                for (int q = 0; q < 4; ++q) v[k][q] = xr[64 * q];
                if (Y) { const GAS unsigned long long* yr = (const GAS unsigned long long*)(Y + (size_t)m * D) + F.lane;
#pragma unroll
                    for (int q = 0; q < 4; ++q) yw[k][q] = yr[64 * q]; } } }
#pragma unroll
        for (int k = 0; k < NR; ++k) { const int m = m0 + k * F.NGW;
            if (m >= M) break;
            if (Y) {
                f32x4 y[4]; float s = 0.f;
#pragma unroll
                for (int q = 0; q < 4; ++q) { const unsigned lo = (unsigned)yw[k][q], hi = (unsigned)(yw[k][q] >> 32);
                    y[q] = (f32x4){bflo(lo), bfhi(lo), bflo(hi), bfhi(hi)}; s += (y[q].x * y[q].x + y[q].y * y[q].y) + (y[q].z * y[q].z + y[q].w * y[q].w); }
                const float rs = rsqrtf(wave_sum(s) * (1.f / D) + EPS);
                const GAS f32x4* gr = (const GAS f32x4*)ga + F.lane;
#pragma unroll
                for (int q = 0; q < 4; ++q) { const f32x4 g = gr[64 * q]; v[k][q] = v[k][q] + y[q] * rs * g; }
            }
            if (Y || xin != xout) { GAS f32x4* xo = (GAS f32x4*)(xout + (size_t)m * D) + F.lane;
#pragma unroll
                for (int q = 0; q < 4; ++q) xo[64 * q] = v[k][q]; }
            if (gb) {
                float s = 0.f;
#pragma unroll
                for (int q = 0; q < 4; ++q) s += (v[k][q].x * v[k][q].x + v[k][q].y * v[k][q].y) + (v[k][q].z * v[k][q].z + v[k][q].w * v[k][q].w);
                const float rs = rsqrtf(wave_sum(s) * (1.f / D) + EPS);
                const GAS f32x4* gr = (const GAS f32x4*)gb + F.lane;
                GAS unsigned long long* o8 = (GAS unsigned long long*)(XN + (size_t)m * D) + F.lane;
#pragma unroll
                for (int q = 0; q < 4; ++q) { const f32x4 g = gr[64 * q]; v[k][q] = v[k][q] * rs * g; o8[64 * q] = (unsigned long long)pk2(v[k][q].x, v[k][q].y) | ((unsigned long long)pk2(v[k][q].z, v[k][q].w) << 32); }
                if (WG) {
                    float acc[8];
#pragma unroll
                    for (int c = 0; c < 8; ++c) acc[c] = 0.f;
#pragma unroll
                    for (int q = 0; q < 4; ++q)
#pragma unroll
                        for (int e = 0; e < 4; ++e) { const GAS f32x4* w = (const GAS f32x4*)(WG + (size_t)(4 * F.lane + 256 * q + e) * wgs); const f32x4 w0 = w[0], w1 = w[1]; const float h = v[k][q][e];
                            acc[0] += h * w0.x; acc[1] += h * w0.y; acc[2] += h * w0.z; acc[3] += h * w0.w; acc[4] += h * w1.x; acc[5] += h * w1.y; acc[6] += h * w1.z; acc[7] += h * w1.w; }
#pragma unroll
                    for (int c = 0; c < 8; ++c) acc[c] = wave_sum(acc[c]);
                    if (F.lane < 8) {
                        float a = 0.f;
#pragma unroll
                        for (int c = 0; c < 8; ++c) a = (F.lane == c) ? acc[c] : a;
                        a = 15.f * tanhf((a + bg[F.lane]) * (1.f / 15.f));
                        if (F.lane >= 4) a = -softplusf(-a);
                        GT[(size_t)m * 8 + F.lane] = a;
                    }
                }
            }
        }
    }
}

namespace sbk {
typedef float f32x16 __attribute__((ext_vector_type(16)));
typedef short s16x4 __attribute__((ext_vector_type(4)));
typedef short v4i16_t __attribute__((ext_vector_type(4)));
__device__ __forceinline__ unsigned cvtpk(float lo, float hi) { typedef float f32x2_t __attribute__((ext_vector_type(2))); typedef __bf16 bf16x2_t __attribute__((ext_vector_type(2)));
    f32x2_t v = {lo, hi}; bf16x2_t b = __builtin_convertvector(v, bf16x2_t); return __builtin_bit_cast(unsigned, b); }
#define SB_MFMA(a, b, c) __builtin_amdgcn_mfma_f32_32x32x16_bf16((a), (b), (c), 0, 0, 0)
constexpr int KB0 = 0, VB0 = 16384;
constexpr float C2 = 0.125f * 1.4426950408889634f;

typedef _Float16 f16x8 __attribute__((ext_vector_type(8)));
#define SB_MFMA16(a, b, c) __builtin_amdgcn_mfma_f32_32x32x16_f16((a), (b), (c), 0, 0, 0)
template <bool MASK>
__device__ __forceinline__ void tile(LAS unsigned char* kb, LAS unsigned char* vb, const bf16x8 (&qr)[4], f32x16 (&o)[2], float& carry, int nv, int lane, int r, int hh, const f16x8 (&TRI)[2], const f16x8 ONES) {
    f32x16 e[2];
    {   f32x16 p0, p1;
#pragma unroll
        for (int i = 0; i < 16; ++i) { p0[i] = 0.f; p1[i] = 0.f; }
#pragma unroll
        for (int ks = 0; ks < 4; ++ks) {
            const bf16x8 k0 = *(const LAS bf16x8*)(kb + r * 128 + (((2 * ks + hh) ^ (r & 7)) << 4));
            const bf16x8 k1 = *(const LAS bf16x8*)(kb + (r + 32) * 128 + (((2 * ks + hh) ^ (r & 7)) << 4));
            p0 = SB_MFMA(k0, qr[ks], p0); p1 = SB_MFMA(k1, qr[ks], p1);
        }
        e[0] = p0; e[1] = p1;
    }
    v4u Lh[2][2];
    float sv = 0.f;
#pragma unroll
    for (int ib = 0; ib < 2; ++ib)
#pragma unroll
        for (int i = 0; i < 16; i += 2) {
            float L[2];
#pragma unroll
            for (int u = 0; u < 2; ++u) {
                const float w = e[ib][i + u];
                const float sp = fmaxf(w, 0.f) + __builtin_amdgcn_logf(1.f + __builtin_amdgcn_exp2f(-fabsf(w)));
                float Lm = -sp;
                if (MASK) { const int ci = ((i + u) & 3) + 8 * ((i + u) >> 2) + 32 * ib; Lm = (ci < nv) ? Lm : 0.f; }
                if (ib == 0 && i + u == 0) sv = (w - sp) - Lm;
                e[ib][i + u] = (w + carry) - sp;
                L[u] = Lm;
            }
            Lh[ib][i >> 3][(i & 7) >> 1] = __builtin_bit_cast(unsigned, __builtin_amdgcn_cvt_pkrtz(L[0], L[1]));
        }
#define SB_H(x) __builtin_bit_cast(f16x8, x)
    e[0] = SB_MFMA16(TRI[0], SB_H(Lh[0][0]), e[0]); e[1] = SB_MFMA16(TRI[0], SB_H(Lh[1][0]), e[1]);
    e[0] = SB_MFMA16(TRI[1], SB_H(Lh[0][1]), e[0]); e[1] = SB_MFMA16(TRI[1], SB_H(Lh[1][1]), e[1]);
    e[0] = SB_MFMA16(ONES, SB_H(Lh[1][0]), e[0]); e[0] = SB_MFMA16(ONES, SB_H(Lh[1][1]), e[0]);
#undef SB_H
    carry = __shfl(e[0][0] - sv, r);
    v4u pa[2][2];
#pragma unroll
    for (int ib = 0; ib < 2; ++ib)
#pragma unroll
        for (int i = 0; i < 16; i += 2) {
            float a[2];
#pragma unroll
            for (int u = 0; u < 2; ++u) {
                a[u] = __builtin_amdgcn_exp2f(e[ib][i + u]);
                if (MASK) { const int ci = ((i + u) & 3) + 8 * ((i + u) >> 2) + 32 * ib; a[u] = (ci < nv) ? a[u] : 0.f; }
            }
            pa[ib][i >> 3][(i & 7) >> 1] = cvtpk(a[0], a[1]);
        }
#define SB_F(x) __builtin_bit_cast(bf16x8, x)
    const int q4 = (lane & 15) >> 2, p4 = lane & 3, g1 = (lane >> 4) & 1;
    LAS unsigned char* vl = vb + (4 * hh + q4) * 128 + (16 * g1 + 4 * p4) * 2;
#pragma unroll
    for (int ib = 0; ib < 2; ++ib)
#pragma unroll
        for (int ks2 = 0; ks2 < 2; ++ks2)
#pragma unroll
            for (int db = 0; db < 2; ++db) {
                LAS unsigned char* pv = vl + (32 * ib + 16 * ks2) * 128 + db * 64;
                const s16x4 lo = __builtin_bit_cast(s16x4, __builtin_amdgcn_ds_read_tr16_b64_v4i16((LAS v4i16_t*)pv));
                const s16x4 hi = __builtin_bit_cast(s16x4, __builtin_amdgcn_ds_read_tr16_b64_v4i16((LAS v4i16_t*)(pv + 8 * 128)));
                const bf16x8 vf = __builtin_shufflevector(lo, hi, 0, 1, 2, 3, 4, 5, 6, 7);
                o[db] = SB_MFMA(SB_F(pa[ib][ks2]), vf, o[db]);
            }
#undef SB_F
}

__device__ __forceinline__ void unit(int b, int h, int qb, const bf16* QKV, bf16* MIX, LAS unsigned char* lds, int tid) {
    const int lane = tid & 63, r = lane & 31, hh = lane >> 5, wid = __builtin_amdgcn_readfirstlane(tid >> 6);
    const size_t rowbase = (size_t)b * SEQ; const int q0 = qb * 256, trow = q0 + 32 * wid + r;
    bf16x8 qr[4];
#pragma unroll
    for (int ks = 0; ks < 4; ++ks) qr[ks] = *(const GAS bf16x8*)(QKV + (rowbase + trow) * 3072 + h * 64 + ks * 16 + hh * 8);
    f16x8 TRI[2], ONES;
#pragma unroll
    for (int ks2 = 0; ks2 < 2; ++ks2)
#pragma unroll
        for (int j = 0; j < 8; ++j) TRI[ks2][j] = ((16 * ks2 + 8 * (j >> 2) + 4 * hh + (j & 3)) > r) ? (_Float16)1.0f : (_Float16)0.0f;
#pragma unroll
    for (int j = 0; j < 8; ++j) ONES[j] = (_Float16)1.0f;
    const int srow = tid >> 3, sc = tid & 7;
    const bf16* kg = QKV + rowbase * 3072 + 1024 + h * 64 + (size_t)srow * 3072 + sc * 8;
    const int kdst = srow * 128 + ((sc ^ (srow & 7)) << 4), vdst = srow * 128 + sc * 16;
    const int NT = 4 * qb + 4;
    { const bf16* p = kg + (size_t)(NT - 1) * 64 * 3072; const v4u kx = *(const GAS v4u*)p, vx = *(const GAS v4u*)(p + 1024);
      *(LAS v4u*)(lds + KB0 + kdst) = kx; *(LAS v4u*)(lds + VB0 + vdst) = vx; }
    v4u k1, v1, k2, v2;
    { const bf16* p = kg + (size_t)(NT - 2) * 64 * 3072; k1 = *(const GAS v4u*)p; v1 = *(const GAS v4u*)(p + 1024); }
    __syncthreads();
    f32x16 o[2];
#pragma unroll
    for (int i = 0; i < 16; ++i) { o[0][i] = 0.f; o[1][i] = 0.f; }
    float carry = 0.f;
    const int wmax = q0 + 32 * wid + 31, wmin = q0 + 32 * wid;
#define SB_STEP(kt_, buf_) do { if (64 * (kt_) < wmax) { const int nv = trow - 64 * (kt_) - 4 * hh; \
        if (64 * (kt_) + 63 >= wmin) tile<true>(lds + KB0 + (buf_) * 8192, lds + VB0 + (buf_) * 8192, qr, o, carry, nv, lane, r, hh, TRI, ONES); \
        else tile<false>(lds + KB0 + (buf_) * 8192, lds + VB0 + (buf_) * 8192, qr, o, carry, nv, lane, r, hh, TRI, ONES); } } while (0)
    for (int kt = NT - 1; kt >= 1; kt -= 2) {
        if (kt >= 2) { const bf16* p = kg + (size_t)(kt - 2) * 64 * 3072; k2 = *(const GAS v4u*)p; v2 = *(const GAS v4u*)(p + 1024); }
        SB_STEP(kt, 0);
        *(LAS v4u*)(lds + KB0 + 8192 + kdst) = k1; *(LAS v4u*)(lds + VB0 + 8192 + vdst) = v1;
        __syncthreads();
        if (kt >= 3) { const bf16* p = kg + (size_t)(kt - 3) * 64 * 3072; k1 = *(const GAS v4u*)p; v1 = *(const GAS v4u*)(p + 1024); }
        SB_STEP(kt - 1, 1);
        if (kt >= 2) { *(LAS v4u*)(lds + KB0 + kdst) = k2; *(LAS v4u*)(lds + VB0 + vdst) = v2; }
        __syncthreads();
    }
#undef SB_STEP
    unsigned short* op = (unsigned short*)MIX + (rowbase + q0 + 32 * wid) * D + h * 64 + r;
#pragma unroll
    for (int db = 0; db < 2; ++db)
#pragma unroll
        for (int i = 0; i < 16; ++i) { const int row = (i & 3) + 8 * (i >> 2) + 4 * hh; ((GAS unsigned short*)op)[(size_t)row * D + 32 * db] = (unsigned short)f2bf(o[db][i]); }
}
#undef SB_MFMA
#undef SB_MFMA16
}
__device__ __forceinline__ void sb_attn_v2(Frame& F, const bf16* QKV, bf16* MIX) {
    relane(F);
    for (int v = blockIdx.x; v < 256; v += F.G) {
        const int bh = v >> 1, sel = v & 1;
#pragma unroll 1
        for (int u = 0; u < 4; ++u) {
            const int qb = sel ? ((u == 0) ? 6 : (u == 1) ? 1 : (u == 2) ? 4 : 3) : ((u == 0) ? 7 : (u == 1) ? 0 : (u == 2) ? 5 : 2);
            sbk::unit(bh >> 4, bh & 15, qb, QKV, MIX, F.lds + RING_OFF, F.tid);
        }
    }
}

namespace mlk {
typedef float f32x16 __attribute__((ext_vector_type(16)));
typedef short s16x4 __attribute__((ext_vector_type(4)));
typedef short v4i16_t __attribute__((ext_vector_type(4)));
#define ML_MFMA(a, b, c) __builtin_amdgcn_mfma_f32_32x32x16_bf16((a), (b), (c), 0, 0, 0)
__device__ __forceinline__ bf16x8 trpair(LAS unsigned char* p, int rowbytes4) {
    const s16x4 lo = __builtin_bit_cast(s16x4, __builtin_amdgcn_ds_read_tr16_b64_v4i16((LAS v4i16_t*)p));
    const s16x4 hi = __builtin_bit_cast(s16x4, __builtin_amdgcn_ds_read_tr16_b64_v4i16((LAS v4i16_t*)(p + rowbytes4)));
    return __builtin_shufflevector(lo, hi, 0, 1, 2, 3, 4, 5, 6, 7);
}
__device__ __forceinline__ float scan_add(float v, int lane) {
#pragma unroll
    for (int o = 1; o < 64; o <<= 1) { const float y = __shfl_up(v, o); if (lane >= o) v += y; }
    return v;
}
__device__ __forceinline__ float scan_max(float v, int lane) {
#pragma unroll
    for (int o = 1; o < 64; o <<= 1) { const float y = __shfl_up(v, o); if (lane >= o) v = fmaxf(v, y); }
    return v;
}
__device__ __forceinline__ void scale8(const v4u in, float w, v4u& out) {
    out.x = pk2(bflo(in.x) * w, bfhi(in.x) * w); out.y = pk2(bflo(in.y) * w, bfhi(in.y) * w); out.z = pk2(bflo(in.z) * w, bfhi(in.z) * w); out.w = pk2(bflo(in.w) * w, bfhi(in.w) * w);
}
constexpr float KSC = 0.08838834764831845f;

__device__ __forceinline__ void phaseA(Frame& F, const bf16* PROJ, const float* GT, bf16* ST, float* NST, float* SCAL) {
    relane(F);
    const int tid = F.tid, lane = F.lane, wv = F.wave, r = lane & 31, hh = lane >> 5, q4 = (lane & 15) >> 2, p4 = lane & 3, g1 = (lane >> 4) & 1;
    LAS unsigned char* KW = F.lds + RING_OFF; LAS unsigned char* VT = KW + 16384; LAS float* wk = (LAS float*)(KW + 49152);
    bf16x8 ONES;
#pragma unroll
    for (int j = 0; j < 8; ++j) ONES[j] = (short)0x3F80;
    for (int unit = blockIdx.x; unit < 1024; unit += F.G) {
        const int bh = unit >> 5, c = unit & 31, b = bh >> 2, h = bh & 3; const size_t row0 = (size_t)b * SEQ + c * 64;
        if (wv == 0) {
            const float lf = GT[(row0 + lane) * 8 + 4 + h], ig = GT[(row0 + lane) * 8 + h];
            const float bc = scan_add(lf, lane), bl = __shfl(bc, 63), g = bl - bc + ig, ml = wave_max(g);
            wk[lane] = __expf(g - ml) * KSC;
            if (lane == 0) { SCAL[unit * 2] = bl; SCAL[unit * 2 + 1] = ml; }
        }
        __syncthreads();
        { const int row = tid >> 3, c8 = tid & 7; const bf16* kp = PROJ + (row0 + row) * 3072 + 512 + h * 128 + c8 * 16;
          const v4u k0 = *(const GAS v4u*)kp, k1 = *(const GAS v4u*)(kp + 8); const bf16* vp = kp + 512 + h * 128 + c8 * 16;
          const v4u v0 = *(const GAS v4u*)vp, v1 = *(const GAS v4u*)(vp + 8), v2 = *(const GAS v4u*)(vp + 16), v3 = *(const GAS v4u*)(vp + 24);
          const float w = wk[row]; v4u o0, o1; scale8(k0, w, o0); scale8(k1, w, o1);
          *(LAS v4u*)(KW + row * 256 + c8 * 32) = o0; *(LAS v4u*)(KW + row * 256 + c8 * 32 + 16) = o1;
          LAS v4u* vd = (LAS v4u*)(VT + row * 512 + c8 * 64); vd[0] = v0; vd[1] = v1; vd[2] = v2; vd[3] = v3; }
        __syncthreads();
        f32x16 acc[4], nacc[4];
#pragma unroll
        for (int cb = 0; cb < 4; ++cb)
#pragma unroll
            for (int i = 0; i < 16; ++i) { acc[cb][i] = 0.f; nacc[cb][i] = 0.f; }
#pragma unroll
        for (int ks = 0; ks < 4; ++ks) {
            const bf16x8 af = trpair(VT + (16 * ks + 8 * hh + q4) * 512 + (32 * wv + 16 * g1 + 4 * p4) * 2, 4 * 512);
#pragma unroll
            for (int cb = 0; cb < 4; ++cb) {
                const bf16x8 bfr = trpair(KW + (16 * ks + 8 * hh + q4) * 256 + (32 * cb + 16 * g1 + 4 * p4) * 2, 4 * 256);
                acc[cb] = ML_MFMA(af, bfr, acc[cb]);
                if (wv == 0) nacc[cb] = ML_MFMA(ONES, bfr, nacc[cb]);
            }
        }
        GAS unsigned short* sp = (GAS unsigned short*)ST + (size_t)unit * 32768 + (size_t)(32 * wv) * 128 + r;
#pragma unroll
        for (int cb = 0; cb < 4; ++cb)
#pragma unroll
            for (int i = 0; i < 16; ++i) sp[((i & 3) + 8 * (i >> 2) + 4 * hh) * 128 + 32 * cb] = (unsigned short)f2bf(acc[cb][i]);
        if (wv == 0 && hh == 0) {
#pragma unroll
            for (int cb = 0; cb < 4; ++cb) NST[(size_t)unit * 128 + 32 * cb + r] = nacc[cb][0];
        }
        __syncthreads();
    }
}
__device__ __forceinline__ void phaseB(Frame& F, bf16* ST, float* NST, const float* SCAL, float* MPREV) {
    relane(F);
    for (int task = blockIdx.x * 512 + F.tid; task < 32 * 4096; task += F.G * 512) {
        const int bh = task >> 12, e0 = (task & 4095) * 8;
        float C[8], m = 0.f;
#pragma unroll
        for (int i = 0; i < 8; ++i) C[i] = 0.f;
        GAS v4u* p = (GAS v4u*)(ST + (size_t)bh * 32 * 32768 + e0);
        const float* sc = SCAL + (size_t)bh * 64;
#pragma unroll 4
        for (int c = 0; c < 32; ++c) {
            const v4u d = p[(size_t)c * 4096];
            const float bl = sc[2 * c], ml = sc[2 * c + 1], mn = fmaxf(bl + m, ml), dec = __expf(bl + m - mn), s = __expf(ml - mn);
            v4u o; o.x = pk2(C[0], C[1]); o.y = pk2(C[2], C[3]); o.z = pk2(C[4], C[5]); o.w = pk2(C[6], C[7]);
            p[(size_t)c * 4096] = o;
            if ((task & 4095) == 0) MPREV[bh * 32 + c] = m;
            C[0] = dec * C[0] + s * bflo(d.x); C[1] = dec * C[1] + s * bfhi(d.x); C[2] = dec * C[2] + s * bflo(d.y); C[3] = dec * C[3] + s * bfhi(d.y);
            C[4] = dec * C[4] + s * bflo(d.z); C[5] = dec * C[5] + s * bfhi(d.z); C[6] = dec * C[6] + s * bflo(d.w); C[7] = dec * C[7] + s * bfhi(d.w);
            m = mn;
        }
    }
    for (int task = blockIdx.x * 512 + F.tid; task < 32 * 128; task += F.G * 512) {
        const int bh = task >> 7, e = task & 127;
        float n = 0.f, m = 0.f; float* p = NST + (size_t)bh * 32 * 128 + e; const float* sc = SCAL + (size_t)bh * 64;
        for (int c = 0; c < 32; ++c) {
            const float d = p[c * 128], bl = sc[2 * c], ml = sc[2 * c + 1], mn = fmaxf(bl + m, ml);
            p[c * 128] = n; n = __expf(bl + m - mn) * n + __expf(ml - mn) * d; m = mn;
        }
    }
}
__device__ __forceinline__ void phaseC(Frame& F, bf16* PROJ, const float* GT, const bf16* ST, const float* NST, const float* MPREV, const float* hgain) {
    relane(F);
    const int tid = F.tid, lane = F.lane, wv = F.wave, r = lane & 31, hh = lane >> 5, q4 = (lane & 15) >> 2, p4 = lane & 3, g1 = (lane >> 4) & 1;
    LAS unsigned char* KT = F.lds + RING_OFF; LAS unsigned char* QT = KT + 16384; LAS unsigned char* VT = KT + 32768; LAS unsigned char* SD = KT + 65536;
    LAS float* sm = (LAS float*)(KT + 73728);
    LAS float* aa = sm; LAS float* ct2 = sm + 64; LAS float* inter = sm + 128; LAS float* emt = sm + 192; LAS float* nq = sm + 256; LAS float* npv = sm + 320; LAS float* densum = sm + 448; LAS float* ssq = sm + 576;
    LAS unsigned char* HT = KT;
    for (int unit = blockIdx.x; unit < 1024; unit += F.G) {
        const int bh = unit >> 5, c = unit & 31, b = bh >> 2, h = bh & 3; const size_t row0 = (size_t)b * SEQ + c * 64;
        { const int row = tid >> 3, c8 = tid & 7; const bf16* qp = PROJ + (row0 + row) * 3072 + h * 128 + c8 * 16;
          const v4u q0 = *(const GAS v4u*)qp, q1 = *(const GAS v4u*)(qp + 8), k0 = *(const GAS v4u*)(qp + 512), k1 = *(const GAS v4u*)(qp + 520);
          const bf16* vp = PROJ + (row0 + row) * 3072 + 1024 + h * 256 + c8 * 32;
          const v4u v0 = *(const GAS v4u*)vp, v1 = *(const GAS v4u*)(vp + 8), v2 = *(const GAS v4u*)(vp + 16), v3 = *(const GAS v4u*)(vp + 24);
          const int sw0 = ((2 * c8) ^ (row & 15)) << 4, sw1 = ((2 * c8 + 1) ^ (row & 15)) << 4;
          *(LAS v4u*)(QT + row * 256 + sw0) = q0; *(LAS v4u*)(QT + row * 256 + sw1) = q1; *(LAS v4u*)(KT + row * 256 + sw0) = k0; *(LAS v4u*)(KT + row * 256 + sw1) = k1;
          LAS v4u* vd = (LAS v4u*)(VT + row * 512 + c8 * 64); vd[0] = v0; vd[1] = v1; vd[2] = v2; vd[3] = v3; }
        const float mprev = MPREV[unit];
        if (wv == 0) {
            const float lf = GT[(row0 + lane) * 8 + 4 + h], ig = GT[(row0 + lane) * 8 + h];
            const float bc = scan_add(lf, lane), a = ig - bc, pm = scan_max(a, lane), ctv = -fmaxf(pm, mprev);
            aa[lane] = a; ct2[lane] = ctv - 2.4260151319598084f  ; inter[lane] = __expf(mprev + ctv); emt[lane] = __expf(ctv - bc);
        } else if (wv == 1) { npv[lane] = NST[(size_t)unit * 128 + lane]; npv[lane + 64] = NST[(size_t)unit * 128 + 64 + lane]; }
        bf16x8 cf[8];
        { const bf16* cp = ST + (size_t)unit * 32768 + (size_t)(32 * wv + r) * 128 + 8 * hh;
#pragma unroll
          for (int ks = 0; ks < 8; ++ks) cf[ks] = *(const GAS bf16x8*)(cp + 16 * ks); }
        __syncthreads();
        if (wv < 4) {
            const int sb = wv & 1, tb = wv >> 1, srow = 32 * sb + r, trow = 32 * tb + r;
            f32x16 s;
#pragma unroll
            for (int i = 0; i < 16; ++i) s[i] = 0.f;
#pragma unroll
            for (int ks = 0; ks < 8; ++ks) {
                const bf16x8 kf = *(const LAS bf16x8*)(KT + srow * 256 + (((2 * ks + hh) ^ (srow & 15)) << 4));
                const bf16x8 qf = *(const LAS bf16x8*)(QT + trow * 256 + (((2 * ks + hh) ^ (trow & 15)) << 4));
                s = ML_MFMA(kf, qf, s);
            }
            const float ctl = ct2[trow]; float dsum = 0.f;
#pragma unroll
            for (int g = 0; g < 4; ++g) {
                float v[4];
#pragma unroll
                for (int u = 0; u < 4; ++u) { const int sidx = 32 * sb + 8 * g + 4 * hh + u; const float d = __expf(aa[sidx] + ctl); v[u] = (sidx <= trow) ? s[4 * g + u] * d : 0.f; dsum += v[u]; }
                const unsigned long long w = (unsigned long long)pk2(v[0], v[1]) | ((unsigned long long)pk2(v[2], v[3]) << 32);
                *(LAS unsigned long long*)(SD + trow * 128 + (((4 * sb + g) ^ (trow & 7)) << 4) + hh * 8) = w;
            }
            dsum += __shfl_xor(dsum, 32);
            if (hh == 0) densum[sb * 64 + trow] = dsum;
        } else if (wv == 4) {
            float a = 0.f;
#pragma unroll
            for (int ch = 0; ch < 16; ++ch) { const v4u qw = *(const LAS v4u*)(QT + lane * 256 + ((ch ^ (lane & 15)) << 4)); const LAS float* np = npv + 8 * ch;
                a += np[0] * bflo(qw.x) + np[1] * bfhi(qw.x) + np[2] * bflo(qw.y) + np[3] * bfhi(qw.y) + np[4] * bflo(qw.z) + np[5] * bfhi(qw.z) + np[6] * bflo(qw.w) + np[7] * bfhi(qw.w); }
            nq[lane] = a;
        }
        __syncthreads();
        f32x16 hv[2];
        {   f32x16 accA[2], accB[2];
#pragma unroll
            for (int tb = 0; tb < 2; ++tb)
#pragma unroll
                for (int i = 0; i < 16; ++i) { accA[tb][i] = 0.f; accB[tb][i] = 0.f; }
#pragma unroll
            for (int ks = 0; ks < 4; ++ks) {
                const bf16x8 af = trpair(VT + (16 * ks + 8 * hh + q4) * 512 + (32 * wv + 16 * g1 + 4 * p4) * 2, 4 * 512);
#pragma unroll
                for (int tb = 0; tb < 2; ++tb) { const int trow = 32 * tb + r;
                    const bf16x8 sf = *(const LAS bf16x8*)(SD + trow * 128 + (((2 * ks + hh) ^ (trow & 7)) << 4));
                    accA[tb] = ML_MFMA(af, sf, accA[tb]); }
            }
#pragma unroll
            for (int ks = 0; ks < 8; ++ks)
#pragma unroll
                for (int tb = 0; tb < 2; ++tb) { const int trow = 32 * tb + r;
                    const bf16x8 qf = *(const LAS bf16x8*)(QT + trow * 256 + (((2 * ks + hh) ^ (trow & 15)) << 4));
                    accB[tb] = ML_MFMA(cf[ks], qf, accB[tb]); }
#pragma unroll
            for (int tb = 0; tb < 2; ++tb) { const int trow = 32 * tb + r;
                const float it = inter[trow], den = densum[trow] + densum[64 + trow] + it * nq[trow], rinv = 1.f / fmaxf(fabsf(den), emt[trow]);
                float q = 0.f;
#pragma unroll
                for (int i = 0; i < 16; ++i) { const float x = (accA[tb][i] + it * accB[tb][i]) * rinv; hv[tb][i] = x; q += x * x; }
                q += __shfl_xor(q, 32);
                if (hh == 0) ssq[wv * 64 + trow] = q; }
        }
        __syncthreads();
#pragma unroll
        for (int tb = 0; tb < 2; ++tb)
#pragma unroll
            for (int g = 0; g < 4; ++g) *(LAS f32x4*)(HT + (32 * tb + r) * 1040 + (32 * wv + 8 * g + 4 * hh) * 4) = (f32x4){hv[tb][4 * g], hv[tb][4 * g + 1], hv[tb][4 * g + 2], hv[tb][4 * g + 3]};
        __syncthreads();
        { const int t = tid >> 3, c8 = tid & 7; float sq = 0.f;
#pragma unroll
          for (int w = 0; w < 8; ++w) sq += ssq[w * 64 + t];
          const float rs = rsqrtf(sq * (1.f / 256.f) + EPS);
          bf16* orow = PROJ + (row0 + t) * 3072 + 1024 + h * 256 + c8 * 32;
#pragma unroll
          for (int q = 0; q < 4; ++q) {
              const f32x4 h0 = *(const LAS f32x4*)(HT + t * 1040 + (32 * c8 + 8 * q) * 4), h1 = *(const LAS f32x4*)(HT + t * 1040 + (32 * c8 + 8 * q + 4) * 4);
              const v4u og = *(const GAS v4u*)(orow + 1024 + 8 * q);
              const f32x4 g0 = *(const GAS f32x4*)(hgain + h * 256 + c8 * 32 + 8 * q), g1v = *(const GAS f32x4*)(hgain + h * 256 + c8 * 32 + 8 * q + 4);
              float y[8];
              y[0] = h0[0] * rs * g0[0] / (1.f + __expf(-bflo(og.x))); y[1] = h0[1] * rs * g0[1] / (1.f + __expf(-bfhi(og.x)));
              y[2] = h0[2] * rs * g0[2] / (1.f + __expf(-bflo(og.y))); y[3] = h0[3] * rs * g0[3] / (1.f + __expf(-bfhi(og.y)));
              y[4] = h1[0] * rs * g1v[0] / (1.f + __expf(-bflo(og.z))); y[5] = h1[1] * rs * g1v[1] / (1.f + __expf(-bfhi(og.z)));
              y[6] = h1[2] * rs * g1v[2] / (1.f + __expf(-bflo(og.w))); y[7] = h1[3] * rs * g1v[3] / (1.f + __expf(-bfhi(og.w)));
              v4u o; o.x = pk2(y[0], y[1]); o.y = pk2(y[2], y[3]); o.z = pk2(y[4], y[5]); o.w = pk2(y[6], y[7]);
              *(GAS v4u*)(orow + 8 * q) = o; } }
        __syncthreads();
    }
}
#undef ML_MFMA
}

template <int MR, int N, int K, bool ALIGN, class Epi> __device__ __forceinline__ void run_gemm(Frame& F, const bf16* A, int lda, const bf16* Bt, int ldb, int pmb, size_t b_batch, const Epi E) {
    int gd = gridDim.x, bi = blockIdx.x; asm volatile("" : "+s"(gd), "+s"(bi));
    pg8::Gemm g{A, Bt, MR, N, K, lda, ldb}; pg8::StaticOrder S; S.init(MR, N, gd, bi, lda, ldb, pmb, b_batch);
    pg8::gemm_phase<Epi, pg8::StaticOrder, ALIGN, true>(F.lds + RING_OFF, g, S, E);
}
__device__ __forceinline__ void xw_gemms(Frame& F, const bf16* KVl, const bf16* WQN, const bf16* WOT, bf16* XWTp) {
    int gd = gridDim.x, bi = blockIdx.x; asm volatile("" : "+s"(gd), "+s"(bi));
    for (int L = bi; L < 256; L += gd) {
        const int idx = L & 127, b = idx >> 4, h = (idx >> 2) & 3, t = idx & 3;
        OneUnit S; int kk = 256; asm volatile("" : "+s"(kk));
        if (L < 128) {
            pg8::Gemm g{KVl + (size_t)(b * NMEM) * 8192 + h * 256, WQN + (size_t)(t * 256) * D + h * 256, 256, 256, kk, 8192, D};
            EpiStore E{XWTp + (size_t)b * D * D + (size_t)(h * 256) * D + t * 256, D, 0, 1.f};
            pg8::gemm_phase<EpiStore, OneUnit, true, true>(F.lds + RING_OFF, g, S, E);
        } else {
            pg8::Gemm g{WOT + (size_t)(t * 256) * D + h * 256, KVl + (size_t)(b * NMEM) * 8192 + 1024 + h * 256, 256, 256, kk, D, 8192};
            EpiStore E{XWTp + (size_t)(8 + b) * D * D + (size_t)(t * 256) * D + h * 256, D, 0, 1.f};
            pg8::gemm_phase<EpiStore, OneUnit, true, true>(F.lds + RING_OFF, g, S, E);
        }
    }
}
struct Args { const float* in[15]; float* out; unsigned char* ws; int pad[2]; };
__global__ void __launch_bounds__(NWAVES * 64, 2) mega_fwd(Args args) {
    extern __shared__ __attribute__((aligned(16))) unsigned char lds[];
    Frame F;
    F.lds = (LAS unsigned char*)lds; F.ws = args.ws;
    relane(F);
    for (int u = F.tid; u < (LDS_BYTES - LDSCTL_OFF) / 4; u += NWAVES * 64) ((LAS unsigned*)(F.lds + LDSCTL_OFF))[u] = 0u;
    __syncthreads();
    if (F.tid < 16) { const unsigned long long p = (F.tid < 15) ? (unsigned long long)args.in[F.tid < 15 ? F.tid : 0] : (unsigned long long)args.out;
        ((LAS unsigned*)(F.lds + LDSCTL_OFF))[2 * F.tid] = (unsigned)p; ((LAS unsigned*)(F.lds + LDSCTL_OFF))[2 * F.tid + 1] = (unsigned)(p >> 32); }
    __syncthreads();
    gu32* ctl = (gu32*)(F.ws + WS_CTL);
    XcdBarrier bar = xcd_barrier_post((unsigned*)(ctl + CW_BAR), (volatile LAS unsigned*)(F.lds + MISC_OFF) + 8);
#define GRID_BAR() xcd_barrier(bar)
#ifndef PROBE_CAT
#define PROBE_CAT 0
#endif
#define TPROBE ((volatile LAS unsigned long long*)(F.lds + MISC_OFF + 64))
#define GBAR(cat) do { xcd_barrier(bar); if (PROBE_CAT != 0 && blockIdx.x == 0 && threadIdx.x == 0) { const unsigned long long now_ = rt(); if ((cat) == PROBE_CAT) TPROBE[1] += now_ - TPROBE[0]; TPROBE[0] = now_; } } while (0)

#define Wb ((bf16*)(F.ws + WS_W))
#define XWT ((bf16*)(F.ws + WS_XWT))
#define XN ((bf16*)(F.ws + WS_XN))
#define MIX ((bf16*)(F.ws + WS_MIX))
#define BIG ((bf16*)(F.ws + WS_BIG))
#define PB (BIG + (size_t)M * D)
#define KV ((bf16*)(F.ws + WS_KV))
#define MEMN ((bf16*)(F.ws + WS_MEMN))
#define GT ((float*)(F.ws + WS_GATES))
#define NSTP ((float*)(F.ws + WS_NST))
#define SCALP ((float*)(F.ws + WS_SCAL))
#define MPREVP ((float*)(F.ws + WS_MPREV))
#define gains inp(F, 3)
#define XOUT ((float*)inp(F, 15))

    if (PROBE_CAT != 0 && blockIdx.x == 0 && threadIdx.x == 0) { TPROBE[0] = rt(); TPROBE[1] = 0ull; }
    p0_convert(F);
    row_phase(F, inp(F, 0), XOUT, nullptr, nullptr, gains, XN, inp(F, 4) + 3072, ML_W, inp(F, 5), GT);
    GBAR(4);
    run_gemm<MM, 8192, D, true>(F, MEMN, D, XWT, D, 0, 0, EpiStore{KV, 8192, 0, 1.f});

#pragma unroll 1
    for (int l = 0; l < DEPTH; ++l) {
#define WL (Wb + (size_t)l * WL_SIZE)
#define GL (gains + (size_t)l * 6 * D)
        const bool ml = (l & 1) == 0;
        run_gemm<M, 3072, D, true>(F, XN, D, WL + WL_IN, D, 0, 0, EpiStore{BIG, 3072, ml ? 0 : 4, sbk::C2}); GBAR(5);
        if (ml) {
            mlk::phaseA(F, BIG, GT, XN, NSTP, SCALP); GBAR(2);
            mlk::phaseB(F, XN, NSTP, SCALP, MPREVP); GBAR(2);
            mlk::phaseC(F, BIG, GT, XN, NSTP, MPREVP, inp(F, 6) + (size_t)(l >> 1) * D); GBAR(2);
            run_gemm<M, D, D, true>(F, BIG + 1024, 3072, WL + WL_OUT, D, 0, 0, EpiStore{MIX, D, 0, 1.f});
        } else {
            sb_attn_v2(F, BIG, MIX); GBAR(3);
            run_gemm<M, D, D, true>(F, MIX, D, WL + WL_OUT, D, 0, 0, EpiStore{BIG, D, 0, 1.f});
        }
        xw_gemms(F, KV + (size_t)l * 2048, WL + WL_QN, WL + WL_OT, XWT); GBAR(6);
        row_phase(F, XOUT, XOUT, ml ? MIX : BIG, GL + D, GL + 2 * D, XN, nullptr, 0, nullptr, nullptr); GBAR(1);
        run_gemm<M, D, D, false>(F, XN, D, XWT, D, 8, (size_t)D * D * 2, EpiSoftmax{PB, D}); GBAR(7);
        run_gemm<M, D, D, true>(F, PB, D, XWT + (size_t)8 * D * D, D, 8, (size_t)D * D * 2, EpiStore{BIG, D, 0, 1.f}); GBAR(7);
        row_phase(F, XOUT, XOUT, BIG, GL + 3 * D, GL + 4 * D, XN, nullptr, 0, nullptr, nullptr); GBAR(1);
        run_gemm<M, 2 * DFF, D, true>(F, XN, D, WL + WL_GU, D, 0, 0, EpiSwiglu{BIG, DFF}); GBAR(8);
        run_gemm<M, D, DFF, true>(F, BIG, DFF, WL + WL_DN, DFF, 0, 0, EpiStore{MIX, D, 0, 1.f}); GBAR(8);
        { const bool last = (l + 1 == DEPTH), gates = !last && (((l + 1) & 1) == 0);
          row_phase(F, XOUT, XOUT, MIX, GL + 5 * D, last ? nullptr : GL + 6 * D, XN,
                    gates ? inp(F, 4) + (size_t)((l + 1) >> 1) * D * ML_W + 3072 : nullptr, ML_W, inp(F, 5) + ((l + 1) >> 1) * 8, GT);
          if (!last) GBAR(1); }
    }
    if (PROBE_CAT != 0 && blockIdx.x == 0 && threadIdx.x == 0) {
        unsigned long long now_ = rt(); if (PROBE_CAT == 1) TPROBE[1] += now_ - TPROBE[0];
        const unsigned long long until = now_ + 20ull * TPROBE[1];
        while (rt() < until) __builtin_amdgcn_s_sleep(32);
    }
}

extern "C" void kernel_launch(void* const* d_in, const int* in_sizes, int n_in, void* d_out, int out_size, void* d_ws, size_t ws_size, hipStream_t stream) {
    static int grid = 0;
    if (grid == 0) {
        if (n_in != 15 || out_size != M * D || ws_size < WS_END) { fprintf(stderr, "kernel_launch: unexpected shapes (n_in %d out %d ws %zu need %zu)\n", n_in, out_size, ws_size, (size_t)WS_END); grid = -1; return; }
        int dev = 0, cus = 0, per_cu = 0;
        if (hipGetDevice(&dev) != hipSuccess || hipDeviceGetAttribute(&cus, hipDeviceAttributeMultiprocessorCount, dev) != hipSuccess) { grid = -1; return; }
        if (hipFuncSetAttribute((const void*)mega_fwd, hipFuncAttributeMaxDynamicSharedMemorySize, LDS_BYTES) != hipSuccess) { fprintf(stderr, "kernel_launch: hipFuncSetAttribute failed\n"); grid = -1; return; }
        if (hipOccupancyMaxActiveBlocksPerMultiprocessor(&per_cu, (const void*)mega_fwd, NWAVES * 64, LDS_BYTES) != hipSuccess || per_cu < 1) fprintf(stderr, "kernel_launch: occupancy query reports %d\n", per_cu);
        (void)hipGetLastError();
        grid = cus;
    }
    if (grid < 0) return;
    if (hipMemsetAsync((char*)d_ws + WS_CTL, 0, CTL_ZERO_BYTES, stream) != hipSuccess) return;
    Args a{};
    for (int i = 0; i < 15; ++i) a.in[i] = (const float*)d_in[i];
    a.out = (float*)d_out; a.ws = (unsigned char*)d_ws;
    hipLaunchKernelGGL(mega_fwd, dim3(grid), dim3(NWAVES * 64), LDS_BYTES, stream, a);
}
```

```cpp
#include <hip/hip_runtime.h>
#include <cstdio>
#include <cstdint>
namespace pg8 {
#define PG8_LAS __attribute__((address_space(3)))
typedef unsigned short bf16_t;
typedef short bf16x8 __attribute__((ext_vector_type(8)));
typedef float f32x4 __attribute__((ext_vector_type(4)));
typedef unsigned u32x4 __attribute__((ext_vector_type(4)));
constexpr int BM = 256, BK = 64, HALF = 128, HTB = HALF * BK * 2  , STAGE_BYTES = 8 * HTB, NXCD = 8, WGM = 8;

__host__ __device__ __forceinline__ int lds_byte(int r, int c) { const int st = (r >> 4) * 2 + (c >> 5), rr = r & 15, cc = c & 31, ob = rr * 64 + cc * 2; return st * 1024 + (ob ^ (((ob >> 9) & 1) << 5)); }
__host__ __device__ __forceinline__ void stage_rc(int b, int& R, int& C) { const int st = b / 1024, sb = b % 1024, swz = sb ^ (((sb >> 9) & 1) << 5); R = (st >> 1) * 16 + swz / 64; C = (st & 1) * 32 + (swz % 64) / 2; }
__host__ __device__ __forceinline__ int perm32(int rho) { const int n = rho >> 4, i = rho & 15; return 8 * (i >> 2) + 4 * n + (i & 3); }

struct Unit { int pm, pn; size_t aoff, boff; };
struct Gemm { const bf16_t* A; const bf16_t* Bt; int M, N, K, lda, ldb; };

struct StaticOrder {
    int nM, nN, nwg, G, c, pmb; size_t a_rt, b_rt, b_batch;
    __host__ __device__ void init(int M, int N, int G_, int c_, int lda, int ldb, int pmb_ = 0, size_t b_batch_ = 0) { nM = M / BM; nN = N / BM; nwg = nM * nN; G = G_; c = c_; a_rt = (size_t)BM * lda * 2; b_rt = (size_t)BM * ldb * 2; pmb = pmb_; b_batch = b_batch_; }
    __host__ __device__ bool next(int i, Unit& u) const {
        const long L = (long)i * G + c; if (L >= nwg) return false;
        int wgid = (int)L; { const int q = nwg / NXCD, r = nwg % NXCD, xcd = wgid % NXCD, off = wgid / NXCD; wgid = (xcd < r ? xcd * (q + 1) : r * (q + 1) + (xcd - r) * q) + off; }
        const int nig = WGM * nN, gid = wgid / nig, fm = gid * WGM, gsz = (nM - fm) < WGM ? (nM - fm) : WGM;
        u.pm = fm + ((wgid % nig) % gsz); u.pn = (wgid % nig) / gsz; u.aoff = (size_t)u.pm * a_rt; u.boff = (size_t)u.pn * b_rt + (pmb ? (size_t)(u.pm / pmb) * b_batch : 0); return true;
    }
    __device__ __forceinline__ void a_ready(const Unit&) const {}
    __device__ __forceinline__ void done(const Unit&) const {}
};

__device__ __forceinline__ unsigned cvt_pk_bf16(float lo, float hi) { unsigned r; asm volatile("v_cvt_pk_bf16_f32 %0, %1, %2" : "=v"(r) : "v"(lo), "v"(hi)); return r; }
typedef float f32x2 __attribute__((ext_vector_type(2)));
__device__ __forceinline__ f32x2 gelu_pk(f32x2 v) {
    const f32x2 av = __builtin_elementwise_abs(v), d = av * 0.2316418882f + 1.0f;
    f32x2 t; t.x = __builtin_amdgcn_rcpf(d.x); t.y = __builtin_amdgcn_rcpf(d.y);
    f32x2 q = t * 0.5307027145f + (-0.7265760135f); q = q * t + 0.7107068705f; q = q * t + (-0.142248368f); q = q * t + 0.127414796f; q = q * t;
    const f32x2 s = (v * v) * (-0.72134752044f);
    f32x2 e; e.x = __builtin_amdgcn_exp2f(s.x); e.y = __builtin_amdgcn_exp2f(s.y);
    const f32x2 m = v * (q * e), r = v - m;
    f32x2 o; o.x = v.x < 0.f ? m.x : r.x; o.y = v.y < 0.f ? m.y : r.y; return o;
}

template <int ACT  > struct EpiBf16 {
    static constexpr bool PERM = true, AFTER_DRAIN = false; static_assert(ACT == 0 || ACT == 1, "EpiBf16: ACT is 0 (none) or 1 (gelu_pk)");
    bf16_t* O; int ldc; const float* bias; int split_cols; size_t split_stride; float scale0;
    __device__ __forceinline__ void operator()(const f32x4 (&acc)[2][2][4][2], const Unit& u, int wr, int wc, int fr, int fq) const {
        const int row0 = u.pm * BM + wr * 64 + fr; int colt = u.pn * BM; bf16_t* base = O;
        float sc = 1.f; if (split_cols) { const int t = colt / split_cols; base += (size_t)t * split_stride; colt -= t * split_cols; if (t == 0) sc = scale0; }
        const int col0 = colt + wc * 32 + 8 * fq, bcol0 = u.pn * BM + wc * 32 + 8 * fq;
        f32x4 bv[2][2];
#pragma unroll
        for (int bj = 0; bj < 2; ++bj)
#pragma unroll
            for (int n = 0; n < 2; ++n) bv[bj][n] = bias ? *(const f32x4*)(bias + bcol0 + bj * HALF + 4 * n) : (f32x4){0.f, 0.f, 0.f, 0.f};
#pragma unroll
        for (int ai = 0; ai < 2; ++ai)
#pragma unroll
            for (int m = 0; m < 4; ++m) { bf16_t* rowp = base + (size_t)(row0 + ai * HALF + m * 16) * ldc + col0;
#pragma unroll
                for (int bj = 0; bj < 2; ++bj) { f32x4 v0 = acc[ai][bj][m][0] + bv[bj][0], v1 = acc[ai][bj][m][1] + bv[bj][1];
                    if (ACT == 1) { f32x2 a = gelu_pk((f32x2){v0[0], v0[1]}), b = gelu_pk((f32x2){v0[2], v0[3]}), c = gelu_pk((f32x2){v1[0], v1[1]}), d = gelu_pk((f32x2){v1[2], v1[3]});
                        v0 = (f32x4){a.x, a.y, b.x, b.y}; v1 = (f32x4){c.x, c.y, d.x, d.y}; }
                    v0 = v0 * sc; v1 = v1 * sc; u32x4 w; w.x = cvt_pk_bf16(v0[0], v0[1]); w.y = cvt_pk_bf16(v0[2], v0[3]); w.z = cvt_pk_bf16(v1[0], v1[1]); w.w = cvt_pk_bf16(v1[2], v1[3]);
                    *(u32x4*)(rowp + bj * HALF) = w; } }
    }
};

struct PanelStats {
    unsigned* xbuf;
    unsigned* cnt;
    unsigned* tmo;
    int ntn; float eps;
    unsigned code;
    __device__ __forceinline__ bool run(const f32x4 (&v)[2][2][4][2], const Unit& u, int wr, int wc, int fr, int fq, PG8_LAS unsigned char* lds, int wid, int lane) const {
        typedef float f32x2v __attribute__((ext_vector_type(2)));
        PG8_LAS f32x2v* P = (PG8_LAS f32x2v*)lds;
        PG8_LAS f32x2v* S = (PG8_LAS f32x2v*)(lds + 8192);
        PG8_LAS unsigned* flag = (PG8_LAS unsigned*)(lds + 8192 + 2048);
#pragma unroll
        for (int ai = 0; ai < 2; ++ai)
#pragma unroll
            for (int m = 0; m < 4; ++m) {
                float s = 0.f;
#pragma unroll
                for (int bj = 0; bj < 2; ++bj)
#pragma unroll
                    for (int n = 0; n < 2; ++n) { const f32x4 x = v[ai][bj][m][n]; s += (x[0] + x[1]) + (x[2] + x[3]); }
                s += __shfl_xor(s, 16); s += __shfl_xor(s, 32);
                const float mw = s * (1.0f / 64.0f); float q = 0.f;
#pragma unroll
                for (int bj = 0; bj < 2; ++bj)
#pragma unroll
                    for (int n = 0; n < 2; ++n) { const f32x4 d = v[ai][bj][m][n] - mw; q += (d[0] * d[0] + d[1] * d[1]) + (d[2] * d[2] + d[3] * d[3]); }
                q += __shfl_xor(q, 16); q += __shfl_xor(q, 32);
                if (fq == 0) P[(ai * HALF + wr * 64 + m * 16 + fr) * 4 + wc] = (f32x2v){mw, q};
            }
        asm volatile("s_waitcnt lgkmcnt(0)" ::: "memory"); __builtin_amdgcn_s_barrier(); asm volatile("" ::: "memory");
#if defined(BROKEN_EXCHANGE_NO_WAIT)
#warning BROKEN CONTROL BUILD: the row-statistics exchange does not wait; results are wrong by design
        if (blockIdx.x >= 64) { const long long t0_ = clock64(); while (clock64() - t0_ < 60000) __builtin_amdgcn_s_sleep(8); }
#endif
        const int row = wid * 32 + (lane & 31);
        if (lane < 32) {
            const f32x2v a = P[row * 4 + 0], b = P[row * 4 + 1], c = P[row * 4 + 2], d = P[row * 4 + 3];
            const float mt = (a.x + b.x + c.x + d.x) * 0.25f;
            const float da = a.x - mt, db = b.x - mt, dc = c.x - mt, dd = d.x - mt;
            const float m2 = (a.y + b.y) + (c.y + d.y) + 64.0f * ((da * da + db * db) + (dc * dc + dd * dd));
            unsigned long long* slot = (unsigned long long*)xbuf + ((size_t)(u.pm * BM + row) * 4 + u.pn);
            __hip_atomic_store(slot, ((unsigned long long)__float_as_uint(m2) << 32) | __float_as_uint(mt), __ATOMIC_RELAXED, __HIP_MEMORY_SCOPE_AGENT);
        }
        asm volatile("s_waitcnt vmcnt(0)" ::: "memory");
        if (lane == 0) __hip_atomic_fetch_add(cnt + 64 * u.pm, 1u, __ATOMIC_RELAXED, __HIP_MEMORY_SCOPE_AGENT);
        if (wid == 0) {
            bool dead = false; const unsigned long long t0 = __builtin_amdgcn_s_memrealtime(); const unsigned want = 8u * (unsigned)ntn;
            for (;;) {
#if defined(BROKEN_EXCHANGE_NO_WAIT)
                break;
#endif
                if ((unsigned)__builtin_amdgcn_readfirstlane(__hip_atomic_load(cnt + 64 * u.pm, __ATOMIC_RELAXED, __HIP_MEMORY_SCOPE_AGENT)) >= want) break;
                if (__builtin_amdgcn_s_memrealtime() - t0 > 2000000ull) {
                    if (lane == 0) { unsigned expect = 0u; __hip_atomic_compare_exchange_strong(tmo + 1, &expect, code | (unsigned)(u.pm & 0xff), __ATOMIC_RELAXED, __ATOMIC_RELAXED, __HIP_MEMORY_SCOPE_AGENT);
                                     __hip_atomic_store(tmo, 1u, __ATOMIC_RELAXED, __HIP_MEMORY_SCOPE_AGENT); }
                    dead = true; break; }
                __builtin_amdgcn_s_sleep(2);
            }
            __builtin_amdgcn_fence(__ATOMIC_ACQUIRE, "agent");
            if (lane == 0) flag[0] = dead ? 1u : 0u;
        }
        asm volatile("s_waitcnt vmcnt(0) lgkmcnt(0)" ::: "memory"); __builtin_amdgcn_s_barrier(); asm volatile("" ::: "memory");
        const bool bad = flag[0] != 0u;
        if (lane < 32) {
            const unsigned long long* slot = (const unsigned long long*)xbuf + (size_t)(u.pm * BM + row) * 4; float mt[4], m2[4]; float ms = 0.f;
#pragma unroll
            for (int t = 0; t < 4; ++t) { if (t < ntn) { const unsigned long long w = __hip_atomic_load(slot + t, __ATOMIC_RELAXED, __HIP_MEMORY_SCOPE_AGENT); mt[t] = __uint_as_float((unsigned)w); m2[t] = __uint_as_float((unsigned)(w >> 32)); } else { mt[t] = 0.f; m2[t] = 0.f; } ms += mt[t]; }
            const float mean = ms / (float)ntn; float q = 0.f;
#pragma unroll
            for (int t = 0; t < 4; ++t) if (t < ntn) { const float dm = mt[t] - mean; q += m2[t] + 256.0f * dm * dm; }
            S[row] = (f32x2v){mean, 1.0f / sqrtf(q / (256.0f * (float)ntn) + eps)};
        }
        asm volatile("s_waitcnt lgkmcnt(0)" ::: "memory"); __builtin_amdgcn_s_barrier(); asm volatile("" ::: "memory");
        return bad;
    }
};
struct EpiLnRes {
    static constexpr bool PERM = false, AFTER_DRAIN = true;
    const float* base; float* out; int ldc; const float* bias; PanelStats st; unsigned poison;
    __device__ __forceinline__ void fused(f32x4 (&acc)[2][2][4][2], const Unit& u, int wr, int wc, int fr, int fq, PG8_LAS unsigned char* lds, int wid, int lane) const {
        typedef float f32x2v __attribute__((ext_vector_type(2)));
        const PG8_LAS f32x2v* S = (const PG8_LAS f32x2v*)(lds + 8192);
        const int col0 = u.pn * BM + wc * 32 + 4 * fq;
#pragma unroll
        for (int bj = 0; bj < 2; ++bj)
#pragma unroll
            for (int n = 0; n < 2; ++n) { const f32x4 bv = bias ? *(const f32x4*)(bias + col0 + bj * HALF + n * 16) : (f32x4){0.f, 0.f, 0.f, 0.f};
#pragma unroll
                for (int ai = 0; ai < 2; ++ai)
#pragma unroll
                    for (int m = 0; m < 4; ++m) acc[ai][bj][m][n] += bv; }
        f32x4 pre[4][2][2];
#pragma unroll
        for (int m = 0; m < 4; ++m) { const size_t off = (size_t)(u.pm * BM + wr * 64 + m * 16 + fr) * ldc + col0;
#pragma unroll
            for (int bj = 0; bj < 2; ++bj)
#pragma unroll
                for (int n = 0; n < 2; ++n) pre[m][bj][n] = *(const f32x4*)(base + off + bj * HALF + n * 16); }
        const bool bad = st.run(acc, u, wr, wc, fr, fq, lds, wid, lane) || poison != 0u;
        const float qnan = __builtin_nanf("");
#pragma unroll
        for (int ai = 0; ai < 2; ++ai)
#pragma unroll
            for (int m = 0; m < 4; ++m) { const int r = ai * HALF + wr * 64 + m * 16 + fr; const f32x2v sr = S[r]; const size_t off = (size_t)(u.pm * BM + r) * ldc + col0;
#pragma unroll
                for (int bj = 0; bj < 2; ++bj)
#pragma unroll
                    for (int n = 0; n < 2; ++n) { const f32x4 bs = ai == 0 ? pre[m][bj][n] : *(const f32x4*)(base + off + bj * HALF + n * 16); f32x4 o = bs + (acc[ai][bj][m][n] - sr.x) * sr.y;
                        if (bad) o = (f32x4){qnan, qnan, qnan, qnan}; *(f32x4*)(out + off + bj * HALF + n * 16) = o; }
                if (m & 1) asm volatile("" ::: "memory"); }
    }
};
struct EpiLnResLn {
    static constexpr bool PERM = false, AFTER_DRAIN = true;
    const float* base; float* out; bf16_t* xn; int ldc; const float* bias; PanelStats st1, st2; unsigned poison;
    __device__ __forceinline__ void fused(f32x4 (&acc)[2][2][4][2], const Unit& u, int wr, int wc, int fr, int fq, PG8_LAS unsigned char* lds, int wid, int lane) const {
        typedef float f32x2v __attribute__((ext_vector_type(2))); typedef unsigned u32x2v __attribute__((ext_vector_type(2)));
        const PG8_LAS f32x2v* S = (const PG8_LAS f32x2v*)(lds + 8192);
        const int col0 = u.pn * BM + wc * 32 + 4 * fq;
#pragma unroll
        for (int bj = 0; bj < 2; ++bj)
#pragma unroll
            for (int n = 0; n < 2; ++n) { const f32x4 bv = bias ? *(const f32x4*)(bias + col0 + bj * HALF + n * 16) : (f32x4){0.f, 0.f, 0.f, 0.f};
#pragma unroll
                for (int ai = 0; ai < 2; ++ai)
#pragma unroll
                    for (int m = 0; m < 4; ++m) acc[ai][bj][m][n] += bv; }
        bool bad = st1.run(acc, u, wr, wc, fr, fq, lds, wid, lane) || poison != 0u;
        const float qnan = __builtin_nanf("");
#pragma unroll
        for (int ai = 0; ai < 2; ++ai)
#pragma unroll
            for (int m = 0; m < 4; ++m) { const int r = ai * HALF + wr * 64 + m * 16 + fr; const f32x2v sr = S[r]; const size_t off = (size_t)(u.pm * BM + r) * ldc + col0;
#pragma unroll
                for (int bj = 0; bj < 2; ++bj)
#pragma unroll
                    for (int n = 0; n < 2; ++n) { const f32x4 bs = *(const f32x4*)(base + off + bj * HALF + n * 16); acc[ai][bj][m][n] = bs + (acc[ai][bj][m][n] - sr.x) * sr.y; }
                asm volatile("" : "+v"(acc[ai][0][m][0]), "+v"(acc[ai][0][m][1]), "+v"(acc[ai][1][m][0]), "+v"(acc[ai][1][m][1]));
                if (m & 1) asm volatile("" ::: "memory"); }
        const bool bad1 = bad;
        bad = st2.run(acc, u, wr, wc, fr, fq, lds, wid, lane) || bad;
#pragma unroll
        for (int ai = 0; ai < 2; ++ai)
#pragma unroll
            for (int m = 0; m < 4; ++m) { const int r = ai * HALF + wr * 64 + m * 16 + fr; const f32x2v sr = S[r]; const size_t off = (size_t)(u.pm * BM + r) * ldc + col0;
#pragma unroll
                for (int bj = 0; bj < 2; ++bj)
#pragma unroll
                    for (int n = 0; n < 2; ++n) { const f32x4 x1 = acc[ai][bj][m][n]; *(f32x4*)(out + off + bj * HALF + n * 16) = bad1 ? (f32x4){qnan, qnan, qnan, qnan} : x1;
                        const f32x4 o = (x1 - sr.x) * sr.y; u32x2v w; w.x = cvt_pk_bf16(o[0], o[1]); w.y = cvt_pk_bf16(o[2], o[3]);
                        if (bad) { w.x = 0x7fc07fc0u; w.y = 0x7fc07fc0u; } *(u32x2v*)(xn + off + bj * HALF + n * 16) = w; }
                asm volatile("" ::: "memory"); }
    }
};

template <class Epi, class Sched, bool ALIGN_EPI = false, bool SP2 = false>
__device__ __forceinline__ void gemm_phase(PG8_LAS unsigned char* lds, const Gemm g, const Sched& S, const Epi& E) {
    int tid_ = threadIdx.x; asm volatile("" : "+v"(tid_));
    const int tid = tid_, wid = __builtin_amdgcn_readfirstlane(tid >> 6), lane = tid & 63, wr = wid >> 2, wc = wid & 3, fr = lane & 15, fq = lane >> 4;
    const int K = g.K, nt = K / BK;
    unsigned voffA[2], voffB[2];
#pragma unroll
    for (int i = 0; i < 2; ++i) { int R, C; stage_rc(tid * 16 + i * 8192, R, C); const int Rb = Epi::PERM ? ((R & ~31) + perm32(R & 31)) : R;
        voffA[i] = (unsigned)(R * g.lda + C) * 2u; voffB[i] = (unsigned)(Rb * g.ldb + C) * 2u; }
    const size_t kstep = (size_t)(BK * 2);
    const size_t hstepA = (size_t)HALF * g.lda * 2, hstepB = (size_t)HALF * g.ldb * 2;
    const unsigned ldsw = (unsigned)wid * 1024u;
    const int aoff = lds_byte(wr * 64 + fr, fq * 8), boff = lds_byte(wc * 32 + fr, fq * 8);
#define PG8_SA(b, h) (((b) * 2 + (h)) * HTB)
#define PG8_SB(b, h) ((4 + (b) * 2 + (h)) * HTB)
#define PG8_STAGE(bufoff, gbase, voff) do { _Pragma("unroll") for (int _i = 0; _i < 2; ++_i) \
        __builtin_amdgcn_global_load_lds((const unsigned*)((const char*)(gbase) + (voff)[_i]), (PG8_LAS unsigned*)(lds + (bufoff) + ldsw + _i * 8192), 16, 0, 0); } while (0)
#define PG8_LDA(dst, b, h) do { _Pragma("unroll") for (int m = 0; m < 4; ++m) _Pragma("unroll") for (int k = 0; k < 2; ++k) dst[m][k] = *(const PG8_LAS bf16x8*)(lds + PG8_SA(b, h) + aoff + m * 2048 + k * 1024); } while (0)
#define PG8_LDB(dst, b, h) do { _Pragma("unroll") for (int n = 0; n < 2; ++n) _Pragma("unroll") for (int k = 0; k < 2; ++k) dst[n][k] = *(const PG8_LAS bf16x8*)(lds + PG8_SB(b, h) + boff + n * 2048 + k * 1024); } while (0)
#define PG8_MMA(ai, bj, At, Bt) do { __builtin_amdgcn_s_setprio(1); _Pragma("unroll") for (int m = 0; m < 4; ++m) _Pragma("unroll") for (int n = 0; n < 2; ++n) _Pragma("unroll") for (int k = 0; k < 2; ++k) \
        acc[ai][bj][m][n] = __builtin_amdgcn_mfma_f32_16x16x32_bf16(Bt[n][k], At[m][k], acc[ai][bj][m][n], 0, 0, 0); __builtin_amdgcn_s_setprio(0); } while (0)
#define PG8_WAIT_V(n) asm volatile("s_waitcnt vmcnt(" #n ")" ::: "memory")
#define PG8_WAIT_L(n) asm volatile("s_waitcnt lgkmcnt(" #n ")" ::: "memory")
#define PG8_BAR __builtin_amdgcn_s_barrier()
#define PG8_SCHED __builtin_amdgcn_sched_barrier(0)
    Unit cur, nxt; int ui = 0;
    if (!S.next(0, cur)) return;
    f32x4 acc[2][2][4][2];
#pragma unroll
    for (int a = 0; a < 2; ++a)
#pragma unroll
        for (int b = 0; b < 2; ++b)
#pragma unroll
            for (int m = 0; m < 4; ++m)
#pragma unroll
                for (int n = 0; n < 2; ++n) acc[a][b][m][n] = (f32x4){0.f, 0.f, 0.f, 0.f};
    bf16x8 At[4][2], B0[2][2], B1[2][2];
    const char* cA = (const char*)g.A + cur.aoff; const char* cB = (const char*)g.Bt + cur.boff;
    S.a_ready(cur);
    if constexpr (SP2) {
        PG8_STAGE(PG8_SB(0, 0), cB, voffB); PG8_STAGE(PG8_SB(0, 1), cB + hstepB, voffB); PG8_STAGE(PG8_SA(0, 0), cA, voffA); PG8_STAGE(PG8_SA(0, 1), cA + hstepA, voffA);
        if (wr == 1) PG8_BAR;
        PG8_WAIT_V(2); PG8_BAR;
        PG8_STAGE(PG8_SB(1, 0), cB + kstep, voffB); PG8_STAGE(PG8_SA(1, 0), cA + kstep, voffA); PG8_STAGE(PG8_SB(1, 1), cB + hstepB + kstep, voffB);
        PG8_WAIT_V(6); PG8_BAR;
    } else {
        PG8_STAGE(PG8_SB(0, 0), cB, voffB); PG8_STAGE(PG8_SA(0, 0), cA, voffA); PG8_STAGE(PG8_SB(0, 1), cB + hstepB, voffB); PG8_STAGE(PG8_SA(0, 1), cA + hstepA, voffA);
        if (wr == 1) PG8_BAR;
        PG8_WAIT_V(4); PG8_BAR;
        PG8_STAGE(PG8_SB(1, 0), cB + kstep, voffB); PG8_STAGE(PG8_SA(1, 0), cA + kstep, voffA); PG8_STAGE(PG8_SB(1, 1), cB + hstepB + kstep, voffB);
        PG8_WAIT_V(6); PG8_BAR;
    }
    for (;;) {
        const bool has_next = S.next(ui + 1, nxt);
        const char* nA = has_next ? (const char*)g.A + nxt.aoff : cA; const char* nB = has_next ? (const char*)g.Bt + nxt.boff : cB;
        for (int t = 0; t < nt; t += 2) {
            const bool last = (t == nt - 2);
            const char* a1 = cA + (size_t)(t + 1) * kstep;
            const char* a2 = last ? nA : cA + (size_t)(t + 2) * kstep; const char* b2 = last ? nB : cB + (size_t)(t + 2) * kstep;
            const char* a3 = a2 + kstep; const char* b3 = b2 + kstep;
            if (last && has_next) S.a_ready(nxt);
            if constexpr (SP2) {
            PG8_LDB(B0, 0, 0); PG8_LDB(B1, 0, 1); PG8_SCHED; PG8_LDA(At, 0, 0); PG8_STAGE(PG8_SA(1, 1), a1 + hstepA, voffA);
            PG8_WAIT_V(8); PG8_WAIT_L(0); PG8_BAR; PG8_MMA(0, 0, At, B0); PG8_MMA(0, 1, At, B1); PG8_BAR; PG8_SCHED;
            PG8_LDA(At, 0, 1); PG8_STAGE(PG8_SB(0, 0), b2, voffB); PG8_STAGE(PG8_SB(0, 1), b2 + hstepB, voffB); PG8_STAGE(PG8_SA(0, 0), a2, voffA);
            PG8_WAIT_V(8); PG8_WAIT_L(0); PG8_BAR; PG8_MMA(1, 0, At, B0); PG8_MMA(1, 1, At, B1); PG8_BAR; PG8_SCHED;
            PG8_LDB(B0, 1, 0); PG8_LDB(B1, 1, 1); PG8_SCHED; PG8_LDA(At, 1, 0); PG8_STAGE(PG8_SA(0, 1), a2 + hstepA, voffA);
            PG8_WAIT_V(8); PG8_WAIT_L(0); PG8_BAR; PG8_MMA(0, 0, At, B0); PG8_MMA(0, 1, At, B1); PG8_BAR; PG8_SCHED;
            PG8_LDA(At, 1, 1); PG8_STAGE(PG8_SB(1, 0), b3, voffB); PG8_STAGE(PG8_SB(1, 1), b3 + hstepB, voffB); PG8_STAGE(PG8_SA(1, 0), a3, voffA);
            PG8_WAIT_V(8); PG8_WAIT_L(0); PG8_BAR; PG8_MMA(1, 0, At, B0); PG8_MMA(1, 1, At, B1); PG8_BAR; PG8_SCHED;
            } else {
            PG8_LDB(B0, 0, 0); PG8_SCHED; PG8_LDA(At, 0, 0); PG8_STAGE(PG8_SA(1, 1), a1 + hstepA, voffA);
            PG8_WAIT_L(8); PG8_BAR; PG8_WAIT_L(0); PG8_MMA(0, 0, At, B0); PG8_BAR; PG8_SCHED;
            PG8_LDB(B1, 0, 1); PG8_STAGE(PG8_SB(0, 0), b2, voffB);
            PG8_BAR; PG8_WAIT_L(0); PG8_MMA(0, 1, At, B1); PG8_BAR;
            PG8_LDA(At, 0, 1); PG8_STAGE(PG8_SA(0, 0), a2, voffA);
            PG8_BAR; PG8_WAIT_L(0); PG8_MMA(1, 0, At, B0); PG8_BAR; PG8_SCHED;
            PG8_STAGE(PG8_SB(0, 1), b2 + hstepB, voffB);
            PG8_WAIT_V(6); PG8_BAR; PG8_MMA(1, 1, At, B1); PG8_BAR;
            PG8_LDB(B0, 1, 0); PG8_SCHED; PG8_LDA(At, 1, 0); PG8_STAGE(PG8_SA(0, 1), a2 + hstepA, voffA);
            PG8_WAIT_L(8); PG8_BAR; PG8_WAIT_L(0); PG8_MMA(0, 0, At, B0); PG8_BAR; PG8_SCHED;
            PG8_LDB(B1, 1, 1); PG8_STAGE(PG8_SB(1, 0), b3, voffB);
            PG8_BAR; PG8_WAIT_L(0); PG8_MMA(0, 1, At, B1); PG8_BAR;
            PG8_LDA(At, 1, 1); PG8_STAGE(PG8_SA(1, 0), a3, voffA);
            PG8_BAR; PG8_WAIT_L(0); PG8_MMA(1, 0, At, B0); PG8_BAR; PG8_SCHED;
            PG8_STAGE(PG8_SB(1, 1), b3 + hstepB, voffB);
            PG8_WAIT_V(6); PG8_BAR; PG8_MMA(1, 1, At, B1); PG8_BAR;
            }
        }
        if constexpr (ALIGN_EPI) { if (wr == 0) PG8_BAR; }
        if constexpr (!Epi::AFTER_DRAIN) { E(acc, cur, wr, wc, fr, fq); S.done(cur); }
        if (!has_next) break;
#pragma unroll
        for (int a = 0; a < 2; ++a)
#pragma unroll
            for (int b = 0; b < 2; ++b)
#pragma unroll
                for (int m = 0; m < 4; ++m)
#pragma unroll
                    for (int n = 0; n < 2; ++n) acc[a][b][m][n] = (f32x4){0.f, 0.f, 0.f, 0.f};
        cur = nxt; cA = nA; cB = nB; ++ui;
        if constexpr (ALIGN_EPI) { if (wr == 1) PG8_BAR; }
    }
    PG8_WAIT_V(0);
    if constexpr (!ALIGN_EPI) { if (wr == 0) PG8_BAR; }
    PG8_BAR;
    if constexpr (Epi::AFTER_DRAIN) { E.fused(acc, cur, wr, wc, fr, fq, lds, wid, lane); S.done(cur); }
#undef PG8_SA
#undef PG8_SB
#undef PG8_STAGE
#undef PG8_LDA
#undef PG8_LDB
#undef PG8_MMA
#undef PG8_WAIT_V
#undef PG8_WAIT_L
#undef PG8_BAR
#undef PG8_SCHED
}
}
#define GAS __attribute__((address_space(1)))
#define LAS __attribute__((address_space(3)))
typedef unsigned short bf16;
typedef unsigned v4u __attribute__((ext_vector_type(4)));
typedef float f32x4 __attribute__((ext_vector_type(4)));
typedef short bf16x8 __attribute__((ext_vector_type(8)));
typedef GAS unsigned gu32;
typedef GAS unsigned long long gu64;
#define RLX_AGENT __ATOMIC_RELAXED, __HIP_MEMORY_SCOPE_AGENT
#define LDS_WAIT() asm volatile("s_waitcnt lgkmcnt(0)" ::: "memory")
#define VM_WAIT() asm volatile("s_waitcnt vmcnt(0)" ::: "memory")
__device__ __forceinline__ unsigned long long rt() { return __builtin_amdgcn_s_memrealtime(); }
__device__ __forceinline__ unsigned f2bf(float f) { unsigned u = __builtin_bit_cast(unsigned, f); return (u + 0x7fffu + ((u >> 16) & 1u)) >> 16; }
__device__ __forceinline__ unsigned pk2(float lo, float hi) { return f2bf(lo) | (f2bf(hi) << 16); }

#define XB_TMO      128
#define XB_XCNT(j)  (256  + 64 * (j))
#define XB_XSUB(j)  (1280 + 64 * (j))
#define XB_XGEN(j)  (2304 + 64 * (j))
#define XB_TOP      3328
#define XB_TOPGEN   3392
#define XCD_BAR_WORDS 3456
#define XB_SPIN_CAP (1u << 18)

__device__ __forceinline__ unsigned xb_ld(unsigned* p)              { return __hip_atomic_load(p, __ATOMIC_RELAXED, __HIP_MEMORY_SCOPE_AGENT); }
__device__ __forceinline__ unsigned xb_add(unsigned* p, unsigned v) { return __hip_atomic_fetch_add(p, v, __ATOMIC_RELAXED, __HIP_MEMORY_SCOPE_AGENT); }
__device__ __forceinline__ unsigned xb_xcc_id() { return (unsigned)__builtin_amdgcn_s_getreg((3 << 11) | 20) & 0xFu; }
#define XB_SPIN(cond, bar) do { unsigned _sp = 0; while (cond) { __builtin_amdgcn_s_sleep(1); \
    if ((++_sp & 255u) == 0u) { if (xb_ld(&(bar)[XB_TMO])) break; if (_sp > XB_SPIN_CAP) { atomicAdd(&(bar)[XB_TMO], 1u); break; } } } } while (0)

struct XcdBarrier {
    unsigned* bar; unsigned x;
    volatile LAS unsigned* st;
};

__device__ __forceinline__ XcdBarrier xcd_barrier_post(unsigned* bar, volatile LAS unsigned* st) {
    XcdBarrier b; b.bar = bar; b.x = xb_xcc_id(); b.st = st;
    if (threadIdx.x == 0) (void)xb_add(&bar[XB_XCNT(b.x)], 1u);
    return b;
}
__device__ __forceinline__ void xcd_barrier_complete(unsigned* bar, unsigned x, unsigned& nloc, unsigned& nx) {
    const unsigned G = gridDim.x * gridDim.y * gridDim.z;
    unsigned sum, cnt, mine, sp = 0u;
    for (;;) {
        sum = 0u; cnt = 0u; mine = 0u;
#pragma unroll
        for (unsigned j = 0; j < 16; ++j) { const unsigned c = xb_ld(&bar[XB_XCNT(j)]); sum += c; cnt += (c > 0u) ? 1u : 0u; mine = (j == x) ? c : mine; }
        if (sum == G) break;
        __builtin_amdgcn_s_sleep(1);
        if ((++sp & 255u) == 0u) { if (xb_ld(&bar[XB_TMO])) break; if (sp > XB_SPIN_CAP) { atomicAdd(&bar[XB_TMO], 1u); break; } }
    }
    nloc = mine > 0u ? mine : 1u; nx = cnt > 0u ? cnt : 1u;
}

__device__ __forceinline__ void xcd_barrier(const XcdBarrier& b) {
    asm volatile("s_waitcnt vmcnt(0)" ::: "memory");
    __syncthreads();
    if (threadIdx.x == 0) {
        unsigned* bar = b.bar;
        __builtin_amdgcn_s_waitcnt(0);
        unsigned nloc = b.st[0], nx = b.st[1];
        if (nloc == 0u) { xcd_barrier_complete(bar, b.x, nloc, nx); b.st[0] = nloc; b.st[1] = nx; }
        const unsigned old = xb_add(&bar[XB_XSUB(b.x)], 1u);
        const unsigned gen = old / nloc;
        if (old + 1u == (gen + 1u) * nloc) {
            __builtin_amdgcn_fence(__ATOMIC_RELEASE, "agent");
            asm volatile("s_waitcnt vmcnt(0)" ::: "memory");
            const unsigned og = xb_add(&bar[XB_TOP], 1u);
            const unsigned tg = og / nx;
            if (og + 1u == (tg + 1u) * nx) xb_add(&bar[XB_TOPGEN], 1u);
            else XB_SPIN(xb_ld(&bar[XB_TOPGEN]) == tg, bar);
            __builtin_amdgcn_fence(__ATOMIC_ACQUIRE, "agent");
            xb_add(&bar[XB_XGEN(b.x)], 1u);
            asm volatile("s_waitcnt vmcnt(0)" ::: "memory");
        } else {
            XB_SPIN(xb_ld(&bar[XB_XGEN(b.x)]) == gen, bar);
            __builtin_amdgcn_fence(__ATOMIC_ACQUIRE, "agent");
            asm volatile("s_waitcnt vmcnt(0)" ::: "memory");
        }
    }
    __syncthreads();
}

constexpr int D = 1024, BATCH = 8, SEQ = 2048, DEPTH = 4, NMEM = 256;
constexpr int M = BATCH * SEQ;
constexpr int MM = BATCH * NMEM;
constexpr int ML_H = 4, ML_DK = 128, ML_DV = 256, ML_W = 3080;
constexpr int SB_H = 16, SB_DH = 64;
constexpr int XA_H = 4, XA_DH = 256;
constexpr int DFF = 2816;
constexpr float EPS = 1e-6f;
constexpr int NWAVES = 8;

constexpr size_t MiB = 1u << 20;
constexpr size_t WS_CTL = 0, CTL_ZERO_BYTES = 1 * MiB;
constexpr size_t WS_WG = 1 * MiB;
constexpr size_t WS_GATES = 1 * MiB + 512 * 1024;
constexpr size_t WS_MEMN = 2 * MiB;
constexpr size_t WS_NST = 6 * MiB, WS_SCAL = 6 * MiB + 512 * 1024, WS_MPREV = WS_SCAL + 16 * 1024;
constexpr size_t WS_W = 8 * MiB;
constexpr size_t WL_IN = 0, WL_OUT = WL_IN + (size_t)3072 * 1024, WL_QN = WL_OUT + (size_t)1024 * 1024, WL_OT = WL_QN + (size_t)1024 * 1024,
                 WL_GU = WL_OT + (size_t)1024 * 1024, WL_DN = WL_GU + (size_t)5632 * 1024, WL_SIZE = WL_DN + (size_t)1024 * 2816;
constexpr size_t WS_XWT = WS_W + 4 * WL_SIZE * 2;
static_assert(WS_XWT == 122 * MiB, "weight region size");
constexpr size_t WS_MIX = WS_XWT + 32 * MiB;
constexpr size_t WS_KV = WS_MIX + 32 * MiB;
constexpr size_t WS_X = WS_KV + 32 * MiB;
constexpr size_t WS_BIG = WS_X + 32 * MiB;
constexpr size_t WS_SSQ = 7 * MiB;
constexpr size_t WS_END = WS_BIG + 96 * MiB;
constexpr int CW_BAR = 4096;

constexpr int RING_OFF = 0, RING_BYTES = 131072;
constexpr int LDSCTL_OFF = RING_BYTES, MISC_OFF = LDSCTL_OFF + 320;
constexpr int LDS_BYTES = 147456;

__device__ __forceinline__ float wave_sum(float v) {
#pragma unroll
    for (int o = 1; o < 64; o <<= 1) v += __shfl_xor(v, o);
    return v;
}
__device__ __forceinline__ float wave_max(float v) {
#pragma unroll
    for (int o = 1; o < 64; o <<= 1) v = fmaxf(v, __shfl_xor(v, o));
    return v;
}
__device__ __forceinline__ float softplusf(float z) { return fmaxf(z, 0.f) + log1pf(__expf(-fabsf(z))); }
__device__ __forceinline__ float bf2f(unsigned short h) { return __uint_as_float((unsigned)h << 16); }
__device__ __forceinline__ float bflo(unsigned w) { return __uint_as_float(w << 16); }
__device__ __forceinline__ float bfhi(unsigned w) { return __uint_as_float(w & 0xffff0000u); }

struct Frame {
    LAS unsigned char* lds;
    int tid, lane, wave, G, gw, NGW;
    unsigned char* ws;
};
__device__ __forceinline__ const float* inp(const Frame& F, int i) {
    volatile LAS unsigned* t = (volatile LAS unsigned*)(F.lds + LDSCTL_OFF) + 2 * i;
    const unsigned lo = __builtin_amdgcn_readfirstlane(t[0]), hi = __builtin_amdgcn_readfirstlane(t[1]);
    return (const float*)(((unsigned long long)hi << 32) | lo);
}
__device__ __forceinline__ void relane(Frame& F) {
    int t = threadIdx.x; asm volatile("" : "+v"(t));
    F.tid = t; F.lane = t & 63; F.wave = __builtin_amdgcn_readfirstlane(t >> 6);
    int g = gridDim.x, b = blockIdx.x; asm volatile("" : "+s"(g), "+s"(b));
    F.G = g; F.gw = b * NWAVES + F.wave; F.NGW = g * NWAVES;
}

struct EpiStore {
    static constexpr bool PERM = true, AFTER_DRAIN = false;
    bf16* O; int ldc; int qtiles; float qscale; const float* ssq;
    __device__ __forceinline__ void operator()(const f32x4 (&acc)[2][2][4][2], const pg8::Unit& u, int wr, int wc, int fr, int fq) const {
        const int row0 = u.pm * 256 + wr * 64 + fr, col0 = u.pn * 256 + wc * 32 + 8 * fq;
        const float sc0 = (u.pn < qtiles) ? qscale : 1.f;
#pragma unroll
        for (int ai = 0; ai < 2; ++ai)
#pragma unroll
            for (int m = 0; m < 4; ++m) { bf16* rowp = O + (size_t)(row0 + ai * 128 + m * 16) * ldc + col0;
                const float sc = ssq ? sc0 * rsqrtf(ssq[row0 + ai * 128 + m * 16] * (1.f / D) + EPS) : sc0;
#pragma unroll
                for (int bj = 0; bj < 2; ++bj) { const f32x4 v0 = acc[ai][bj][m][0] * sc, v1 = acc[ai][bj][m][1] * sc;
                    pg8::u32x4 w; w.x = pg8::cvt_pk_bf16(v0[0], v0[1]); w.y = pg8::cvt_pk_bf16(v0[2], v0[3]); w.z = pg8::cvt_pk_bf16(v1[0], v1[1]); w.w = pg8::cvt_pk_bf16(v1[2], v1[3]);
                    *(pg8::u32x4*)(rowp + bj * 128) = w; } }
    }
};
struct EpiSwiglu {
    static constexpr bool PERM = true, AFTER_DRAIN = false;
    bf16* O; int ldc; const float* ssq;
    __device__ __forceinline__ void operator()(const f32x4 (&acc)[2][2][4][2], const pg8::Unit& u, int wr, int wc, int fr, int fq) const {
        const int row0 = u.pm * 256 + wr * 64 + fr, col0 = u.pn * 128 + wc * 32 + 8 * fq;
#pragma unroll
        for (int ai = 0; ai < 2; ++ai)
#pragma unroll
            for (int m = 0; m < 4; ++m) { bf16* rowp = O + (size_t)(row0 + ai * 128 + m * 16) * ldc + col0;
                const float rs = rsqrtf(ssq[row0 + ai * 128 + m * 16] * (1.f / D) + EPS);
                float r[8];
#pragma unroll
                for (int n = 0; n < 2; ++n)
#pragma unroll
                    for (int e = 0; e < 4; ++e) { const float g = acc[ai][0][m][n][e] * rs, up = acc[ai][1][m][n][e] * rs; r[n * 4 + e] = g * __builtin_amdgcn_rcpf(1.f + __expf(-g)) * up; }
                pg8::u32x4 w; w.x = pg8::cvt_pk_bf16(r[0], r[1]); w.y = pg8::cvt_pk_bf16(r[2], r[3]); w.z = pg8::cvt_pk_bf16(r[4], r[5]); w.w = pg8::cvt_pk_bf16(r[6], r[7]);
                *(pg8::u32x4*)rowp = w; }
    }
};

struct EpiSoftmax {
    static constexpr bool PERM = true, AFTER_DRAIN = true;
    bf16* O; int ldc; const float* ssq;
    __device__ __forceinline__ void fused(f32x4 (&acc)[2][2][4][2], const pg8::Unit& u, int wr, int wc, int fr, int fq, LAS unsigned char* lds, int wid, int lane) const {
        typedef float f32x2v __attribute__((ext_vector_type(2)));
        constexpr float C2 = 0.0625f * 1.4426950408889634f;
#pragma unroll
        for (int ai = 0; ai < 2; ++ai)
#pragma unroll
            for (int m = 0; m < 4; ++m) { const float rs = rsqrtf(ssq[u.pm * 256 + ai * 128 + wr * 64 + m * 16 + fr] * (1.f / D) + EPS);
#pragma unroll
                for (int bj = 0; bj < 2; ++bj)
#pragma unroll
                    for (int n = 0; n < 2; ++n) acc[ai][bj][m][n] = acc[ai][bj][m][n] * rs; }
        LAS f32x2v* ST = (LAS f32x2v*)lds;
#pragma unroll
        for (int ai = 0; ai < 2; ++ai)
#pragma unroll
            for (int m = 0; m < 4; ++m) {
                float mx = -INFINITY;
#pragma unroll
                for (int bj = 0; bj < 2; ++bj)
#pragma unroll
                    for (int n = 0; n < 2; ++n) { const f32x4 x = acc[ai][bj][m][n]; mx = fmaxf(mx, fmaxf(fmaxf(x[0], x[1]), fmaxf(x[2], x[3]))); }
                mx = fmaxf(mx, __shfl_xor(mx, 16)); mx = fmaxf(mx, __shfl_xor(mx, 32));
                float sum = 0.f;
#pragma unroll
                for (int bj = 0; bj < 2; ++bj)
#pragma unroll
                    for (int n = 0; n < 2; ++n) { f32x4 x = acc[ai][bj][m][n];
#pragma unroll
                        for (int e = 0; e < 4; ++e) { x[e] = __builtin_amdgcn_exp2f((x[e] - mx) * C2); sum += x[e]; }
                        acc[ai][bj][m][n] = x; }
                sum += __shfl_xor(sum, 16); sum += __shfl_xor(sum, 32);
                if (fq == 0) ST[(ai * 128 + wr * 64 + m * 16 + fr) * 4 + wc] = (f32x2v){mx, sum};
            }
        asm volatile("s_waitcnt lgkmcnt(0)" ::: "memory"); __builtin_amdgcn_s_barrier(); asm volatile("" ::: "memory");
        const int row0 = u.pm * 256 + wr * 64 + fr, col0 = u.pn * 256 + wc * 32 + 8 * fq;
#pragma unroll
        for (int ai = 0; ai < 2; ++ai)
#pragma unroll
            for (int m = 0; m < 4; ++m) {
                const LAS f32x2v* sp = ST + (ai * 128 + wr * 64 + m * 16 + fr) * 4;
                const f32x2v s0 = sp[0], s1 = sp[1], s2 = sp[2], s3 = sp[3];
                const float MX = fmaxf(fmaxf(s0.x, s1.x), fmaxf(s2.x, s3.x));
                const float L = s0.y * __builtin_amdgcn_exp2f((s0.x - MX) * C2) + s1.y * __builtin_amdgcn_exp2f((s1.x - MX) * C2) + s2.y * __builtin_amdgcn_exp2f((s2.x - MX) * C2) + s3.y * __builtin_amdgcn_exp2f((s3.x - MX) * C2);
                const float mine = (wc == 0) ? s0.x : (wc == 1) ? s1.x : (wc == 2) ? s2.x : s3.x;
                const float f = __builtin_amdgcn_exp2f((mine - MX) * C2) / L;
                bf16* rowp = O + (size_t)(row0 + ai * 128 + m * 16) * ldc + col0;
#pragma unroll
                for (int bj = 0; bj < 2; ++bj) { const f32x4 v0 = acc[ai][bj][m][0] * f, v1 = acc[ai][bj][m][1] * f;
                    pg8::u32x4 w; w.x = pg8::cvt_pk_bf16(v0[0], v0[1]); w.y = pg8::cvt_pk_bf16(v0[2], v0[3]); w.z = pg8::cvt_pk_bf16(v1[0], v1[1]); w.w = pg8::cvt_pk_bf16(v1[2], v1[3]);
                    *(pg8::u32x4*)(rowp + bj * 128) = w; }
            }
    }
};
struct OneUnit {
    __device__ __forceinline__ bool next(int i, pg8::Unit& u) const { if (i) return false; u.pm = 0; u.pn = 0; u.aoff = 0; u.boff = 0; return true; }
    __device__ __forceinline__ void a_ready(const pg8::Unit&) const {}
    __device__ __forceinline__ void done(const pg8::Unit&) const {}
};

__device__ __forceinline__ void transpose_item(const float* W, int ld, int K, bf16* WT, int k0, int n0, int drow, LAS float* scr, int lane, const float* gk = nullptr) {
    LAS unsigned short* t16 = (LAS unsigned short*)scr;
    const int kr = lane >> 3, c4 = lane & 7;
    f32x4 v[8];
#pragma unroll
    for (int i = 0; i < 8; ++i) v[i] = *(const GAS f32x4*)(W + (size_t)(k0 + kr + 8 * i) * ld + n0 + 4 * c4);
    if (gk) {
#pragma unroll
        for (int i = 0; i < 8; ++i) v[i] = v[i] * gk[k0 + kr + 8 * i]; }
#pragma unroll
    for (int i = 0; i < 8; ++i)
#pragma unroll
        for (int j = 0; j < 4; ++j) t16[(4 * c4 + j) * 72 + kr + 8 * i] = (unsigned short)f2bf(v[i][j]);
    LDS_WAIT(); asm volatile("" ::: "memory");
#pragma unroll
    for (int q = 0; q < 4; ++q) { const int n = kr + 8 * q; const v4u o = *(const LAS v4u*)(t16 + n * 72 + 8 * c4);
        *(GAS v4u*)(WT + (size_t)(drow + n) * K + k0 + 8 * c4) = o; }
    LDS_WAIT(); asm volatile("" ::: "memory");
}
__device__ __forceinline__ void p0_convert(Frame& F) {
    relane(F);
    LAS float* scr = (LAS float*)(F.lds + RING_OFF + F.wave * 16384);
    bf16* Wb = (bf16*)(F.ws + WS_W); bf16* Wkv = (bf16*)(F.ws + WS_XWT);
    constexpr int I_IN = 16 * 96, I_OUT = 16 * 32, I_Q = 16 * 32, I_O = 16 * 32, I_KV = 16 * 64, I_GU = 16 * 176, I_DN = 44 * 32;
    constexpr int I_LAYER = I_IN + I_OUT + I_Q + I_O + I_KV + I_GU + I_DN;
    for (int it = F.gw; it < 4 * I_LAYER; it += F.NGW) {
        const int l = it / I_LAYER, j = l >> 1; int r = it % I_LAYER;
        bf16* WL = Wb + (size_t)l * WL_SIZE;
        if (r < I_IN) { const int kb = r / 96, nb = r % 96;
            if (l & 1) transpose_item(inp(F, 8) + (size_t)j * D * 3072, 3072, D, WL + WL_IN, kb * 64, nb * 32, nb * 32, scr, F.lane, inp(F, 3) + (size_t)l * 6 * D);
            else       transpose_item(inp(F, 4) + (size_t)j * D * ML_W, ML_W, D, WL + WL_IN, kb * 64, nb * 32, nb * 32, scr, F.lane, inp(F, 3) + (size_t)l * 6 * D);
            continue; } r -= I_IN;
        if (r < I_OUT) { const int kb = r / 32, nb = r % 32;
            transpose_item(((l & 1) ? inp(F, 9) : inp(F, 7)) + (size_t)j * D * D, D, D, WL + WL_OUT, kb * 64, nb * 32, nb * 32, scr, F.lane); continue; } r -= I_OUT;
        if (r < I_Q) { const int e0 = r * 2048 + F.lane * 8;
#pragma unroll
            for (int q = 0; q < 4; ++q) { const GAS f32x4* sp = (const GAS f32x4*)(inp(F, 10) + (size_t)l * D * D + e0 + q * 512); const float gq = inp(F, 3)[(size_t)(l * 6 + 2) * D + ((e0 + q * 512) >> 10)]; const f32x4 x0 = sp[0] * gq, x1 = sp[1] * gq;
                v4u o; o.x = pk2(x0.x, x0.y); o.y = pk2(x0.z, x0.w); o.z = pk2(x1.x, x1.y); o.w = pk2(x1.z, x1.w); *(GAS v4u*)(WL + WL_QN + e0 + q * 512) = o; }
            continue; } r -= I_Q;
        if (r < I_O) { const int kb = r / 32, nb = r % 32; transpose_item(inp(F, 12) + (size_t)l * D * D, D, D, WL + WL_OT, kb * 64, nb * 32, nb * 32, scr, F.lane); continue; } r -= I_O;
        if (r < I_KV) { const int kb = r / 64, nb = r % 64; transpose_item(inp(F, 11) + (size_t)l * D * 2048, 2048, D, Wkv, kb * 64, nb * 32, l * 2048 + nb * 32, scr, F.lane); continue; } r -= I_KV;
        if (r < I_GU) { const int kb = r / 176, nb = r % 176; const int c0 = nb * 32; const int up = c0 >= DFF, jj = up ? c0 - DFF : c0;
            transpose_item(inp(F, 13) + (size_t)l * D * 2 * DFF, 2 * DFF, D, WL + WL_GU, kb * 64, c0, 256 * (jj >> 7) + 128 * up + (jj & 127), scr, F.lane, inp(F, 3) + (size_t)(l * 6 + 4) * D); continue; } r -= I_GU;
        { const int kb = r / 32, nb = r % 32; transpose_item(inp(F, 14) + (size_t)l * DFF * D, D, DFF, WL + WL_DN, kb * 64, nb * 32, nb * 32, scr, F.lane); }
    }
    bf16* MEMN = (bf16*)(F.ws + WS_MEMN);
    for (int m = F.gw; m < MM; m += F.NGW) {
        const GAS f32x4* xr = (const GAS f32x4*)(inp(F, 1) + (size_t)m * D) + F.lane; const GAS f32x4* gr = (const GAS f32x4*)inp(F, 2) + F.lane;
        f32x4 v[4]; float s = 0.f;
#pragma unroll
        for (int q = 0; q < 4; ++q) { v[q] = xr[64 * q]; s += (v[q].x * v[q].x + v[q].y * v[q].y) + (v[q].z * v[q].z + v[q].w * v[q].w); }
        const float rs = rsqrtf(wave_sum(s) * (1.f / D) + EPS);
        GAS unsigned long long* o8 = (GAS unsigned long long*)(MEMN + (size_t)m * D) + F.lane;
#pragma unroll
        for (int q = 0; q < 4; ++q) { const f32x4 g = gr[64 * q]; o8[64 * q] = (unsigned long long)pk2(v[q].x * rs * g.x, v[q].y * rs * g.y) | ((unsigned long long)pk2(v[q].z * rs * g.z, v[q].w * rs * g.w) << 32); }
    }
}

__device__ __forceinline__ void row_phase(Frame& F, const float* xin32, bf16* X, const bf16* Y, const float* ga, float* ssq, float* out32, const float* g0, const float* WG, int wgs, const float* bg, float* GT) {
    relane(F);
    constexpr int NR = 4;
    for (int m0 = F.gw; m0 < M; m0 += NR * F.NGW) {
        f32x4 v[NR][4]; unsigned long long yw[NR][4];
#pragma unroll
        for (int k = 0; k < NR; ++k) { const int m = m0 + k * F.NGW;
            if (m < M) {
                if (xin32) { const GAS f32x4* xr = (const GAS f32x4*)(xin32 + (size_t)m * D) + F.lane;
#pragma unroll
                    for (int q = 0; q < 4; ++q) v[k][q] = xr[64 * q]; }
                else { const GAS unsigned long long* xr = (const GAS unsigned long long*)(X + (size_t)m * D) + F.lane;
#pragma unroll
                    for (int q = 0; q < 4; ++q) { const unsigned long long w = xr[64 * q]; v[k][q] = (f32x4){bflo((unsigned)w), bfhi((unsigned)w), bflo((unsigned)(w >> 32)), bfhi((unsigned)(w >> 32))}; } }
                if (Y) { const GAS unsigned long long* yr = (const GAS unsigned long long*)(Y + (size_t)m * D) + F.lane;
#pragma unroll
                    for (int q = 0; q < 4; ++q) yw[k][q] = yr[64 * q]; } } }
#pragma unroll
        for (int k = 0; k < NR; ++k) { const int m = m0 + k * F.NGW;
            if (m >= M) break;
            if (Y) {
                f32x4 y[4]; float s = 0.f;
#pragma unroll
                for (int q = 0; q < 4; ++q) { const unsigned lo = (unsigned)yw[k][q], hi = (unsigned)(yw[k][q] >> 32);
                    y[q] = (f32x4){bflo(lo), bfhi(lo), bflo(hi), bfhi(hi)}; s += (y[q].x * y[q].x + y[q].y * y[q].y) + (y[q].z * y[q].z + y[q].w * y[q].w); }
                const float rs = rsqrtf(wave_sum(s) * (1.f / D) + EPS);
                const GAS f32x4* gr = (const GAS f32x4*)ga + F.lane;
#pragma unroll
                for (int q = 0; q < 4; ++q) { const f32x4 g = gr[64 * q]; v[k][q] = v[k][q] + y[q] * rs * g; }
            }
            if (out32) { GAS f32x4* xo = (GAS f32x4*)(out32 + (size_t)m * D) + F.lane;
#pragma unroll
                for (int q = 0; q < 4; ++q) xo[64 * q] = v[k][q]; }
            else { GAS unsigned long long* xo = (GAS unsigned long long*)(X + (size_t)m * D) + F.lane;
#pragma unroll
                for (int q = 0; q < 4; ++q) xo[64 * q] = (unsigned long long)pk2(v[k][q].x, v[k][q].y) | ((unsigned long long)pk2(v[k][q].z, v[k][q].w) << 32);
                float s = 0.f;
#pragma unroll
                for (int q = 0; q < 4; ++q) s += (v[k][q].x * v[k][q].x + v[k][q].y * v[k][q].y) + (v[k][q].z * v[k][q].z + v[k][q].w * v[k][q].w);
                s = wave_sum(s);
                if (F.lane == 0) ssq[m] = s;
                if (WG) {
                    const float rs = rsqrtf(s * (1.f / D) + EPS);
                    const GAS f32x4* gr = (const GAS f32x4*)g0 + F.lane;
                    float acc[8];
#pragma unroll
                    for (int c = 0; c < 8; ++c) acc[c] = 0.f;
#pragma unroll
                    for (int q = 0; q < 4; ++q) { const f32x4 g = gr[64 * q]; const f32x4 hq = v[k][q] * rs * g;
#pragma unroll
                        for (int e = 0; e < 4; ++e) { const GAS f32x4* w = (const GAS f32x4*)(WG + (size_t)(4 * F.lane + 256 * q + e) * wgs); const f32x4 w0 = w[0], w1 = w[1]; const float h = hq[e];
                            acc[0] += h * w0.x; acc[1] += h * w0.y; acc[2] += h * w0.z; acc[3] += h * w0.w; acc[4] += h * w1.x; acc[5] += h * w1.y; acc[6] += h * w1.z; acc[7] += h * w1.w; } }
#pragma unroll
                    for (int c = 0; c < 8; ++c) acc[c] = wave_sum(acc[c]);
                    if (F.lane < 8) {
                        float a = 0.f;
#pragma unroll
                        for (int c = 0; c < 8; ++c) a = (F.lane == c) ? acc[c] : a;
                        a = 15.f * tanhf((a + bg[F.lane]) * (1.f / 15.f));
                        if (F.lane >= 4) a = -softplusf(-a);
                        GT[(size_t)m * 8 + F.lane] = a;
                    }
                }
            }
        }
    }
}

namespace sbk {
typedef float f32x16 __attribute__((ext_vector_type(16)));
typedef short s16x4 __attribute__((ext_vector_type(4)));
typedef short v4i16_t __attribute__((ext_vector_type(4)));
__device__ __forceinline__ unsigned cvtpk(float lo, float hi) { typedef float f32x2_t __attribute__((ext_vector_type(2))); typedef __bf16 bf16x2_t __attribute__((ext_vector_type(2)));
    f32x2_t v = {lo, hi}; bf16x2_t b = __builtin_convertvector(v, bf16x2_t); return __builtin_bit_cast(unsigned, b); }
#define SB_MFMA(a, b, c) __builtin_amdgcn_mfma_f32_32x32x16_bf16((a), (b), (c), 0, 0, 0)
constexpr int KB0 = 0, VB0 = 16384;
constexpr float C2 = 0.125f * 1.4426950408889634f;

typedef _Float16 f16x8 __attribute__((ext_vector_type(8)));
#define SB_MFMA16(a, b, c) __builtin_amdgcn_mfma_f32_32x32x16_f16((a), (b), (c), 0, 0, 0)
template <bool MASK>
__device__ __forceinline__ void tile(LAS unsigned char* kb, LAS unsigned char* vb, const bf16x8 (&qr)[4], f32x16 (&o)[2], float& carry, int nv, int lane, int r, int hh, const f16x8 (&TRI)[2], const f16x8 ONES) {
    f32x16 e[2];
    {   f32x16 p0, p1;
#pragma unroll
        for (int i = 0; i < 16; ++i) { p0[i] = 0.f; p1[i] = 0.f; }
#pragma unroll
        for (int ks = 0; ks < 4; ++ks) {
            const bf16x8 k0 = *(const LAS bf16x8*)(kb + r * 128 + (((2 * ks + hh) ^ (r & 7)) << 4));
            const bf16x8 k1 = *(const LAS bf16x8*)(kb + (r + 32) * 128 + (((2 * ks + hh) ^ (r & 7)) << 4));
            p0 = SB_MFMA(k0, qr[ks], p0); p1 = SB_MFMA(k1, qr[ks], p1);
        }
        e[0] = p0; e[1] = p1;
    }
    v4u Lh[2][2];
    float sv = 0.f;
#pragma unroll
    for (int ib = 0; ib < 2; ++ib)
#pragma unroll
        for (int i = 0; i < 16; i += 2) {
            float L[2];
#pragma unroll
            for (int u = 0; u < 2; ++u) {
                const float w = e[ib][i + u];
                const float sp = fmaxf(w, 0.f) + __builtin_amdgcn_logf(1.f + __builtin_amdgcn_exp2f(-fabsf(w)));
                float Lm = -sp;
                if (MASK) { const int ci = ((i + u) & 3) + 8 * ((i + u) >> 2) + 32 * ib; Lm = (ci < nv) ? Lm : 0.f; }
                if (ib == 0 && i + u == 0) sv = (w - sp) - Lm;
                e[ib][i + u] = (w + carry) - sp;
                L[u] = Lm;
            }
            Lh[ib][i >> 3][(i & 7) >> 1] = __builtin_bit_cast(unsigned, __builtin_amdgcn_cvt_pkrtz(L[0], L[1]));
        }
#define SB_H(x) __builtin_bit_cast(f16x8, x)
    e[0] = SB_MFMA16(TRI[0], SB_H(Lh[0][0]), e[0]); e[1] = SB_MFMA16(TRI[0], SB_H(Lh[1][0]), e[1]);
    e[0] = SB_MFMA16(TRI[1], SB_H(Lh[0][1]), e[0]); e[1] = SB_MFMA16(TRI[1], SB_H(Lh[1][1]), e[1]);
    e[0] = SB_MFMA16(ONES, SB_H(Lh[1][0]), e[0]); e[0] = SB_MFMA16(ONES, SB_H(Lh[1][1]), e[0]);
#undef SB_H
    carry = __shfl(e[0][0] - sv, r);
    v4u pa[2][2];
#pragma unroll
    for (int ib = 0; ib < 2; ++ib)
#pragma unroll
        for (int i = 0; i < 16; i += 2) {
            float a[2];
#pragma unroll
            for (int u = 0; u < 2; ++u) {
                a[u] = __builtin_amdgcn_exp2f(e[ib][i + u]);
                if (MASK) { const int ci = ((i + u) & 3) + 8 * ((i + u) >> 2) + 32 * ib; a[u] = (ci < nv) ? a[u] : 0.f; }
            }
            pa[ib][i >> 3][(i & 7) >> 1] = cvtpk(a[0], a[1]);
        }
#define SB_F(x) __builtin_bit_cast(bf16x8, x)
    const int q4 = (lane & 15) >> 2, p4 = lane & 3, g1 = (lane >> 4) & 1;
    LAS unsigned char* vl = vb + (4 * hh + q4) * 128 + (16 * g1 + 4 * p4) * 2;
#pragma unroll
    for (int ib = 0; ib < 2; ++ib)
#pragma unroll
        for (int ks2 = 0; ks2 < 2; ++ks2)
#pragma unroll
            for (int db = 0; db < 2; ++db) {
                LAS unsigned char* pv = vl + (32 * ib + 16 * ks2) * 128 + db * 64;
                const s16x4 lo = __builtin_bit_cast(s16x4, __builtin_amdgcn_ds_read_tr16_b64_v4i16((LAS v4i16_t*)pv));
                const s16x4 hi = __builtin_bit_cast(s16x4, __builtin_amdgcn_ds_read_tr16_b64_v4i16((LAS v4i16_t*)(pv + 8 * 128)));
                const bf16x8 vf = __builtin_shufflevector(lo, hi, 0, 1, 2, 3, 4, 5, 6, 7);
                o[db] = SB_MFMA(SB_F(pa[ib][ks2]), vf, o[db]);
            }
#undef SB_F
}

__device__ __forceinline__ void unit(int b, int h, int qb, const bf16* QKV, bf16* MIX, LAS unsigned char* lds, int tid) {
    const int lane = tid & 63, r = lane & 31, hh = lane >> 5, wid = __builtin_amdgcn_readfirstlane(tid >> 6);
    const size_t rowbase = (size_t)b * SEQ; const int q0 = qb * 256, trow = q0 + 32 * wid + r;
    bf16x8 qr[4];
#pragma unroll
    for (int ks = 0; ks < 4; ++ks) qr[ks] = *(const GAS bf16x8*)(QKV + (rowbase + trow) * 3072 + h * 64 + ks * 16 + hh * 8);
    f16x8 TRI[2], ONES;
#pragma unroll
    for (int ks2 = 0; ks2 < 2; ++ks2)
#pragma unroll
        for (int j = 0; j < 8; ++j) TRI[ks2][j] = ((16 * ks2 + 8 * (j >> 2) + 4 * hh + (j & 3)) > r) ? (_Float16)1.0f : (_Float16)0.0f;
#pragma unroll
    for (int j = 0; j < 8; ++j) ONES[j] = (_Float16)1.0f;
    const int srow = tid >> 3, sc = tid & 7;
    const bf16* kg = QKV + rowbase * 3072 + 1024 + h * 64 + (size_t)srow * 3072 + sc * 8;
    const int kdst = srow * 128 + ((sc ^ (srow & 7)) << 4), vdst = srow * 128 + sc * 16;
    const int NT = 4 * qb + 4;
    { const bf16* p = kg + (size_t)(NT - 1) * 64 * 3072; const v4u kx = *(const GAS v4u*)p, vx = *(const GAS v4u*)(p + 1024);
      *(LAS v4u*)(lds + KB0 + kdst) = kx; *(LAS v4u*)(lds + VB0 + vdst) = vx; }
    v4u k1, v1, k2, v2;
    { const bf16* p = kg + (size_t)(NT - 2) * 64 * 3072; k1 = *(const GAS v4u*)p; v1 = *(const GAS v4u*)(p + 1024); }
    __syncthreads();
    f32x16 o[2];
#pragma unroll
    for (int i = 0; i < 16; ++i) { o[0][i] = 0.f; o[1][i] = 0.f; }
    float carry = 0.f;
    const int wmax = q0 + 32 * wid + 31, wmin = q0 + 32 * wid;
#define SB_STEP(kt_, buf_) do { if (64 * (kt_) < wmax) { const int nv = trow - 64 * (kt_) - 4 * hh; \
        if (64 * (kt_) + 63 >= wmin) tile<true>(lds + KB0 + (buf_) * 8192, lds + VB0 + (buf_) * 8192, qr, o, carry, nv, lane, r, hh, TRI, ONES); \
        else tile<false>(lds + KB0 + (buf_) * 8192, lds + VB0 + (buf_) * 8192, qr, o, carry, nv, lane, r, hh, TRI, ONES); } } while (0)
    for (int kt = NT - 1; kt >= 1; kt -= 2) {
        if (kt >= 2) { const bf16* p = kg + (size_t)(kt - 2) * 64 * 3072; k2 = *(const GAS v4u*)p; v2 = *(const GAS v4u*)(p + 1024); }
        SB_STEP(kt, 0);
        *(LAS v4u*)(lds + KB0 + 8192 + kdst) = k1; *(LAS v4u*)(lds + VB0 + 8192 + vdst) = v1;
        __syncthreads();
        if (kt >= 3) { const bf16* p = kg + (size_t)(kt - 3) * 64 * 3072; k1 = *(const GAS v4u*)p; v1 = *(const GAS v4u*)(p + 1024); }
        SB_STEP(kt - 1, 1);
        if (kt >= 2) { *(LAS v4u*)(lds + KB0 + kdst) = k2; *(LAS v4u*)(lds + VB0 + vdst) = v2; }
        __syncthreads();
    }
#undef SB_STEP
    unsigned short* op = (unsigned short*)MIX + (rowbase + q0 + 32 * wid) * D + h * 64 + r;
#pragma unroll
    for (int db = 0; db < 2; ++db)
#pragma unroll
        for (int i = 0; i < 16; ++i) { const int row = (i & 3) + 8 * (i >> 2) + 4 * hh; ((GAS unsigned short*)op)[(size_t)row * D + 32 * db] = (unsigned short)f2bf(o[db][i]); }
}
#undef SB_MFMA
#undef SB_MFMA16
}
__device__ __forceinline__ void sb_attn_v2(Frame& F, const bf16* QKV, bf16* MIX) {
    relane(F);
    for (int v = blockIdx.x; v < 256; v += F.G) {
        const int bh = v >> 1, sel = v & 1;
#pragma unroll 1
        for (int u = 0; u < 4; ++u) {
            const int qb = sel ? ((u == 0) ? 6 : (u == 1) ? 1 : (u == 2) ? 4 : 3) : ((u == 0) ? 7 : (u == 1) ? 0 : (u == 2) ? 5 : 2);
            sbk::unit(bh >> 4, bh & 15, qb, QKV, MIX, F.lds + RING_OFF, F.tid);
        }
    }
}

namespace mlk {
typedef float f32x16 __attribute__((ext_vector_type(16)));
typedef short s16x4 __attribute__((ext_vector_type(4)));
typedef short v4i16_t __attribute__((ext_vector_type(4)));
#define ML_MFMA(a, b, c) __builtin_amdgcn_mfma_f32_32x32x16_bf16((a), (b), (c), 0, 0, 0)
__device__ __forceinline__ bf16x8 trpair(LAS unsigned char* p, int rowbytes4) {
    const s16x4 lo = __builtin_bit_cast(s16x4, __builtin_amdgcn_ds_read_tr16_b64_v4i16((LAS v4i16_t*)p));
    const s16x4 hi = __builtin_bit_cast(s16x4, __builtin_amdgcn_ds_read_tr16_b64_v4i16((LAS v4i16_t*)(p + rowbytes4)));
    return __builtin_shufflevector(lo, hi, 0, 1, 2, 3, 4, 5, 6, 7);
}
__device__ __forceinline__ float scan_add(float v, int lane) {
#pragma unroll
    for (int o = 1; o < 64; o <<= 1) { const float y = __shfl_up(v, o); if (lane >= o) v += y; }
    return v;
}
__device__ __forceinline__ float scan_max(float v, int lane) {
#pragma unroll
    for (int o = 1; o < 64; o <<= 1) { const float y = __shfl_up(v, o); if (lane >= o) v = fmaxf(v, y); }
    return v;
}
__device__ __forceinline__ void scale8(const v4u in, float w, v4u& out) {
    out.x = pk2(bflo(in.x) * w, bfhi(in.x) * w); out.y = pk2(bflo(in.y) * w, bfhi(in.y) * w); out.z = pk2(bflo(in.z) * w, bfhi(in.z) * w); out.w = pk2(bflo(in.w) * w, bfhi(in.w) * w);
}
constexpr float KSC = 0.08838834764831845f;

__device__ __forceinline__ void phaseA(Frame& F, const bf16* PROJ, const float* GT, bf16* ST, float* NST, float* SCAL) {
    relane(F);
    const int tid = F.tid, lane = F.lane, wv = F.wave, r = lane & 31, hh = lane >> 5, q4 = (lane & 15) >> 2, p4 = lane & 3, g1 = (lane >> 4) & 1;
    LAS unsigned char* KW = F.lds + RING_OFF; LAS unsigned char* VT = KW + 16384; LAS float* wk = (LAS float*)(KW + 49152);
    bf16x8 ONES;
#pragma unroll
    for (int j = 0; j < 8; ++j) ONES[j] = (short)0x3F80;
    for (int unit = blockIdx.x; unit < 1024; unit += F.G) {
        const int bh = unit >> 5, c = unit & 31, b = bh >> 2, h = bh & 3; const size_t row0 = (size_t)b * SEQ + c * 64;
        if (wv == 0) {
            const float lf = GT[(row0 + lane) * 8 + 4 + h], ig = GT[(row0 + lane) * 8 + h];
            const float bc = scan_add(lf, lane), bl = __shfl(bc, 63), g = bl - bc + ig, ml = wave_max(g);
            wk[lane] = __expf(g - ml) * KSC;
            if (lane == 0) { SCAL[unit * 2] = bl; SCAL[unit * 2 + 1] = ml; }
        }
        __syncthreads();
        { const int row = tid >> 3, c8 = tid & 7; const bf16* kp = PROJ + (row0 + row) * 3072 + 512 + h * 128 + c8 * 16;
          const v4u k0 = *(const GAS v4u*)kp, k1 = *(const GAS v4u*)(kp + 8); const bf16* vp = kp + 512 + h * 128 + c8 * 16;
          const v4u v0 = *(const GAS v4u*)vp, v1 = *(const GAS v4u*)(vp + 8), v2 = *(const GAS v4u*)(vp + 16), v3 = *(const GAS v4u*)(vp + 24);
          const float w = wk[row]; v4u o0, o1; scale8(k0, w, o0); scale8(k1, w, o1);
          *(LAS v4u*)(KW + row * 256 + c8 * 32) = o0; *(LAS v4u*)(KW + row * 256 + c8 * 32 + 16) = o1;
          LAS v4u* vd = (LAS v4u*)(VT + row * 512 + c8 * 64); vd[0] = v0; vd[1] = v1; vd[2] = v2; vd[3] = v3; }
        __syncthreads();
        f32x16 acc[4], nacc[4];
#pragma unroll
        for (int cb = 0; cb < 4; ++cb)
#pragma unroll
            for (int i = 0; i < 16; ++i) { acc[cb][i] = 0.f; nacc[cb][i] = 0.f; }
#pragma unroll
        for (int ks = 0; ks < 4; ++ks) {
            const bf16x8 af = trpair(VT + (16 * ks + 8 * hh + q4) * 512 + (32 * wv + 16 * g1 + 4 * p4) * 2, 4 * 512);
#pragma unroll
            for (int cb = 0; cb < 4; ++cb) {
                const bf16x8 bfr = trpair(KW + (16 * ks + 8 * hh + q4) * 256 + (32 * cb + 16 * g1 + 4 * p4) * 2, 4 * 256);
                acc[cb] = ML_MFMA(af, bfr, acc[cb]);
                if (wv == 0) nacc[cb] = ML_MFMA(ONES, bfr, nacc[cb]);
            }
        }
        GAS unsigned short* sp = (GAS unsigned short*)ST + (size_t)unit * 32768 + (size_t)(32 * wv) * 128 + r;
#pragma unroll
        for (int cb = 0; cb < 4; ++cb)
#pragma unroll
            for (int i = 0; i < 16; ++i) sp[((i & 3) + 8 * (i >> 2) + 4 * hh) * 128 + 32 * cb] = (unsigned short)f2bf(acc[cb][i]);
        if (wv == 0 && hh == 0) {
#pragma unroll
            for (int cb = 0; cb < 4; ++cb) NST[(size_t)unit * 128 + 32 * cb + r] = nacc[cb][0];
        }
        __syncthreads();
    }
}
__device__ __forceinline__ void phaseB(Frame& F, bf16* ST, float* NST, const float* SCAL, float* MPREV) {
    relane(F);
    for (int task = blockIdx.x * 512 + F.tid; task < 32 * 4096; task += F.G * 512) {
        const int bh = task >> 12, e0 = (task & 4095) * 8;
        float C[8], m = 0.f;
#pragma unroll
        for (int i = 0; i < 8; ++i) C[i] = 0.f;
        GAS v4u* p = (GAS v4u*)(ST + (size_t)bh * 32 * 32768 + e0);
        const float* sc = SCAL + (size_t)bh * 64;
#pragma unroll 4
        for (int c = 0; c < 32; ++c) {
            const v4u d = p[(size_t)c * 4096];
            const float bl = sc[2 * c], ml = sc[2 * c + 1], mn = fmaxf(bl + m, ml), dec = __expf(bl + m - mn), s = __expf(ml - mn);
            v4u o; o.x = pk2(C[0], C[1]); o.y = pk2(C[2], C[3]); o.z = pk2(C[4], C[5]); o.w = pk2(C[6], C[7]);
            p[(size_t)c * 4096] = o;
            if ((task & 4095) == 0) MPREV[bh * 32 + c] = m;
            C[0] = dec * C[0] + s * bflo(d.x); C[1] = dec * C[1] + s * bfhi(d.x); C[2] = dec * C[2] + s * bflo(d.y); C[3] = dec * C[3] + s * bfhi(d.y);
            C[4] = dec * C[4] + s * bflo(d.z); C[5] = dec * C[5] + s * bfhi(d.z); C[6] = dec * C[6] + s * bflo(d.w); C[7] = dec * C[7] + s * bfhi(d.w);
            m = mn;
        }
    }
    for (int task = blockIdx.x * 512 + F.tid; task < 32 * 128; task += F.G * 512) {
        const int bh = task >> 7, e = task & 127;
        float n = 0.f, m = 0.f; float* p = NST + (size_t)bh * 32 * 128 + e; const float* sc = SCAL + (size_t)bh * 64;
        for (int c = 0; c < 32; ++c) {
            const float d = p[c * 128], bl = sc[2 * c], ml = sc[2 * c + 1], mn = fmaxf(bl + m, ml);
            p[c * 128] = n; n = __expf(bl + m - mn) * n + __expf(ml - mn) * d; m = mn;
        }
    }
}
__device__ __forceinline__ void phaseC(Frame& F, bf16* PROJ, const float* GT, const bf16* ST, const float* NST, const float* MPREV, const float* hgain) {
    relane(F);
    const int tid = F.tid, lane = F.lane, wv = F.wave, r = lane & 31, hh = lane >> 5, q4 = (lane & 15) >> 2, p4 = lane & 3, g1 = (lane >> 4) & 1;
    LAS unsigned char* KT = F.lds + RING_OFF; LAS unsigned char* QT = KT + 16384; LAS unsigned char* VT = KT + 32768; LAS unsigned char* SD = KT + 65536;
    LAS float* sm = (LAS float*)(KT + 73728);
    LAS float* aa = sm; LAS float* ct2 = sm + 64; LAS float* inter = sm + 128; LAS float* emt = sm + 192; LAS float* nq = sm + 256; LAS float* npv = sm + 320; LAS float* densum = sm + 448; LAS float* ssq = sm + 576;
    LAS unsigned char* HT = KT;
    for (int unit = blockIdx.x; unit < 1024; unit += F.G) {
        const int bh = unit >> 5, c = unit & 31, b = bh >> 2, h = bh & 3; const size_t row0 = (size_t)b * SEQ + c * 64;
        { const int row = tid >> 3, c8 = tid & 7; const bf16* qp = PROJ + (row0 + row) * 3072 + h * 128 + c8 * 16;
          const v4u q0 = *(const GAS v4u*)qp, q1 = *(const GAS v4u*)(qp + 8), k0 = *(const GAS v4u*)(qp + 512), k1 = *(const GAS v4u*)(qp + 520);
          const bf16* vp = PROJ + (row0 + row) * 3072 + 1024 + h * 256 + c8 * 32;
          const v4u v0 = *(const GAS v4u*)vp, v1 = *(const GAS v4u*)(vp + 8), v2 = *(const GAS v4u*)(vp + 16), v3 = *(const GAS v4u*)(vp + 24);
          const int sw0 = ((2 * c8) ^ (row & 15)) << 4, sw1 = ((2 * c8 + 1) ^ (row & 15)) << 4;
          *(LAS v4u*)(QT + row * 256 + sw0) = q0; *(LAS v4u*)(QT + row * 256 + sw1) = q1; *(LAS v4u*)(KT + row * 256 + sw0) = k0; *(LAS v4u*)(KT + row * 256 + sw1) = k1;
          LAS v4u* vd = (LAS v4u*)(VT + row * 512 + c8 * 64); vd[0] = v0; vd[1] = v1; vd[2] = v2; vd[3] = v3; }
        const float mprev = MPREV[unit];
        if (wv == 0) {
            const float lf = GT[(row0 + lane) * 8 + 4 + h], ig = GT[(row0 + lane) * 8 + h];
            const float bc = scan_add(lf, lane), a = ig - bc, pm = scan_max(a, lane), ctv = -fmaxf(pm, mprev);
            aa[lane] = a; ct2[lane] = ctv - 2.4260151319598084f  ; inter[lane] = __expf(mprev + ctv); emt[lane] = __expf(ctv - bc);
        } else if (wv == 1) { npv[lane] = NST[(size_t)unit * 128 + lane]; npv[lane + 64] = NST[(size_t)unit * 128 + 64 + lane]; }
        bf16x8 cf[8];
        { const bf16* cp = ST + (size_t)unit * 32768 + (size_t)(32 * wv + r) * 128 + 8 * hh;
#pragma unroll
          for (int ks = 0; ks < 8; ++ks) cf[ks] = *(const GAS bf16x8*)(cp + 16 * ks); }
        __syncthreads();
        if (wv < 4) {
            const int sb = wv & 1, tb = wv >> 1, srow = 32 * sb + r, trow = 32 * tb + r;
            f32x16 s;
#pragma unroll
            for (int i = 0; i < 16; ++i) s[i] = 0.f;
#pragma unroll
            for (int ks = 0; ks < 8; ++ks) {
                const bf16x8 kf = *(const LAS bf16x8*)(KT + srow * 256 + (((2 * ks + hh) ^ (srow & 15)) << 4));
                const bf16x8 qf = *(const LAS bf16x8*)(QT + trow * 256 + (((2 * ks + hh) ^ (trow & 15)) << 4));
                s = ML_MFMA(kf, qf, s);
            }
            const float ctl = ct2[trow]; float dsum = 0.f;
#pragma unroll
            for (int g = 0; g < 4; ++g) {
                float v[4];
#pragma unroll
                for (int u = 0; u < 4; ++u) { const int sidx = 32 * sb + 8 * g + 4 * hh + u; const float d = __expf(aa[sidx] + ctl); v[u] = (sidx <= trow) ? s[4 * g + u] * d : 0.f; dsum += v[u]; }
                const unsigned long long w = (unsigned long long)pk2(v[0], v[1]) | ((unsigned long long)pk2(v[2], v[3]) << 32);
                *(LAS unsigned long long*)(SD + trow * 128 + (((4 * sb + g) ^ (trow & 7)) << 4) + hh * 8) = w;
            }
            dsum += __shfl_xor(dsum, 32);
            if (hh == 0) densum[sb * 64 + trow] = dsum;
        } else if (wv == 4) {
            float a = 0.f;
#pragma unroll
            for (int ch = 0; ch < 16; ++ch) { const v4u qw = *(const LAS v4u*)(QT + lane * 256 + ((ch ^ (lane & 15)) << 4)); const LAS float* np = npv + 8 * ch;
                a += np[0] * bflo(qw.x) + np[1] * bfhi(qw.x) + np[2] * bflo(qw.y) + np[3] * bfhi(qw.y) + np[4] * bflo(qw.z) + np[5] * bfhi(qw.z) + np[6] * bflo(qw.w) + np[7] * bfhi(qw.w); }
            nq[lane] = a;
        }
        __syncthreads();
        f32x16 hv[2];
        {   f32x16 accA[2], accB[2];
#pragma unroll
            for (int tb = 0; tb < 2; ++tb)
#pragma unroll
                for (int i = 0; i < 16; ++i) { accA[tb][i] = 0.f; accB[tb][i] = 0.f; }
#pragma unroll
            for (int ks = 0; ks < 4; ++ks) {
                const bf16x8 af = trpair(VT + (16 * ks + 8 * hh + q4) * 512 + (32 * wv + 16 * g1 + 4 * p4) * 2, 4 * 512);
#pragma unroll
                for (int tb = 0; tb < 2; ++tb) { const int trow = 32 * tb + r;
                    const bf16x8 sf = *(const LAS bf16x8*)(SD + trow * 128 + (((2 * ks + hh) ^ (trow & 7)) << 4));
                    accA[tb] = ML_MFMA(af, sf, accA[tb]); }
            }
#pragma unroll
            for (int ks = 0; ks < 8; ++ks)
#pragma unroll
                for (int tb = 0; tb < 2; ++tb) { const int trow = 32 * tb + r;
                    const bf16x8 qf = *(const LAS bf16x8*)(QT + trow * 256 + (((2 * ks + hh) ^ (trow & 15)) << 4));
                    accB[tb] = ML_MFMA(cf[ks], qf, accB[tb]); }
#pragma unroll
            for (int tb = 0; tb < 2; ++tb) { const int trow = 32 * tb + r;
                const float it = inter[trow], den = densum[trow] + densum[64 + trow] + it * nq[trow], rinv = 1.f / fmaxf(fabsf(den), emt[trow]);
                float q = 0.f;
#pragma unroll
                for (int i = 0; i < 16; ++i) { const float x = (accA[tb][i] + it * accB[tb][i]) * rinv; hv[tb][i] = x; q += x * x; }
                q += __shfl_xor(q, 32);
                if (hh == 0) ssq[wv * 64 + trow] = q; }
        }
        __syncthreads();
#pragma unroll
        for (int tb = 0; tb < 2; ++tb)
#pragma unroll
            for (int g = 0; g < 4; ++g) *(LAS f32x4*)(HT + (32 * tb + r) * 1040 + (32 * wv + 8 * g + 4 * hh) * 4) = (f32x4){hv[tb][4 * g], hv[tb][4 * g + 1], hv[tb][4 * g + 2], hv[tb][4 * g + 3]};
        __syncthreads();
        { const int t = tid >> 3, c8 = tid & 7; float sq = 0.f;
#pragma unroll
          for (int w = 0; w < 8; ++w) sq += ssq[w * 64 + t];
          const float rs = rsqrtf(sq * (1.f / 256.f) + EPS);
          bf16* orow = PROJ + (row0 + t) * 3072 + 1024 + h * 256 + c8 * 32;
#pragma unroll
          for (int q = 0; q < 4; ++q) {
              const f32x4 h0 = *(const LAS f32x4*)(HT + t * 1040 + (32 * c8 + 8 * q) * 4), h1 = *(const LAS f32x4*)(HT + t * 1040 + (32 * c8 + 8 * q + 4) * 4);
              const v4u og = *(const GAS v4u*)(orow + 1024 + 8 * q);
              const f32x4 g0 = *(const GAS f32x4*)(hgain + h * 256 + c8 * 32 + 8 * q), g1v = *(const GAS f32x4*)(hgain + h * 256 + c8 * 32 + 8 * q + 4);
              float y[8];
              y[0] = h0[0] * rs * g0[0] / (1.f + __expf(-bflo(og.x))); y[1] = h0[1] * rs * g0[1] / (1.f + __expf(-bfhi(og.x)));
              y[2] = h0[2] * rs * g0[2] / (1.f + __expf(-bflo(og.y))); y[3] = h0[3] * rs * g0[3] / (1.f + __expf(-bfhi(og.y)));
              y[4] = h1[0] * rs * g1v[0] / (1.f + __expf(-bflo(og.z))); y[5] = h1[1] * rs * g1v[1] / (1.f + __expf(-bfhi(og.z)));
              y[6] = h1[2] * rs * g1v[2] / (1.f + __expf(-bflo(og.w))); y[7] = h1[3] * rs * g1v[3] / (1.f + __expf(-bfhi(og.w)));
              v4u o; o.x = pk2(y[0], y[1]); o.y = pk2(y[2], y[3]); o.z = pk2(y[4], y[5]); o.w = pk2(y[6], y[7]);
              *(GAS v4u*)(orow + 8 * q) = o; } }
        __syncthreads();
    }
}
#undef ML_MFMA
}

template <int MR, int N, int K, bool ALIGN, class Epi> __device__ __forceinline__ void run_gemm(Frame& F, const bf16* A, int lda, const bf16* Bt, int ldb, int pmb, size_t b_batch, const Epi E) {
    int gd = gridDim.x, bi = blockIdx.x; asm volatile("" : "+s"(gd), "+s"(bi));
    pg8::Gemm g{A, Bt, MR, N, K, lda, ldb}; pg8::StaticOrder S; S.init(MR, N, gd, bi, lda, ldb, pmb, b_batch);
    pg8::gemm_phase<Epi, pg8::StaticOrder, ALIGN, true>(F.lds + RING_OFF, g, S, E);
}
__device__ __forceinline__ void xw_gemms(Frame& F, const bf16* KVl, const bf16* WQN, const bf16* WOT, bf16* XWTp) {
    int gd = gridDim.x, bi = blockIdx.x; asm volatile("" : "+s"(gd), "+s"(bi));
    for (int L = bi; L < 256; L += gd) {
        const int idx = L & 127, b = idx >> 4, h = (idx >> 2) & 3, t = idx & 3;
        OneUnit S; int kk = 256; asm volatile("" : "+s"(kk));
        if (L < 128) {
            pg8::Gemm g{KVl + (size_t)(b * NMEM) * 8192 + h * 256, WQN + (size_t)(t * 256) * D + h * 256, 256, 256, kk, 8192, D};
            EpiStore E{XWTp + (size_t)b * D * D + (size_t)(h * 256) * D + t * 256, D, 0, 1.f};
            pg8::gemm_phase<EpiStore, OneUnit, true, true>(F.lds + RING_OFF, g, S, E);
        } else {
            pg8::Gemm g{WOT + (size_t)(t * 256) * D + h * 256, KVl + (size_t)(b * NMEM) * 8192 + 1024 + h * 256, 256, 256, kk, D, 8192};
            EpiStore E{XWTp + (size_t)(8 + b) * D * D + (size_t)(t * 256) * D + h * 256, D, 0, 1.f};
            pg8::gemm_phase<EpiStore, OneUnit, true, true>(F.lds + RING_OFF, g, S, E);
        }
    }
}
struct Args { const float* in[15]; float* out; unsigned char* ws; int pad[2]; };
__global__ void __launch_bounds__(NWAVES * 64, 2) mega_fwd(Args args) {
    extern __shared__ __attribute__((aligned(16))) unsigned char lds[];
    Frame F;
    F.lds = (LAS unsigned char*)lds; F.ws = args.ws;
    relane(F);
    for (int u = F.tid; u < (LDS_BYTES - LDSCTL_OFF) / 4; u += NWAVES * 64) ((LAS unsigned*)(F.lds + LDSCTL_OFF))[u] = 0u;
    __syncthreads();
    if (F.tid < 16) { const unsigned long long p = (F.tid < 15) ? (unsigned long long)args.in[F.tid < 15 ? F.tid : 0] : (unsigned long long)args.out;
        ((LAS unsigned*)(F.lds + LDSCTL_OFF))[2 * F.tid] = (unsigned)p; ((LAS unsigned*)(F.lds + LDSCTL_OFF))[2 * F.tid + 1] = (unsigned)(p >> 32); }
    __syncthreads();
    gu32* ctl = (gu32*)(F.ws + WS_CTL);
    XcdBarrier bar = xcd_barrier_post((unsigned*)(ctl + CW_BAR), (volatile LAS unsigned*)(F.lds + MISC_OFF) + 8);
#define GRID_BAR() xcd_barrier(bar)
#ifndef PROBE_CAT
#define PROBE_CAT 0
#endif
#define TPROBE ((volatile LAS unsigned long long*)(F.lds + MISC_OFF + 64))
#define GBAR(cat) do { xcd_barrier(bar); if (PROBE_CAT != 0 && blockIdx.x == 0 && threadIdx.x == 0) { const unsigned long long now_ = rt(); if ((cat) == PROBE_CAT) TPROBE[1] += now_ - TPROBE[0]; TPROBE[0] = now_; } } while (0)

#define Wb ((bf16*)(F.ws + WS_W))
#define XWT ((bf16*)(F.ws + WS_XWT))
#define XB ((bf16*)(F.ws + WS_X))
#define SSQ ((float*)(F.ws + WS_SSQ))
#define MIX ((bf16*)(F.ws + WS_MIX))
#define BIG ((bf16*)(F.ws + WS_BIG))
#define PB (BIG + (size_t)M * D)
#define KV ((bf16*)(F.ws + WS_KV))
#define MEMN ((bf16*)(F.ws + WS_MEMN))
#define GT ((float*)(F.ws + WS_GATES))
#define NSTP ((float*)(F.ws + WS_NST))
#define SCALP ((float*)(F.ws + WS_SCAL))
#define MPREVP ((float*)(F.ws + WS_MPREV))
#define gains inp(F, 3)
#define XOUT ((float*)inp(F, 15))

    if (PROBE_CAT != 0 && blockIdx.x == 0 && threadIdx.x == 0) { TPROBE[0] = rt(); TPROBE[1] = 0ull; }
    p0_convert(F);
    row_phase(F, inp(F, 0), XB, nullptr, nullptr, SSQ, nullptr, gains, inp(F, 4) + 3072, ML_W, inp(F, 5), GT);
    GBAR(4);
    run_gemm<MM, 8192, D, true>(F, MEMN, D, XWT, D, 0, 0, EpiStore{KV, 8192, 0, 1.f, nullptr});

#pragma unroll 1
    for (int l = 0; l < DEPTH; ++l) {
#define WL (Wb + (size_t)l * WL_SIZE)
#define GL (gains + (size_t)l * 6 * D)
        const bool ml = (l & 1) == 0;
        run_gemm<M, 3072, D, true>(F, XB, D, WL + WL_IN, D, 0, 0, EpiStore{BIG, 3072, ml ? 0 : 4, sbk::C2, SSQ}); GBAR(5);
        if (ml) {
            mlk::phaseA(F, BIG, GT, XWT, NSTP, SCALP); GBAR(2);
            mlk::phaseB(F, XWT, NSTP, SCALP, MPREVP); GBAR(2);
            mlk::phaseC(F, BIG, GT, XWT, NSTP, MPREVP, inp(F, 6) + (size_t)(l >> 1) * D); GBAR(2);
            run_gemm<M, D, D, true>(F, BIG + 1024, 3072, WL + WL_OUT, D, 0, 0, EpiStore{MIX, D, 0, 1.f, nullptr});
        } else {
            sb_attn_v2(F, BIG, MIX); GBAR(3);
            run_gemm<M, D, D, true>(F, MIX, D, WL + WL_OUT, D, 0, 0, EpiStore{BIG, D, 0, 1.f, nullptr});
        }
        xw_gemms(F, KV + (size_t)l * 2048, WL + WL_QN, WL + WL_OT, XWT); GBAR(6);
        row_phase(F, nullptr, XB, ml ? MIX : BIG, GL + D, SSQ, nullptr, nullptr, nullptr, 0, nullptr, nullptr); GBAR(1);
        run_gemm<M, D, D, false>(F, XB, D, XWT, D, 8, (size_t)D * D * 2, EpiSoftmax{PB, D, SSQ}); GBAR(7);
        run_gemm<M, D, D, true>(F, PB, D, XWT + (size_t)8 * D * D, D, 8, (size_t)D * D * 2, EpiStore{BIG, D, 0, 1.f, nullptr}); GBAR(7);
        row_phase(F, nullptr, XB, BIG, GL + 3 * D, SSQ, nullptr, nullptr, nullptr, 0, nullptr, nullptr); GBAR(1);
        run_gemm<M, 2 * DFF, D, true>(F, XB, D, WL + WL_GU, D, 0, 0, EpiSwiglu{BIG, DFF, SSQ}); GBAR(8);
        run_gemm<M, D, DFF, true>(F, BIG, DFF, WL + WL_DN, DFF, 0, 0, EpiStore{MIX, D, 0, 1.f, nullptr}); GBAR(8);
        { const bool last = (l + 1 == DEPTH), gates = !last && (((l + 1) & 1) == 0);
          row_phase(F, nullptr, XB, MIX, GL + 5 * D, SSQ, last ? XOUT : nullptr, GL + 6 * D,
                    gates ? inp(F, 4) + (size_t)((l + 1) >> 1) * D * ML_W + 3072 : nullptr, ML_W, inp(F, 5) + ((l + 1) >> 1) * 8, GT);
          if (!last) GBAR(1); }
    }
    if (PROBE_CAT != 0 && blockIdx.x == 0 && threadIdx.x == 0) {
        unsigned long long now_ = rt(); if (PROBE_CAT == 1) TPROBE[1] += now_ - TPROBE[0];
        const unsigned long long until = now_ + 20ull * TPROBE[1];
        while (rt() < until) __builtin_amdgcn_s_sleep(32);
    }
}

extern "C" void kernel_launch(void* const* d_in, const int* in_sizes, int n_in, void* d_out, int out_size, void* d_ws, size_t ws_size, hipStream_t stream) {
    static int grid = 0;
    if (grid == 0) {
        if (n_in != 15 || out_size != M * D || ws_size < WS_END) { fprintf(stderr, "kernel_launch: unexpected shapes (n_in %d out %d ws %zu need %zu)\n", n_in, out_size, ws_size, (size_t)WS_END); grid = -1; return; }
        int dev = 0, cus = 0, per_cu = 0;
        if (hipGetDevice(&dev) != hipSuccess || hipDeviceGetAttribute(&cus, hipDeviceAttributeMultiprocessorCount, dev) != hipSuccess) { grid = -1; return; }
        if (hipFuncSetAttribute((const void*)mega_fwd, hipFuncAttributeMaxDynamicSharedMemorySize, LDS_BYTES) != hipSuccess) { fprintf(stderr, "kernel_launch: hipFuncSetAttribute failed\n"); grid = -1; return; }
        if (hipOccupancyMaxActiveBlocksPerMultiprocessor(&per_cu, (const void*)mega_fwd, NWAVES * 64, LDS_BYTES) != hipSuccess || per_cu < 1) fprintf(stderr, "kernel_launch: occupancy query reports %d\n", per_cu);
        (void)hipGetLastError();
        grid = cus;
    }
    if (grid < 0) return;
    if (hipMemsetAsync((char*)d_ws + WS_CTL, 0, CTL_ZERO_BYTES, stream) != hipSuccess) return;
    Args a{};
    for (int i = 0; i < 15; ++i) a.in[i] = (const float*)d_in[i];
    a.out = (float*)d_out; a.ws = (unsigned char*)d_ws;
    hipLaunchKernelGGL(mega_fwd, dim3(grid), dim3(NWAVES * 64), LDS_BYTES, stream, a);
}
```
